# Optimizing an MI355X kernel written in HIP

```python
import jax, jax.numpy as jnp
from jax import lax
import numpy as np

D_MODEL = 1024
BATCH = 32
SEQ = 2048
DEPTH = 4

CHUNK = 64
N_MIXERS = 3
N_A = len(range(0, DEPTH, N_MIXERS))
N_B = len(range(1, DEPTH, N_MIXERS))
N_C = len(range(2, DEPTH, N_MIXERS))
ALPHA = (2 * DEPTH) ** 0.25
BETA = (8 * DEPTH) ** -0.25

A_HEADS = 16
A_HEAD_DIM = 64
A_Q_RANK = 256
A_KV_RANK = 128
IDX_HEADS = 8
IDX_DIM = 64
IDX_TOPK_MAX = 256
Q_BLOCK = 128
RNN_WIDTH = 1280
RNN_BLOCKS = 16
RNN_BLOCK_DIM = RNN_WIDTH // RNN_BLOCKS
CONV_WIDTH = 4
LRU_C = 8.0
RET_HEADS = 4
RET_KEY_DIM = 256
RET_VAL_DIM = 512
N_KEYS = 128
N_EXPERTS = N_KEYS * N_KEYS
PEER_HEADS = 8
PEER_KEY_DIM = 256
PEER_TOPK = 16
TOKEN_BLOCK = 128
PLE_DIM = 256

kernel_name = "hybrid_dsa_rglru_retention_peer_encoder"

F32 = jnp.float32


def layer_norm(x, g, b, eps=1e-5):
    xf = x.astype(F32)
    mu = xf.mean(-1, keepdims=True)
    var = jnp.square(xf - mu).mean(-1, keepdims=True)
    return ((xf - mu) * lax.rsqrt(var + eps) * g + b).astype(x.dtype)


def rms_norm(x, g, eps=1e-6):
    xf = x.astype(F32)
    return (xf * lax.rsqrt(jnp.square(xf).mean(-1, keepdims=True) + eps) * g).astype(x.dtype)


def dsa_mixer(x, w_in, cq_gain, ckv_gain, w_uq, w_uk, w_qidx, kidx_gain, kidx_bias, w_uv, w_o):
    B, S, _ = x.shape
    split = [A_Q_RANK, A_Q_RANK + A_KV_RANK, A_Q_RANK + A_KV_RANK + IDX_DIM]
    c_q, c_kv, k_idx, w_idx = jnp.split(x @ w_in, split, axis=-1)
    c_q = rms_norm(c_q, cq_gain)
    c_kv = rms_norm(c_kv, ckv_gain)
    k_idx = layer_norm(k_idx, kidx_gain, kidx_bias)
    q_nope = (c_q @ w_uq).reshape(B, S, A_HEADS, A_HEAD_DIM)
    q_lat = jnp.einsum('bshd,hdc->bshc', q_nope, w_uk)
    q_idx = (c_q @ w_qidx).reshape(B, S, IDX_HEADS, IDX_DIM)
    w_idx = w_idx * IDX_HEADS ** -0.5
    topk = min(IDX_TOPK_MAX, S // 4)
    n_blk = S // Q_BLOCK
    key_chunk = jnp.arange(S) // CHUNK

    def to_blocks(t):
        return jnp.moveaxis(t.reshape(B, n_blk, Q_BLOCK, *t.shape[2:]), 1, 0)

    def block_fn(args):
        qb, qib, wb, start = args
        q_chunk = (start + jnp.arange(Q_BLOCK)) // CHUNK
        admissible = key_chunk[None, :] <= q_chunk[:, None]
        rel = jax.nn.relu(jnp.einsum('bthd,bsd->bths', qib.astype(F32), k_idx.astype(F32))) * IDX_DIM ** -0.5
        score = jnp.einsum('bths,bth->bts', rel, wb.astype(F32))
        score = jnp.where(admissible[None], score, -jnp.inf)
        top_val, top_idx = lax.top_k(score, topk)
        valid = jnp.isfinite(top_val)
        kv_sel = jax.vmap(lambda c, i: c[i])(c_kv, top_idx)
        logits = jnp.einsum('bthc,btkc->bthk', qb, kv_sel).astype(F32) * A_HEAD_DIM ** -0.5
        logits = jnp.where(valid[:, :, None, :], logits, -jnp.inf)
        probs = jax.nn.softmax(logits, axis=-1).astype(x.dtype)
        return jnp.einsum('bthk,btkc->bthc', probs, kv_sel)

    starts = jnp.arange(n_blk) * Q_BLOCK
    o_lat = lax.map(block_fn, (to_blocks(q_lat), to_blocks(q_idx), to_blocks(w_idx), starts))
    o_lat = jnp.moveaxis(o_lat, 0, 1).reshape(B, S, A_HEADS, A_KV_RANK)
    o = jnp.einsum('bshc,hcd->bshd', o_lat, w_uv).reshape(B, S, A_HEADS * A_HEAD_DIM)
    return o @ w_o


def rglru_mixer(x, w_in, conv_w, conv_b, w_a, b_a, w_x, b_x, lam, w_o):
    B, S, _ = x.shape
    gate, u = jnp.split(x @ w_in, 2, axis=-1)
    u_pad = jnp.pad(u, ((0, 0), (CONV_WIDTH - 1, 0), (0, 0)))
    conv = conv_b
    for j in range(CONV_WIDTH):
        conv = conv + u_pad[:, j:j + S] * conv_w[j]
    ub = conv.reshape(B, S, RNN_BLOCKS, RNN_BLOCK_DIM)
    r = jax.nn.sigmoid(jnp.einsum('bsnc,ncd->bsnd', ub, w_a).reshape(B, S, RNN_WIDTH) + b_a)
    i = jax.nn.sigmoid(jnp.einsum('bsnc,ncd->bsnd', ub, w_x).reshape(B, S, RNN_WIDTH) + b_x)
    log_a = -LRU_C * r.astype(F32) * jax.nn.softplus(-lam.astype(F32))
    a = jnp.exp(log_a)
    b_in = jnp.sqrt(-jnp.expm1(2.0 * log_a)) * (i * conv).astype(F32)

    def combine(left, right):
        a1, b1 = left
        a2, b2 = right
        return a1 * a2, a2 * b1 + b2

    _, h = lax.associative_scan(combine, (a, b_in), axis=1)
    y = jax.nn.gelu(gate) * h.astype(x.dtype)
    return y @ w_o


def rotate_half(t, cos, sin):
    t1, t2 = jnp.split(t.astype(F32), 2, axis=-1)
    return jnp.concatenate([t1 * cos - t2 * sin, t1 * sin + t2 * cos], axis=-1)


def retention_mixer(x, w_in, w_o):
    B, S, _ = x.shape
    H, dk, dv = RET_HEADS, RET_KEY_DIM, RET_VAL_DIM
    q, k, v, g = jnp.split(x @ w_in, [H * dk, 2 * H * dk, 2 * H * dk + H * dv], axis=-1)
    q = q.reshape(B, S, H, dk)
    k = k.reshape(B, S, H, dk) * dk ** -0.5
    v = v.reshape(B, S, H, dv)
    pos = jnp.arange(S, dtype=F32)
    inv_freq = 1.0 / (10000.0 ** jnp.linspace(0.0, 1.0, dk // 2, dtype=F32))
    ang = pos[:, None] * inv_freq[None, :]
    cos = jnp.cos(ang)[None, :, None, :]
    sin = jnp.sin(ang)[None, :, None, :]
    q = rotate_half(q, cos, sin).astype(x.dtype)
    k = rotate_half(k, cos, sin).astype(x.dtype)
    log_gamma = jnp.log(1.0 - 2.0 ** (-5.0 - jnp.arange(H, dtype=F32)))
    idx = jnp.arange(CHUNK, dtype=F32)
    diff = idx[:, None] - idx[None, :]
    decay_mask = jnp.where(diff[None] >= 0, jnp.exp(log_gamma[:, None, None] * jnp.maximum(diff, 0.0)[None]), 0.0)
    cross_decay = jnp.exp(log_gamma[None, :] * (idx[:, None] + 1.0))
    state_decay = jnp.exp(log_gamma[None, :] * (CHUNK - 1.0 - idx[:, None]))
    chunk_decay = jnp.exp(log_gamma * CHUNK)
    n_chunks = S // CHUNK

    def to_chunks(t):
        return jnp.moveaxis(t.reshape(B, n_chunks, CHUNK, H, t.shape[-1]), 1, 0)

    def step(R, inp):
        qc, kc, vc = inp
        inner = jnp.einsum('bihd,bjhd->bhij', qc, kc) * decay_mask[None]
        o = jnp.einsum('bhij,bjhe->bihe', inner, vc) \
            + jnp.einsum('bihd,bhde->bihe', qc, R) * cross_decay[None, :, :, None]
        R = R * chunk_decay[None, :, None, None] \
            + jnp.einsum('bjhd,bjhe->bhde', kc * state_decay[None, :, :, None], vc)
        return R, o

    R0 = jnp.zeros((B, H, dk, dv), F32)
    _, o = lax.scan(step, R0, (to_chunks(q), to_chunks(k), to_chunks(v)))
    o = jnp.moveaxis(o, 0, 1).reshape(B, S, H, dv).astype(F32)
    mu = o.mean(-1, keepdims=True)
    var = jnp.square(o - mu).mean(-1, keepdims=True)
    o = ((o - mu) * lax.rsqrt(var + 1e-5)).reshape(B, S, H * dv).astype(x.dtype)
    return (jax.nn.silu(g) * o) @ w_o


def peer_ffn(x, w_q, sub_keys, u_tab, v_tab):
    B, S, D = x.shape
    T = B * S
    xt = x.reshape(T, D)
    q = (xt @ w_q).reshape(T, PEER_HEADS, 2, PEER_KEY_DIM // 2)
    s = jnp.einsum('thpd,hpnd->thpn', q, sub_keys).astype(F32)
    half_val, half_idx = lax.top_k(s, PEER_TOPK)
    cand = half_val[:, :, 0, :, None] + half_val[:, :, 1, None, :]
    cand_id = half_idx[:, :, 0, :, None] * N_KEYS + half_idx[:, :, 1, None, :]
    top_s, pos = lax.top_k(cand.reshape(T, PEER_HEADS, -1), PEER_TOPK)
    expert_id = jnp.take_along_axis(cand_id.reshape(T, PEER_HEADS, -1), pos, axis=-1)
    gates = jax.nn.softmax(top_s, axis=-1).astype(x.dtype)
    n_sel = PEER_HEADS * PEER_TOPK
    n_blk = T // TOKEN_BLOCK

    def block_fn(args):
        xb, ids, gb = args
        act = jax.nn.gelu(jnp.einsum('tkd,td->tk', u_tab[ids], xb))
        return jnp.einsum('tk,tkd->td', act * gb, v_tab[ids])

    y = lax.map(block_fn, (xt.reshape(n_blk, TOKEN_BLOCK, D),
                           expert_id.reshape(n_blk, TOKEN_BLOCK, n_sel),
                           gates.reshape(n_blk, TOKEN_BLOCK, n_sel)))
    return y.reshape(B, S, D)


def setup_inputs(seed: int = 0) -> dict:
    key = jax.random.key(seed)
    ks = iter(jax.random.split(key, 40))
    D = D_MODEL

    def nrm(shape, scale):
        return jax.random.normal(next(ks), shape, F32) * scale

    def gain(shape):
        return 1.0 + 0.02 * jax.random.normal(next(ks), shape, F32)

    lam_u = jax.random.uniform(next(ks), (N_B, RNN_WIDTH), F32, 0.9, 0.999)
    lam_s = lam_u ** (1.0 / LRU_C)
    return {
        'x': nrm((BATCH, SEQ, D), 1.0),
        'p': nrm((DEPTH, BATCH, SEQ, PLE_DIM), 1.0),
        'a_w_in': nrm((N_A, D, A_Q_RANK + A_KV_RANK + IDX_DIM + IDX_HEADS), D ** -0.5),
        'a_cq_gain': gain((N_A, A_Q_RANK)),
        'a_ckv_gain': gain((N_A, A_KV_RANK)),
        'a_w_uq': nrm((N_A, A_Q_RANK, A_HEADS * A_HEAD_DIM), A_Q_RANK ** -0.5),
        'a_w_uk': nrm((N_A, A_HEADS, A_HEAD_DIM, A_KV_RANK), A_HEAD_DIM ** -0.5),
        'a_w_qidx': nrm((N_A, A_Q_RANK, IDX_HEADS * IDX_DIM), A_Q_RANK ** -0.5),
        'a_kidx_gain': gain((N_A, IDX_DIM)),
        'a_kidx_bias': nrm((N_A, IDX_DIM), 0.02),
        'a_w_uv': nrm((N_A, A_HEADS, A_KV_RANK, A_HEAD_DIM), A_KV_RANK ** -0.5),
        'a_w_o': nrm((N_A, A_HEADS * A_HEAD_DIM, D), BETA * (A_HEADS * A_HEAD_DIM) ** -0.5),
        'b_w_in': nrm((N_B, D, 2 * RNN_WIDTH), D ** -0.5),
        'b_conv_w': nrm((N_B, CONV_WIDTH, RNN_WIDTH), CONV_WIDTH ** -0.5),
        'b_conv_b': nrm((N_B, RNN_WIDTH), 0.01),
        'b_w_a': nrm((N_B, RNN_BLOCKS, RNN_BLOCK_DIM, RNN_BLOCK_DIM), RNN_BLOCK_DIM ** -0.5),
        'b_b_a': nrm((N_B, RNN_WIDTH), 0.01),
        'b_w_x': nrm((N_B, RNN_BLOCKS, RNN_BLOCK_DIM, RNN_BLOCK_DIM), RNN_BLOCK_DIM ** -0.5),
        'b_b_x': nrm((N_B, RNN_WIDTH), 0.01),
        'b_lambda': jnp.log(lam_s) - jnp.log1p(-lam_s),
        'b_w_o': nrm((N_B, RNN_WIDTH, D), BETA * RNN_WIDTH ** -0.5),
        'c_w_in': nrm((N_C, D, 2 * RET_HEADS * RET_KEY_DIM + 2 * RET_HEADS * RET_VAL_DIM), D ** -0.5),
        'c_w_o': nrm((N_C, RET_HEADS * RET_VAL_DIM, D), BETA * (RET_HEADS * RET_VAL_DIM) ** -0.5),
        'ln1_gain': gain((DEPTH, D)),
        'ln1_bias': nrm((DEPTH, D), 0.02),
        'peer_w_q': nrm((DEPTH, D, PEER_HEADS * PEER_KEY_DIM), D ** -0.5),
        'peer_sub_keys': nrm((DEPTH, PEER_HEADS, 2, N_KEYS, PEER_KEY_DIM // 2), (PEER_KEY_DIM // 2) ** -0.5),
        'peer_u': nrm((DEPTH, N_EXPERTS, D), D ** -0.5),
        'peer_v': nrm((DEPTH, N_EXPERTS, D), BETA * PEER_HEADS ** -0.5),
        'ln2_gain': gain((DEPTH, D)),
        'ln2_bias': nrm((DEPTH, D), 0.02),
        'ple_w_proj': nrm((DEPTH, PLE_DIM, D), PLE_DIM ** -0.5),
        'ple_w_gate': nrm((DEPTH, D, D), D ** -0.5),
        'ple_b_gate': nrm((DEPTH, D), 0.01),
    }


def reference(x, p, a_w_in, a_cq_gain, a_ckv_gain, a_w_uq, a_w_uk, a_w_qidx, a_kidx_gain, a_kidx_bias,
              a_w_uv, a_w_o, b_w_in, b_conv_w, b_conv_b, b_w_a, b_b_a, b_w_x, b_b_x, b_lambda, b_w_o,
              c_w_in, c_w_o, ln1_gain, ln1_bias, peer_w_q, peer_sub_keys, peer_u, peer_v,
              ln2_gain, ln2_bias, ple_w_proj, ple_w_gate, ple_b_gate):
    for i in range(DEPTH):
        kind = i % N_MIXERS
        j = i // N_MIXERS
        if kind == 0:
            h = dsa_mixer(x, a_w_in[j], a_cq_gain[j], a_ckv_gain[j], a_w_uq[j], a_w_uk[j], a_w_qidx[j],
                          a_kidx_gain[j], a_kidx_bias[j], a_w_uv[j], a_w_o[j])
        elif kind == 1:
            h = rglru_mixer(x, b_w_in[j], b_conv_w[j], b_conv_b[j], b_w_a[j], b_b_a[j], b_w_x[j], b_b_x[j],
                            b_lambda[j], b_w_o[j])
        else:
            h = retention_mixer(x, c_w_in[j], c_w_o[j])
        x = layer_norm(ALPHA * x + h, ln1_gain[i], ln1_bias[i])
        f = peer_ffn(x, peer_w_q[i], peer_sub_keys[i], peer_u[i], peer_v[i])
        x = layer_norm(ALPHA * x + f, ln2_gain[i], ln2_bias[i])
        gate = jax.nn.sigmoid(x @ ple_w_gate[i] + ple_b_gate[i])
        x = x + gate * (p[i] @ ple_w_proj[i])
    return x
```

```cpp
#define MK_CHECK 0
#define MK_ONE_LAUNCH 0
#include <cstdio>
#include <cmath>
#include <hip/hip_runtime.h>
namespace pg8 {
#define PG8_LAS __attribute__((address_space(3)))
typedef unsigned short bf16_t;
typedef short bf16x8 __attribute__((ext_vector_type(8)));
typedef float f32x4 __attribute__((ext_vector_type(4)));
typedef unsigned u32x4 __attribute__((ext_vector_type(4)));
constexpr int BM = 256, BK = 64, HALF = 128, HTB = HALF * BK * 2  , STAGE_BYTES = 8 * HTB, NXCD = 8, WGM = 8;

__host__ __device__ __forceinline__ int lds_byte(int r, int c) { const int st = (r >> 4) * 2 + (c >> 5), rr = r & 15, cc = c & 31, ob = rr * 64 + cc * 2; return st * 1024 + (ob ^ (((ob >> 9) & 1) << 5)); }
__host__ __device__ __forceinline__ void stage_rc(int b, int& R, int& C) { const int st = b / 1024, sb = b % 1024, swz = sb ^ (((sb >> 9) & 1) << 5); R = (st >> 1) * 16 + swz / 64; C = (st & 1) * 32 + (swz % 64) / 2; }
__host__ __device__ __forceinline__ int perm32(int rho) { const int n = rho >> 4, i = rho & 15; return 8 * (i >> 2) + 4 * n + (i & 3); }

struct Unit { int pm, pn; };
struct Gemm { const bf16_t* A; const bf16_t* Bt; int M, N, K; };

struct StaticOrder {
    int nM, nN, nwg, G, c;
    __host__ __device__ void init(int M, int N, int G_, int c_) { nM = M / BM; nN = N / BM; nwg = nM * nN; G = G_; c = c_; }
    __host__ __device__ bool next(int i, Unit& u) const {
        const long L = (long)i * G + c; if (L >= nwg) return false;
        int wgid = (int)L; { const int q = nwg / NXCD, r = nwg % NXCD, xcd = wgid % NXCD, off = wgid / NXCD; wgid = (xcd < r ? xcd * (q + 1) : r * (q + 1) + (xcd - r) * q) + off; }
        const int nig = WGM * nN, gid = wgid / nig, fm = gid * WGM, gsz = (nM - fm) < WGM ? (nM - fm) : WGM;
        u.pm = fm + ((wgid % nig) % gsz); u.pn = (wgid % nig) / gsz; return true;
    }
    __device__ __forceinline__ void a_ready(const Unit&) const {}
    __device__ __forceinline__ void done(const Unit&) const {}
};
struct CountedOrder : StaticOrder {
    const unsigned* ready; unsigned need; unsigned* tmo;
    __device__ __forceinline__ void a_ready(const Unit& u) const {
        if (threadIdx.x < 64) {
            const unsigned long long t0 = __builtin_amdgcn_s_memrealtime(); unsigned polls = 0;
            while ((unsigned)__builtin_amdgcn_readfirstlane(__hip_atomic_load(ready + 64 * u.pm, __ATOMIC_RELAXED, __HIP_MEMORY_SCOPE_AGENT)) < need) {
                if ((++polls & 255u) == 0u && __builtin_amdgcn_readfirstlane(__hip_atomic_load(tmo, __ATOMIC_RELAXED, __HIP_MEMORY_SCOPE_AGENT)) != 0u) break;
                if (__builtin_amdgcn_s_memrealtime() - t0 > 2000000ull) {
                    if (threadIdx.x == 0) { unsigned expect = 0u; __hip_atomic_compare_exchange_strong(tmo + 1, &expect, 0x600u | (unsigned)(u.pm & 0xff), __ATOMIC_RELAXED, __ATOMIC_RELAXED, __HIP_MEMORY_SCOPE_AGENT); __hip_atomic_store(tmo, 1u, __ATOMIC_RELAXED, __HIP_MEMORY_SCOPE_AGENT); }
                    break; }
                __builtin_amdgcn_s_sleep(2); }
            __builtin_amdgcn_fence(__ATOMIC_ACQUIRE, "agent");
            asm volatile("s_waitcnt vmcnt(0)" ::: "memory");
        }
#if !defined(BROKEN_HOOK_NO_BARRIER)
        asm volatile("" ::: "memory"); __builtin_amdgcn_s_barrier(); asm volatile("" ::: "memory");
#endif
    }
};

__device__ __forceinline__ unsigned cvt_pk_bf16(float lo, float hi) { unsigned r; asm volatile("v_cvt_pk_bf16_f32 %0, %1, %2" : "=v"(r) : "v"(lo), "v"(hi)); return r; }
typedef float f32x2 __attribute__((ext_vector_type(2)));
__device__ __forceinline__ f32x2 gelu_pk(f32x2 v) {
    const f32x2 av = __builtin_elementwise_abs(v), d = av * 0.2316418882f + 1.0f;
    f32x2 t; t.x = __builtin_amdgcn_rcpf(d.x); t.y = __builtin_amdgcn_rcpf(d.y);
    f32x2 q = t * 0.5307027145f + (-0.7265760135f); q = q * t + 0.7107068705f; q = q * t + (-0.142248368f); q = q * t + 0.127414796f; q = q * t;
    const f32x2 s = (v * v) * (-0.72134752044f);
    f32x2 e; e.x = __builtin_amdgcn_exp2f(s.x); e.y = __builtin_amdgcn_exp2f(s.y);
    const f32x2 m = v * (q * e), r = v - m;
    f32x2 o; o.x = v.x < 0.f ? m.x : r.x; o.y = v.y < 0.f ? m.y : r.y; return o;
}

struct EpiF32 {
    static constexpr bool PERM = false, AFTER_DRAIN = false;
    float* C; int ldc; const float* bias;
    __device__ __forceinline__ void operator()(const f32x4 (&acc)[2][2][4][2], const Unit& u, int wr, int wc, int fr, int fq) const {
        const int row0 = u.pm * BM + wr * 64 + fr, col0 = u.pn * BM + wc * 32 + 4 * fq;
        f32x4 bv[2][2];
#pragma unroll
        for (int bj = 0; bj < 2; ++bj)
#pragma unroll
            for (int n = 0; n < 2; ++n) bv[bj][n] = bias ? *(const f32x4*)(bias + col0 + bj * HALF + n * 16) : (f32x4){0.f, 0.f, 0.f, 0.f};
#pragma unroll
        for (int ai = 0; ai < 2; ++ai)
#pragma unroll
            for (int m = 0; m < 4; ++m) { float* rowp = C + (size_t)(row0 + ai * HALF + m * 16) * ldc + col0;
#pragma unroll
                for (int bj = 0; bj < 2; ++bj)
#pragma unroll
                    for (int n = 0; n < 2; ++n) *(f32x4*)(rowp + bj * HALF + n * 16) = acc[ai][bj][m][n] + bv[bj][n]; }
    }
};
template <int ACT  > struct EpiBf16 {
    static constexpr bool PERM = true, AFTER_DRAIN = false;
    bf16_t* O; int ldc; const float* bias; int split_cols; size_t split_stride;
    __device__ __forceinline__ void operator()(const f32x4 (&acc)[2][2][4][2], const Unit& u, int wr, int wc, int fr, int fq) const {
        const int row0 = u.pm * BM + wr * 64 + fr; int colt = u.pn * BM; bf16_t* base = O;
        if (split_cols) { const int t = colt / split_cols; base += (size_t)t * split_stride; colt -= t * split_cols; }
        const int col0 = colt + wc * 32 + 8 * fq, bcol0 = u.pn * BM + wc * 32 + 8 * fq;
        f32x4 bv[2][2];
#pragma unroll
        for (int bj = 0; bj < 2; ++bj)
#pragma unroll
            for (int n = 0; n < 2; ++n) bv[bj][n] = bias ? *(const f32x4*)(bias + bcol0 + bj * HALF + 4 * n) : (f32x4){0.f, 0.f, 0.f, 0.f};
#pragma unroll
        for (int ai = 0; ai < 2; ++ai)
#pragma unroll
            for (int m = 0; m < 4; ++m) { bf16_t* rowp = base + (size_t)(row0 + ai * HALF + m * 16) * ldc + col0;
#pragma unroll
                for (int bj = 0; bj < 2; ++bj) { f32x4 v0 = acc[ai][bj][m][0] + bv[bj][0], v1 = acc[ai][bj][m][1] + bv[bj][1];
                    if (ACT == 1) { f32x2 a = gelu_pk((f32x2){v0[0], v0[1]}), b = gelu_pk((f32x2){v0[2], v0[3]}), c = gelu_pk((f32x2){v1[0], v1[1]}), d = gelu_pk((f32x2){v1[2], v1[3]});
                        v0 = (f32x4){a.x, a.y, b.x, b.y}; v1 = (f32x4){c.x, c.y, d.x, d.y}; }
                    if (ACT == 2) {
#pragma unroll
                        for (int j = 0; j < 4; ++j) { v0[j] = 0.5f * v0[j] * (1.0f + erff(v0[j] * 0.70710678f)); v1[j] = 0.5f * v1[j] * (1.0f + erff(v1[j] * 0.70710678f)); } }
                    u32x4 w; w.x = cvt_pk_bf16(v0[0], v0[1]); w.y = cvt_pk_bf16(v0[2], v0[3]); w.z = cvt_pk_bf16(v1[0], v1[1]); w.w = cvt_pk_bf16(v1[2], v1[3]);
                    *(u32x4*)(rowp + bj * HALF) = w; } }
    }
};

struct PanelStats {
    unsigned* xbuf;
    unsigned* cnt;
    unsigned* tmo;
    int ntn; float eps;
    unsigned code;
    __device__ __forceinline__ bool run(const f32x4 (&v)[2][2][4][2], const Unit& u, int wr, int wc, int fr, int fq, PG8_LAS unsigned char* lds, int wid, int lane) const {
        typedef float f32x2v __attribute__((ext_vector_type(2)));
        PG8_LAS f32x2v* P = (PG8_LAS f32x2v*)lds;
        PG8_LAS f32x2v* S = (PG8_LAS f32x2v*)(lds + 8192);
        PG8_LAS unsigned* flag = (PG8_LAS unsigned*)(lds + 8192 + 2048);
#pragma unroll
        for (int ai = 0; ai < 2; ++ai)
#pragma unroll
            for (int m = 0; m < 4; ++m) {
                float s = 0.f;
#pragma unroll
                for (int bj = 0; bj < 2; ++bj)
#pragma unroll
                    for (int n = 0; n < 2; ++n) { const f32x4 x = v[ai][bj][m][n]; s += (x[0] + x[1]) + (x[2] + x[3]); }
                s += __shfl_xor(s, 16); s += __shfl_xor(s, 32);
                const float mw = s * (1.0f / 64.0f); float q = 0.f;
#pragma unroll
                for (int bj = 0; bj < 2; ++bj)
#pragma unroll
                    for (int n = 0; n < 2; ++n) { const f32x4 d = v[ai][bj][m][n] - mw; q += (d[0] * d[0] + d[1] * d[1]) + (d[2] * d[2] + d[3] * d[3]); }
                q += __shfl_xor(q, 16); q += __shfl_xor(q, 32);
                if (fq == 0) P[(ai * HALF + wr * 64 + m * 16 + fr) * 4 + wc] = (f32x2v){mw, q};
            }
        asm volatile("s_waitcnt lgkmcnt(0)" ::: "memory"); __builtin_amdgcn_s_barrier(); asm volatile("" ::: "memory");
#if defined(BROKEN_NO_WAIT)
        if (blockIdx.x >= 64) { const long long t0 = clock64(); while (clock64() - t0 < 60000) __builtin_amdgcn_s_sleep(8); }
#endif
        const int row = wid * 32 + (lane & 31);
        if (lane < 32) {
            const f32x2v a = P[row * 4 + 0], b = P[row * 4 + 1], c = P[row * 4 + 2], d = P[row * 4 + 3];
            const float mt = (a.x + b.x + c.x + d.x) * 0.25f;
            const float da = a.x - mt, db = b.x - mt, dc = c.x - mt, dd = d.x - mt;
            const float m2 = (a.y + b.y) + (c.y + d.y) + 64.0f * ((da * da + db * db) + (dc * dc + dd * dd));
            unsigned long long* slot = (unsigned long long*)xbuf + ((size_t)(u.pm * BM + row) * 4 + u.pn);
            __hip_atomic_store(slot, ((unsigned long long)__float_as_uint(m2) << 32) | __float_as_uint(mt), __ATOMIC_RELAXED, __HIP_MEMORY_SCOPE_AGENT);
        }
        asm volatile("s_waitcnt vmcnt(0)" ::: "memory");
        if (lane == 0) __hip_atomic_fetch_add(cnt + 64 * u.pm, 1u, __ATOMIC_RELAXED, __HIP_MEMORY_SCOPE_AGENT);
        if (wid == 0) {
            bool dead = false; const unsigned long long t0 = __builtin_amdgcn_s_memrealtime(); const unsigned want = 8u * (unsigned)ntn;
            for (;;) {
#if defined(BROKEN_NO_WAIT)
                break;
#endif
                if ((unsigned)__builtin_amdgcn_readfirstlane(__hip_atomic_load(cnt + 64 * u.pm, __ATOMIC_RELAXED, __HIP_MEMORY_SCOPE_AGENT)) >= want) break;
                if (__builtin_amdgcn_s_memrealtime() - t0 > 2000000ull) {
                    if (lane == 0) { unsigned expect = 0u; __hip_atomic_compare_exchange_strong(tmo + 1, &expect, code | (unsigned)(u.pm & 0xff), __ATOMIC_RELAXED, __ATOMIC_RELAXED, __HIP_MEMORY_SCOPE_AGENT);
                                     __hip_atomic_store(tmo, 1u, __ATOMIC_RELAXED, __HIP_MEMORY_SCOPE_AGENT); }
                    dead = true; break; }
                __builtin_amdgcn_s_sleep(2);
            }
            __builtin_amdgcn_fence(__ATOMIC_ACQUIRE, "agent");
            if (lane == 0) flag[0] = dead ? 1u : 0u;
        }
        asm volatile("s_waitcnt vmcnt(0) lgkmcnt(0)" ::: "memory"); __builtin_amdgcn_s_barrier(); asm volatile("" ::: "memory");
        const bool bad = flag[0] != 0u;
        if (lane < 32) {
            const unsigned long long* slot = (const unsigned long long*)xbuf + (size_t)(u.pm * BM + row) * 4; float mt[4], m2[4]; float ms = 0.f;
#pragma unroll
            for (int t = 0; t < 4; ++t) { if (t < ntn) { const unsigned long long w = __hip_atomic_load(slot + t, __ATOMIC_RELAXED, __HIP_MEMORY_SCOPE_AGENT); mt[t] = __uint_as_float((unsigned)w); m2[t] = __uint_as_float((unsigned)(w >> 32)); } else { mt[t] = 0.f; m2[t] = 0.f; } ms += mt[t]; }
            const float mean = ms / (float)ntn; float q = 0.f;
#pragma unroll
            for (int t = 0; t < 4; ++t) if (t < ntn) { const float dm = mt[t] - mean; q += m2[t] + 256.0f * dm * dm; }
            S[row] = (f32x2v){mean, 1.0f / sqrtf(q / (256.0f * (float)ntn) + eps)};
        }
        asm volatile("s_waitcnt lgkmcnt(0)" ::: "memory"); __builtin_amdgcn_s_barrier(); asm volatile("" ::: "memory");
        return bad;
    }
};
struct EpiLnRes {
    static constexpr bool PERM = false, AFTER_DRAIN = true;
    const float* base; float* out; int ldc; const float* bias; PanelStats st; unsigned poison;
    __device__ __forceinline__ void refuse(size_t i0, size_t stride, int M, int N) const { const float q = __builtin_nanf(""); for (size_t i = i0; i < (size_t)M * N; i += stride) out[(i / N) * ldc + i % N] = q;
        if (i0 == 0) { unsigned expect = 0u; __hip_atomic_compare_exchange_strong(st.tmo + 1, &expect, 0x7f0u, __ATOMIC_RELAXED, __ATOMIC_RELAXED, __HIP_MEMORY_SCOPE_AGENT); __hip_atomic_store(st.tmo, 1u, __ATOMIC_RELAXED, __HIP_MEMORY_SCOPE_AGENT); } }
    __device__ __forceinline__ void fused(f32x4 (&acc)[2][2][4][2], const Unit& u, int wr, int wc, int fr, int fq, PG8_LAS unsigned char* lds, int wid, int lane) const {
        typedef float f32x2v __attribute__((ext_vector_type(2)));
        const PG8_LAS f32x2v* S = (const PG8_LAS f32x2v*)(lds + 8192);
        const int col0 = u.pn * BM + wc * 32 + 4 * fq;
#pragma unroll
        for (int bj = 0; bj < 2; ++bj)
#pragma unroll
            for (int n = 0; n < 2; ++n) { const f32x4 bv = bias ? *(const f32x4*)(bias + col0 + bj * HALF + n * 16) : (f32x4){0.f, 0.f, 0.f, 0.f};
#pragma unroll
                for (int ai = 0; ai < 2; ++ai)
#pragma unroll
                    for (int m = 0; m < 4; ++m) acc[ai][bj][m][n] += bv; }
        const bool bad = st.run(acc, u, wr, wc, fr, fq, lds, wid, lane) || poison != 0u;
        const float qnan = __builtin_nanf("");
#pragma unroll
        for (int ai = 0; ai < 2; ++ai)
#pragma unroll
            for (int m = 0; m < 4; ++m) { const int r = ai * HALF + wr * 64 + m * 16 + fr; const f32x2v sr = S[r]; const size_t off = (size_t)(u.pm * BM + r) * ldc + col0;
#pragma unroll
                for (int bj = 0; bj < 2; ++bj)
#pragma unroll
                    for (int n = 0; n < 2; ++n) { const f32x4 bs = *(const f32x4*)(base + off + bj * HALF + n * 16); f32x4 o = bs + (acc[ai][bj][m][n] - sr.x) * sr.y;
                        if (bad) o = (f32x4){qnan, qnan, qnan, qnan}; *(f32x4*)(out + off + bj * HALF + n * 16) = o; }
                asm volatile("" ::: "memory"); }
    }
};
struct EpiLnResLn {
    static constexpr bool PERM = false, AFTER_DRAIN = true;
    const float* base; float* out; bf16_t* xn; int ldc; const float* bias; PanelStats st1, st2; unsigned poison;
    __device__ __forceinline__ void refuse(size_t i0, size_t stride, int M, int N) const { const float q = __builtin_nanf(""); for (size_t i = i0; i < (size_t)M * N; i += stride) { const size_t o = (i / N) * ldc + i % N; out[o] = q; xn[o] = (bf16_t)0x7fc0u; }
        if (i0 == 0) { unsigned expect = 0u; __hip_atomic_compare_exchange_strong(st1.tmo + 1, &expect, 0x7f0u, __ATOMIC_RELAXED, __ATOMIC_RELAXED, __HIP_MEMORY_SCOPE_AGENT); __hip_atomic_store(st1.tmo, 1u, __ATOMIC_RELAXED, __HIP_MEMORY_SCOPE_AGENT); } }
    __device__ __forceinline__ void fused(f32x4 (&acc)[2][2][4][2], const Unit& u, int wr, int wc, int fr, int fq, PG8_LAS unsigned char* lds, int wid, int lane) const {
        typedef float f32x2v __attribute__((ext_vector_type(2))); typedef unsigned u32x2v __attribute__((ext_vector_type(2)));
        const PG8_LAS f32x2v* S = (const PG8_LAS f32x2v*)(lds + 8192);
        const int col0 = u.pn * BM + wc * 32 + 4 * fq;
#pragma unroll
        for (int bj = 0; bj < 2; ++bj)
#pragma unroll
            for (int n = 0; n < 2; ++n) { const f32x4 bv = bias ? *(const f32x4*)(bias + col0 + bj * HALF + n * 16) : (f32x4){0.f, 0.f, 0.f, 0.f};
#pragma unroll
                for (int ai = 0; ai < 2; ++ai)
#pragma unroll
                    for (int m = 0; m < 4; ++m) acc[ai][bj][m][n] += bv; }
        bool bad = st1.run(acc, u, wr, wc, fr, fq, lds, wid, lane) || poison != 0u;
        const float qnan = __builtin_nanf("");
#pragma unroll
        for (int ai = 0; ai < 2; ++ai)
#pragma unroll
            for (int m = 0; m < 4; ++m) { const int r = ai * HALF + wr * 64 + m * 16 + fr; const f32x2v sr = S[r]; const size_t off = (size_t)(u.pm * BM + r) * ldc + col0;
#pragma unroll
                for (int bj = 0; bj < 2; ++bj)
#pragma unroll
                    for (int n = 0; n < 2; ++n) { const f32x4 bs = *(const f32x4*)(base + off + bj * HALF + n * 16); acc[ai][bj][m][n] = bs + (acc[ai][bj][m][n] - sr.x) * sr.y; }
                asm volatile("" : "+v"(acc[ai][0][m][0]), "+v"(acc[ai][0][m][1]), "+v"(acc[ai][1][m][0]), "+v"(acc[ai][1][m][1]));
                if (m & 1) asm volatile("" ::: "memory"); }
        const bool bad1 = bad;
        bad = st2.run(acc, u, wr, wc, fr, fq, lds, wid, lane) || bad;
#pragma unroll
        for (int ai = 0; ai < 2; ++ai)
#pragma unroll
            for (int m = 0; m < 4; ++m) { const int r = ai * HALF + wr * 64 + m * 16 + fr; const f32x2v sr = S[r]; const size_t off = (size_t)(u.pm * BM + r) * ldc + col0;
#pragma unroll
                for (int bj = 0; bj < 2; ++bj)
#pragma unroll
                    for (int n = 0; n < 2; ++n) { const f32x4 x1 = acc[ai][bj][m][n]; *(f32x4*)(out + off + bj * HALF + n * 16) = bad1 ? (f32x4){qnan, qnan, qnan, qnan} : x1;
                        const f32x4 o = (x1 - sr.x) * sr.y; u32x2v w; w.x = cvt_pk_bf16(o[0], o[1]); w.y = cvt_pk_bf16(o[2], o[3]);
                        if (bad) { w.x = 0x7fc07fc0u; w.y = 0x7fc07fc0u; } *(u32x2v*)(xn + off + bj * HALF + n * 16) = w; }
                asm volatile("" ::: "memory"); }
    }
};

template <class Epi, class Sched, bool STAMP = false>
__device__ __forceinline__ void gemm_phase(PG8_LAS unsigned char* lds, const Gemm g, const Sched& S, const Epi& E, unsigned long long* stamps) {
    int tid_l = threadIdx.x; asm volatile("" : "+v"(tid_l));
    const int tid = tid_l, wid = __builtin_amdgcn_readfirstlane(tid >> 6), lane = tid & 63, wr = wid >> 2, wc = wid & 3, fr = lane & 15, fq = lane >> 4;
    const int K = g.K, nt = K / BK;
    int ts_lo = 0, ts_hi = 0, nts = 0; const unsigned long long rt_entry = STAMP ? (unsigned long long)wall_clock64() : 0ull;
#define PG8_STAMP() do { if (STAMP && wid == 0 && nts < 64) { const unsigned long long _c = (unsigned long long)clock64(); \
        ts_lo = (lane == nts) ? (int)(unsigned)_c : ts_lo; ts_hi = (lane == nts) ? (int)(unsigned)(_c >> 32) : ts_hi; ++nts; } } while (0)
    PG8_STAMP();
    unsigned voffA[2], voffB[2];
#pragma unroll
    for (int i = 0; i < 2; ++i) { int R, C; stage_rc(tid * 16 + i * 8192, R, C); const int Rb = Epi::PERM ? ((R & ~31) + perm32(R & 31)) : R;
        voffA[i] = (unsigned)(R * K + C) * 2u; voffB[i] = (unsigned)(Rb * K + C) * 2u; }
    const size_t kstep = (size_t)(BK * 2);
    const size_t hstep = (size_t)HALF * K * 2;
    const size_t tstep = 2 * hstep;
    const unsigned ldsw = (unsigned)wid * 1024u;
    const int aoff = lds_byte(wr * 64 + fr, fq * 8), boff = lds_byte(wc * 32 + fr, fq * 8);
#define PG8_SA(b, h) (((b) * 2 + (h)) * HTB)
#define PG8_SB(b, h) ((4 + (b) * 2 + (h)) * HTB)
#define PG8_STAGE(bufoff, gbase, voff) do { _Pragma("unroll") for (int _i = 0; _i < 2; ++_i) \
        __builtin_amdgcn_global_load_lds((const unsigned*)((const char*)(gbase) + (voff)[_i]), (PG8_LAS unsigned*)(lds + (bufoff) + ldsw + _i * 8192), 16, 0, 0); } while (0)
#define PG8_LDA(dst, b, h) do { _Pragma("unroll") for (int m = 0; m < 4; ++m) _Pragma("unroll") for (int k = 0; k < 2; ++k) dst[m][k] = *(const PG8_LAS bf16x8*)(lds + PG8_SA(b, h) + aoff + m * 2048 + k * 1024); } while (0)
#define PG8_LDB(dst, b, h) do { _Pragma("unroll") for (int n = 0; n < 2; ++n) _Pragma("unroll") for (int k = 0; k < 2; ++k) dst[n][k] = *(const PG8_LAS bf16x8*)(lds + PG8_SB(b, h) + boff + n * 2048 + k * 1024); } while (0)
#define PG8_MMA(ai, bj, At, Bt) do { __builtin_amdgcn_s_setprio(1); _Pragma("unroll") for (int m = 0; m < 4; ++m) _Pragma("unroll") for (int n = 0; n < 2; ++n) _Pragma("unroll") for (int k = 0; k < 2; ++k) \
        acc[ai][bj][m][n] = __builtin_amdgcn_mfma_f32_16x16x32_bf16(Bt[n][k], At[m][k], acc[ai][bj][m][n], 0, 0, 0); __builtin_amdgcn_s_setprio(0); } while (0)
#define PG8_WAIT_V(n) asm volatile("s_waitcnt vmcnt(" #n ")" ::: "memory")
#define PG8_WAIT_L(n) asm volatile("s_waitcnt lgkmcnt(" #n ")" ::: "memory")
#define PG8_BAR __builtin_amdgcn_s_barrier()
#define PG8_SCHED __builtin_amdgcn_sched_barrier(0)
    Unit cur, nxt; int ui = 0;
    if (!S.next(0, cur)) return;
    f32x4 acc[2][2][4][2];
#pragma unroll
    for (int a = 0; a < 2; ++a)
#pragma unroll
        for (int b = 0; b < 2; ++b)
#pragma unroll
            for (int m = 0; m < 4; ++m)
#pragma unroll
                for (int n = 0; n < 2; ++n) acc[a][b][m][n] = (f32x4){0.f, 0.f, 0.f, 0.f};
    bf16x8 At[4][2], B0[2][2], B1[2][2];
    const char* cA = (const char*)g.A + (size_t)cur.pm * tstep; const char* cB = (const char*)g.Bt + (size_t)cur.pn * tstep;
    S.a_ready(cur);
    PG8_STAGE(PG8_SB(0, 0), cB, voffB); PG8_STAGE(PG8_SA(0, 0), cA, voffA); PG8_STAGE(PG8_SB(0, 1), cB + hstep, voffB); PG8_STAGE(PG8_SA(0, 1), cA + hstep, voffA);
    if (wr == 1) PG8_BAR;
    PG8_WAIT_V(4); PG8_BAR;
    PG8_STAGE(PG8_SB(1, 0), cB + kstep, voffB); PG8_STAGE(PG8_SA(1, 0), cA + kstep, voffA); PG8_STAGE(PG8_SB(1, 1), cB + hstep + kstep, voffB);
    PG8_WAIT_V(6); PG8_BAR;
    PG8_STAMP();
    for (;;) {
        const bool has_next = S.next(ui + 1, nxt);
        const char* nA = has_next ? (const char*)g.A + (size_t)nxt.pm * tstep : cA; const char* nB = has_next ? (const char*)g.Bt + (size_t)nxt.pn * tstep : cB;
        for (int t = 0; t < nt; t += 2) {
            const bool last = (t == nt - 2);
            const char* a1 = cA + (size_t)(t + 1) * kstep;
            const char* a2 = last ? nA : cA + (size_t)(t + 2) * kstep; const char* b2 = last ? nB : cB + (size_t)(t + 2) * kstep;
            const char* a3 = a2 + kstep; const char* b3 = b2 + kstep;
            if (last && has_next) S.a_ready(nxt);
            PG8_LDB(B0, 0, 0); PG8_SCHED; PG8_LDA(At, 0, 0); PG8_STAGE(PG8_SA(1, 1), a1 + hstep, voffA);
            PG8_WAIT_L(8); PG8_BAR; PG8_WAIT_L(0); PG8_MMA(0, 0, At, B0); PG8_BAR; PG8_SCHED;
            PG8_LDB(B1, 0, 1); PG8_STAGE(PG8_SB(0, 0), b2, voffB);
            PG8_BAR; PG8_WAIT_L(0); PG8_MMA(0, 1, At, B1); PG8_BAR;
            PG8_LDA(At, 0, 1); PG8_STAGE(PG8_SA(0, 0), a2, voffA);
            PG8_BAR; PG8_WAIT_L(0); PG8_MMA(1, 0, At, B0); PG8_BAR; PG8_SCHED;
            PG8_STAGE(PG8_SB(0, 1), b2 + hstep, voffB);
            PG8_WAIT_V(6); PG8_BAR; PG8_MMA(1, 1, At, B1); PG8_BAR;
            PG8_LDB(B0, 1, 0); PG8_SCHED; PG8_LDA(At, 1, 0); PG8_STAGE(PG8_SA(0, 1), a2 + hstep, voffA);
            PG8_WAIT_L(8); PG8_BAR; PG8_WAIT_L(0); PG8_MMA(0, 0, At, B0); PG8_BAR; PG8_SCHED;
            PG8_LDB(B1, 1, 1); PG8_STAGE(PG8_SB(1, 0), b3, voffB);
            PG8_BAR; PG8_WAIT_L(0); PG8_MMA(0, 1, At, B1); PG8_BAR;
            PG8_LDA(At, 1, 1); PG8_STAGE(PG8_SA(1, 0), a3, voffA);
            PG8_BAR; PG8_WAIT_L(0); PG8_MMA(1, 0, At, B0); PG8_BAR; PG8_SCHED;
            PG8_STAGE(PG8_SB(1, 1), b3 + hstep, voffB);
            PG8_WAIT_V(6); PG8_BAR; PG8_MMA(1, 1, At, B1); PG8_BAR;
        }
        PG8_STAMP();
        if constexpr (!Epi::AFTER_DRAIN) { E(acc, cur, wr, wc, fr, fq); S.done(cur); }
        PG8_STAMP();
        if (!has_next) break;
#pragma unroll
        for (int a = 0; a < 2; ++a)
#pragma unroll
            for (int b = 0; b < 2; ++b)
#pragma unroll
                for (int m = 0; m < 4; ++m)
#pragma unroll
                    for (int n = 0; n < 2; ++n) acc[a][b][m][n] = (f32x4){0.f, 0.f, 0.f, 0.f};
        cur = nxt; cA = nA; cB = nB; ++ui;
    }
    PG8_WAIT_V(0);
    if (wr == 0) PG8_BAR;
    PG8_BAR;
    if constexpr (Epi::AFTER_DRAIN) { E.fused(acc, cur, wr, wc, fr, fq, lds, wid, lane); S.done(cur); }
    PG8_STAMP();
    if (STAMP && wid == 0) { stamps[lane] = lane < nts ? (((unsigned long long)(unsigned)ts_hi << 32) | (unsigned)ts_lo) : 0ull;
        if (lane == 62) stamps[62] = rt_entry; if (lane == 63) stamps[63] = (unsigned long long)wall_clock64(); }
#undef PG8_STAMP
#undef PG8_SA
#undef PG8_SB
#undef PG8_STAGE
#undef PG8_LDA
#undef PG8_LDB
#undef PG8_MMA
#undef PG8_WAIT_V
#undef PG8_WAIT_L
#undef PG8_BAR
#undef PG8_SCHED
}
}

#define GAS __attribute__((address_space(1)))
#define LAS __attribute__((address_space(3)))
typedef unsigned short bf16;
typedef unsigned v4u __attribute__((ext_vector_type(4)));
typedef unsigned v2u __attribute__((ext_vector_type(2)));
typedef float f32x4 __attribute__((ext_vector_type(4)));
typedef float f32x2 __attribute__((ext_vector_type(2)));
typedef float f32x16 __attribute__((ext_vector_type(16)));
typedef short bf16x8 __attribute__((ext_vector_type(8)));
typedef short bf16x4 __attribute__((ext_vector_type(4)));

#ifndef MK_CHECK
#define MK_CHECK 0
#endif
#ifndef MK_ONE_LAUNCH
#define MK_ONE_LAUNCH 0
#endif

constexpr int T_TOK = 65536, DM = 1024, SEQ = 2048, NBATCH = 32;
constexpr float ALPHA_DN = 1.6817928305074290f;
constexpr int NWAVES = 8, NTHR = 512;
constexpr int NPH_LAYER = 12;
constexpr int N_PHASES = 1 + 4 * NPH_LAYER;

constexpr size_t MiB = 1u << 20;
constexpr size_t WS_CTL = 0, CTL_BYTES = 1 * MiB;
constexpr size_t WS_ROT = 1 * MiB;
constexpr size_t WS_WPEER = 4 * MiB;
constexpr size_t WS_WPLEG = 20 * MiB;
constexpr size_t WS_WPLEP = 28 * MiB;
constexpr size_t WS_WAIN = 30 * MiB;
constexpr size_t WS_WAQ = 32 * MiB;
constexpr size_t WAQ_STRIDE = 2560 * 256 * 2;
constexpr size_t WS_WAOV = 35 * MiB;
constexpr size_t WS_WBIN = 43 * MiB;
constexpr size_t WS_WBO = 48 * MiB;
constexpr size_t WS_WCIN = 51 * MiB;
constexpr size_t WS_WCO = 63 * MiB;
constexpr size_t WS_TABU = 68 * MiB, WS_TABV = 100 * MiB;
constexpr size_t WS_XB0 = 132 * MiB, WS_XB1 = 260 * MiB;
constexpr size_t WS_M = 388 * MiB;
constexpr size_t M_SC = 0, M_IDS = 512 * MiB, M_GATES = 544 * MiB, M_PB = 576 * MiB, M_PP = 0;
constexpr size_t M_RAW = 0, M_CQ = 128 * MiB, M_CKV = 160 * MiB, M_CKVT = 176 * MiB, M_KIDX = 192 * MiB, M_WIDX = 200 * MiB,
                 M_MASK = 202 * MiB, M_QLAT = 218 * MiB, M_QIDX = 474 * MiB;
constexpr size_t M_GU = 0, M_Y = 320 * MiB;
constexpr size_t M_Q = 0, M_K = 128 * MiB, M_V = 256 * MiB, M_STAT = 512 * MiB;
constexpr size_t WS_END = WS_M + 608 * MiB;
constexpr int CW_DIAG = 64;
constexpr int CW_BAR = 4096;

constexpr int RING_BYTES = 131072, LDSCTL_OFF = RING_BYTES, MISC_OFF = LDSCTL_OFF + 320, LDS_BYTES = 147456;

enum { I_X = 0, I_P, I_A_W_IN, I_A_CQ_GAIN, I_A_CKV_GAIN, I_A_W_UQ, I_A_W_UK, I_A_W_QIDX, I_A_KIDX_GAIN, I_A_KIDX_BIAS, I_A_W_UV, I_A_W_O,
       I_B_W_IN, I_B_CONV_W, I_B_CONV_B, I_B_W_A, I_B_B_A, I_B_W_X, I_B_B_X, I_B_LAMBDA, I_B_W_O, I_C_W_IN, I_C_W_O,
       I_LN1_G, I_LN1_B, I_PEER_WQ, I_PEER_SK, I_PEER_U, I_PEER_V, I_LN2_G, I_LN2_B, I_PLE_WP, I_PLE_WG, I_PLE_BG, N_IN };

struct Params { const float* in[N_IN]; float* out; unsigned char* ws; int ph_lo, ph_hi, flags, pad; };

typedef const float* const __attribute__((address_space(4)))* InTab;
struct Ctx {
    LAS unsigned char* lds;
    int tid, lane, wave, bid, G;
    InTab in; float* out; unsigned char* ws;
};
#define INP(cx, i) ((const float*)(const GAS float*)((cx).in[i]))

#define LDS_WAIT() asm volatile("s_waitcnt lgkmcnt(0)" ::: "memory")
#define VM_WAIT() asm volatile("s_waitcnt vmcnt(0)" ::: "memory")

__device__ __forceinline__ unsigned f2bf(float f) { unsigned u = __builtin_bit_cast(unsigned, f); return (u + 0x7fffu + ((u >> 16) & 1u)) >> 16; }
__device__ __forceinline__ unsigned pk2(float lo, float hi) { return f2bf(lo) | (f2bf(hi) << 16); }
__device__ __forceinline__ float bflo(unsigned w) { return __builtin_bit_cast(float, w << 16); }
__device__ __forceinline__ float bfhi(unsigned w) { return __builtin_bit_cast(float, w & 0xffff0000u); }
__device__ __forceinline__ float bf2f(bf16 b) { return __builtin_bit_cast(float, ((unsigned)b) << 16); }
__device__ __forceinline__ float wave_sum(float v) {
#pragma unroll
    for (int o = 1; o < 64; o <<= 1) v += __shfl_xor(v, o);
    return v;
}
__device__ __forceinline__ float gelu_tanh(float x) {
    const float u = 0.7978845608028654f * (x + 0.044715f * x * x * x);
    const float e = __expf(2.0f * u);
    const float th = 1.0f - 2.0f / (e + 1.0f);
    return 0.5f * x * (1.0f + th);
}
__device__ __forceinline__ float sigmoidf_(float x) { return 1.0f / (1.0f + __expf(-x)); }

#define XB_TMO      128
#define XB_XCNT(j)  (256  + 64 * (j))
#define XB_XSUB(j)  (1280 + 64 * (j))
#define XB_XGEN(j)  (2304 + 64 * (j))
#define XB_TOP      3328
#define XB_TOPGEN   3392
#define XCD_BAR_WORDS 3456
#define XB_SPIN_CAP (1u << 25)
__device__ __forceinline__ unsigned xb_ld(unsigned* p)              { return __hip_atomic_load(p, __ATOMIC_RELAXED, __HIP_MEMORY_SCOPE_AGENT); }
__device__ __forceinline__ unsigned xb_add(unsigned* p, unsigned v) { return __hip_atomic_fetch_add(p, v, __ATOMIC_RELAXED, __HIP_MEMORY_SCOPE_AGENT); }
__device__ __forceinline__ unsigned xb_xcc_id() { return (unsigned)__builtin_amdgcn_s_getreg((3 << 11) | 20) & 0xFu; }
#define XB_SPIN(cond, bar) do { unsigned _sp = 0; while (cond) { __builtin_amdgcn_s_sleep(1); \
    if ((++_sp & 255u) == 0u) { if (xb_ld(&(bar)[XB_TMO])) break; if (_sp > XB_SPIN_CAP) { atomicAdd(&(bar)[XB_TMO], 1u); break; } } } } while (0)
struct XcdBarrier { unsigned* bar; unsigned x; volatile LAS unsigned* st; };
__device__ __forceinline__ XcdBarrier xcd_barrier_post(unsigned* bar, volatile LAS unsigned* st) {
    XcdBarrier b; b.bar = bar; b.x = xb_xcc_id(); b.st = st;
    if (threadIdx.x == 0) (void)xb_add(&bar[XB_XCNT(b.x)], 1u);
    return b;
}
__device__ __forceinline__ void xcd_barrier_complete(unsigned* bar, unsigned x, unsigned& nloc, unsigned& nx) {
    const unsigned G = gridDim.x * gridDim.y * gridDim.z;
    unsigned sum, cnt, mine, sp = 0u;
    for (;;) {
        sum = 0u; cnt = 0u; mine = 0u;
#pragma unroll
        for (unsigned j = 0; j < 16; ++j) { const unsigned c = xb_ld(&bar[XB_XCNT(j)]); sum += c; cnt += (c > 0u) ? 1u : 0u; mine = (j == x) ? c : mine; }
        if (sum == G) break;
        __builtin_amdgcn_s_sleep(1);
        if ((++sp & 255u) == 0u) { if (xb_ld(&bar[XB_TMO])) break; if (sp > XB_SPIN_CAP) { atomicAdd(&bar[XB_TMO], 1u); break; } }
    }
    nloc = mine > 0u ? mine : 1u; nx = cnt > 0u ? cnt : 1u;
}
__device__ __forceinline__ void xcd_barrier(const XcdBarrier& b) {
    asm volatile("s_waitcnt vmcnt(0)" ::: "memory");
    __syncthreads();
    if (threadIdx.x == 0) {
        unsigned* bar = b.bar;
        __builtin_amdgcn_s_waitcnt(0);
        unsigned nloc = b.st[0], nx = b.st[1];
        if (nloc == 0u) { xcd_barrier_complete(bar, b.x, nloc, nx); b.st[0] = nloc; b.st[1] = nx; }
        const unsigned old = xb_add(&bar[XB_XSUB(b.x)], 1u);
        const unsigned gen = old / nloc;
        if (old + 1u == (gen + 1u) * nloc) {
            __builtin_amdgcn_fence(__ATOMIC_RELEASE, "agent");
            asm volatile("s_waitcnt vmcnt(0)" ::: "memory");
            const unsigned og = xb_add(&bar[XB_TOP], 1u);
            const unsigned tg = og / nx;
            if (og + 1u == (tg + 1u) * nx) xb_add(&bar[XB_TOPGEN], 1u);
            else XB_SPIN(xb_ld(&bar[XB_TOPGEN]) == tg, bar);
            __builtin_amdgcn_fence(__ATOMIC_ACQUIRE, "agent");
            xb_add(&bar[XB_XGEN(b.x)], 1u);
            asm volatile("s_waitcnt vmcnt(0)" ::: "memory");
        } else {
            XB_SPIN(xb_ld(&bar[XB_XGEN(b.x)]) == gen, bar);
            __builtin_amdgcn_fence(__ATOMIC_ACQUIRE, "agent");
            asm volatile("s_waitcnt vmcnt(0)" ::: "memory");
        }
    }
    __syncthreads();
}

__device__ __forceinline__ void p0_transpose_item(const float* W, int K, int N, bf16* WT, int row_off, float scale, LAS float* scr, int item, int lane) {
    const int nblk = N / 32, kb = item / nblk, nb = item % nblk, k0 = 64 * kb, n0 = 32 * nb;
#pragma unroll 8
    for (int i = 0; i < 32; ++i) { const int kk = 2 * i + (lane >> 5); scr[kk * 33 + (lane & 31)] = W[(size_t)(k0 + kk) * N + n0 + (lane & 31)] * scale; }
    LDS_WAIT(); asm volatile("" ::: "memory");
    const int c = lane & 7;
#pragma unroll
    for (int j = 0; j < 4; ++j) { const int n = (lane >> 3) + 8 * j; const LAS float* s = scr + (8 * c) * 33 + n;
        v4u o; o.x = pk2(s[0 * 33], s[1 * 33]); o.y = pk2(s[2 * 33], s[3 * 33]); o.z = pk2(s[4 * 33], s[5 * 33]); o.w = pk2(s[6 * 33], s[7 * 33]);
        *(v4u*)(WT + (size_t)(row_off + n0 + n) * K + k0 + 8 * c) = o; }
    LDS_WAIT(); asm volatile("" ::: "memory");
}

__device__ __forceinline__ void small_gemm_tile(const Ctx& c, const float* A, long sa_n, long sa_d, const float* Bm, long sb_k, long sb_d, int Kd,
                                                bf16* C, int ldc, int n0, int k0, float scale) {
    LAS float* As = (LAS float*)c.lds; LAS float* Bs = As + 128 * 68;
    __syncthreads();
    for (int e = c.tid; e < 64 * Kd; e += NTHR) {
        int r, d;
        if (sa_d == 1) { d = e % Kd; r = e / Kd; } else { r = e & 63; d = e >> 6; }
        As[d * 68 + r] = A[(long)(n0 + r) * sa_n + (long)d * sa_d];
    }
    for (int e = c.tid; e < 64 * Kd; e += NTHR) {
        int r, d;
        if (sb_d == 1) { d = e % Kd; r = e / Kd; } else { r = e & 63; d = e >> 6; }
        Bs[d * 68 + r] = Bm[(long)(k0 + r) * sb_k + (long)d * sb_d];
    }
    __syncthreads();
    if (c.tid < 256) {
        const int tn = (c.tid >> 4) * 4, tk = (c.tid & 15) * 4;
        float acc[4][4];
#pragma unroll
        for (int i = 0; i < 4; ++i)
#pragma unroll
            for (int j = 0; j < 4; ++j) acc[i][j] = 0.f;
        for (int d = 0; d < Kd; ++d) {
            const f32x4 a = *(const LAS f32x4*)(As + d * 68 + tn), b = *(const LAS f32x4*)(Bs + d * 68 + tk);
#pragma unroll
            for (int i = 0; i < 4; ++i)
#pragma unroll
                for (int j = 0; j < 4; ++j) acc[i][j] += a[i] * b[j];
        }
#pragma unroll
        for (int i = 0; i < 4; ++i) {
            v2u o; o.x = pk2(acc[i][0] * scale, acc[i][1] * scale); o.y = pk2(acc[i][2] * scale, acc[i][3] * scale);
            *(v2u*)(C + (size_t)(n0 + tn + i) * ldc + k0 + tk) = o;
        }
    }
}

__device__ __forceinline__ void ln_store_row(float (&v)[16], const float* gain, const float* bias, float* of, bf16* ob, int lane) {
    float s = 0.f;
#pragma unroll
    for (int j = 0; j < 16; ++j) s += v[j];
    const float mean = wave_sum(s) * (1.f / 1024.f);
    float s2 = 0.f;
#pragma unroll
    for (int j = 0; j < 16; ++j) { v[j] -= mean; s2 += v[j] * v[j]; }
    const float rstd = 1.0f / sqrtf(wave_sum(s2) * (1.f / 1024.f) + 1e-5f);
#pragma unroll
    for (int h = 0; h < 2; ++h) {
        const int col = h * 512 + 8 * lane;
        const f32x4 g0 = *(const f32x4*)(gain + col), g1 = *(const f32x4*)(gain + col + 4), b0 = *(const f32x4*)(bias + col), b1 = *(const f32x4*)(bias + col + 4);
        f32x4 o0, o1;
#pragma unroll
        for (int j = 0; j < 4; ++j) { o0[j] = v[h * 8 + j] * rstd * g0[j] + b0[j]; o1[j] = v[h * 8 + 4 + j] * rstd * g1[j] + b1[j]; }
        *(f32x4*)(of + col) = o0; *(f32x4*)(of + col + 4) = o1;
        v4u w; w.x = pk2(o0[0], o0[1]); w.y = pk2(o0[2], o0[3]); w.z = pk2(o1[0], o1[1]); w.w = pk2(o1[2], o1[3]);
        *(v4u*)(ob + col) = w;
    }
}
__device__ __forceinline__ void load_row16(const float* row, float (&v)[16], int lane) {
#pragma unroll
    for (int h = 0; h < 2; ++h) { const f32x4 a = *(const f32x4*)(row + h * 512 + 8 * lane), b = *(const f32x4*)(row + h * 512 + 8 * lane + 4);
#pragma unroll
        for (int j = 0; j < 4; ++j) { v[h * 8 + j] = a[j]; v[h * 8 + 4 + j] = b[j]; } }
}

__device__ __forceinline__ void phase_prologue(const Ctx& c) {
    unsigned char* ws = c.ws;
    LAS float* scr = (LAS float*)(c.lds + c.wave * 16384);
    const int gw = c.bid * NWAVES + c.wave, NGW = c.G * NWAVES;
    {
        struct TI { const float* W; int K, N; bf16* WT; int row_off; float scale; };
        int base = 0;
#define TR_ITEMS(Wp, Kv, Nv, WTp, roff, sc) do { const int ni = ((Kv) / 64) * ((Nv) / 32); \
            for (int it = gw; it < ni; it += NGW) p0_transpose_item((Wp), (Kv), (Nv), (WTp), (roff), (sc), scr, it, c.lane); base += ni; } while (0)
        for (int i = 0; i < 4; ++i) {
            TR_ITEMS(INP(c, I_PLE_WG) + (size_t)i * 1024 * 1024, 1024, 1024, (bf16*)(ws + WS_WPLEG) + (size_t)i * 1024 * 1024, 0, 1.0f);
            TR_ITEMS(INP(c, I_PLE_WP) + (size_t)i * 256 * 1024, 256, 1024, (bf16*)(ws + WS_WPLEP) + (size_t)i * 1024 * 256, 0, 1.0f);
        }
        for (int j = 0; j < 2; ++j)
            TR_ITEMS(INP(c, I_A_W_QIDX) + (size_t)j * 256 * 512, 256, 512, (bf16*)(ws + WS_WAQ + j * WAQ_STRIDE), 2048, 0.125f);
        TR_ITEMS(INP(c, I_B_W_IN), 1024, 2560, (bf16*)(ws + WS_WBIN), 0, 1.0f);
        TR_ITEMS(INP(c, I_B_W_O), 1280, 1024, (bf16*)(ws + WS_WBO), 0, 1.0f);
        TR_ITEMS(INP(c, I_C_W_IN), 1024, 6144, (bf16*)(ws + WS_WCIN), 0, 1.0f);
        TR_ITEMS(INP(c, I_C_W_O), 2048, 1024, (bf16*)(ws + WS_WCO), 0, 1.0f);
#undef TR_ITEMS
        (void)base;
    }
    for (int j = 0; j < 2; ++j) {
        const float* W = INP(c, I_A_W_IN) + (size_t)j * 1024 * 456; bf16* WT = (bf16*)(ws + WS_WAIN) + (size_t)j * 512 * 1024;
        for (int e = c.bid * NTHR + c.tid; e < 512 * 1024; e += c.G * NTHR) { const int n = e >> 10, k = e & 1023; WT[e] = (bf16)(n < 456 ? f2bf(W[(size_t)k * 456 + n]) : 0u); }
    }
    {
        float* ct = (float*)(ws + WS_ROT); float* st = ct + 2048 * 128;
        for (int e = c.bid * NTHR + c.tid; e < 2048 * 128; e += c.G * NTHR) {
            const int pos = e >> 7, f = e & 127;
            const float lin = (float)f * (1.0f / 127.0f);
            const float p = (float)pow(10000.0, (double)lin);
            const float invf = 1.0f / p;
            const float ang = (float)pos * invf;
            ct[e] = (float)cos((double)ang); st[e] = (float)sin((double)ang);
        }
    }
    for (int m = gw; m < T_TOK; m += NGW) {
        const float* xr = INP(c, I_X) + (size_t)m * DM; float* of = c.out + (size_t)m * DM; bf16* ob = (bf16*)(ws + WS_XB0) + (size_t)m * DM;
#pragma unroll
        for (int h = 0; h < 2; ++h) { const int col = h * 512 + 8 * c.lane; const f32x4 a = *(const f32x4*)(xr + col), b = *(const f32x4*)(xr + col + 4);
            *(f32x4*)(of + col) = a; *(f32x4*)(of + col + 4) = b;
            v4u w; w.x = pk2(a[0], a[1]); w.y = pk2(a[2], a[3]); w.z = pk2(b[0], b[1]); w.w = pk2(b[2], b[3]); *(v4u*)(ob + col) = w; }
    }
    {
        int tbase = 0;
        {
            const int ntile = 4 * 16 * 2 * 16;
            for (int t = c.bid; t < ntile; t += c.G) {
                const int i = t / 512, r = t % 512, hp = r / 32, tt = r % 32, nt = tt / 16, kt = tt % 16;
                const float* A = INP(c, I_PEER_SK) + (size_t)i * 8 * 2 * 128 * 128 + (size_t)hp * 128 * 128;
                const float* Bm = INP(c, I_PEER_WQ) + (size_t)i * 1024 * 2048 + hp * 128;
                bf16* C = (bf16*)(ws + WS_WPEER) + (size_t)i * 2048 * 1024 + (size_t)hp * 128 * 1024;
                small_gemm_tile(c, A, 128, 1, Bm, 2048, 1, 128, C, 1024, nt * 64, kt * 64, 1.0f);
            }
            tbase += ntile;
        }
        {
            const int ntile = 2 * 16 * 2 * 4;
            for (int t = c.bid; t < ntile; t += c.G) {
                const int j = t / 128, r = t % 128, h = r / 8, tt = r % 8, nt = tt / 4, kt = tt % 4;
                const float* A = INP(c, I_A_W_UK) + (size_t)j * 16 * 64 * 128 + (size_t)h * 64 * 128;
                const float* Bm = INP(c, I_A_W_UQ) + (size_t)j * 256 * 1024 + h * 64;
                bf16* C = (bf16*)(ws + WS_WAQ + j * WAQ_STRIDE) + (size_t)h * 128 * 256;
                small_gemm_tile(c, A, 1, 128, Bm, 1024, 1, 64, C, 256, nt * 64, kt * 64, 0.125f);
            }
        }
        {
            const int ntile = 2 * 16 * 16 * 2;
            for (int t = c.bid; t < ntile; t += c.G) {
                const int j = t / 512, r = t % 512, h = r / 32, tt = r % 32, nt = tt / 2, kt = tt % 2;
                const float* A = INP(c, I_A_W_O) + (size_t)j * 1024 * 1024 + (size_t)h * 64 * 1024;
                const float* Bm = INP(c, I_A_W_UV) + (size_t)j * 16 * 128 * 64 + (size_t)h * 128 * 64;
                bf16* C = (bf16*)(ws + WS_WAOV) + (size_t)j * 1024 * 2048 + h * 128;
                small_gemm_tile(c, A, 1, 1024, Bm, 64, 1, 64, C, 2048, nt * 64, kt * 64, 1.0f);
            }
        }
        (void)tbase;
    }
}

__device__ __forceinline__ void phase_ln1(const Ctx& c, int layer) {
    const int gw = c.bid * NWAVES + c.wave, NGW = c.G * NWAVES;
    const float* gain = INP(c, I_LN1_G) + layer * DM; const float* bias = INP(c, I_LN1_B) + layer * DM;
    bf16* xb = (bf16*)(c.ws + ((layer & 1) ? WS_XB1 : WS_XB0));
    for (int m = gw; m < T_TOK; m += NGW) {
        float v[16]; load_row16(c.out + (size_t)m * DM, v, c.lane);
        ln_store_row(v, gain, bias, c.out + (size_t)m * DM, xb + (size_t)m * DM, c.lane);
    }
    {
        const float* U = INP(c, I_PEER_U) + (size_t)layer * 16384 * 1024; const float* V = INP(c, I_PEER_V) + (size_t)layer * 16384 * 1024;
        bf16* tu = (bf16*)(c.ws + WS_TABU); bf16* tv = (bf16*)(c.ws + WS_TABV);
        const size_t n8 = (size_t)16384 * 1024 / 8;
        for (size_t e = (size_t)c.bid * NTHR + c.tid; e < n8; e += (size_t)c.G * NTHR) {
            const f32x4 a = *(const f32x4*)(U + e * 8), b = *(const f32x4*)(U + e * 8 + 4);
            v4u w; w.x = pk2(a[0], a[1]); w.y = pk2(a[2], a[3]); w.z = pk2(b[0], b[1]); w.w = pk2(b[2], b[3]); *(v4u*)(tu + e * 8) = w;
            const f32x4 a2 = *(const f32x4*)(V + e * 8), b2 = *(const f32x4*)(V + e * 8 + 4);
            v4u w2; w2.x = pk2(a2[0], a2[1]); w2.y = pk2(a2[2], a2[3]); w2.z = pk2(b2[0], b2[1]); w2.w = pk2(b2[2], b2[3]); *(v4u*)(tv + e * 8) = w2;
        }
    }
    {
        const float* P = INP(c, I_P) + (size_t)layer * T_TOK * 256; bf16* pb = (bf16*)(c.ws + WS_M + M_PB);
        const size_t n8 = (size_t)T_TOK * 256 / 8;
        for (size_t e = (size_t)c.bid * NTHR + c.tid; e < n8; e += (size_t)c.G * NTHR) {
            const f32x4 a = *(const f32x4*)(P + e * 8), b = *(const f32x4*)(P + e * 8 + 4);
            v4u w; w.x = pk2(a[0], a[1]); w.y = pk2(a[2], a[3]); w.z = pk2(b[0], b[1]); w.w = pk2(b[2], b[3]); *(v4u*)(pb + e * 8) = w;
        }
    }
}

using pg8::Unit;
constexpr int BMT = 256, HALFT = 128;

struct EpiResid {
    static constexpr bool PERM = false, AFTER_DRAIN = false;
    float* X; float alpha;
    __device__ __forceinline__ void operator()(const pg8::f32x4 (&acc)[2][2][4][2], const Unit& u, int wr, int wc, int fr, int fq) const {
        const int row0 = u.pm * BMT + wr * 64 + fr, col0 = u.pn * BMT + wc * 32 + 4 * fq;
#pragma unroll
        for (int ai = 0; ai < 2; ++ai)
#pragma unroll
            for (int m = 0; m < 4; ++m) { float* rowp = X + (size_t)(row0 + ai * HALFT + m * 16) * DM + col0;
                pg8::f32x4 xv[2][2];
#pragma unroll
                for (int bj = 0; bj < 2; ++bj)
#pragma unroll
                    for (int n = 0; n < 2; ++n) xv[bj][n] = *(const pg8::f32x4*)(rowp + bj * HALFT + n * 16);
#pragma unroll
                for (int bj = 0; bj < 2; ++bj)
#pragma unroll
                    for (int n = 0; n < 2; ++n) *(pg8::f32x4*)(rowp + bj * HALFT + n * 16) = xv[bj][n] * alpha + acc[ai][bj][m][n]; }
    }
};

template <int ACT0  > struct EpiBf16R {
    static constexpr bool PERM = true, AFTER_DRAIN = false;
    bf16 *O0, *O1, *O2; int ld0, ld1, ld2, c1, c2;
    __device__ __forceinline__ void operator()(const pg8::f32x4 (&acc)[2][2][4][2], const Unit& u, int wr, int wc, int fr, int fq) const {
        const int row0 = u.pm * BMT + wr * 64 + fr; int colt = u.pn * BMT; bf16* base; int ld; bool act = false;
        if (colt < c1) { base = O0; ld = ld0; act = (ACT0 == 1); } else if (colt < c2) { base = O1; ld = ld1; colt -= c1; } else { base = O2; ld = ld2; colt -= c2; }
        const int col0 = colt + wc * 32 + 8 * fq;
#pragma unroll
        for (int ai = 0; ai < 2; ++ai)
#pragma unroll
            for (int m = 0; m < 4; ++m) { bf16* rowp = base + (size_t)(row0 + ai * HALFT + m * 16) * ld + col0;
#pragma unroll
                for (int bj = 0; bj < 2; ++bj) { pg8::f32x4 v0 = acc[ai][bj][m][0], v1 = acc[ai][bj][m][1];
                    if (ACT0 == 1 && act) {
#pragma unroll
                        for (int j = 0; j < 4; ++j) { v0[j] = gelu_tanh(v0[j]); v1[j] = gelu_tanh(v1[j]); } }
                    v4u w; w.x = pk2(v0[0], v0[1]); w.y = pk2(v0[2], v0[3]); w.z = pk2(v1[0], v1[1]); w.w = pk2(v1[2], v1[3]);
                    *(v4u*)(rowp + bj * HALFT) = w; } }
    }
};

struct EpiRetIn {
    static constexpr bool PERM = true, AFTER_DRAIN = false;
    bf16 *Q, *K, *V; const float* cs; const float* sn;
    __device__ __forceinline__ void operator()(const pg8::f32x4 (&acc)[2][2][4][2], const Unit& u, int wr, int wc, int fr, int fq) const {
        const int row0 = u.pm * BMT + wr * 64 + fr; const int colt = u.pn * BMT;
        if (colt >= 2048) {
            const int col0 = colt - 2048 + wc * 32 + 8 * fq;
#pragma unroll
            for (int ai = 0; ai < 2; ++ai)
#pragma unroll
                for (int m = 0; m < 4; ++m) { bf16* rowp = V + (size_t)(row0 + ai * HALFT + m * 16) * 2048 + col0;
#pragma unroll
                    for (int bj = 0; bj < 2; ++bj) { const pg8::f32x4 v0 = acc[ai][bj][m][0], v1 = acc[ai][bj][m][1];
                        v4u w; w.x = pk2(v0[0], v0[1]); w.y = pk2(v0[2], v0[3]); w.z = pk2(v1[0], v1[1]); w.w = pk2(v1[2], v1[3]);
                        *(v4u*)(rowp + bj * HALFT) = w; } }
        } else {
            const bool isk = colt >= 1024; bf16* base = isk ? K : Q; const float sc = isk ? 0.0625f : 1.0f;
            const int col0 = (isk ? colt - 1024 : colt) + wc * 32 + 8 * fq; const int f0 = wc * 32 + 8 * fq;
#pragma unroll
            for (int ai = 0; ai < 2; ++ai)
#pragma unroll
                for (int m = 0; m < 4; ++m) { const int row = row0 + ai * HALFT + m * 16; const int pos = row & (SEQ - 1);
                    const pg8::f32x4 c0 = *(const pg8::f32x4*)(cs + pos * 128 + f0), c1 = *(const pg8::f32x4*)(cs + pos * 128 + f0 + 4);
                    const pg8::f32x4 s0 = *(const pg8::f32x4*)(sn + pos * 128 + f0), s1 = *(const pg8::f32x4*)(sn + pos * 128 + f0 + 4);
                    const pg8::f32x4 a0 = acc[ai][0][m][0] * sc, a1 = acc[ai][0][m][1] * sc, b0 = acc[ai][1][m][0] * sc, b1 = acc[ai][1][m][1] * sc;
                    const pg8::f32x4 r0 = a0 * c0 - b0 * s0, r1 = a1 * c1 - b1 * s1, q0 = a0 * s0 + b0 * c0, q1 = a1 * s1 + b1 * c1;
                    bf16* rowp = base + (size_t)row * 1024 + col0;
                    v4u w; w.x = pk2(r0[0], r0[1]); w.y = pk2(r0[2], r0[3]); w.z = pk2(r1[0], r1[1]); w.w = pk2(r1[2], r1[3]); *(v4u*)(rowp) = w;
                    v4u w2; w2.x = pk2(q0[0], q0[1]); w2.y = pk2(q0[2], q0[3]); w2.z = pk2(q1[0], q1[1]); w2.w = pk2(q1[2], q1[3]); *(v4u*)(rowp + HALFT) = w2; }
        }
    }
};

struct EpiRetGate {
    static constexpr bool PERM = true, AFTER_DRAIN = false;
    bf16* O; const float* STAT;
    __device__ __forceinline__ void operator()(const pg8::f32x4 (&acc)[2][2][4][2], const Unit& u, int wr, int wc, int fr, int fq) const {
        const int row0 = u.pm * BMT + wr * 64 + fr; const int head = u.pn >> 1; const int col0 = u.pn * BMT + wc * 32 + 8 * fq;
#pragma unroll
        for (int ai = 0; ai < 2; ++ai)
#pragma unroll
            for (int m = 0; m < 4; ++m) { const int row = row0 + ai * HALFT + m * 16;
                const pg8::f32x4 st = *(const pg8::f32x4*)(STAT + (size_t)row * 16 + head * 4);
                const float mean = (st[0] + st[2]) * (1.0f / 512.0f); const float var = (st[1] + st[3]) * (1.0f / 512.0f) - mean * mean;
                const float rstd = 1.0f / sqrtf(fmaxf(var, 0.f) + 1e-5f);
                bf16* rowp = O + (size_t)row * 2048 + col0;
#pragma unroll
                for (int bj = 0; bj < 2; ++bj) { const v4u ov = *(const v4u*)(rowp + bj * HALFT);
                    const pg8::f32x4 g0 = acc[ai][bj][m][0], g1 = acc[ai][bj][m][1];
                    float o[8] = {bflo(ov.x), bfhi(ov.x), bflo(ov.y), bfhi(ov.y), bflo(ov.z), bfhi(ov.z), bflo(ov.w), bfhi(ov.w)};
                    float r[8];
#pragma unroll
                    for (int j = 0; j < 8; ++j) { const float g = j < 4 ? g0[j] : g1[j - 4]; r[j] = g * sigmoidf_(g) * (o[j] - mean) * rstd; }
                    v4u w; w.x = pk2(r[0], r[1]); w.y = pk2(r[2], r[3]); w.z = pk2(r[4], r[5]); w.w = pk2(r[6], r[7]);
                    *(v4u*)(rowp + bj * HALFT) = w; } }
    }
};

struct EpiPle {
    static constexpr bool PERM = true, AFTER_DRAIN = false;
    float* X; const bf16* PP; bf16* XBo; const float* bg;
    __device__ __forceinline__ void operator()(const pg8::f32x4 (&acc)[2][2][4][2], const Unit& u, int wr, int wc, int fr, int fq) const {
        const int row0 = u.pm * BMT + wr * 64 + fr; const int col0 = u.pn * BMT + wc * 32 + 8 * fq;
        pg8::f32x4 bv[2][2];
#pragma unroll
        for (int bj = 0; bj < 2; ++bj)
#pragma unroll
            for (int n = 0; n < 2; ++n) bv[bj][n] = *(const pg8::f32x4*)(bg + col0 + bj * HALFT + 4 * n);
#pragma unroll
        for (int ai = 0; ai < 2; ++ai)
#pragma unroll
            for (int m = 0; m < 4; ++m) { const size_t off = (size_t)(row0 + ai * HALFT + m * 16) * DM + col0;
#pragma unroll
                for (int bj = 0; bj < 2; ++bj) {
                    const v4u pv = *(const v4u*)(PP + off + bj * HALFT);
                    const pg8::f32x4 x0 = *(const pg8::f32x4*)(X + off + bj * HALFT), x1 = *(const pg8::f32x4*)(X + off + bj * HALFT + 4);
                    const float pp[8] = {bflo(pv.x), bfhi(pv.x), bflo(pv.y), bfhi(pv.y), bflo(pv.z), bfhi(pv.z), bflo(pv.w), bfhi(pv.w)};
                    pg8::f32x4 o0, o1;
#pragma unroll
                    for (int j = 0; j < 4; ++j) { o0[j] = x0[j] + sigmoidf_(acc[ai][bj][m][0][j] + bv[bj][0][j]) * pp[j];
                                                  o1[j] = x1[j] + sigmoidf_(acc[ai][bj][m][1][j] + bv[bj][1][j]) * pp[4 + j]; }
                    *(pg8::f32x4*)(X + off + bj * HALFT) = o0; *(pg8::f32x4*)(X + off + bj * HALFT + 4) = o1;
                    v4u w; w.x = pk2(o0[0], o0[1]); w.y = pk2(o0[2], o0[3]); w.z = pk2(o1[0], o1[1]); w.w = pk2(o1[2], o1[3]);
                    *(v4u*)(XBo + off + bj * HALFT) = w; } }
    }
};

template <class Epi>
__device__ __forceinline__ void run_gemm(const Ctx& c, const bf16* A, const bf16* Bt, int N, int K, const Epi& E) {
    asm volatile("" : "+s"(K), "+s"(N));
    pg8::Gemm g{A, Bt, T_TOK, N, K}; pg8::StaticOrder S; S.init(T_TOK, N, c.G, c.bid);
    pg8::gemm_phase<Epi, pg8::StaticOrder, false>((PG8_LAS unsigned char*)c.lds, g, S, E, nullptr);
}

__device__ __forceinline__ unsigned sort_key(float f) { const unsigned u = __builtin_bit_cast(unsigned, f); return (u & 0x80000000u) ? ~u : (u | 0x80000000u); }
__device__ __forceinline__ unsigned half_sel(unsigned long long m, int half) { return half ? (unsigned)(m >> 32) : (unsigned)m; }

__device__ __forceinline__ void phase_peer_topk(const Ctx& c) {
    const int gw = c.bid * NWAVES + c.wave, NGW = c.G * NWAVES;
    const float* SC = (const float*)(c.ws + WS_M + M_SC); int* IDS = (int*)(c.ws + WS_M + M_IDS); float* GATES = (float*)(c.ws + WS_M + M_GATES);
    LAS float* lv = (LAS float*)(c.lds + c.wave * 1024);
    LAS int* li = (LAS int*)(c.lds + c.wave * 1024 + 128);
    LAS float* l2v = (LAS float*)(c.lds + c.wave * 1024 + 256);
    LAS int* l2i = (LAS int*)(c.lds + c.wave * 1024 + 320);
    const int lane = c.lane, half = lane >> 5, l31 = lane & 31; const unsigned ltmask = (1u << l31) - 1u;
    for (int tok = gw; tok < T_TOK; tok += NGW) {
        const float* srow = SC + (size_t)tok * 2048;
        f32x4 sv[8];
#pragma unroll
        for (int i = 0; i < 8; ++i) sv[i] = *(const f32x4*)(srow + 4 * lane + 256 * i);
#pragma unroll 1
        for (int hd = 0; hd < 8; ++hd) {
            f32x4 cur = sv[0];
#pragma unroll
            for (int i = 1; i < 8; ++i) if (hd == i) cur = sv[i];
            unsigned key[4];
#pragma unroll
            for (int j = 0; j < 4; ++j) key[j] = sort_key(cur[j]);
            unsigned v = 0u, cv = 128u;
            for (int bit = 31; bit >= 0; --bit) {
                const unsigned cand = v | (1u << bit); unsigned cnt = 0u;
#pragma unroll
                for (int j = 0; j < 4; ++j) cnt += __popc(half_sel(__ballot(key[j] >= cand), half));
                if (cnt >= 16u) { v = cand; cv = cnt; }
                if (__all(cv == 16u)) break;
            }
            unsigned cg = 0u;
#pragma unroll
            for (int j = 0; j < 4; ++j) cg += __popc(half_sel(__ballot(key[j] > v), half));
            const unsigned need = 16u - cg; unsigned gbase = 0u, ebase = 0u;
#pragma unroll
            for (int j = 0; j < 4; ++j) {
                const bool gt = key[j] > v, eq = key[j] == v;
                const unsigned gm = half_sel(__ballot(gt), half), em = half_sel(__ballot(eq), half);
                const unsigned gp = gbase + __popc(gm & ltmask), ep = ebase + __popc(em & ltmask);
                if (gt) { lv[half * 16 + gp] = cur[j]; li[half * 16 + gp] = 4 * l31 + j; }
                else if (eq && ep < need) { lv[half * 16 + cg + ep] = cur[j]; li[half * 16 + cg + ep] = 4 * l31 + j; }
                gbase += __popc(gm); ebase += __popc(em);
            }
            LDS_WAIT(); asm volatile("" ::: "memory");
            const int a = lane >> 2; const float va = lv[a]; const int ia = li[a];
            float cs[4]; unsigned k2[4]; int id2[4];
#pragma unroll
            for (int r = 0; r < 4; ++r) { const int b = 4 * (lane & 3) + r; cs[r] = va + lv[16 + b]; id2[r] = ia * 128 + li[16 + b]; k2[r] = sort_key(cs[r]); }
            unsigned v2 = 0u, cv2 = 256u;
            for (int bit = 31; bit >= 0; --bit) {
                const unsigned cand = v2 | (1u << bit); unsigned cnt = 0u;
#pragma unroll
                for (int r = 0; r < 4; ++r) cnt += (unsigned)__popcll(__ballot(k2[r] >= cand));
                if (cnt >= 16u) { v2 = cand; cv2 = cnt; }
                if (cv2 == 16u) break;
            }
            unsigned cg2 = 0u;
#pragma unroll
            for (int r = 0; r < 4; ++r) cg2 += (unsigned)__popcll(__ballot(k2[r] > v2));
            const unsigned need2 = 16u - cg2; unsigned gb2 = 0u, eb2 = 0u; const unsigned long long ltm64 = (1ull << lane) - 1ull;
#pragma unroll
            for (int r = 0; r < 4; ++r) {
                const bool gt = k2[r] > v2, eq = k2[r] == v2;
                const unsigned long long gm = __ballot(gt), em = __ballot(eq);
                const unsigned gp = gb2 + (unsigned)__popcll(gm & ltm64), ep = eb2 + (unsigned)__popcll(em & ltm64);
                if (gt) { l2v[gp] = cs[r]; l2i[gp] = id2[r]; }
                else if (eq && ep < need2) { l2v[cg2 + ep] = cs[r]; l2i[cg2 + ep] = id2[r]; }
                gb2 += (unsigned)__popcll(gm); eb2 += (unsigned)__popcll(em);
            }
            LDS_WAIT(); asm volatile("" ::: "memory");
            const float s = l2v[lane & 15]; const int eid = l2i[lane & 15];
            float mx = s;
#pragma unroll
            for (int o = 1; o < 16; o <<= 1) mx = fmaxf(mx, __shfl_xor(mx, o));
            const float e = __expf(s - mx); float sum = e;
#pragma unroll
            for (int o = 1; o < 16; o <<= 1) sum += __shfl_xor(sum, o);
            if (lane < 16) { IDS[(size_t)tok * 128 + hd * 16 + lane] = eid; GATES[(size_t)tok * 128 + hd * 16 + lane] = e / sum; }
            LDS_WAIT(); asm volatile("" ::: "memory");
        }
    }
}

__device__ __forceinline__ void peer_dot8(const v4u& w, const float* x, float& acc) {
    acc += bflo(w.x) * x[0]; acc += bfhi(w.x) * x[1]; acc += bflo(w.y) * x[2]; acc += bfhi(w.y) * x[3];
    acc += bflo(w.z) * x[4]; acc += bfhi(w.z) * x[5]; acc += bflo(w.w) * x[6]; acc += bfhi(w.w) * x[7];
}
__device__ __forceinline__ void peer_axpy8(const v4u& w, float a, float* y) {
    y[0] += a * bflo(w.x); y[1] += a * bfhi(w.x); y[2] += a * bflo(w.y); y[3] += a * bfhi(w.y);
    y[4] += a * bflo(w.z); y[5] += a * bfhi(w.z); y[6] += a * bflo(w.w); y[7] += a * bfhi(w.w);
}
__device__ __forceinline__ void phase_peer_gather(const Ctx& c, int layer) {
    const int gw = c.bid * NWAVES + c.wave, NGW = c.G * NWAVES;
    const int* IDS = (const int*)(c.ws + WS_M + M_IDS); const float* GATES = (const float*)(c.ws + WS_M + M_GATES);
    const bf16* TU = (const bf16*)(c.ws + WS_TABU); const bf16* TV = (const bf16*)(c.ws + WS_TABV);
    const float* gain = INP(c, I_LN2_G) + layer * DM; const float* bias = INP(c, I_LN2_B) + layer * DM;
    bf16* xb = (bf16*)(c.ws + ((layer & 1) ? WS_XB1 : WS_XB0));
    const int lane = c.lane;
    for (int tok = gw; tok < T_TOK; tok += NGW) {
        float x[16], y[16];
        load_row16(c.out + (size_t)tok * DM, x, lane);
#pragma unroll
        for (int j = 0; j < 16; ++j) y[j] = 0.f;
        const int idA = IDS[(size_t)tok * 128 + lane], idB = IDS[(size_t)tok * 128 + 64 + lane];
        const float gA = GATES[(size_t)tok * 128 + lane], gB = GATES[(size_t)tok * 128 + 64 + lane];
#pragma unroll 1
        for (int hh = 0; hh < 2; ++hh) {
            const int idv = hh ? idB : idA; const float gv = hh ? gB : gA;
#pragma unroll 1
            for (int kb = 0; kb < 64; kb += 4) {
                v4u uu[4][2], vv[4][2]; float gate[4];
#pragma unroll
                for (int e = 0; e < 4; ++e) {
                    const int id = __builtin_amdgcn_readlane(idv, kb + e); gate[e] = __builtin_bit_cast(float, __builtin_amdgcn_readlane(__builtin_bit_cast(int, gv), kb + e));
                    const bf16* ur = TU + (size_t)id * 1024 + 8 * lane; const bf16* vr = TV + (size_t)id * 1024 + 8 * lane;
                    uu[e][0] = *(const v4u*)ur; uu[e][1] = *(const v4u*)(ur + 512); vv[e][0] = *(const v4u*)vr; vv[e][1] = *(const v4u*)(vr + 512);
                }
                float d[4];
#pragma unroll
                for (int e = 0; e < 4; ++e) { d[e] = 0.f; peer_dot8(uu[e][0], x, d[e]); peer_dot8(uu[e][1], x + 8, d[e]); }
#pragma unroll
                for (int e = 0; e < 4; ++e) d[e] = wave_sum(d[e]);
#pragma unroll
                for (int e = 0; e < 4; ++e) { const float a = gelu_tanh(d[e]) * gate[e]; peer_axpy8(vv[e][0], a, y); peer_axpy8(vv[e][1], a, y + 8); }
            }
        }
#pragma unroll
        for (int j = 0; j < 16; ++j) y[j] += ALPHA_DN * x[j];
        ln_store_row(y, gain, bias, c.out + (size_t)tok * DM, xb + (size_t)tok * DM, lane);
    }
}

__device__ __forceinline__ void phase_dsa_norm(const Ctx& c, int j) {
    const int gw = c.bid * NWAVES + c.wave, NGW = c.G * NWAVES, lane = c.lane;
    const float* RAW = (const float*)(c.ws + WS_M + M_RAW);
    bf16* CQ = (bf16*)(c.ws + WS_M + M_CQ); bf16* CKV = (bf16*)(c.ws + WS_M + M_CKV); bf16* CKVT = (bf16*)(c.ws + WS_M + M_CKVT);
    bf16* KIDX = (bf16*)(c.ws + WS_M + M_KIDX); float* WIDX = (float*)(c.ws + WS_M + M_WIDX);
    const float* gq = INP(c, I_A_CQ_GAIN) + j * 256; const float* gkv = INP(c, I_A_CKV_GAIN) + j * 128;
    const float* gk = INP(c, I_A_KIDX_GAIN) + j * 64; const float* bk = INP(c, I_A_KIDX_BIAS) + j * 64;
    for (int tok = gw; tok < T_TOK; tok += NGW) {
        const f32x4 a = *(const f32x4*)(RAW + (size_t)tok * 512 + 8 * lane), b = *(const f32x4*)(RAW + (size_t)tok * 512 + 8 * lane + 4);
        float v[8] = {a[0], a[1], a[2], a[3], b[0], b[1], b[2], b[3]};
        float ss = 0.f, s = 0.f;
#pragma unroll
        for (int i = 0; i < 8; ++i) { ss += v[i] * v[i]; s += v[i]; }
        const bool isq = lane < 32, iskv = lane >= 32 && lane < 48, isk = lane >= 48 && lane < 56;
        const float ssq_q = wave_sum(isq ? ss : 0.f), ssq_kv = wave_sum(iskv ? ss : 0.f), sum_k = wave_sum(isk ? s : 0.f);
        const float mean_k = sum_k * (1.0f / 64.0f);
        float dv = 0.f;
#pragma unroll
        for (int i = 0; i < 8; ++i) { const float d = v[i] - mean_k; dv += d * d; }
        const float var_k = wave_sum(isk ? dv : 0.f) * (1.0f / 64.0f);
        if (isq) {
            const float r = 1.0f / sqrtf(ssq_q * (1.0f / 256.0f) + 1e-6f); const float* g = gq + 8 * lane;
            v4u w; w.x = pk2(v[0] * r * g[0], v[1] * r * g[1]); w.y = pk2(v[2] * r * g[2], v[3] * r * g[3]); w.z = pk2(v[4] * r * g[4], v[5] * r * g[5]); w.w = pk2(v[6] * r * g[6], v[7] * r * g[7]);
            *(v4u*)(CQ + (size_t)tok * 256 + 8 * lane) = w;
        } else if (iskv) {
            const int c0 = 8 * (lane - 32); const float r = 1.0f / sqrtf(ssq_kv * (1.0f / 128.0f) + 1e-6f); const float* g = gkv + c0;
            float o[8];
#pragma unroll
            for (int i = 0; i < 8; ++i) o[i] = v[i] * r * g[i];
            v4u w; w.x = pk2(o[0], o[1]); w.y = pk2(o[2], o[3]); w.z = pk2(o[4], o[5]); w.w = pk2(o[6], o[7]);
            *(v4u*)(CKV + (size_t)tok * 128 + c0) = w;
            const int bb = tok >> 11, sp = tok & 2047;
#pragma unroll
            for (int i = 0; i < 8; ++i) CKVT[((size_t)bb * 128 + c0 + i) * 2048 + sp] = (bf16)f2bf(o[i]);
        } else if (isk) {
            const int c0 = 8 * (lane - 48); const float r = 1.0f / sqrtf(var_k + 1e-5f);
            float o[8];
#pragma unroll
            for (int i = 0; i < 8; ++i) o[i] = (v[i] - mean_k) * r * gk[c0 + i] + bk[c0 + i];
            v4u w; w.x = pk2(o[0], o[1]); w.y = pk2(o[2], o[3]); w.z = pk2(o[4], o[5]); w.w = pk2(o[6], o[7]);
            *(v4u*)(KIDX + (size_t)tok * 64 + c0) = w;
        } else if (lane == 56) {
            const float sc = 0.35355339059327373f;
            f32x4 o0 = {v[0] * sc, v[1] * sc, v[2] * sc, v[3] * sc}, o1 = {v[4] * sc, v[5] * sc, v[6] * sc, v[7] * sc};
            *(f32x4*)(WIDX + (size_t)tok * 8) = o0; *(f32x4*)(WIDX + (size_t)tok * 8 + 4) = o1;
        }
    }
}

__device__ __forceinline__ void phase_dsa_index(const Ctx& c) {
    const bf16* KIDX = (const bf16*)(c.ws + WS_M + M_KIDX); const bf16* QIDX = (const bf16*)(c.ws + WS_M + M_QIDX);
    const float* WIDX = (const float*)(c.ws + WS_M + M_WIDX); unsigned* MASK = (unsigned*)(c.ws + WS_M + M_MASK);
    const int lane = c.lane, n = lane & 31, h = lane >> 5;
    const unsigned ltmask = (1u << n) - 1u;
    LAS unsigned* kl = (LAS unsigned*)(c.lds + c.wave * 16384) + lane * 4;
    for (int u = c.bid; u < 2048; u += c.G) {
        const int b = u & 31, rest = u >> 5, qc = rest >> 1, sub = rest & 1;
        const int tw0 = b * 2048 + qc * 64 + sub * 32 + 4 * c.wave;
        const int nt = 2 * (qc + 1), ng = (nt + 3) >> 2;
        if (nt <= 8) {
            if (n == 0) {
                for (int tt = 0; tt < 2; ++tt)
                    for (int tile = 0; tile < nt; ++tile) MASK[(size_t)(tw0 + 2 * h + tt) * 64 + tile] = 0xffffffffu;
            }
            continue;
        }
        const int ti = 2 * ((n >> 2) & 1) + (n >> 4), hd = 4 * ((n >> 3) & 1) + (n & 3);
        bf16x8 Aq[4];
#pragma unroll
        for (int s = 0; s < 4; ++s) Aq[s] = *(const bf16x8*)(QIDX + (size_t)(tw0 + ti) * 512 + hd * 64 + 16 * s + 8 * h);
#pragma unroll 1
        for (int tt = 0; tt < 2; ++tt) {
            const int tok = tw0 + 2 * h + tt;
            float wv[8];
            { const f32x4 w0 = *(const f32x4*)(WIDX + (size_t)tok * 8), w1 = *(const f32x4*)(WIDX + (size_t)tok * 8 + 4);
#pragma unroll
              for (int i = 0; i < 4; ++i) { wv[i] = w0[i]; wv[4 + i] = w1[i]; } }
            const bf16* kbase = KIDX + (size_t)(b * 2048 + n) * 64 + 8 * h;
#pragma unroll 2
            for (int tile = 0; tile < nt; ++tile) {
                const bf16* kr = kbase + (size_t)tile * 32 * 64;
                f32x16 acc;
#pragma unroll
                for (int i = 0; i < 16; ++i) acc[i] = 0.f;
                bf16x8 Bk[4];
#pragma unroll
                for (int s = 0; s < 4; ++s) Bk[s] = *(const bf16x8*)(kr + 16 * s);
#pragma unroll
                for (int s = 0; s < 4; ++s) acc = __builtin_amdgcn_mfma_f32_32x32x16_bf16(Aq[s], Bk[s], acc, 0, 0, 0);
                float sc0 = 0.f, sc1 = 0.f;
#pragma unroll
                for (int jj = 0; jj < 2; ++jj)
#pragma unroll
                    for (int k = 0; k < 4; ++k) { sc0 += wv[4 * jj + k] * fmaxf(acc[4 * jj + k], 0.f); sc1 += wv[4 * jj + k] * fmaxf(acc[8 + 4 * jj + k], 0.f); }
                kl[(tile >> 2) * 256 + (tile & 3)] = sort_key(tt ? sc1 : sc0) >> 1;
            }
            if (nt & 2) { kl[(nt >> 2) * 256 + 2] = 0u; kl[(nt >> 2) * 256 + 3] = 0u; }
            LDS_WAIT(); asm volatile("" ::: "memory");
            unsigned v = 0u, cv = 0xffffu;
            for (int bit = 30; bit >= 0; --bit) {
                const unsigned cand = v | (1u << bit); unsigned lt = 0u;
                for (int g = 0; g < ng; ++g) { const v4u k4 = *(const LAS v4u*)(kl + g * 256);
                    lt += ((unsigned)((int)(k4.x - cand)) >> 31) + ((unsigned)((int)(k4.y - cand)) >> 31) + ((unsigned)((int)(k4.z - cand)) >> 31) + ((unsigned)((int)(k4.w - cand)) >> 31); }
                unsigned cnt = 4u * (unsigned)ng - lt;
#pragma unroll
                for (int o = 1; o < 32; o <<= 1) cnt += __shfl_xor(cnt, o);
                if (cnt >= 256u) { v = cand; cv = cnt; }
                if (__all(cv == 256u)) break;
            }
            unsigned cgt = 0u;
            for (int g = 0; g < ng; ++g) { const v4u k4 = *(const LAS v4u*)(kl + g * 256);
                cgt += ((unsigned)((int)(v - k4.x)) >> 31) + ((unsigned)((int)(v - k4.y)) >> 31) + ((unsigned)((int)(v - k4.z)) >> 31) + ((unsigned)((int)(v - k4.w)) >> 31); }
#pragma unroll
            for (int o = 1; o < 32; o <<= 1) cgt += __shfl_xor(cgt, o);
            const unsigned need = 256u - cgt; unsigned ebase = 0u;
            for (int tile = 0; tile < nt; ++tile) {
                const unsigned key = kl[(tile >> 2) * 256 + (tile & 3)];
                const bool gt = key > v, eq = key == v;
                const unsigned em = half_sel(__ballot(eq), h);
                const bool take = gt || (eq && (ebase + __popc(em & ltmask) < need));
                ebase += __popc(em);
                const unsigned word = half_sel(__ballot(take), h);
                if (n == 0) MASK[(size_t)tok * 64 + tile] = word;
            }
            LDS_WAIT(); asm volatile("" ::: "memory");
        }
    }
}

__device__ __forceinline__ void phase_dsa_attn(const Ctx& c) {
    const bf16* CKV = (const bf16*)(c.ws + WS_M + M_CKV); const bf16* CKVT = (const bf16*)(c.ws + WS_M + M_CKVT);
    bf16* QLAT = (bf16*)(c.ws + WS_M + M_QLAT); const unsigned* MASK = (const unsigned*)(c.ws + WS_M + M_MASK);
    const int lane = c.lane, n = lane & 31, h = lane >> 5, tt = n >> 4, head = n & 15;
    for (int u = c.bid; u < 4096; u += c.G) {
        const int b = u & 31, rest = u >> 5, qc = rest >> 2, sub = rest & 3;
        const int tokq = b * 2048 + qc * 64 + sub * 16 + 2 * c.wave + tt;
        const int nt = 2 * (qc + 1);
        bf16x8 Bq[8];
#pragma unroll
        for (int s = 0; s < 8; ++s) Bq[s] = *(const bf16x8*)(QLAT + (size_t)tokq * 2048 + head * 128 + 16 * s + 8 * h);
        float m_run = -INFINITY, l_run = 0.f;
        f32x16 O[4];
#pragma unroll
        for (int dt = 0; dt < 4; ++dt)
#pragma unroll
            for (int i = 0; i < 16; ++i) O[dt][i] = 0.f;
#pragma unroll 1
        for (int tile = 0; tile < nt; ++tile) {
            const int key0 = b * 2048 + 32 * tile;
            const unsigned mw = MASK[(size_t)tokq * 64 + tile];
            f32x16 S;
#pragma unroll
            for (int i = 0; i < 16; ++i) S[i] = 0.f;
            const bf16* kr = CKV + (size_t)(key0 + n) * 128 + 8 * h;
#pragma unroll
            for (int s = 0; s < 8; ++s) { const bf16x8 Ak = *(const bf16x8*)(kr + 16 * s); S = __builtin_amdgcn_mfma_f32_32x32x16_bf16(Ak, Bq[s], S, 0, 0, 0); }
            float mx = -INFINITY;
#pragma unroll
            for (int i = 0; i < 16; ++i) { const int kb = 8 * (i >> 2) + 4 * h + (i & 3); const bool ok = (mw >> kb) & 1u; S[i] = ok ? S[i] : -INFINITY; mx = fmaxf(mx, S[i]); }
            mx = fmaxf(mx, __shfl_xor(mx, 32));
            const float m_new = fmaxf(m_run, mx); const float m_use = (m_new == -INFINITY) ? 0.f : m_new;
            const float alpha = __expf(m_run - m_use);
            float p[16], ps = 0.f;
#pragma unroll
            for (int i = 0; i < 16; ++i) { p[i] = __expf(S[i] - m_use); ps += p[i]; }
            l_run = l_run * alpha + ps; m_run = m_new;
#pragma unroll
            for (int dt = 0; dt < 4; ++dt)
#pragma unroll
                for (int i = 0; i < 16; ++i) O[dt][i] *= alpha;
            bf16x8 Bp[2];
#pragma unroll
            for (int s = 0; s < 2; ++s) { v4u w; w.x = pk2(p[8 * s + 0], p[8 * s + 1]); w.y = pk2(p[8 * s + 2], p[8 * s + 3]); w.z = pk2(p[8 * s + 4], p[8 * s + 5]); w.w = pk2(p[8 * s + 6], p[8 * s + 7]);
                Bp[s] = __builtin_bit_cast(bf16x8, w); }
#pragma unroll
            for (int dt = 0; dt < 4; ++dt) {
                const bf16* vr = CKVT + ((size_t)b * 128 + 32 * dt + n) * 2048 + 32 * tile + 4 * h;
#pragma unroll
                for (int s = 0; s < 2; ++s) {
                    const v2u lo = *(const v2u*)(vr + 16 * s), hi = *(const v2u*)(vr + 16 * s + 8);
                    v4u w; w.x = lo.x; w.y = lo.y; w.z = hi.x; w.w = hi.y;
                    O[dt] = __builtin_amdgcn_mfma_f32_32x32x16_bf16(__builtin_bit_cast(bf16x8, w), Bp[s], O[dt], 0, 0, 0);
                }
            }
        }
        const float l_tot = l_run + __shfl_xor(l_run, 32); const float inv = 1.0f / l_tot;
#pragma unroll
        for (int dt = 0; dt < 4; ++dt)
#pragma unroll
            for (int j4 = 0; j4 < 4; ++j4) {
                v2u w; w.x = pk2(O[dt][4 * j4 + 0] * inv, O[dt][4 * j4 + 1] * inv); w.y = pk2(O[dt][4 * j4 + 2] * inv, O[dt][4 * j4 + 3] * inv);
                *(v2u*)(QLAT + (size_t)tokq * 2048 + head * 128 + 32 * dt + 8 * j4 + 4 * h) = w;
            }
    }
}

__device__ __forceinline__ void phase_rglru(const Ctx& c) {
    const bf16* GU = (const bf16*)(c.ws + WS_M + M_GU); bf16* Y = (bf16*)(c.ws + WS_M + M_Y);
    LAS float* wA = (LAS float*)c.lds;
    LAS float* wX = wA + 6400;
    LAS float* ut = wX + 6400;
    LAS float* cv = ut + 5360;
    LAS float* bs = cv + 5120;
    LAS float* cst = bs + 5120;
    const int tid = c.tid;
    for (int u = c.bid; u < 512; u += c.G) {
        const int b = u >> 4, nb = u & 15, ch0 = nb * 80;
        __syncthreads();
        for (int e = tid; e < 6400; e += NTHR) { wA[e] = INP(c, I_B_W_A)[(size_t)nb * 6400 + e]; wX[e] = INP(c, I_B_W_X)[(size_t)nb * 6400 + e]; }
        if (tid < 80) {
            const int cc = ch0 + tid;
#pragma unroll
            for (int j = 0; j < 4; ++j) cst[j * 80 + tid] = INP(c, I_B_CONV_W)[j * 1280 + cc];
            cst[320 + tid] = INP(c, I_B_CONV_B)[cc]; cst[400 + tid] = INP(c, I_B_B_A)[cc]; cst[480 + tid] = INP(c, I_B_B_X)[cc];
            cst[560 + tid] = log1pf(expf(-INP(c, I_B_LAMBDA)[cc]));
            cst[640 + tid] = 0.f;
        }
        for (int chunk = 0; chunk < 32; ++chunk) {
            const int t0 = b * 2048 + chunk * 64;
            __syncthreads();
            for (int e = tid; e < 67 * 80; e += NTHR) { const int i = e / 80, cc = e % 80; const int sp = chunk * 64 - 3 + i;
                ut[e] = sp >= 0 ? bf2f(GU[(size_t)(b * 2048 + sp) * 2560 + 1280 + ch0 + cc]) : 0.f; }
            __syncthreads();
            for (int e = tid; e < 5120; e += NTHR) { const int t = e / 80, cc = e % 80;
                float s = cst[320 + cc];
#pragma unroll
                for (int j = 0; j < 4; ++j) s += ut[(t + j) * 80 + cc] * cst[j * 80 + cc];
                cv[e] = s; }
            __syncthreads();
            if (tid < 480) {
                const int cc = tid % 80, tg = tid / 80;
                float aa[11], ax[11];
#pragma unroll
                for (int i = 0; i < 11; ++i) { aa[i] = 0.f; ax[i] = 0.f; }
                for (int k = 0; k < 80; ++k) {
                    const float wa = wA[k * 80 + cc], wx = wX[k * 80 + cc];
#pragma unroll
                    for (int i = 0; i < 11; ++i) { const int t = tg + 6 * i; const float v = cv[(t < 64 ? t : 63) * 80 + k]; aa[i] += v * wa; ax[i] += v * wx; }
                }
                const float ba = cst[400 + cc], bx = cst[480 + cc], sp = cst[560 + cc];
#pragma unroll
                for (int i = 0; i < 11; ++i) { const int t = tg + 6 * i;
                    if (t < 64) {
                        const float r = sigmoidf_(aa[i] + ba), ig = sigmoidf_(ax[i] + bx);
                        const float log_a = -8.0f * r * sp; const float a = expf(log_a);
                        const float bb = sqrtf(-expm1f(2.0f * log_a)) * (ig * cv[t * 80 + cc]);
                        ut[t * 80 + cc] = a; bs[t * 80 + cc] = bb;
                    } }
            }
            __syncthreads();
            if (tid < 80) {
                float hcar = cst[640 + tid];
#pragma unroll 4
                for (int t = 0; t < 64; ++t) { hcar = ut[t * 80 + tid] * hcar + bs[t * 80 + tid]; bs[t * 80 + tid] = hcar; }
                cst[640 + tid] = hcar;
            }
            __syncthreads();
            for (int e = tid; e < 5120; e += NTHR) { const int t = e / 80, cc = e % 80;
                const float g = bf2f(GU[(size_t)(t0 + t) * 2560 + ch0 + cc]);
                Y[(size_t)(t0 + t) * 1280 + ch0 + cc] = (bf16)f2bf(g * bs[e]); }
        }
    }
}

template <int OFF0, int OFF1>
__device__ __forceinline__ void tr_read2(unsigned a, v2u& r0, v2u& r1) {
    asm volatile("ds_read_b64_tr_b16 %0, %2 offset:%3\n\tds_read_b64_tr_b16 %1, %2 offset:%4\n\ts_waitcnt lgkmcnt(0)" : "=&v"(r0), "=&v"(r1) : "v"(a), "n"(OFF0), "n"(OFF1) : "memory");
}
__device__ __forceinline__ void phase_ret_core(const Ctx& c) {
    const bf16* Qg = (const bf16*)(c.ws + WS_M + M_Q); const bf16* Kg = (const bf16*)(c.ws + WS_M + M_K); bf16* Vg = (bf16*)(c.ws + WS_M + M_V);
    float* STAT = (float*)(c.ws + WS_M + M_STAT);
    constexpr int RS = 528, SS = 144, QS_OFF = 0, KS_OFF = 64 * RS, VS_OFF = 2 * 64 * RS, SS_OFF = 3 * 64 * RS;
    LAS unsigned char* L = c.lds; const unsigned lbase = (unsigned)(size_t)c.lds;
    const int tid0 = c.tid, w = c.wave;
    for (int u = c.bid; u < 256; u += c.G) {
        const int b = u >> 3, hh = (u >> 1) & 3, eh = u & 1;
        const float gam = 1.0f - exp2f(-5.0f - (float)hh); const float lg0 = log2f(gam);
        f32x16 R[8];
#pragma unroll
        for (int dt = 0; dt < 8; ++dt)
#pragma unroll
            for (int i = 0; i < 16; ++i) R[dt][i] = 0.f;
        const float cdec = exp2f(lg0 * 64.0f);
#pragma unroll 1
        for (int chunk = 0; chunk < 32; ++chunk) {
            const int t0 = b * 2048 + chunk * 64;
            float lg = lg0; int tid = tid0; asm volatile("" : "+v"(lg), "+v"(tid));
            const int lane = tid & 63, n = lane & 31, h = lane >> 5, hl = h;
            const int blk = (lane >> 4) & 1, q4 = (lane & 15) >> 2, p4 = lane & 3;
            const unsigned trbK = lbase + (8 * h + q4) * RS + (16 * blk + 4 * p4) * 2;
            const unsigned trbV = trbK + VS_OFF + 64 * w;
            __syncthreads();
#pragma unroll
            for (int i = 0; i < 4; ++i) { const int e = tid + NTHR * i, row = e >> 5, ch = e & 31;
                *(LAS v4u*)(L + QS_OFF + row * RS + ch * 16) = *(const v4u*)(Qg + (size_t)(t0 + row) * 1024 + hh * 256 + ch * 8);
                *(LAS v4u*)(L + KS_OFF + row * RS + ch * 16) = *(const v4u*)(Kg + (size_t)(t0 + row) * 1024 + hh * 256 + ch * 8); }
            asm volatile("" ::: "memory");
#pragma unroll
            for (int i = 0; i < 4; ++i) { const int e = tid + NTHR * i, row = e >> 5, ch = e & 31;
                *(LAS v4u*)(L + VS_OFF + row * RS + ch * 16) = *(const v4u*)(Vg + (size_t)(t0 + row) * 2048 + hh * 512 + eh * 256 + ch * 8); }
            __syncthreads();
            {
                const int i16 = w >> 1, l15 = lane & 15, g4 = lane >> 4; const int l15d = l15, g4d = g4;
                bf16x8 Af[8];
#pragma unroll
                for (int s = 0; s < 8; ++s) Af[s] = *(const LAS bf16x8*)(L + QS_OFF + (16 * i16 + l15) * RS + (32 * s + 8 * g4) * 2);
#pragma unroll
                for (int jj = 0; jj < 2; ++jj) { const int j16 = 2 * (w & 1) + jj;
                    f32x4 acc = {0.f, 0.f, 0.f, 0.f};
                    if (j16 <= i16) {
#pragma unroll
                        for (int s = 0; s < 8; ++s) { const bf16x8 Bf = *(const LAS bf16x8*)(L + KS_OFF + (16 * j16 + l15) * RS + (32 * s + 8 * g4) * 2);
                            acc = __builtin_amdgcn_mfma_f32_16x16x32_bf16(Af[s], Bf, acc, 0, 0, 0); }
                    }
                    const int ja = 16 * j16 + l15, jad = 16 * j16 + l15d;
#pragma unroll
                    for (int r = 0; r < 4; ++r) { const int ia = 16 * i16 + 4 * g4 + r, iad = 16 * i16 + 4 * g4d + r; const float dec = (iad >= jad) ? exp2f(lg * (float)(iad - jad)) : 0.f;
                        *(LAS bf16*)(L + SS_OFF + ia * SS + ja * 2) = (bf16)f2bf(acc[r] * dec); }
                }
            }
            __syncthreads();
            bf16x8 Vf[4];
#define RC_VF(ks) { v2u r0, r1; tr_read2<16 * (ks) * RS, 16 * (ks) * RS + 4 * RS>(trbV, r0, r1); v4u wv; wv.x = r0.x; wv.y = r0.y; wv.z = r1.x; wv.w = r1.y; Vf[ks] = __builtin_bit_cast(bf16x8, wv); }
            RC_VF(0) RC_VF(1) RC_VF(2) RC_VF(3)
#undef RC_VF
            {
                f32x16 Oa[2];
#pragma unroll
                for (int it = 0; it < 2; ++it)
#pragma unroll
                    for (int i = 0; i < 16; ++i) Oa[it][i] = 0.f;
#pragma unroll
                for (int dt = 0; dt < 8; ++dt)
#pragma unroll
                    for (int s = 0; s < 2; ++s) {
                        v4u bw; bw.x = pk2(R[dt][8 * s + 0], R[dt][8 * s + 1]); bw.y = pk2(R[dt][8 * s + 2], R[dt][8 * s + 3]); bw.z = pk2(R[dt][8 * s + 4], R[dt][8 * s + 5]); bw.w = pk2(R[dt][8 * s + 6], R[dt][8 * s + 7]);
#pragma unroll
                        for (int it = 0; it < 2; ++it) {
                            const LAS unsigned char* qrow = L + QS_OFF + (32 * it + n) * RS;
                            const v2u lo = *(const LAS v2u*)(qrow + (32 * dt + 16 * s + 4 * h) * 2), hi = *(const LAS v2u*)(qrow + (32 * dt + 16 * s + 8 + 4 * h) * 2);
                            v4u aw; aw.x = lo.x; aw.y = lo.y; aw.z = hi.x; aw.w = hi.y;
                            Oa[it] = __builtin_amdgcn_mfma_f32_32x32x16_bf16(__builtin_bit_cast(bf16x8, aw), __builtin_bit_cast(bf16x8, bw), Oa[it], 0, 0, 0);
                        }
                    }
#pragma unroll
                for (int it = 0; it < 2; ++it) {
#pragma unroll
                    for (int i = 0; i < 16; ++i) { const int ia = 32 * it + 8 * (i >> 2) + 4 * h + (i & 3); Oa[it][i] *= exp2f(lg * (float)(32 * it + 8 * (i >> 2) + 4 * hl + (i & 3) + 1)); }
#pragma unroll
                    for (int ks = 0; ks < 4; ++ks) if (ks < 2 * (it + 1)) {
                        const bf16x8 Sf = *(const LAS bf16x8*)(L + SS_OFF + (32 * it + n) * SS + (16 * ks + 8 * h) * 2);
                        Oa[it] = __builtin_amdgcn_mfma_f32_32x32x16_bf16(Sf, Vf[ks], Oa[it], 0, 0, 0);
                    }
#pragma unroll
                    for (int i = 0; i < 16; ++i) { const int ia = 32 * it + 8 * (i >> 2) + 4 * h + (i & 3);
                        *(LAS bf16*)(L + VS_OFF + ia * RS + (32 * w + n) * 2) = (bf16)f2bf(Oa[it][i]); }
                }
            }
            bf16x8 Vs2[4];
#pragma unroll
            for (int ks = 0; ks < 4; ++ks) { const v4u wv = __builtin_bit_cast(v4u, Vf[ks]); float f[8] = {bflo(wv.x), bfhi(wv.x), bflo(wv.y), bfhi(wv.y), bflo(wv.z), bfhi(wv.z), bflo(wv.w), bfhi(wv.w)};
#pragma unroll
                for (int j = 0; j < 8; ++j) { const int key = 16 * ks + 8 * hl + j; f[j] *= exp2f(lg * (float)(63 - key)); }
                v4u o; o.x = pk2(f[0], f[1]); o.y = pk2(f[2], f[3]); o.z = pk2(f[4], f[5]); o.w = pk2(f[6], f[7]); Vs2[ks] = __builtin_bit_cast(bf16x8, o); }
#define RC_KS(dt, ks) { v2u r0, r1; tr_read2<KS_OFF + 16 * (ks) * RS + 64 * (dt), KS_OFF + 16 * (ks) * RS + 64 * (dt) + 4 * RS>(trbK, r0, r1); \
                v4u aw; aw.x = r0.x; aw.y = r0.y; aw.z = r1.x; aw.w = r1.y; R[dt] = __builtin_amdgcn_mfma_f32_32x32x16_bf16(__builtin_bit_cast(bf16x8, aw), Vs2[ks], R[dt], 0, 0, 0); }
#define RC_DT(dt) { _Pragma("unroll") for (int i = 0; i < 16; ++i) R[dt][i] *= cdec; RC_KS(dt, 0) RC_KS(dt, 1) RC_KS(dt, 2) RC_KS(dt, 3) }
            RC_DT(0) RC_DT(1) RC_DT(2) RC_DT(3) RC_DT(4) RC_DT(5) RC_DT(6) RC_DT(7)
#undef RC_DT
#undef RC_KS
            __syncthreads();
#pragma unroll
            for (int i = 0; i < 4; ++i) { const int e = tid + NTHR * i, row = e >> 5, ch = e & 31;
                const v4u ov = *(const LAS v4u*)(L + VS_OFF + row * RS + ch * 16);
                *(v4u*)(Vg + (size_t)(t0 + row) * 2048 + hh * 512 + eh * 256 + ch * 8) = ov;
                const float f[8] = {bflo(ov.x), bfhi(ov.x), bflo(ov.y), bfhi(ov.y), bflo(ov.z), bfhi(ov.z), bflo(ov.w), bfhi(ov.w)};
                float s = 0.f, s2 = 0.f;
#pragma unroll
                for (int j = 0; j < 8; ++j) { s += f[j]; s2 += f[j] * f[j]; }
#pragma unroll
                for (int o = 1; o < 32; o <<= 1) { s += __shfl_xor(s, o); s2 += __shfl_xor(s2, o); }
                if ((tid & 31) == 0) { f32x2 st = {s, s2}; *(f32x2*)(STAT + (size_t)(t0 + row) * 16 + hh * 4 + eh * 2) = st; }
            }
        }
    }
}

__host__ __device__ __forceinline__ bool slot_active(int kind, int s) {
    if (s == 2) return kind != 1;
    if (s == 3 || s == 4) return kind == 0;
    return true;
}

#ifndef MK_EN
#define MK_EN 0xffffffffu
#endif
#define EN(b) ((MK_EN >> (b)) & 1u)
__global__ void __launch_bounds__(NTHR, 2) mk_fwd(Params p) {
    extern __shared__ __attribute__((aligned(16))) unsigned char lds_raw[];
    Ctx c;
    c.lds = (LAS unsigned char*)lds_raw; c.tid = threadIdx.x; c.lane = c.tid & 63; c.wave = __builtin_amdgcn_readfirstlane(c.tid >> 6);
    c.bid = blockIdx.x; c.G = gridDim.x; c.in = (InTab)(unsigned long)__builtin_amdgcn_kernarg_segment_ptr(); c.out = p.out; c.ws = p.ws;
    volatile LAS unsigned* MISC = (volatile LAS unsigned*)(c.lds + MISC_OFF);
    for (int u = c.tid; u < (LDS_BYTES - LDSCTL_OFF) / 4; u += NTHR) ((LAS unsigned*)(c.lds + LDSCTL_OFF))[u] = 0u;
    __syncthreads();
    const bool one = (p.flags & 1) != 0;
    XcdBarrier bar; bar.bar = (unsigned*)(p.ws + WS_CTL) + CW_BAR; bar.x = 0; bar.st = MISC + 8;
    if (one) bar = xcd_barrier_post((unsigned*)(p.ws + WS_CTL) + CW_BAR, MISC + 8);
    const int lo = p.ph_lo, hi = p.ph_hi;
#define IN(k) (lo <= (k) && (k) < hi)
#define LCTX() Ctx cl = c; { unsigned long k_ = (unsigned long)__builtin_amdgcn_kernarg_segment_ptr(); unsigned long w_ = (unsigned long)p.ws, o_ = (unsigned long)p.out; int t_ = threadIdx.x; asm volatile("" : "+s"(k_), "+s"(w_), "+s"(o_), "+v"(t_)); cl.tid = t_; cl.lane = t_ & 63; cl.wave = __builtin_amdgcn_readfirstlane(t_ >> 6); cl.in = (InTab)k_; cl.ws = (unsigned char*)(GAS unsigned char*)w_; cl.out = (float*)(GAS float*)o_; } unsigned char* ws = cl.ws; (void)ws
#define SEAM(k) do { if (one && IN(k) && (k) + 1 < hi) xcd_barrier(bar); } while (0)
    if (EN(0) && IN(0)) { LCTX(); phase_prologue(cl); }
    SEAM(0);
#pragma unroll 1
    for (int layer = 0; layer < 4; ++layer) {
        const int kind = layer % 3, j = layer / 3, base = 1 + layer * NPH_LAYER;
        const size_t xin_off = (layer & 1) ? WS_XB1 : WS_XB0, xnext_off = (layer & 1) ? WS_XB0 : WS_XB1;
#define xin ((const bf16*)(ws + xin_off))
#define xnext ((bf16*)(ws + xnext_off))
        if (IN(base + 0)) { LCTX();
            if (EN(1) && kind == 0) { pg8::EpiF32 E{(float*)(ws + WS_M + M_RAW), 512, nullptr};
                run_gemm(cl, xin, (const bf16*)(ws + WS_WAIN) + (size_t)j * 512 * 1024, 512, 1024, E); }
            else if (EN(2) && kind == 1) { bf16* GU = (bf16*)(ws + WS_M + M_GU); EpiBf16R<1> E{GU, GU + 1280, GU + 1280, 2560, 2560, 2560, 1280, 1 << 30};
                run_gemm(cl, xin, (const bf16*)(ws + WS_WBIN), 2560, 1024, E); }
            else if (EN(3) && kind == 2) { EpiRetIn E{(bf16*)(ws + WS_M + M_Q), (bf16*)(ws + WS_M + M_K), (bf16*)(ws + WS_M + M_V), (const float*)(ws + WS_ROT), (const float*)(ws + WS_ROT) + 2048 * 128};
                run_gemm(cl, xin, (const bf16*)(ws + WS_WCIN), 4096, 1024, E); }
        }
        SEAM(base + 0);
        if (IN(base + 1)) { LCTX();
            if (EN(4) && kind == 0) phase_dsa_norm(cl, j);
            else if (EN(5) && kind == 1) phase_rglru(cl);
            else if (EN(6) && kind == 2) phase_ret_core(cl);
        }
        SEAM(base + 1);
        if (IN(base + 2) && kind != 1) { LCTX();
            if (EN(7) && kind == 0) { EpiBf16R<0> E{(bf16*)(ws + WS_M + M_QLAT), (bf16*)(ws + WS_M + M_QIDX), (bf16*)(ws + WS_M + M_QIDX), 2048, 512, 512, 2048, 1 << 30};
                run_gemm(cl, (const bf16*)(ws + WS_M + M_CQ), (const bf16*)(ws + WS_WAQ + j * WAQ_STRIDE), 2560, 256, E); }
            else if (EN(8) && kind == 2) { EpiRetGate E{(bf16*)(ws + WS_M + M_V), (const float*)(ws + WS_M + M_STAT)};
                run_gemm(cl, xin, (const bf16*)(ws + WS_WCIN) + (size_t)4096 * 1024, 2048, 1024, E); }
        }
        if (kind != 1) SEAM(base + 2);
        if (EN(9) && IN(base + 3) && kind == 0) { LCTX(); phase_dsa_index(cl); }
        if (kind == 0) SEAM(base + 3);
        if (EN(10) && IN(base + 4) && kind == 0) { LCTX(); phase_dsa_attn(cl); }
        if (kind == 0) SEAM(base + 4);
        if (EN(11) && IN(base + 5)) { LCTX();
            const bf16* A = (const bf16*)(ws + WS_M + (kind == 0 ? M_QLAT : (kind == 1 ? M_Y : M_V)));
            const bf16* Bt = kind == 0 ? (const bf16*)(ws + WS_WAOV) + (size_t)j * 1024 * 2048 : (kind == 1 ? (const bf16*)(ws + WS_WBO) : (const bf16*)(ws + WS_WCO));
            const int K = kind == 1 ? 1280 : 2048;
            EpiResid E{cl.out, ALPHA_DN};
            run_gemm(cl, A, Bt, 1024, K, E);
        }
        SEAM(base + 5);
        if (EN(12) && IN(base + 6)) { LCTX(); phase_ln1(cl, layer); }
        SEAM(base + 6);
        if (EN(13) && IN(base + 7)) { LCTX(); pg8::EpiF32 E{(float*)(ws + WS_M + M_SC), 2048, nullptr};
            run_gemm(cl, xin, (const bf16*)(ws + WS_WPEER) + (size_t)layer * 2048 * 1024, 2048, 1024, E); }
        SEAM(base + 7);
        if (EN(14) && IN(base + 8)) { LCTX(); phase_peer_topk(cl); }
        SEAM(base + 8);
        if (EN(15) && IN(base + 9)) { LCTX(); phase_peer_gather(cl, layer); }
        SEAM(base + 9);
        if (EN(16) && IN(base + 10)) { LCTX(); bf16* PP = (bf16*)(ws + WS_M + M_PP); EpiBf16R<0> E{PP, PP, PP, 1024, 1024, 1024, 1 << 30, 1 << 30};
            run_gemm(cl, (const bf16*)(ws + WS_M + M_PB), (const bf16*)(ws + WS_WPLEP) + (size_t)layer * 1024 * 256, 1024, 256, E); }
        SEAM(base + 10);
        if (EN(17) && IN(base + 11)) { LCTX(); EpiPle E{cl.out, (const bf16*)(ws + WS_M + M_PP), xnext, INP(cl, I_PLE_BG) + layer * DM};
            run_gemm(cl, xin, (const bf16*)(ws + WS_WPLEG) + (size_t)layer * 1024 * 1024, 1024, 1024, E); }
        SEAM(base + 11);
    }
#undef IN
#undef SEAM
#undef xin
#undef xnext
#undef LCTX
}

#if MK_CHECK
#include "CHECKS_PLACEHOLDER"
#endif

extern "C" void kernel_launch(void* const* d_in, const int* in_sizes, int n_in, void* d_out, int out_size, void* d_ws, size_t ws_size, hipStream_t stream) {
    static int grid = 0;
    if (grid == 0) {
        if (n_in != N_IN || out_size != T_TOK * DM || ws_size < WS_END) { fprintf(stderr, "kernel_launch: unexpected shapes (n_in %d out %d ws %zu need %zu)\n", n_in, out_size, ws_size, (size_t)WS_END); grid = -1; return; }
        int dev = 0, cus = 0, per_cu = 0;
        if (hipGetDevice(&dev) != hipSuccess || hipDeviceGetAttribute(&cus, hipDeviceAttributeMultiprocessorCount, dev) != hipSuccess) { grid = -1; return; }
        if (hipFuncSetAttribute((const void*)mk_fwd, hipFuncAttributeMaxDynamicSharedMemorySize, LDS_BYTES) != hipSuccess) { fprintf(stderr, "hipFuncSetAttribute failed\n"); grid = -1; return; }
        if (hipOccupancyMaxActiveBlocksPerMultiprocessor(&per_cu, (const void*)mk_fwd, NTHR, LDS_BYTES) != hipSuccess || per_cu < 1) { fprintf(stderr, "occupancy query: %d\n", per_cu); }
        (void)hipGetLastError();
        grid = cus;
    }
    if (grid < 0) return;
    (void)hipMemsetAsync((char*)d_ws + WS_CTL, 0, CTL_BYTES, stream);
    Params p{};
    for (int i = 0; i < N_IN; ++i) p.in[i] = (const float*)d_in[i];
    p.out = (float*)d_out; p.ws = (unsigned char*)d_ws; p.pad = 0;
#if MK_ONE_LAUNCH
    p.ph_lo = 0; p.ph_hi = N_PHASES; p.flags = 1;
    hipLaunchKernelGGL(mk_fwd, dim3(grid), dim3(NTHR), LDS_BYTES, stream, p);
#else
    p.flags = 0;
    for (int ph = 0; ph < N_PHASES; ++ph) {
        if (ph > 0) { const int layer = (ph - 1) / NPH_LAYER, s = (ph - 1) % NPH_LAYER; if (!slot_active(layer % 3, s)) continue; }
        p.ph_lo = ph; p.ph_hi = ph + 1;
#if MK_CHECK
        check_pre(ph, p, grid, stream);
#endif
        hipLaunchKernelGGL(mk_fwd, dim3(grid), dim3(NTHR), LDS_BYTES, stream, p);
#if MK_CHECK
        check_post(ph, p, grid, stream);
#endif
    }
#if MK_CHECK
    check_report(p, stream);
#endif
#endif
}
```

```cpp
#define MK_CHECK 0
#define MK_ONE_LAUNCH 1
#include <cstdio>
#include <cmath>
#include <type_traits>
#include <hip/hip_runtime.h>
namespace pg8 {
#define PG8_LAS __attribute__((address_space(3)))
typedef unsigned short bf16_t;
typedef short bf16x8 __attribute__((ext_vector_type(8)));
typedef float f32x4 __attribute__((ext_vector_type(4)));
typedef unsigned u32x4 __attribute__((ext_vector_type(4)));
constexpr int BM = 256, BK = 64, HALF = 128, HTB = HALF * BK * 2  , STAGE_BYTES = 8 * HTB, NXCD = 8, WGM = 8;

__host__ __device__ __forceinline__ int lds_byte(int r, int c) { const int st = (r >> 4) * 2 + (c >> 5), rr = r & 15, cc = c & 31, ob = rr * 64 + cc * 2; return st * 1024 + (ob ^ (((ob >> 9) & 1) << 5)); }
__host__ __device__ __forceinline__ void stage_rc(int b, int& R, int& C) { const int st = b / 1024, sb = b % 1024, swz = sb ^ (((sb >> 9) & 1) << 5); R = (st >> 1) * 16 + swz / 64; C = (st & 1) * 32 + (swz % 64) / 2; }
__host__ __device__ __forceinline__ int perm32(int rho) { const int n = rho >> 4, i = rho & 15; return 8 * (i >> 2) + 4 * n + (i & 3); }

struct Unit { int pm, pn; };
struct Gemm { const bf16_t* A; const bf16_t* Bt; int M, N, K; };

struct StaticOrder {
    int nM, nN, nwg, G, c;
    __host__ __device__ void init(int M, int N, int G_, int c_) { nM = M / BM; nN = N / BM; nwg = nM * nN; G = G_; c = c_; }
    __host__ __device__ bool next(int i, Unit& u) const {
        const long L = (long)i * G + c; if (L >= nwg) return false;
        int wgid = (int)L; { const int q = nwg / NXCD, r = nwg % NXCD, xcd = wgid % NXCD, off = wgid / NXCD; wgid = (xcd < r ? xcd * (q + 1) : r * (q + 1) + (xcd - r) * q) + off; }
        const int nig = WGM * nN, gid = wgid / nig, fm = gid * WGM, gsz = (nM - fm) < WGM ? (nM - fm) : WGM;
        u.pm = fm + ((wgid % nig) % gsz); u.pn = (wgid % nig) / gsz; return true;
    }
    __device__ __forceinline__ void a_ready(const Unit&) const {}
    __device__ __forceinline__ void done(const Unit&) const {}
};
struct CountedOrder : StaticOrder {
    const unsigned* ready; unsigned need; unsigned* tmo;
    __device__ __forceinline__ void a_ready(const Unit& u) const {
        if (threadIdx.x < 64) {
            const unsigned long long t0 = __builtin_amdgcn_s_memrealtime(); unsigned polls = 0;
            while ((unsigned)__builtin_amdgcn_readfirstlane(__hip_atomic_load(ready + 64 * u.pm, __ATOMIC_RELAXED, __HIP_MEMORY_SCOPE_AGENT)) < need) {
                if ((++polls & 255u) == 0u && __builtin_amdgcn_readfirstlane(__hip_atomic_load(tmo, __ATOMIC_RELAXED, __HIP_MEMORY_SCOPE_AGENT)) != 0u) break;
                if (__builtin_amdgcn_s_memrealtime() - t0 > 2000000ull) {
                    if (threadIdx.x == 0) { unsigned expect = 0u; __hip_atomic_compare_exchange_strong(tmo + 1, &expect, 0x600u | (unsigned)(u.pm & 0xff), __ATOMIC_RELAXED, __ATOMIC_RELAXED, __HIP_MEMORY_SCOPE_AGENT); __hip_atomic_store(tmo, 1u, __ATOMIC_RELAXED, __HIP_MEMORY_SCOPE_AGENT); }
                    break; }
                __builtin_amdgcn_s_sleep(2); }
            __builtin_amdgcn_fence(__ATOMIC_ACQUIRE, "agent");
            asm volatile("s_waitcnt vmcnt(0)" ::: "memory");
        }
#if !defined(BROKEN_HOOK_NO_BARRIER)
        asm volatile("" ::: "memory"); __builtin_amdgcn_s_barrier(); asm volatile("" ::: "memory");
#endif
    }
};

__device__ __forceinline__ unsigned cvt_pk_bf16(float lo, float hi) { unsigned r; asm volatile("v_cvt_pk_bf16_f32 %0, %1, %2" : "=v"(r) : "v"(lo), "v"(hi)); return r; }
typedef float f32x2 __attribute__((ext_vector_type(2)));
__device__ __forceinline__ f32x2 gelu_pk(f32x2 v) {
    const f32x2 av = __builtin_elementwise_abs(v), d = av * 0.2316418882f + 1.0f;
    f32x2 t; t.x = __builtin_amdgcn_rcpf(d.x); t.y = __builtin_amdgcn_rcpf(d.y);
    f32x2 q = t * 0.5307027145f + (-0.7265760135f); q = q * t + 0.7107068705f; q = q * t + (-0.142248368f); q = q * t + 0.127414796f; q = q * t;
    const f32x2 s = (v * v) * (-0.72134752044f);
    f32x2 e; e.x = __builtin_amdgcn_exp2f(s.x); e.y = __builtin_amdgcn_exp2f(s.y);
    const f32x2 m = v * (q * e), r = v - m;
    f32x2 o; o.x = v.x < 0.f ? m.x : r.x; o.y = v.y < 0.f ? m.y : r.y; return o;
}

struct EpiF32 {
    static constexpr bool PERM = false, AFTER_DRAIN = false;
    float* C; int ldc; const float* bias;
    __device__ __forceinline__ void operator()(const f32x4 (&acc)[2][2][4][2], const Unit& u, int wr, int wc, int fr, int fq) const {
        const int row0 = u.pm * BM + wr * 64 + fr, col0 = u.pn * BM + wc * 32 + 4 * fq;
        f32x4 bv[2][2];
#pragma unroll
        for (int bj = 0; bj < 2; ++bj)
#pragma unroll
            for (int n = 0; n < 2; ++n) bv[bj][n] = bias ? *(const f32x4*)(bias + col0 + bj * HALF + n * 16) : (f32x4){0.f, 0.f, 0.f, 0.f};
#pragma unroll
        for (int ai = 0; ai < 2; ++ai)
#pragma unroll
            for (int m = 0; m < 4; ++m) { float* rowp = C + (size_t)(row0 + ai * HALF + m * 16) * ldc + col0;
#pragma unroll
                for (int bj = 0; bj < 2; ++bj)
#pragma unroll
                    for (int n = 0; n < 2; ++n) *(f32x4*)(rowp + bj * HALF + n * 16) = acc[ai][bj][m][n] + bv[bj][n]; }
    }
};
template <int ACT  > struct EpiBf16 {
    static constexpr bool PERM = true, AFTER_DRAIN = false;
    bf16_t* O; int ldc; const float* bias; int split_cols; size_t split_stride;
    __device__ __forceinline__ void operator()(const f32x4 (&acc)[2][2][4][2], const Unit& u, int wr, int wc, int fr, int fq) const {
        const int row0 = u.pm * BM + wr * 64 + fr; int colt = u.pn * BM; bf16_t* base = O;
        if (split_cols) { const int t = colt / split_cols; base += (size_t)t * split_stride; colt -= t * split_cols; }
        const int col0 = colt + wc * 32 + 8 * fq, bcol0 = u.pn * BM + wc * 32 + 8 * fq;
        f32x4 bv[2][2];
#pragma unroll
        for (int bj = 0; bj < 2; ++bj)
#pragma unroll
            for (int n = 0; n < 2; ++n) bv[bj][n] = bias ? *(const f32x4*)(bias + bcol0 + bj * HALF + 4 * n) : (f32x4){0.f, 0.f, 0.f, 0.f};
#pragma unroll
        for (int ai = 0; ai < 2; ++ai)
#pragma unroll
            for (int m = 0; m < 4; ++m) { bf16_t* rowp = base + (size_t)(row0 + ai * HALF + m * 16) * ldc + col0;
#pragma unroll
                for (int bj = 0; bj < 2; ++bj) { f32x4 v0 = acc[ai][bj][m][0] + bv[bj][0], v1 = acc[ai][bj][m][1] + bv[bj][1];
                    if (ACT == 1) { f32x2 a = gelu_pk((f32x2){v0[0], v0[1]}), b = gelu_pk((f32x2){v0[2], v0[3]}), c = gelu_pk((f32x2){v1[0], v1[1]}), d = gelu_pk((f32x2){v1[2], v1[3]});
                        v0 = (f32x4){a.x, a.y, b.x, b.y}; v1 = (f32x4){c.x, c.y, d.x, d.y}; }
                    if (ACT == 2) {
#pragma unroll
                        for (int j = 0; j < 4; ++j) { v0[j] = 0.5f * v0[j] * (1.0f + erff(v0[j] * 0.70710678f)); v1[j] = 0.5f * v1[j] * (1.0f + erff(v1[j] * 0.70710678f)); } }
                    u32x4 w; w.x = cvt_pk_bf16(v0[0], v0[1]); w.y = cvt_pk_bf16(v0[2], v0[3]); w.z = cvt_pk_bf16(v1[0], v1[1]); w.w = cvt_pk_bf16(v1[2], v1[3]);
                    *(u32x4*)(rowp + bj * HALF) = w; } }
    }
};

struct PanelStats {
    unsigned* xbuf;
    unsigned* cnt;
    unsigned* tmo;
    int ntn; float eps;
    unsigned code;
    __device__ __forceinline__ bool run(const f32x4 (&v)[2][2][4][2], const Unit& u, int wr, int wc, int fr, int fq, PG8_LAS unsigned char* lds, int wid, int lane) const {
        typedef float f32x2v __attribute__((ext_vector_type(2)));
        PG8_LAS f32x2v* P = (PG8_LAS f32x2v*)lds;
        PG8_LAS f32x2v* S = (PG8_LAS f32x2v*)(lds + 8192);
        PG8_LAS unsigned* flag = (PG8_LAS unsigned*)(lds + 8192 + 2048);
#pragma unroll
        for (int ai = 0; ai < 2; ++ai)
#pragma unroll
            for (int m = 0; m < 4; ++m) {
                float s = 0.f;
#pragma unroll
                for (int bj = 0; bj < 2; ++bj)
#pragma unroll
                    for (int n = 0; n < 2; ++n) { const f32x4 x = v[ai][bj][m][n]; s += (x[0] + x[1]) + (x[2] + x[3]); }
                s += __shfl_xor(s, 16); s += __shfl_xor(s, 32);
                const float mw = s * (1.0f / 64.0f); float q = 0.f;
#pragma unroll
                for (int bj = 0; bj < 2; ++bj)
#pragma unroll
                    for (int n = 0; n < 2; ++n) { const f32x4 d = v[ai][bj][m][n] - mw; q += (d[0] * d[0] + d[1] * d[1]) + (d[2] * d[2] + d[3] * d[3]); }
                q += __shfl_xor(q, 16); q += __shfl_xor(q, 32);
                if (fq == 0) P[(ai * HALF + wr * 64 + m * 16 + fr) * 4 + wc] = (f32x2v){mw, q};
            }
        asm volatile("s_waitcnt lgkmcnt(0)" ::: "memory"); __builtin_amdgcn_s_barrier(); asm volatile("" ::: "memory");
#if defined(BROKEN_NO_WAIT)
        if (blockIdx.x >= 64) { const long long t0 = clock64(); while (clock64() - t0 < 60000) __builtin_amdgcn_s_sleep(8); }
#endif
        const int row = wid * 32 + (lane & 31);
        if (lane < 32) {
            const f32x2v a = P[row * 4 + 0], b = P[row * 4 + 1], c = P[row * 4 + 2], d = P[row * 4 + 3];
            const float mt = (a.x + b.x + c.x + d.x) * 0.25f;
            const float da = a.x - mt, db = b.x - mt, dc = c.x - mt, dd = d.x - mt;
            const float m2 = (a.y + b.y) + (c.y + d.y) + 64.0f * ((da * da + db * db) + (dc * dc + dd * dd));
            unsigned long long* slot = (unsigned long long*)xbuf + ((size_t)(u.pm * BM + row) * 4 + u.pn);
            __hip_atomic_store(slot, ((unsigned long long)__float_as_uint(m2) << 32) | __float_as_uint(mt), __ATOMIC_RELAXED, __HIP_MEMORY_SCOPE_AGENT);
        }
        asm volatile("s_waitcnt vmcnt(0)" ::: "memory");
        if (lane == 0) __hip_atomic_fetch_add(cnt + 64 * u.pm, 1u, __ATOMIC_RELAXED, __HIP_MEMORY_SCOPE_AGENT);
        if (wid == 0) {
            bool dead = false; const unsigned long long t0 = __builtin_amdgcn_s_memrealtime(); const unsigned want = 8u * (unsigned)ntn;
            for (;;) {
#if defined(BROKEN_NO_WAIT)
                break;
#endif
                if ((unsigned)__builtin_amdgcn_readfirstlane(__hip_atomic_load(cnt + 64 * u.pm, __ATOMIC_RELAXED, __HIP_MEMORY_SCOPE_AGENT)) >= want) break;
                if (__builtin_amdgcn_s_memrealtime() - t0 > 2000000ull) {
                    if (lane == 0) { unsigned expect = 0u; __hip_atomic_compare_exchange_strong(tmo + 1, &expect, code | (unsigned)(u.pm & 0xff), __ATOMIC_RELAXED, __ATOMIC_RELAXED, __HIP_MEMORY_SCOPE_AGENT);
                                     __hip_atomic_store(tmo, 1u, __ATOMIC_RELAXED, __HIP_MEMORY_SCOPE_AGENT); }
                    dead = true; break; }
                __builtin_amdgcn_s_sleep(2);
            }
            __builtin_amdgcn_fence(__ATOMIC_ACQUIRE, "agent");
            if (lane == 0) flag[0] = dead ? 1u : 0u;
        }
        asm volatile("s_waitcnt vmcnt(0) lgkmcnt(0)" ::: "memory"); __builtin_amdgcn_s_barrier(); asm volatile("" ::: "memory");
        const bool bad = flag[0] != 0u;
        if (lane < 32) {
            const unsigned long long* slot = (const unsigned long long*)xbuf + (size_t)(u.pm * BM + row) * 4; float mt[4], m2[4]; float ms = 0.f;
#pragma unroll
            for (int t = 0; t < 4; ++t) { if (t < ntn) { const unsigned long long w = __hip_atomic_load(slot + t, __ATOMIC_RELAXED, __HIP_MEMORY_SCOPE_AGENT); mt[t] = __uint_as_float((unsigned)w); m2[t] = __uint_as_float((unsigned)(w >> 32)); } else { mt[t] = 0.f; m2[t] = 0.f; } ms += mt[t]; }
            const float mean = ms / (float)ntn; float q = 0.f;
#pragma unroll
            for (int t = 0; t < 4; ++t) if (t < ntn) { const float dm = mt[t] - mean; q += m2[t] + 256.0f * dm * dm; }
            S[row] = (f32x2v){mean, 1.0f / sqrtf(q / (256.0f * (float)ntn) + eps)};
        }
        asm volatile("s_waitcnt lgkmcnt(0)" ::: "memory"); __builtin_amdgcn_s_barrier(); asm volatile("" ::: "memory");
        return bad;
    }
};
struct EpiLnRes {
    static constexpr bool PERM = false, AFTER_DRAIN = true;
    const float* base; float* out; int ldc; const float* bias; PanelStats st; unsigned poison;
    __device__ __forceinline__ void refuse(size_t i0, size_t stride, int M, int N) const { const float q = __builtin_nanf(""); for (size_t i = i0; i < (size_t)M * N; i += stride) out[(i / N) * ldc + i % N] = q;
        if (i0 == 0) { unsigned expect = 0u; __hip_atomic_compare_exchange_strong(st.tmo + 1, &expect, 0x7f0u, __ATOMIC_RELAXED, __ATOMIC_RELAXED, __HIP_MEMORY_SCOPE_AGENT); __hip_atomic_store(st.tmo, 1u, __ATOMIC_RELAXED, __HIP_MEMORY_SCOPE_AGENT); } }
    __device__ __forceinline__ void fused(f32x4 (&acc)[2][2][4][2], const Unit& u, int wr, int wc, int fr, int fq, PG8_LAS unsigned char* lds, int wid, int lane) const {
        typedef float f32x2v __attribute__((ext_vector_type(2)));
        const PG8_LAS f32x2v* S = (const PG8_LAS f32x2v*)(lds + 8192);
        const int col0 = u.pn * BM + wc * 32 + 4 * fq;
#pragma unroll
        for (int bj = 0; bj < 2; ++bj)
#pragma unroll
            for (int n = 0; n < 2; ++n) { const f32x4 bv = bias ? *(const f32x4*)(bias + col0 + bj * HALF + n * 16) : (f32x4){0.f, 0.f, 0.f, 0.f};
#pragma unroll
                for (int ai = 0; ai < 2; ++ai)
#pragma unroll
                    for (int m = 0; m < 4; ++m) acc[ai][bj][m][n] += bv; }
        const bool bad = st.run(acc, u, wr, wc, fr, fq, lds, wid, lane) || poison != 0u;
        const float qnan = __builtin_nanf("");
#pragma unroll
        for (int ai = 0; ai < 2; ++ai)
#pragma unroll
            for (int m = 0; m < 4; ++m) { const int r = ai * HALF + wr * 64 + m * 16 + fr; const f32x2v sr = S[r]; const size_t off = (size_t)(u.pm * BM + r) * ldc + col0;
#pragma unroll
                for (int bj = 0; bj < 2; ++bj)
#pragma unroll
                    for (int n = 0; n < 2; ++n) { const f32x4 bs = *(const f32x4*)(base + off + bj * HALF + n * 16); f32x4 o = bs + (acc[ai][bj][m][n] - sr.x) * sr.y;
                        if (bad) o = (f32x4){qnan, qnan, qnan, qnan}; *(f32x4*)(out + off + bj * HALF + n * 16) = o; }
                asm volatile("" ::: "memory"); }
    }
};
struct EpiLnResLn {
    static constexpr bool PERM = false, AFTER_DRAIN = true;
    const float* base; float* out; bf16_t* xn; int ldc; const float* bias; PanelStats st1, st2; unsigned poison;
    __device__ __forceinline__ void refuse(size_t i0, size_t stride, int M, int N) const { const float q = __builtin_nanf(""); for (size_t i = i0; i < (size_t)M * N; i += stride) { const size_t o = (i / N) * ldc + i % N; out[o] = q; xn[o] = (bf16_t)0x7fc0u; }
        if (i0 == 0) { unsigned expect = 0u; __hip_atomic_compare_exchange_strong(st1.tmo + 1, &expect, 0x7f0u, __ATOMIC_RELAXED, __ATOMIC_RELAXED, __HIP_MEMORY_SCOPE_AGENT); __hip_atomic_store(st1.tmo, 1u, __ATOMIC_RELAXED, __HIP_MEMORY_SCOPE_AGENT); } }
    __device__ __forceinline__ void fused(f32x4 (&acc)[2][2][4][2], const Unit& u, int wr, int wc, int fr, int fq, PG8_LAS unsigned char* lds, int wid, int lane) const {
        typedef float f32x2v __attribute__((ext_vector_type(2))); typedef unsigned u32x2v __attribute__((ext_vector_type(2)));
        const PG8_LAS f32x2v* S = (const PG8_LAS f32x2v*)(lds + 8192);
        const int col0 = u.pn * BM + wc * 32 + 4 * fq;
#pragma unroll
        for (int bj = 0; bj < 2; ++bj)
#pragma unroll
            for (int n = 0; n < 2; ++n) { const f32x4 bv = bias ? *(const f32x4*)(bias + col0 + bj * HALF + n * 16) : (f32x4){0.f, 0.f, 0.f, 0.f};
#pragma unroll
                for (int ai = 0; ai < 2; ++ai)
#pragma unroll
                    for (int m = 0; m < 4; ++m) acc[ai][bj][m][n] += bv; }
        bool bad = st1.run(acc, u, wr, wc, fr, fq, lds, wid, lane) || poison != 0u;
        const float qnan = __builtin_nanf("");
#pragma unroll
        for (int ai = 0; ai < 2; ++ai)
#pragma unroll
            for (int m = 0; m < 4; ++m) { const int r = ai * HALF + wr * 64 + m * 16 + fr; const f32x2v sr = S[r]; const size_t off = (size_t)(u.pm * BM + r) * ldc + col0;
#pragma unroll
                for (int bj = 0; bj < 2; ++bj)
#pragma unroll
                    for (int n = 0; n < 2; ++n) { const f32x4 bs = *(const f32x4*)(base + off + bj * HALF + n * 16); acc[ai][bj][m][n] = bs + (acc[ai][bj][m][n] - sr.x) * sr.y; }
                asm volatile("" : "+v"(acc[ai][0][m][0]), "+v"(acc[ai][0][m][1]), "+v"(acc[ai][1][m][0]), "+v"(acc[ai][1][m][1]));
                if (m & 1) asm volatile("" ::: "memory"); }
        const bool bad1 = bad;
        bad = st2.run(acc, u, wr, wc, fr, fq, lds, wid, lane) || bad;
#pragma unroll
        for (int ai = 0; ai < 2; ++ai)
#pragma unroll
            for (int m = 0; m < 4; ++m) { const int r = ai * HALF + wr * 64 + m * 16 + fr; const f32x2v sr = S[r]; const size_t off = (size_t)(u.pm * BM + r) * ldc + col0;
#pragma unroll
                for (int bj = 0; bj < 2; ++bj)
#pragma unroll
                    for (int n = 0; n < 2; ++n) { const f32x4 x1 = acc[ai][bj][m][n]; *(f32x4*)(out + off + bj * HALF + n * 16) = bad1 ? (f32x4){qnan, qnan, qnan, qnan} : x1;
                        const f32x4 o = (x1 - sr.x) * sr.y; u32x2v w; w.x = cvt_pk_bf16(o[0], o[1]); w.y = cvt_pk_bf16(o[2], o[3]);
                        if (bad) { w.x = 0x7fc07fc0u; w.y = 0x7fc07fc0u; } *(u32x2v*)(xn + off + bj * HALF + n * 16) = w; }
                asm volatile("" ::: "memory"); }
    }
};

template <class Epi, class Sched, bool STAMP = false>
__device__ __forceinline__ void gemm_phase(PG8_LAS unsigned char* lds, const Gemm g, const Sched& S, const Epi& E, unsigned long long* stamps) {
    int tid_l = threadIdx.x; asm volatile("" : "+v"(tid_l));
    const int tid = tid_l, wid = __builtin_amdgcn_readfirstlane(tid >> 6), lane = tid & 63, wr = wid >> 2, wc = wid & 3, fr = lane & 15, fq = lane >> 4;
    const int K = g.K, nt = K / BK;
    int ts_lo = 0, ts_hi = 0, nts = 0; const unsigned long long rt_entry = STAMP ? (unsigned long long)wall_clock64() : 0ull;
#define PG8_STAMP() do { if (STAMP && wid == 0 && nts < 64) { const unsigned long long _c = (unsigned long long)clock64(); \
        ts_lo = (lane == nts) ? (int)(unsigned)_c : ts_lo; ts_hi = (lane == nts) ? (int)(unsigned)(_c >> 32) : ts_hi; ++nts; } } while (0)
    PG8_STAMP();
    unsigned voffA[2], voffB[2];
#pragma unroll
    for (int i = 0; i < 2; ++i) { int R, C; stage_rc(tid * 16 + i * 8192, R, C); const int Rb = Epi::PERM ? ((R & ~31) + perm32(R & 31)) : R;
        voffA[i] = (unsigned)(R * K + C) * 2u; voffB[i] = (unsigned)(Rb * K + C) * 2u; }
    const size_t kstep = (size_t)(BK * 2);
    const size_t hstep = (size_t)HALF * K * 2;
    const size_t tstep = 2 * hstep;
    const unsigned ldsw = (unsigned)wid * 1024u;
    const int aoff = lds_byte(wr * 64 + fr, fq * 8), boff = lds_byte(wc * 32 + fr, fq * 8);
#define PG8_SA(b, h) (((b) * 2 + (h)) * HTB)
#define PG8_SB(b, h) ((4 + (b) * 2 + (h)) * HTB)
#define PG8_STAGE(bufoff, gbase, voff) do { _Pragma("unroll") for (int _i = 0; _i < 2; ++_i) \
        __builtin_amdgcn_global_load_lds((const unsigned*)((const char*)(gbase) + (voff)[_i]), (PG8_LAS unsigned*)(lds + (bufoff) + ldsw + _i * 8192), 16, 0, 0); } while (0)
#define PG8_LDA(dst, b, h) do { _Pragma("unroll") for (int m = 0; m < 4; ++m) _Pragma("unroll") for (int k = 0; k < 2; ++k) dst[m][k] = *(const PG8_LAS bf16x8*)(lds + PG8_SA(b, h) + aoff + m * 2048 + k * 1024); } while (0)
#define PG8_LDB(dst, b, h) do { _Pragma("unroll") for (int n = 0; n < 2; ++n) _Pragma("unroll") for (int k = 0; k < 2; ++k) dst[n][k] = *(const PG8_LAS bf16x8*)(lds + PG8_SB(b, h) + boff + n * 2048 + k * 1024); } while (0)
#define PG8_MMA(ai, bj, At, Bt) do { __builtin_amdgcn_s_setprio(1); _Pragma("unroll") for (int m = 0; m < 4; ++m) _Pragma("unroll") for (int n = 0; n < 2; ++n) _Pragma("unroll") for (int k = 0; k < 2; ++k) \
        acc[ai][bj][m][n] = __builtin_amdgcn_mfma_f32_16x16x32_bf16(Bt[n][k], At[m][k], acc[ai][bj][m][n], 0, 0, 0); __builtin_amdgcn_s_setprio(0); } while (0)
#define PG8_WAIT_V(n) asm volatile("s_waitcnt vmcnt(" #n ")" ::: "memory")
#define PG8_WAIT_L(n) asm volatile("s_waitcnt lgkmcnt(" #n ")" ::: "memory")
#define PG8_BAR __builtin_amdgcn_s_barrier()
#define PG8_SCHED __builtin_amdgcn_sched_barrier(0)
    Unit cur, nxt; int ui = 0;
    if (!S.next(0, cur)) return;
    f32x4 acc[2][2][4][2];
#pragma unroll
    for (int a = 0; a < 2; ++a)
#pragma unroll
        for (int b = 0; b < 2; ++b)
#pragma unroll
            for (int m = 0; m < 4; ++m)
#pragma unroll
                for (int n = 0; n < 2; ++n) acc[a][b][m][n] = (f32x4){0.f, 0.f, 0.f, 0.f};
    bf16x8 At[4][2], B0[2][2], B1[2][2];
    const char* cA = (const char*)g.A + (size_t)cur.pm * tstep; const char* cB = (const char*)g.Bt + (size_t)cur.pn * tstep;
    S.a_ready(cur);
    PG8_STAGE(PG8_SB(0, 0), cB, voffB); PG8_STAGE(PG8_SA(0, 0), cA, voffA); PG8_STAGE(PG8_SB(0, 1), cB + hstep, voffB); PG8_STAGE(PG8_SA(0, 1), cA + hstep, voffA);
    if (wr == 1) PG8_BAR;
    PG8_WAIT_V(4); PG8_BAR;
    PG8_STAGE(PG8_SB(1, 0), cB + kstep, voffB); PG8_STAGE(PG8_SA(1, 0), cA + kstep, voffA); PG8_STAGE(PG8_SB(1, 1), cB + hstep + kstep, voffB);
    PG8_WAIT_V(6); PG8_BAR;
    PG8_STAMP();
    for (;;) {
        const bool has_next = S.next(ui + 1, nxt);
        const char* nA = has_next ? (const char*)g.A + (size_t)nxt.pm * tstep : cA; const char* nB = has_next ? (const char*)g.Bt + (size_t)nxt.pn * tstep : cB;
        for (int t = 0; t < nt; t += 2) {
            const bool last = (t == nt - 2);
            const char* a1 = cA + (size_t)(t + 1) * kstep;
            const char* a2 = last ? nA : cA + (size_t)(t + 2) * kstep; const char* b2 = last ? nB : cB + (size_t)(t + 2) * kstep;
            const char* a3 = a2 + kstep; const char* b3 = b2 + kstep;
            if (last && has_next) S.a_ready(nxt);
            PG8_LDB(B0, 0, 0); PG8_SCHED; PG8_LDA(At, 0, 0); PG8_STAGE(PG8_SA(1, 1), a1 + hstep, voffA);
            PG8_WAIT_L(8); PG8_BAR; PG8_WAIT_L(0); PG8_MMA(0, 0, At, B0); PG8_BAR; PG8_SCHED;
            PG8_LDB(B1, 0, 1); PG8_STAGE(PG8_SB(0, 0), b2, voffB);
            PG8_BAR; PG8_WAIT_L(0); PG8_MMA(0, 1, At, B1); PG8_BAR;
            PG8_LDA(At, 0, 1); PG8_STAGE(PG8_SA(0, 0), a2, voffA);
            PG8_BAR; PG8_WAIT_L(0); PG8_MMA(1, 0, At, B0); PG8_BAR; PG8_SCHED;
            PG8_STAGE(PG8_SB(0, 1), b2 + hstep, voffB);
            PG8_WAIT_V(6); PG8_BAR; PG8_MMA(1, 1, At, B1); PG8_BAR;
            PG8_LDB(B0, 1, 0); PG8_SCHED; PG8_LDA(At, 1, 0); PG8_STAGE(PG8_SA(0, 1), a2 + hstep, voffA);
            PG8_WAIT_L(8); PG8_BAR; PG8_WAIT_L(0); PG8_MMA(0, 0, At, B0); PG8_BAR; PG8_SCHED;
            PG8_LDB(B1, 1, 1); PG8_STAGE(PG8_SB(1, 0), b3, voffB);
            PG8_BAR; PG8_WAIT_L(0); PG8_MMA(0, 1, At, B1); PG8_BAR;
            PG8_LDA(At, 1, 1); PG8_STAGE(PG8_SA(1, 0), a3, voffA);
            PG8_BAR; PG8_WAIT_L(0); PG8_MMA(1, 0, At, B0); PG8_BAR; PG8_SCHED;
            PG8_STAGE(PG8_SB(1, 1), b3 + hstep, voffB);
            PG8_WAIT_V(6); PG8_BAR; PG8_MMA(1, 1, At, B1); PG8_BAR;
        }
        PG8_STAMP();
        if constexpr (!Epi::AFTER_DRAIN) { E(acc, cur, wr, wc, fr, fq); S.done(cur); }
        PG8_STAMP();
        if (!has_next) break;
#pragma unroll
        for (int a = 0; a < 2; ++a)
#pragma unroll
            for (int b = 0; b < 2; ++b)
#pragma unroll
                for (int m = 0; m < 4; ++m)
#pragma unroll
                    for (int n = 0; n < 2; ++n) acc[a][b][m][n] = (f32x4){0.f, 0.f, 0.f, 0.f};
        cur = nxt; cA = nA; cB = nB; ++ui;
    }
    PG8_WAIT_V(0);
    if (wr == 0) PG8_BAR;
    PG8_BAR;
    if constexpr (Epi::AFTER_DRAIN) { E.fused(acc, cur, wr, wc, fr, fq, lds, wid, lane); S.done(cur); }
    PG8_STAMP();
    if (STAMP && wid == 0) { stamps[lane] = lane < nts ? (((unsigned long long)(unsigned)ts_hi << 32) | (unsigned)ts_lo) : 0ull;
        if (lane == 62) stamps[62] = rt_entry; if (lane == 63) stamps[63] = (unsigned long long)wall_clock64(); }
#undef PG8_STAMP
#undef PG8_SA
#undef PG8_SB
#undef PG8_STAGE
#undef PG8_LDA
#undef PG8_LDB
#undef PG8_MMA
#undef PG8_WAIT_V
#undef PG8_WAIT_L
#undef PG8_BAR
#undef PG8_SCHED
}
}

#define GAS __attribute__((address_space(1)))
#define LAS __attribute__((address_space(3)))
typedef unsigned short bf16;
typedef unsigned v4u __attribute__((ext_vector_type(4)));
typedef unsigned v2u __attribute__((ext_vector_type(2)));
typedef float f32x4 __attribute__((ext_vector_type(4)));
typedef float f32x2 __attribute__((ext_vector_type(2)));
typedef float f32x16 __attribute__((ext_vector_type(16)));
typedef short bf16x8 __attribute__((ext_vector_type(8)));
typedef short bf16x4 __attribute__((ext_vector_type(4)));

#ifndef MK_CHECK
#define MK_CHECK 0
#endif
#ifndef MK_ONE_LAUNCH
#define MK_ONE_LAUNCH 0
#endif
#ifndef MK_PROBE
#define MK_PROBE 0
#endif
#ifndef MK_DUP10
#define MK_DUP10 0
#endif
#ifndef MK_PROBE_KERNEL
#define MK_PROBE_KERNEL 0
#endif
#ifndef MK_PROBE_FLAGS
#define MK_PROBE_FLAGS 0
#endif
#ifndef MK_REPEAT_K
#define MK_REPEAT_K (-1)
#endif
#ifndef MK_PROBE_A
#define MK_PROBE_A 0u
#endif
#ifndef MK_PROBE_C
#define MK_PROBE_C 0u
#endif

constexpr int T_TOK = 65536, DM = 1024, SEQ = 2048, NBATCH = 32;
constexpr float ALPHA_DN = 1.6817928305074290f;
#ifndef PEER_U4
#define PEER_U4 1
#endif
#ifndef PEER_V4
#define PEER_V4 1
#endif
constexpr float PEER_USCALE = PEER_U4 ? 64.0f : 256.0f, PEER_VSCALE = PEER_V4 ? 12.8f : 32.0f;
constexpr int PEER_UROW = PEER_U4 ? 512 : 1024, PEER_VROW = PEER_V4 ? 512 : 1024;
constexpr int NWAVES = 8, NTHR = 512;
constexpr int NPH_LAYER = 12;
constexpr int N_PHASES = 1 + 4 * NPH_LAYER;

constexpr size_t MiB = 1u << 20;
constexpr size_t WS_CTL = 0, CTL_BYTES = 1 * MiB;
constexpr size_t WS_ROT = 1 * MiB;
constexpr size_t WS_WPEER = 4 * MiB;
constexpr size_t WS_WPLEG = 20 * MiB;
constexpr size_t WS_WPLEP = 28 * MiB;
constexpr size_t WS_WAIN = 30 * MiB;
constexpr size_t WS_WAQ = 32 * MiB;
constexpr size_t WAQ_STRIDE = 2560 * 256 * 2;
constexpr size_t WS_WAOV = 35 * MiB;
constexpr size_t WS_WBIN = 43 * MiB;
constexpr size_t WS_WBO = 48 * MiB;
constexpr size_t WS_WCIN = 51 * MiB;
constexpr size_t WS_WCO = 63 * MiB;
constexpr size_t WS_TABU = 68 * MiB, WS_TABV = 100 * MiB;
constexpr size_t WS_XB0 = 132 * MiB, WS_XB1 = 260 * MiB;
constexpr size_t WS_M = 388 * MiB;
constexpr size_t M_SC = 0, M_IDS = 512 * MiB, M_GATES = 544 * MiB, M_PB = 576 * MiB, M_PP = 0;
constexpr size_t M_RAW = 0, M_CQ = 128 * MiB, M_CKV = 160 * MiB, M_CKVT = 176 * MiB, M_KIDX = 192 * MiB, M_WIDX = 200 * MiB,
                 M_MASK = 202 * MiB, M_QLAT = 218 * MiB, M_QIDX = 474 * MiB;
constexpr size_t M_GU = 0, M_Y = 320 * MiB;
constexpr size_t M_Q = 0, M_K = 128 * MiB, M_V = 256 * MiB, M_STAT = 512 * MiB;
constexpr size_t WS_PP = WS_M + 608 * MiB;
constexpr size_t WS_END = WS_PP + 128 * MiB;
constexpr int CW_DIAG = 64;
constexpr int CW_BAR = 4096;

constexpr int RING_BYTES = 131072, LDS_BYTES = 147456, LDSCTL_OFF = LDS_BYTES - 512, MISC_OFF = LDSCTL_OFF + 320;

enum { I_X = 0, I_P, I_A_W_IN, I_A_CQ_GAIN, I_A_CKV_GAIN, I_A_W_UQ, I_A_W_UK, I_A_W_QIDX, I_A_KIDX_GAIN, I_A_KIDX_BIAS, I_A_W_UV, I_A_W_O,
       I_B_W_IN, I_B_CONV_W, I_B_CONV_B, I_B_W_A, I_B_B_A, I_B_W_X, I_B_B_X, I_B_LAMBDA, I_B_W_O, I_C_W_IN, I_C_W_O,
       I_LN1_G, I_LN1_B, I_PEER_WQ, I_PEER_SK, I_PEER_U, I_PEER_V, I_LN2_G, I_LN2_B, I_PLE_WP, I_PLE_WG, I_PLE_BG, N_IN };

struct Params { const float* in[N_IN]; float* out; unsigned char* ws; int ph_lo, ph_hi, flags, pad; };

typedef const float* const __attribute__((address_space(4)))* InTab;
struct Ctx {
    LAS unsigned char* lds;
    int tid, lane, wave, bid, G;
    InTab in; float* out; unsigned char* ws;
};
#define INP(cx, i) ((const float*)(const GAS float*)((cx).in[i]))

#define LDS_WAIT() asm volatile("s_waitcnt lgkmcnt(0)" ::: "memory")
#define VM_WAIT() asm volatile("s_waitcnt vmcnt(0)" ::: "memory")

typedef __bf16 bf16v2_t __attribute__((ext_vector_type(2)));
__device__ __forceinline__ unsigned pk2(float lo, float hi) { const f32x2 v = {lo, hi}; const bf16v2_t b = __builtin_convertvector(v, bf16v2_t); return __builtin_bit_cast(unsigned, b); }
__device__ __forceinline__ unsigned f2bf(float f) { return (unsigned)__builtin_bit_cast(unsigned short, (__bf16)f); }
__device__ __forceinline__ float bflo(unsigned w) { return __builtin_bit_cast(float, w << 16); }
__device__ __forceinline__ float bfhi(unsigned w) { return __builtin_bit_cast(float, w & 0xffff0000u); }
__device__ __forceinline__ float bf2f(bf16 b) { return __builtin_bit_cast(float, ((unsigned)b) << 16); }
template <int CTRL, int ROWMASK>
__device__ __forceinline__ float dpp_f(float v) { return __builtin_bit_cast(float, __builtin_amdgcn_update_dpp(0, __builtin_bit_cast(int, v), CTRL, ROWMASK, 0xf, false)); }
__device__ __forceinline__ float wave_sum_uniform(float v) {
    v += dpp_f<0xB1, 0xf>(v);
    v += dpp_f<0x4E, 0xf>(v);
    v += dpp_f<0x141, 0xf>(v);
    v += dpp_f<0x140, 0xf>(v);
    v += dpp_f<0x142, 0xa>(v);
    v += dpp_f<0x143, 0xc>(v);
    return __builtin_bit_cast(float, __builtin_amdgcn_readlane(__builtin_bit_cast(int, v), 63));
}
__device__ __forceinline__ float wave_sum(float v) { return wave_sum_uniform(v); }
__device__ __forceinline__ float gelu_tanh(float x) {
    const float u = 0.7978845608028654f * (x + 0.044715f * x * x * x);
    const float e = __expf(2.0f * u);
    const float th = 1.0f - 2.0f * __builtin_amdgcn_rcpf(e + 1.0f);
    return 0.5f * x * (1.0f + th);
}
__device__ __forceinline__ float sigmoidf_(float x) { return __builtin_amdgcn_rcpf(1.0f + __expf(-x)); }

#define XB_TMO      128
#define XB_XCNT(j)  (256  + 64 * (j))
#define XB_XSUB(j)  (1280 + 64 * (j))
#define XB_XGEN(j)  (2304 + 64 * (j))
#define XB_TOP      3328
#define XB_TOPGEN   3392
#define XCD_BAR_WORDS 3456
#define XB_SPIN_CAP (1u << 25)
__device__ __forceinline__ unsigned xb_ld(unsigned* p)              { return __hip_atomic_load(p, __ATOMIC_RELAXED, __HIP_MEMORY_SCOPE_AGENT); }
__device__ __forceinline__ unsigned xb_add(unsigned* p, unsigned v) { return __hip_atomic_fetch_add(p, v, __ATOMIC_RELAXED, __HIP_MEMORY_SCOPE_AGENT); }
__device__ __forceinline__ unsigned xb_xcc_id() { return (unsigned)__builtin_amdgcn_s_getreg((3 << 11) | 20) & 0xFu; }
#define XB_SPIN(cond, bar) do { unsigned _sp = 0; while (cond) { __builtin_amdgcn_s_sleep(1); \
    if ((++_sp & 255u) == 0u) { if (xb_ld(&(bar)[XB_TMO])) break; if (_sp > XB_SPIN_CAP) { atomicAdd(&(bar)[XB_TMO], 1u); break; } } } } while (0)
struct XcdBarrier { unsigned* bar; unsigned x; volatile LAS unsigned* st; };
__device__ __forceinline__ XcdBarrier xcd_barrier_post(unsigned* bar, volatile LAS unsigned* st) {
    XcdBarrier b; b.bar = bar; b.x = xb_xcc_id(); b.st = st;
    if (threadIdx.x == 0) (void)xb_add(&bar[XB_XCNT(b.x)], 1u);
    return b;
}
__device__ __forceinline__ void xcd_barrier_complete(unsigned* bar, unsigned x, unsigned& nloc, unsigned& nx) {
    const unsigned G = gridDim.x * gridDim.y * gridDim.z;
    unsigned sum, cnt, mine, sp = 0u;
    for (;;) {
        sum = 0u; cnt = 0u; mine = 0u;
#pragma unroll
        for (unsigned j = 0; j < 16; ++j) { const unsigned c = xb_ld(&bar[XB_XCNT(j)]); sum += c; cnt += (c > 0u) ? 1u : 0u; mine = (j == x) ? c : mine; }
        if (sum == G) break;
        __builtin_amdgcn_s_sleep(1);
        if ((++sp & 255u) == 0u) { if (xb_ld(&bar[XB_TMO])) break; if (sp > XB_SPIN_CAP) { atomicAdd(&bar[XB_TMO], 1u); break; } }
    }
    nloc = mine > 0u ? mine : 1u; nx = cnt > 0u ? cnt : 1u;
}
__device__ __forceinline__ void xcd_barrier(const XcdBarrier& b) {
    asm volatile("s_waitcnt vmcnt(0)" ::: "memory");
    __syncthreads();
    if (threadIdx.x == 0) {
        unsigned* bar = b.bar;
        __builtin_amdgcn_s_waitcnt(0);
        unsigned nloc = b.st[0], nx = b.st[1];
        if (nloc == 0u) { xcd_barrier_complete(bar, b.x, nloc, nx); b.st[0] = nloc; b.st[1] = nx; }
        const unsigned old = xb_add(&bar[XB_XSUB(b.x)], 1u);
        const unsigned gen = old / nloc;
        if (old + 1u == (gen + 1u) * nloc) {
            __builtin_amdgcn_fence(__ATOMIC_RELEASE, "agent");
            asm volatile("s_waitcnt vmcnt(0)" ::: "memory");
            const unsigned og = xb_add(&bar[XB_TOP], 1u);
            const unsigned tg = og / nx;
            if (og + 1u == (tg + 1u) * nx) xb_add(&bar[XB_TOPGEN], 1u);
            else XB_SPIN(xb_ld(&bar[XB_TOPGEN]) == tg, bar);
            __builtin_amdgcn_fence(__ATOMIC_ACQUIRE, "agent");
            xb_add(&bar[XB_XGEN(b.x)], 1u);
            asm volatile("s_waitcnt vmcnt(0)" ::: "memory");
        } else {
            XB_SPIN(xb_ld(&bar[XB_XGEN(b.x)]) == gen, bar);
            __builtin_amdgcn_fence(__ATOMIC_ACQUIRE, "agent");
            asm volatile("s_waitcnt vmcnt(0)" ::: "memory");
        }
    }
    __syncthreads();
}

__device__ __forceinline__ void p0_transpose_item(const float* W, int K, int N, bf16* WT, int row_off, float scale, LAS float* scr, int item, int lane) {
    const int nblk = N / 32, kb = item / nblk, nb = item % nblk, k0 = 64 * kb, n0 = 32 * nb;
#pragma unroll 8
    for (int i = 0; i < 32; ++i) { const int kk = 2 * i + (lane >> 5); scr[kk * 33 + (lane & 31)] = W[(size_t)(k0 + kk) * N + n0 + (lane & 31)] * scale; }
    LDS_WAIT(); asm volatile("" ::: "memory");
    const int c = lane & 7;
#pragma unroll
    for (int j = 0; j < 4; ++j) { const int n = (lane >> 3) + 8 * j; const LAS float* s = scr + (8 * c) * 33 + n;
        v4u o; o.x = pk2(s[0 * 33], s[1 * 33]); o.y = pk2(s[2 * 33], s[3 * 33]); o.z = pk2(s[4 * 33], s[5 * 33]); o.w = pk2(s[6 * 33], s[7 * 33]);
        *(v4u*)(WT + (size_t)(row_off + n0 + n) * K + k0 + 8 * c) = o; }
    LDS_WAIT(); asm volatile("" ::: "memory");
}

__device__ __forceinline__ void small_gemm_tile(const Ctx& c, const float* A, long sa_n, long sa_d, const float* Bm, long sb_k, long sb_d, int Kd,
                                                bf16* C, int ldc, int n0, int k0, float scale) {
    LAS float* As = (LAS float*)c.lds; LAS float* Bs = As + 128 * 68;
    __syncthreads();
    for (int e = c.tid; e < 64 * Kd; e += NTHR) {
        int r, d;
        if (sa_d == 1) { d = e % Kd; r = e / Kd; } else { r = e & 63; d = e >> 6; }
        As[d * 68 + r] = A[(long)(n0 + r) * sa_n + (long)d * sa_d];
    }
    for (int e = c.tid; e < 64 * Kd; e += NTHR) {
        int r, d;
        if (sb_d == 1) { d = e % Kd; r = e / Kd; } else { r = e & 63; d = e >> 6; }
        Bs[d * 68 + r] = Bm[(long)(k0 + r) * sb_k + (long)d * sb_d];
    }
    __syncthreads();
    {
        const int tn = (c.tid >> 5) * 4, tk = (c.tid & 31) * 2;
        float acc[4][2];
#pragma unroll
        for (int i = 0; i < 4; ++i) { acc[i][0] = 0.f; acc[i][1] = 0.f; }
        for (int d = 0; d < Kd; ++d) {
            const f32x4 a = *(const LAS f32x4*)(As + d * 68 + tn); const f32x2 b = *(const LAS f32x2*)(Bs + d * 68 + tk);
#pragma unroll
            for (int i = 0; i < 4; ++i) { acc[i][0] += a[i] * b[0]; acc[i][1] += a[i] * b[1]; }
        }
#pragma unroll
        for (int i = 0; i < 4; ++i) *(unsigned*)(C + (size_t)(n0 + tn + i) * ldc + k0 + tk) = pk2(acc[i][0] * scale, acc[i][1] * scale);
    }
}

__device__ __forceinline__ void ln_store_row(float (&v)[16], const float* gain, const float* bias, float* of, bf16* ob, int lane) {
    float s = 0.f;
#pragma unroll
    for (int j = 0; j < 16; ++j) s += v[j];
    const float mean = wave_sum(s) * (1.f / 1024.f);
    float s2 = 0.f;
#pragma unroll
    for (int j = 0; j < 16; ++j) { v[j] -= mean; s2 += v[j] * v[j]; }
    const float rstd = __builtin_amdgcn_rsqf(wave_sum(s2) * (1.f / 1024.f) + 1e-5f);
#pragma unroll
    for (int h = 0; h < 2; ++h) {
        const int col = h * 512 + 8 * lane;
        const f32x4 g0 = *(const f32x4*)(gain + col), g1 = *(const f32x4*)(gain + col + 4), b0 = *(const f32x4*)(bias + col), b1 = *(const f32x4*)(bias + col + 4);
        f32x4 o0, o1;
#pragma unroll
        for (int j = 0; j < 4; ++j) { o0[j] = v[h * 8 + j] * rstd * g0[j] + b0[j]; o1[j] = v[h * 8 + 4 + j] * rstd * g1[j] + b1[j]; }
        *(f32x4*)(of + col) = o0; *(f32x4*)(of + col + 4) = o1;
        v4u w; w.x = pk2(o0[0], o0[1]); w.y = pk2(o0[2], o0[3]); w.z = pk2(o1[0], o1[1]); w.w = pk2(o1[2], o1[3]);
        *(v4u*)(ob + col) = w;
    }
}
__device__ __forceinline__ void load_row16(const float* row, float (&v)[16], int lane) {
#pragma unroll
    for (int h = 0; h < 2; ++h) { const f32x4 a = *(const f32x4*)(row + h * 512 + 8 * lane), b = *(const f32x4*)(row + h * 512 + 8 * lane + 4);
#pragma unroll
        for (int j = 0; j < 4; ++j) { v[h * 8 + j] = a[j]; v[h * 8 + 4 + j] = b[j]; } }
}

__device__ __forceinline__ void load_row16c(const float* row, float (&v)[16], int lane) {
#pragma unroll
    for (int q = 0; q < 4; ++q) { const f32x4 a = *(const f32x4*)(row + 16 * lane + 4 * q);
#pragma unroll
        for (int j = 0; j < 4; ++j) v[4 * q + j] = a[j]; }
}
__device__ __forceinline__ void ln_store_row_c(float (&v)[16], const float* gain, const float* bias, float* of, bf16* ob, int lane) {
    float s = 0.f;
#pragma unroll
    for (int j = 0; j < 16; ++j) s += v[j];
    const float mean = wave_sum(s) * (1.f / 1024.f);
    float s2 = 0.f;
#pragma unroll
    for (int j = 0; j < 16; ++j) { v[j] -= mean; s2 += v[j] * v[j]; }
    const float rstd = __builtin_amdgcn_rsqf(wave_sum(s2) * (1.f / 1024.f) + 1e-5f);
    const int col = 16 * lane;
    float o[16];
#pragma unroll
    for (int q = 0; q < 4; ++q) { const f32x4 g = *(const f32x4*)(gain + col + 4 * q), b = *(const f32x4*)(bias + col + 4 * q); f32x4 r;
#pragma unroll
        for (int j = 0; j < 4; ++j) { r[j] = v[4 * q + j] * rstd * g[j] + b[j]; o[4 * q + j] = r[j]; }
        *(f32x4*)(of + col + 4 * q) = r; }
    v4u w0, w1; w0.x = pk2(o[0], o[1]); w0.y = pk2(o[2], o[3]); w0.z = pk2(o[4], o[5]); w0.w = pk2(o[6], o[7]);
    w1.x = pk2(o[8], o[9]); w1.y = pk2(o[10], o[11]); w1.z = pk2(o[12], o[13]); w1.w = pk2(o[14], o[15]);
    *(v4u*)(ob + col) = w0; *(v4u*)(ob + col + 8) = w1;
}

__device__ __forceinline__ void phase_prologue(const Ctx& c) {
    unsigned char* ws = c.ws;
    LAS float* scr = (LAS float*)(c.lds + c.wave * 16384);
    const int gw = c.bid * NWAVES + c.wave, NGW = c.G * NWAVES;
    {
        struct TI { const float* W; int K, N; bf16* WT; int row_off; float scale; };
        int base = 0;
#define TR_ITEMS(Wp, Kv, Nv, WTp, roff, sc) do { const int ni = ((Kv) / 64) * ((Nv) / 32); \
            for (int it = gw; it < ni; it += NGW) p0_transpose_item((Wp), (Kv), (Nv), (WTp), (roff), (sc), scr, it, c.lane); base += ni; } while (0)
        for (int i = 0; i < 4; ++i) {
            TR_ITEMS(INP(c, I_PLE_WG) + (size_t)i * 1024 * 1024, 1024, 1024, (bf16*)(ws + WS_WPLEG) + (size_t)i * 1024 * 1024, 0, 1.0f);
            TR_ITEMS(INP(c, I_PLE_WP) + (size_t)i * 256 * 1024, 256, 1024, (bf16*)(ws + WS_WPLEP) + (size_t)i * 1024 * 256, 0, 1.0f);
        }
        for (int j = 0; j < 2; ++j)
            TR_ITEMS(INP(c, I_A_W_QIDX) + (size_t)j * 256 * 512, 256, 512, (bf16*)(ws + WS_WAQ + j * WAQ_STRIDE), 2048, 0.125f);
        TR_ITEMS(INP(c, I_B_W_IN), 1024, 2560, (bf16*)(ws + WS_WBIN), 0, 1.0f);
        TR_ITEMS(INP(c, I_B_W_O), 1280, 1024, (bf16*)(ws + WS_WBO), 0, 1.0f);
        TR_ITEMS(INP(c, I_C_W_IN), 1024, 6144, (bf16*)(ws + WS_WCIN), 0, 1.0f);
        TR_ITEMS(INP(c, I_C_W_O), 2048, 1024, (bf16*)(ws + WS_WCO), 0, 1.0f);
#undef TR_ITEMS
        (void)base;
    }
    for (int j = 0; j < 2; ++j) {
        const float* W = INP(c, I_A_W_IN) + (size_t)j * 1024 * 456; bf16* WT = (bf16*)(ws + WS_WAIN) + (size_t)j * 512 * 1024;
        for (int e = c.bid * NTHR + c.tid; e < 512 * 1024; e += c.G * NTHR) { const int n = e >> 10, k = e & 1023; WT[e] = (bf16)(n < 456 ? f2bf(W[(size_t)k * 456 + n]) : 0u); }
    }
    {
        float* ct = (float*)(ws + WS_ROT); float* st = ct + 2048 * 128;
        for (int e = c.bid * NTHR + c.tid; e < 2048 * 128; e += c.G * NTHR) {
            const int pos = e >> 7, f = e & 127;
            const float lin = (float)f * (1.0f / 127.0f);
            const float p = (float)pow(10000.0, (double)lin);
            const float invf = 1.0f / p;
            const float ang = (float)pos * invf;
            ct[e] = (float)cos((double)ang); st[e] = (float)sin((double)ang);
        }
    }
    for (int m = gw; m < T_TOK; m += NGW) {
        const float* xr = INP(c, I_X) + (size_t)m * DM; bf16* ob = (bf16*)(ws + WS_XB0) + (size_t)m * DM;
#pragma unroll
        for (int h = 0; h < 2; ++h) { const int col = h * 512 + 8 * c.lane; const f32x4 a = *(const f32x4*)(xr + col), b = *(const f32x4*)(xr + col + 4);
            v4u w; w.x = pk2(a[0], a[1]); w.y = pk2(a[2], a[3]); w.z = pk2(b[0], b[1]); w.w = pk2(b[2], b[3]); *(v4u*)(ob + col) = w; }
    }
    {
        int tbase = 0;
        {
            const int ntile = 4 * 16 * 2 * 16;
            for (int t = c.bid; t < ntile; t += c.G) {
                const int i = t / 512, r = t % 512, hp = r / 32, tt = r % 32, nt = tt / 16, kt = tt % 16;
                const float* A = INP(c, I_PEER_SK) + (size_t)i * 8 * 2 * 128 * 128 + (size_t)hp * 128 * 128;
                const float* Bm = INP(c, I_PEER_WQ) + (size_t)i * 1024 * 2048 + hp * 128;
                bf16* C = (bf16*)(ws + WS_WPEER) + (size_t)i * 2048 * 1024 + (size_t)hp * 128 * 1024;
                small_gemm_tile(c, A, 128, 1, Bm, 2048, 1, 128, C, 1024, nt * 64, kt * 64, 1.0f);
            }
            tbase += ntile;
        }
        {
            const int ntile = 2 * 16 * 2 * 4;
            for (int t = c.bid; t < ntile; t += c.G) {
                const int j = t / 128, r = t % 128, h = r / 8, tt = r % 8, nt = tt / 4, kt = tt % 4;
                const float* A = INP(c, I_A_W_UK) + (size_t)j * 16 * 64 * 128 + (size_t)h * 64 * 128;
                const float* Bm = INP(c, I_A_W_UQ) + (size_t)j * 256 * 1024 + h * 64;
                bf16* C = (bf16*)(ws + WS_WAQ + j * WAQ_STRIDE) + (size_t)h * 128 * 256;
                small_gemm_tile(c, A, 1, 128, Bm, 1024, 1, 64, C, 256, nt * 64, kt * 64, 0.125f * 1.4426950408889634f);
            }
        }
        {
            const int ntile = 2 * 16 * 16 * 2;
            for (int t = c.bid; t < ntile; t += c.G) {
                const int j = t / 512, r = t % 512, h = r / 32, tt = r % 32, nt = tt / 2, kt = tt % 2;
                const float* A = INP(c, I_A_W_O) + (size_t)j * 1024 * 1024 + (size_t)h * 64 * 1024;
                const float* Bm = INP(c, I_A_W_UV) + (size_t)j * 16 * 128 * 64 + (size_t)h * 128 * 64;
                bf16* C = (bf16*)(ws + WS_WAOV) + (size_t)j * 1024 * 2048 + h * 128;
                small_gemm_tile(c, A, 1, 1024, Bm, 64, 1, 64, C, 2048, nt * 64, kt * 64, 1.0f);
            }
        }
        (void)tbase;
    }
}

template <int FP4> __device__ __forceinline__ void peer_pack_row16(const float (&v)[16], unsigned char* dst) {
    if (FP4) { v2u w;
#pragma unroll
        for (int d = 0; d < 2; ++d) { unsigned p = 0u;
            p = __builtin_amdgcn_cvt_scalef32_pk_fp4_f32(p, v[8 * d + 0], v[8 * d + 1], 1.0f, 0); p = __builtin_amdgcn_cvt_scalef32_pk_fp4_f32(p, v[8 * d + 2], v[8 * d + 3], 1.0f, 1);
            p = __builtin_amdgcn_cvt_scalef32_pk_fp4_f32(p, v[8 * d + 4], v[8 * d + 5], 1.0f, 2); p = __builtin_amdgcn_cvt_scalef32_pk_fp4_f32(p, v[8 * d + 6], v[8 * d + 7], 1.0f, 3);
            w[d] = p; }
        *(v2u*)dst = w;
    } else { v4u w;
#pragma unroll
        for (int q = 0; q < 4; ++q) { int pa = 0; pa = __builtin_amdgcn_cvt_pk_fp8_f32(v[4 * q], v[4 * q + 1], pa, false); pa = __builtin_amdgcn_cvt_pk_fp8_f32(v[4 * q + 2], v[4 * q + 3], pa, true); w[q] = (unsigned)pa; }
        *(v4u*)dst = w;
    }
}

__device__ __forceinline__ void phase_ln1(const Ctx& c, int layer) {
    const int gw = c.bid * NWAVES + c.wave, NGW = c.G * NWAVES;
    const float* gain = INP(c, I_LN1_G) + layer * DM; const float* bias = INP(c, I_LN1_B) + layer * DM;
    bf16* xb = (bf16*)(c.ws + ((layer & 1) ? WS_XB1 : WS_XB0));
    for (int m = gw; m < T_TOK; m += NGW) {
        float v[16]; load_row16(c.out + (size_t)m * DM, v, c.lane);
        ln_store_row(v, gain, bias, c.out + (size_t)m * DM, xb + (size_t)m * DM, c.lane);
    }
    {
        const float* U = INP(c, I_PEER_U) + (size_t)layer * 16384 * 1024; const float* V = INP(c, I_PEER_V) + (size_t)layer * 16384 * 1024;
        unsigned char* tu = c.ws + WS_TABU; unsigned char* tv = c.ws + WS_TABV;
        const size_t n16 = (size_t)16384 * 1024 / 16;
        for (size_t e = (size_t)c.bid * NTHR + c.tid; e < n16; e += (size_t)c.G * NTHR) {
            float ua[16], va[16];
#pragma unroll
            for (int q = 0; q < 4; ++q) { const f32x4 a4 = *(const f32x4*)(U + e * 16 + 4 * q) * PEER_USCALE, b4 = *(const f32x4*)(V + e * 16 + 4 * q) * PEER_VSCALE;
#pragma unroll
                for (int j = 0; j < 4; ++j) { ua[4 * q + j] = a4[j]; va[4 * q + j] = b4[j]; } }
            if (PEER_U4 && PEER_V4) {
                const size_t row = e >> 6, l16 = e & 63; peer_pack_row16<1>(ua, tu + row * 1024 + l16 * 8); peer_pack_row16<1>(va, tu + row * 1024 + 512 + l16 * 8);
            } else { peer_pack_row16<PEER_U4>(ua, tu + e * (PEER_UROW / 64)); peer_pack_row16<PEER_V4>(va, tv + e * (PEER_VROW / 64)); }
        }
    }
    {
        const float* P = INP(c, I_P) + (size_t)layer * T_TOK * 256; bf16* pb = (bf16*)(c.ws + WS_M + M_PB);
        const size_t n8 = (size_t)T_TOK * 256 / 8;
        for (size_t e = (size_t)c.bid * NTHR + c.tid; e < n8; e += (size_t)c.G * NTHR) {
            const f32x4 a = *(const f32x4*)(P + e * 8), b = *(const f32x4*)(P + e * 8 + 4);
            v4u w; w.x = pk2(a[0], a[1]); w.y = pk2(a[2], a[3]); w.z = pk2(b[0], b[1]); w.w = pk2(b[2], b[3]); *(v4u*)(pb + e * 8) = w;
        }
    }
}

using pg8::Unit;
constexpr int BMT = 256, HALFT = 128;

struct EpiResid {
    static constexpr bool PERM = false, AFTER_DRAIN = false;
    float* X; float alpha; const float* Xsrc;
    __device__ __forceinline__ void operator()(const pg8::f32x4 (&acc)[2][2][4][2], const Unit& u, int wr, int wc, int fr, int fq) const {
        const int row0 = u.pm * BMT + wr * 64 + fr, col0 = u.pn * BMT + wc * 32 + 4 * fq;
#pragma unroll
        for (int ai = 0; ai < 2; ++ai)
#pragma unroll
            for (int m = 0; m < 4; ++m) { const size_t roff = (size_t)(row0 + ai * HALFT + m * 16) * DM + col0; float* rowp = X + roff; const float* srcp = Xsrc + roff;
                pg8::f32x4 xv[2][2];
#pragma unroll
                for (int bj = 0; bj < 2; ++bj)
#pragma unroll
                    for (int n = 0; n < 2; ++n) xv[bj][n] = *(const pg8::f32x4*)(srcp + bj * HALFT + n * 16);
#pragma unroll
                for (int bj = 0; bj < 2; ++bj)
#pragma unroll
                    for (int n = 0; n < 2; ++n) *(pg8::f32x4*)(rowp + bj * HALFT + n * 16) = xv[bj][n] * alpha + acc[ai][bj][m][n]; }
    }
};

struct EpiF32T {
    static constexpr bool PERM = true, AFTER_DRAIN = false;
    bf16* C;
    __device__ __forceinline__ void operator()(const pg8::f32x4 (&acc)[2][2][4][2], const Unit& u, int wr, int wc, int fr, int fq) const {
        const int row0 = u.pm * BMT + wr * 64 + fr, cg0 = (u.pn * BMT + wc * 32 + 8 * fq) >> 3;
#pragma unroll
        for (int ai = 0; ai < 2; ++ai)
#pragma unroll
            for (int m = 0; m < 4; ++m) { const int r = row0 + ai * HALFT + m * 16; bf16* bp = C + (((size_t)(r >> 6) * 256 + cg0) * 64 + (r & 63)) * 8;
#pragma unroll
                for (int bj = 0; bj < 2; ++bj) { const pg8::f32x4 v0 = acc[ai][bj][m][0], v1 = acc[ai][bj][m][1];
                    v4u w; w.x = pk2(v0[0], v0[1]); w.y = pk2(v0[2], v0[3]); w.z = pk2(v1[0], v1[1]); w.w = pk2(v1[2], v1[3]);
                    *(v4u*)(bp + (size_t)(bj * 16) * 512) = w; } }
    }
};

template <int ACT0  > struct EpiBf16R {
    static constexpr bool PERM = true, AFTER_DRAIN = false;
    bf16 *O0, *O1, *O2; int ld0, ld1, ld2, c1, c2;
    __device__ __forceinline__ void operator()(const pg8::f32x4 (&acc)[2][2][4][2], const Unit& u, int wr, int wc, int fr, int fq) const {
        const int row0 = u.pm * BMT + wr * 64 + fr; int colt = u.pn * BMT; bf16* base; int ld; bool act = false;
        if (colt < c1) { base = O0; ld = ld0; act = (ACT0 == 1); } else if (colt < c2) { base = O1; ld = ld1; colt -= c1; } else { base = O2; ld = ld2; colt -= c2; }
        const int col0 = colt + wc * 32 + 8 * fq;
#pragma unroll
        for (int ai = 0; ai < 2; ++ai)
#pragma unroll
            for (int m = 0; m < 4; ++m) { bf16* rowp = base + (size_t)(row0 + ai * HALFT + m * 16) * ld + col0;
#pragma unroll
                for (int bj = 0; bj < 2; ++bj) { pg8::f32x4 v0 = acc[ai][bj][m][0], v1 = acc[ai][bj][m][1];
                    if (ACT0 == 1 && act) {
#pragma unroll
                        for (int j = 0; j < 4; ++j) { v0[j] = gelu_tanh(v0[j]); v1[j] = gelu_tanh(v1[j]); } }
                    v4u w; w.x = pk2(v0[0], v0[1]); w.y = pk2(v0[2], v0[3]); w.z = pk2(v1[0], v1[1]); w.w = pk2(v1[2], v1[3]);
                    *(v4u*)(rowp + bj * HALFT) = w; } }
    }
};

struct EpiRetIn {
    static constexpr bool PERM = true, AFTER_DRAIN = false;
    bf16 *Q, *K, *V; const float* cs; const float* sn;
    __device__ __forceinline__ void operator()(const pg8::f32x4 (&acc)[2][2][4][2], const Unit& u, int wr, int wc, int fr, int fq) const {
        const int row0 = u.pm * BMT + wr * 64 + fr; const int colt = u.pn * BMT;
        if (colt >= 2048) {
            const int col0 = colt - 2048 + wc * 32 + 8 * fq;
#pragma unroll
            for (int ai = 0; ai < 2; ++ai)
#pragma unroll
                for (int m = 0; m < 4; ++m) { bf16* rowp = V + (size_t)(row0 + ai * HALFT + m * 16) * 2048 + col0;
#pragma unroll
                    for (int bj = 0; bj < 2; ++bj) { const pg8::f32x4 v0 = acc[ai][bj][m][0], v1 = acc[ai][bj][m][1];
                        v4u w; w.x = pk2(v0[0], v0[1]); w.y = pk2(v0[2], v0[3]); w.z = pk2(v1[0], v1[1]); w.w = pk2(v1[2], v1[3]);
                        *(v4u*)(rowp + bj * HALFT) = w; } }
        } else {
            const bool isk = colt >= 1024; bf16* base = isk ? K : Q; const float sc = isk ? 0.0625f : 1.0f;
            const int col0 = (isk ? colt - 1024 : colt) + wc * 32 + 8 * fq; const int f0 = wc * 32 + 8 * fq;
#pragma unroll
            for (int ai = 0; ai < 2; ++ai)
#pragma unroll
                for (int m = 0; m < 4; ++m) { const int row = row0 + ai * HALFT + m * 16; const int pos = row & (SEQ - 1);
                    const pg8::f32x4 c0 = *(const pg8::f32x4*)(cs + pos * 128 + f0), c1 = *(const pg8::f32x4*)(cs + pos * 128 + f0 + 4);
                    const pg8::f32x4 s0 = *(const pg8::f32x4*)(sn + pos * 128 + f0), s1 = *(const pg8::f32x4*)(sn + pos * 128 + f0 + 4);
                    const pg8::f32x4 a0 = acc[ai][0][m][0] * sc, a1 = acc[ai][0][m][1] * sc, b0 = acc[ai][1][m][0] * sc, b1 = acc[ai][1][m][1] * sc;
                    const pg8::f32x4 r0 = a0 * c0 - b0 * s0, r1 = a1 * c1 - b1 * s1, q0 = a0 * s0 + b0 * c0, q1 = a1 * s1 + b1 * c1;
                    bf16* rowp = base + (size_t)row * 1024 + col0;
                    v4u w; w.x = pk2(r0[0], r0[1]); w.y = pk2(r0[2], r0[3]); w.z = pk2(r1[0], r1[1]); w.w = pk2(r1[2], r1[3]); *(v4u*)(rowp) = w;
                    v4u w2; w2.x = pk2(q0[0], q0[1]); w2.y = pk2(q0[2], q0[3]); w2.z = pk2(q1[0], q1[1]); w2.w = pk2(q1[2], q1[3]); *(v4u*)(rowp + HALFT) = w2; }
        }
    }
};

struct EpiRetGate {
    static constexpr bool PERM = true, AFTER_DRAIN = false;
    bf16* O; const float* STAT;
    __device__ __forceinline__ void operator()(const pg8::f32x4 (&acc)[2][2][4][2], const Unit& u, int wr, int wc, int fr, int fq) const {
        const int row0 = u.pm * BMT + wr * 64 + fr; const int head = u.pn >> 1; const int col0 = u.pn * BMT + wc * 32 + 8 * fq;
#pragma unroll
        for (int ai = 0; ai < 2; ++ai)
#pragma unroll
            for (int m = 0; m < 4; ++m) { const int row = row0 + ai * HALFT + m * 16;
                const pg8::f32x4 st = *(const pg8::f32x4*)(STAT + (size_t)row * 16 + head * 4);
                const float mean = (st[0] + st[2]) * (1.0f / 512.0f); const float var = (st[1] + st[3]) * (1.0f / 512.0f) - mean * mean;
                const float rstd = __builtin_amdgcn_rsqf(fmaxf(var, 0.f) + 1e-5f);
                bf16* rowp = O + (size_t)row * 2048 + col0;
#pragma unroll
                for (int bj = 0; bj < 2; ++bj) { const v4u ov = *(const v4u*)(rowp + bj * HALFT);
                    const pg8::f32x4 g0 = acc[ai][bj][m][0], g1 = acc[ai][bj][m][1];
                    float o[8] = {bflo(ov.x), bfhi(ov.x), bflo(ov.y), bfhi(ov.y), bflo(ov.z), bfhi(ov.z), bflo(ov.w), bfhi(ov.w)};
                    float r[8];
#pragma unroll
                    for (int j = 0; j < 8; ++j) { const float g = j < 4 ? g0[j] : g1[j - 4]; r[j] = g * sigmoidf_(g) * (o[j] - mean) * rstd; }
                    v4u w; w.x = pk2(r[0], r[1]); w.y = pk2(r[2], r[3]); w.z = pk2(r[4], r[5]); w.w = pk2(r[6], r[7]);
                    *(v4u*)(rowp + bj * HALFT) = w; } }
    }
};

struct EpiPle {
    static constexpr bool PERM = true, AFTER_DRAIN = false;
    float* X; const bf16* PP; bf16* XBo; const float* bg;
    __device__ __forceinline__ void operator()(const pg8::f32x4 (&acc)[2][2][4][2], const Unit& u, int wr, int wc, int fr, int fq) const {
        const int row0 = u.pm * BMT + wr * 64 + fr; const int col0 = u.pn * BMT + wc * 32 + 8 * fq;
        pg8::f32x4 bv[2][2];
#pragma unroll
        for (int bj = 0; bj < 2; ++bj)
#pragma unroll
            for (int n = 0; n < 2; ++n) bv[bj][n] = *(const pg8::f32x4*)(bg + col0 + bj * HALFT + 4 * n);
#pragma unroll
        for (int ai = 0; ai < 2; ++ai)
#pragma unroll
            for (int m = 0; m < 4; ++m) { const size_t off = (size_t)(row0 + ai * HALFT + m * 16) * DM + col0;
#pragma unroll
                for (int bj = 0; bj < 2; ++bj) {
                    const v4u pv = *(const v4u*)(PP + off + bj * HALFT);
                    const pg8::f32x4 x0 = *(const pg8::f32x4*)(X + off + bj * HALFT), x1 = *(const pg8::f32x4*)(X + off + bj * HALFT + 4);
                    const float pp[8] = {bflo(pv.x), bfhi(pv.x), bflo(pv.y), bfhi(pv.y), bflo(pv.z), bfhi(pv.z), bflo(pv.w), bfhi(pv.w)};
                    pg8::f32x4 o0, o1;
#pragma unroll
                    for (int j = 0; j < 4; ++j) { o0[j] = x0[j] + sigmoidf_(acc[ai][bj][m][0][j] + bv[bj][0][j]) * pp[j];
                                                  o1[j] = x1[j] + sigmoidf_(acc[ai][bj][m][1][j] + bv[bj][1][j]) * pp[4 + j]; }
                    *(pg8::f32x4*)(X + off + bj * HALFT) = o0; *(pg8::f32x4*)(X + off + bj * HALFT + 4) = o1;
                    v4u w; w.x = pk2(o0[0], o0[1]); w.y = pk2(o0[2], o0[3]); w.z = pk2(o1[0], o1[1]); w.w = pk2(o1[2], o1[3]);
                    *(v4u*)(XBo + off + bj * HALFT) = w; } }
    }
};

template <class Epi>
__device__ __forceinline__ void run_gemm(const Ctx& c, const bf16* A, const bf16* Bt, int N, int K, const Epi& E) {
    asm volatile("" : "+s"(K), "+s"(N));
    pg8::Gemm g{A, Bt, T_TOK, N, K}; pg8::StaticOrder S; S.init(T_TOK, N, c.G, c.bid);
    pg8::gemm_phase<Epi, pg8::StaticOrder, false>((PG8_LAS unsigned char*)c.lds, g, S, E, nullptr);
}

__device__ __forceinline__ unsigned sort_key(float f) { const unsigned u = __builtin_bit_cast(unsigned, f); return (u & 0x80000000u) ? ~u : (u | 0x80000000u); }
__device__ __forceinline__ unsigned half_sel(unsigned long long m, int half) { return half ? (unsigned)(m >> 32) : (unsigned)m; }

#define PK_CE(i, j) { const unsigned hi_ = b[i] > b[j] ? b[i] : b[j], lo_ = b[i] > b[j] ? b[j] : b[i]; b[i] = hi_; b[j] = lo_; }
__device__ __forceinline__ void sort16_desc(unsigned (&b)[16]) {
#define CE(i, j) PK_CE(i, j)
    CE(0,1) CE(2,3) CE(0,2) CE(1,3) CE(1,2) CE(4,5) CE(6,7) CE(4,6) CE(5,7) CE(5,6) CE(0,4) CE(2,6) CE(2,4) CE(1,5) CE(3,7) CE(3,5) CE(1,2) CE(3,4) CE(5,6) CE(8,9) CE(10,11) CE(8,10) CE(9,11) CE(9,10) CE(12,13) CE(14,15) CE(12,14) CE(13,15) CE(13,14) CE(8,12) CE(10,14) CE(10,12) CE(9,13) CE(11,15) CE(11,13) CE(9,10) CE(11,12) CE(13,14) CE(0,8) CE(4,12) CE(4,8) CE(2,10) CE(6,14) CE(6,10) CE(2,4) CE(6,8) CE(10,12) CE(1,9) CE(5,13) CE(5,9) CE(3,11) CE(7,15) CE(7,11) CE(3,5) CE(7,9) CE(11,13) CE(1,2) CE(3,4) CE(5,6) CE(7,8) CE(9,10) CE(11,12) CE(13,14)
#undef CE
}
__device__ __forceinline__ void merge16_desc(unsigned (&t)[16], const unsigned (&bb)[16]) {
    unsigned b[16];
#pragma unroll
    for (int i = 0; i < 16; ++i) b[i] = t[i] > bb[15 - i] ? t[i] : bb[15 - i];
#pragma unroll
    for (int d = 8; d >= 1; d >>= 1)
#pragma unroll
        for (int i = 0; i < 16; ++i) if ((i & d) == 0) PK_CE(i, i + d)
#pragma unroll
    for (int i = 0; i < 16; ++i) t[i] = b[i];
}
__device__ __forceinline__ void ins16(unsigned (&t)[16], unsigned x) {
#pragma unroll
    for (int p = 0; p < 16; ++p) { const unsigned hi = x > t[p] ? x : t[p], lo = x > t[p] ? t[p] : x; t[p] = hi; x = lo; }
}
__device__ __forceinline__ float unsort_key(unsigned k) { const unsigned u = (k & 0x80000000u) ? (k & 0x7fffffffu) : ~k; return __builtin_bit_cast(float, u); }
__device__ __forceinline__ void phase_peer_topk(const Ctx& c) {
    const int gw = c.bid * NWAVES + c.wave, NGW = c.G * NWAVES, lane = c.lane;
    const bf16* SCT = (const bf16*)(c.ws + WS_M + M_SC); int* IDS = (int*)(c.ws + WS_M + M_IDS); float* GATES = (float*)(c.ws + WS_M + M_GATES);
    LAS unsigned char* lidx = c.lds + c.wave * 2048 + lane * 32;
    for (int wu = gw; wu < 8192; wu += NGW) {
        const int tblk = wu >> 3, hd = wu & 7, tok = tblk * 64 + lane;
        unsigned tA[16], tB[16];
        const v4u* pa = (const v4u*)SCT + ((size_t)tblk * 256 + hd * 32) * 64 + lane; const v4u* pb = pa + 16 * 64;
#pragma unroll 1
        for (int blk = 0; blk < 8; ++blk) {
            unsigned ka[16], kb[16];
#pragma unroll
            for (int gg = 0; gg < 2; ++gg) { const v4u xa = pa[(2 * blk + gg) * 64], xb = pb[(2 * blk + gg) * 64];
#pragma unroll
                for (int j = 0; j < 4; ++j) { const unsigned lo0 = (unsigned)(127 - (16 * blk + 8 * gg + 2 * j)), lo1 = lo0 - 1u;
                    ka[8 * gg + 2 * j] = (sort_key(bflo(xa[j])) & ~127u) | lo0; ka[8 * gg + 2 * j + 1] = (sort_key(bfhi(xa[j])) & ~127u) | lo1;
                    kb[8 * gg + 2 * j] = (sort_key(bflo(xb[j])) & ~127u) | lo0; kb[8 * gg + 2 * j + 1] = (sort_key(bfhi(xb[j])) & ~127u) | lo1; } }
            sort16_desc(ka); sort16_desc(kb);
            if (blk == 0) {
#pragma unroll
                for (int i = 0; i < 16; ++i) { tA[i] = ka[i]; tB[i] = kb[i]; }
            } else { merge16_desc(tA, ka); merge16_desc(tB, kb); }
        }
        float a[16], b[16];
#pragma unroll
        for (int i = 0; i < 16; ++i) { a[i] = unsort_key(tA[i] & ~127u); b[i] = unsort_key(tB[i] & ~127u); lidx[i] = (unsigned char)(127u - (tA[i] & 127u)); lidx[16 + i] = (unsigned char)(127u - (tB[i] & 127u)); }
        unsigned uu[16];
        uu[0] = (sort_key(a[0] + b[0]) & ~255u) | 0u;
        uu[1] = (sort_key(a[0] + b[1]) & ~255u) | 1u;
        uu[2] = (sort_key(a[0] + b[2]) & ~255u) | 2u;
        uu[3] = (sort_key(a[0] + b[3]) & ~255u) | 3u;
        uu[4] = (sort_key(a[0] + b[4]) & ~255u) | 4u;
        uu[5] = (sort_key(a[0] + b[5]) & ~255u) | 5u;
        uu[6] = (sort_key(a[0] + b[6]) & ~255u) | 6u;
        uu[7] = (sort_key(a[0] + b[7]) & ~255u) | 7u;
        uu[8] = (sort_key(a[0] + b[8]) & ~255u) | 8u;
        uu[9] = (sort_key(a[0] + b[9]) & ~255u) | 9u;
        uu[10] = (sort_key(a[0] + b[10]) & ~255u) | 10u;
        uu[11] = (sort_key(a[0] + b[11]) & ~255u) | 11u;
        uu[12] = (sort_key(a[0] + b[12]) & ~255u) | 12u;
        uu[13] = (sort_key(a[0] + b[13]) & ~255u) | 13u;
        uu[14] = (sort_key(a[0] + b[14]) & ~255u) | 14u;
        uu[15] = (sort_key(a[0] + b[15]) & ~255u) | 15u;
        sort16_desc(uu);
        unsigned cb[16];
        cb[0] = (sort_key(a[1] + b[0]) & ~255u) | 16u;
        cb[1] = (sort_key(a[1] + b[1]) & ~255u) | 17u;
        cb[2] = (sort_key(a[1] + b[2]) & ~255u) | 18u;
        cb[3] = (sort_key(a[1] + b[3]) & ~255u) | 19u;
        cb[4] = (sort_key(a[1] + b[4]) & ~255u) | 20u;
        cb[5] = (sort_key(a[1] + b[5]) & ~255u) | 21u;
        cb[6] = (sort_key(a[1] + b[6]) & ~255u) | 22u;
        cb[7] = (sort_key(a[1] + b[7]) & ~255u) | 23u;
        cb[8] = (sort_key(a[2] + b[0]) & ~255u) | 32u;
        cb[9] = (sort_key(a[2] + b[1]) & ~255u) | 33u;
        cb[10] = (sort_key(a[2] + b[2]) & ~255u) | 34u;
        cb[11] = (sort_key(a[2] + b[3]) & ~255u) | 35u;
        cb[12] = (sort_key(a[2] + b[4]) & ~255u) | 36u;
        cb[13] = (sort_key(a[3] + b[0]) & ~255u) | 48u;
        cb[14] = (sort_key(a[3] + b[1]) & ~255u) | 49u;
        cb[15] = (sort_key(a[3] + b[2]) & ~255u) | 50u;
        sort16_desc(cb); merge16_desc(uu, cb);
        cb[0] = (sort_key(a[3] + b[3]) & ~255u) | 51u;
        cb[1] = (sort_key(a[4] + b[0]) & ~255u) | 64u;
        cb[2] = (sort_key(a[4] + b[1]) & ~255u) | 65u;
        cb[3] = (sort_key(a[4] + b[2]) & ~255u) | 66u;
        cb[4] = (sort_key(a[5] + b[0]) & ~255u) | 80u;
        cb[5] = (sort_key(a[5] + b[1]) & ~255u) | 81u;
        cb[6] = (sort_key(a[6] + b[0]) & ~255u) | 96u;
        cb[7] = (sort_key(a[6] + b[1]) & ~255u) | 97u;
        cb[8] = (sort_key(a[7] + b[0]) & ~255u) | 112u;
        cb[9] = (sort_key(a[7] + b[1]) & ~255u) | 113u;
        cb[10] = (sort_key(a[8] + b[0]) & ~255u) | 128u;
        cb[11] = (sort_key(a[9] + b[0]) & ~255u) | 144u;
        cb[12] = (sort_key(a[10] + b[0]) & ~255u) | 160u;
        cb[13] = (sort_key(a[11] + b[0]) & ~255u) | 176u;
        cb[14] = (sort_key(a[12] + b[0]) & ~255u) | 192u;
        cb[15] = (sort_key(a[13] + b[0]) & ~255u) | 208u;
        sort16_desc(cb); merge16_desc(uu, cb);
        cb[0] = (sort_key(a[14] + b[0]) & ~255u) | 224u;
        cb[1] = (sort_key(a[15] + b[0]) & ~255u) | 240u;
        cb[2] = 0u;
        cb[3] = 0u;
        cb[4] = 0u;
        cb[5] = 0u;
        cb[6] = 0u;
        cb[7] = 0u;
        cb[8] = 0u;
        cb[9] = 0u;
        cb[10] = 0u;
        cb[11] = 0u;
        cb[12] = 0u;
        cb[13] = 0u;
        cb[14] = 0u;
        cb[15] = 0u;
        sort16_desc(cb); merge16_desc(uu, cb);
        LDS_WAIT(); asm volatile("" ::: "memory");
        float sc[16], sum = 0.f; int eid[16];
        const float s0 = unsort_key(uu[0] & ~255u);
#pragma unroll
        for (int r = 0; r < 16; ++r) { const float s = unsort_key(uu[r] & ~255u); sc[r] = __expf(s - s0); sum += sc[r];
            const int i = (uu[r] >> 4) & 15, j = uu[r] & 15; eid[r] = (int)lidx[i] * 128 + (int)lidx[16 + j]; }
        const float inv = 1.0f / sum;
#pragma unroll
        for (int q = 0; q < 4; ++q) {
            *(v4u*)(IDS + (size_t)tok * 128 + hd * 16 + 4 * q) = (v4u){(unsigned)eid[4 * q], (unsigned)eid[4 * q + 1], (unsigned)eid[4 * q + 2], (unsigned)eid[4 * q + 3]};
            *(f32x4*)(GATES + (size_t)tok * 128 + hd * 16 + 4 * q) = (f32x4){sc[4 * q] * inv, sc[4 * q + 1] * inv, sc[4 * q + 2] * inv, sc[4 * q + 3] * inv};
        }
        LDS_WAIT(); asm volatile("" ::: "memory");
    }
}

#if !(PEER_U4 && PEER_V4)
#error "this gather expects both expert tables in fp4 (interleaved rows)"
#endif
typedef int v8i_t __attribute__((ext_vector_type(8)));
constexpr float PEER_XSCALE = 8.0f;
struct PeerGroup { v4u ua[8]; float g4[4]; };
__device__ __forceinline__ void peer_load(PeerGroup& B, const unsigned char* TAB, int idv, float gv, int kb, int lane) {
    const int m = lane & 15, kg = lane >> 4;
    const int idm = __builtin_amdgcn_ds_bpermute(4 * (kb + m), idv);
    const unsigned char* up = TAB + (size_t)idm * 1024 + 16 * kg;
#pragma unroll
    for (int cc = 0; cc < 8; ++cc) B.ua[cc] = *(const v4u*)(up + 64 * cc);
#pragma unroll
    for (int r = 0; r < 4; ++r) B.g4[r] = __builtin_bit_cast(float, __builtin_amdgcn_ds_bpermute(4 * (kb + 4 * kg + r), __builtin_bit_cast(int, gv)));
}
template <int J> __device__ __forceinline__ f32x2 fp4_pair(const v4u& w) { return __builtin_amdgcn_cvt_scalef32_pk_f32_fp4(w[J >> 2], 1.0f, J & 3); }
__device__ __forceinline__ void peer_compute(const PeerGroup& B, const unsigned char* TAB, int idv, int kb, const LAS unsigned char* xb8, f32x2 (&y2)[16], int lane) {
    const int hf = lane >> 5, l31 = lane & 31;
    v4u vv[8];
#pragma unroll
    for (int e = 0; e < 8; ++e) {
        const int ida = __builtin_amdgcn_readlane(idv, kb + 2 * e), idb = __builtin_amdgcn_readlane(idv, kb + 2 * e + 1);
        vv[e] = *(const v4u*)(TAB + (size_t)(hf ? idb : ida) * 1024 + 512 + 16 * l31);
    }
    f32x4 d = {0.f, 0.f, 0.f, 0.f};
#pragma unroll
    for (int cc = 0; cc < 8; ++cc) {
        asm volatile("" ::: "memory");
        const v4u b0 = *(const LAS v4u*)(xb8 + 128 * cc), b1 = *(const LAS v4u*)(xb8 + 128 * cc + 64);
        const v8i_t bx = {(int)b0.x, (int)b0.y, (int)b0.z, (int)b0.w, (int)b1.x, (int)b1.y, (int)b1.z, (int)b1.w};
        const v8i_t ax = {(int)B.ua[cc].x, (int)B.ua[cc].y, (int)B.ua[cc].z, (int)B.ua[cc].w, 0, 0, 0, 0};
        d = __builtin_amdgcn_mfma_scale_f32_16x16x128_f8f6f4(ax, bx, d, 4  , 0  , 0, 127, 0, 127);
    }
    float a4[4];
#pragma unroll
    for (int r = 0; r < 4; ++r) a4[r] = gelu_tanh(d[r] * (1.0f / (PEER_USCALE * PEER_XSCALE))) * B.g4[r] * (1.0f / PEER_VSCALE);
#pragma unroll
    for (int e = 0; e < 8; ++e) {
        const int ma = 2 * e, mb = 2 * e + 1;
        const float a0 = __builtin_bit_cast(float, __builtin_amdgcn_readlane(__builtin_bit_cast(int, a4[ma & 3]), 16 * (ma >> 2))), a1 = __builtin_bit_cast(float, __builtin_amdgcn_readlane(__builtin_bit_cast(int, a4[mb & 3]), 16 * (mb >> 2)));
        const float a = hf ? a1 : a0; const f32x2 a2 = {a, a};
#define PEER_AXPY(J) y2[J] = __builtin_elementwise_fma(a2, fp4_pair<J>(vv[e]), y2[J]);
        PEER_AXPY(0) PEER_AXPY(1) PEER_AXPY(2) PEER_AXPY(3) PEER_AXPY(4) PEER_AXPY(5) PEER_AXPY(6) PEER_AXPY(7)
        PEER_AXPY(8) PEER_AXPY(9) PEER_AXPY(10) PEER_AXPY(11) PEER_AXPY(12) PEER_AXPY(13) PEER_AXPY(14) PEER_AXPY(15)
#undef PEER_AXPY
    }
}
template <class BarFn>
__device__ __forceinline__ void phase_peer_gather(const Ctx& c, int layer, const BarFn&) {
    const int gw = c.bid * NWAVES + c.wave, NGW = c.G * NWAVES;
    const int* IDS = (const int*)(c.ws + WS_M + M_IDS); const float* GATES = (const float*)(c.ws + WS_M + M_GATES);
    const unsigned char* TAB = c.ws + WS_TABU;
    const float* gain = INP(c, I_LN2_G) + layer * DM; const float* bias = INP(c, I_LN2_B) + layer * DM;
    bf16* xb = (bf16*)(c.ws + ((layer & 1) ? WS_XB1 : WS_XB0));
    const int lane = c.lane, hf = lane >> 5, l31 = lane & 31;
    LAS unsigned char* xbase = c.lds + c.wave * 3072;
    { unsigned z = 0u; asm volatile("" : "+v"(z));
      *(LAS v4u*)(xbase + 2048 + 16 * lane) = (v4u){z, z, z, z}; }
    const bool col0 = (lane & 15) == 0;
    auto stage_x = [&](int tk, int buf) {
        const float* xr = c.out + (size_t)tk * DM + 32 * l31; v4u w0, w1;
#pragma unroll
        for (int q = 0; q < 8; ++q) { const f32x4 a = *(const f32x4*)(xr + 4 * q) * PEER_XSCALE; int pa = 0;
            pa = __builtin_amdgcn_cvt_pk_fp8_f32(a[0], a[1], pa, false); pa = __builtin_amdgcn_cvt_pk_fp8_f32(a[2], a[3], pa, true);
            if (q < 4) w0[q] = (unsigned)pa; else w1[q - 4] = (unsigned)pa; }
        if (hf == 0) { *(LAS v4u*)(xbase + 1024 * buf + 32 * l31) = w0; *(LAS v4u*)(xbase + 1024 * buf + 32 * l31 + 16) = w1; } };
    int tok = gw, par = 0;
    int idA = 0, idB = 0; float gA = 0.f, gB = 0.f;
    PeerGroup G0, G1;
    if (tok < T_TOK) {
        idA = IDS[(size_t)tok * 128 + lane]; idB = IDS[(size_t)tok * 128 + 64 + lane]; gA = GATES[(size_t)tok * 128 + lane]; gB = GATES[(size_t)tok * 128 + 64 + lane];
        stage_x(tok, 0);
        peer_load(G0, TAB, idA, gA, 0, lane);
    }
#pragma unroll 1
    while (tok < T_TOK) {
        const int ntok = tok + NGW; const bool has_next = ntok < T_TOK;
        int nidA = 0, nidB = 0; float ngA = 0.f, ngB = 0.f;
        if (has_next) { nidA = IDS[(size_t)ntok * 128 + lane]; nidB = IDS[(size_t)ntok * 128 + 64 + lane]; ngA = GATES[(size_t)ntok * 128 + lane]; ngB = GATES[(size_t)ntok * 128 + 64 + lane]; }
        const LAS unsigned char* xb8 = col0 ? (xbase + 1024 * par + 16 * (lane >> 4)) : (xbase + 2048);
        f32x2 y2[16];
#pragma unroll
        for (int j = 0; j < 16; ++j) y2[j] = (f32x2){0.f, 0.f};
        f32x4 xres[4];
#pragma unroll
        for (int q = 0; q < 4; ++q) xres[q] = (f32x4){0.f, 0.f, 0.f, 0.f};
        LDS_WAIT(); asm volatile("" ::: "memory");
#define PEER_LD(Gx, g) peer_load(Gx, TAB, ((g) >= 4) ? idB : idA, ((g) >= 4) ? gB : gA, ((g) & 3) * 16, lane)
#define PEER_CP(Gx, g) peer_compute(Gx, TAB, ((g) >= 4) ? idB : idA, ((g) & 3) * 16, xb8, y2, lane)
#pragma unroll 1
        for (int g = 0; g < 8; g += 2) {
            PEER_LD(G1, g + 1); PEER_CP(G0, g);
            if (g == 2 && has_next) stage_x(ntok, par ^ 1);
            if (g + 2 < 8) PEER_LD(G0, g + 2); else if (has_next) peer_load(G0, TAB, nidA, ngA, 0, lane);
            if (g == 6) {
#pragma unroll
                for (int q = 0; q < 4; ++q) xres[q] = *(const f32x4*)(c.out + (size_t)tok * DM + 32 * l31 + 16 * hf + 4 * q); }
            PEER_CP(G1, g + 1);
        }
#undef PEER_LD
#undef PEER_CP
        float z[16];
#pragma unroll
        for (int j = 0; j < 16; ++j) { const float tx = y2[j].x + __shfl_xor(y2[j].x, 32), ty = y2[j].y + __shfl_xor(y2[j].y, 32); y2[j] = (f32x2){tx, ty}; }
#pragma unroll
        for (int j = 0; j < 8; ++j) { z[2 * j] = (hf ? y2[8 + j].x : y2[j].x) + ALPHA_DN * xres[j >> 1][2 * (j & 1)]; z[2 * j + 1] = (hf ? y2[8 + j].y : y2[j].y) + ALPHA_DN * xres[j >> 1][2 * (j & 1) + 1]; }
        float s = 0.f;
#pragma unroll
        for (int j = 0; j < 16; ++j) s += z[j];
        const float mean = wave_sum(s) * (1.f / 1024.f);
        float s2 = 0.f;
#pragma unroll
        for (int j = 0; j < 16; ++j) { z[j] -= mean; s2 += z[j] * z[j]; }
        const float rstd = __builtin_amdgcn_rsqf(wave_sum(s2) * (1.f / 1024.f) + 1e-5f);
        const int col = 32 * l31 + 16 * hf; float o[16];
#pragma unroll
        for (int q = 0; q < 4; ++q) { const f32x4 gq = *(const f32x4*)(gain + col + 4 * q), bq = *(const f32x4*)(bias + col + 4 * q); f32x4 r;
#pragma unroll
            for (int j = 0; j < 4; ++j) { r[j] = z[4 * q + j] * rstd * gq[j] + bq[j]; o[4 * q + j] = r[j]; }
            *(f32x4*)(c.out + (size_t)tok * DM + col + 4 * q) = r; }
        v4u w0, w1; w0.x = pk2(o[0], o[1]); w0.y = pk2(o[2], o[3]); w0.z = pk2(o[4], o[5]); w0.w = pk2(o[6], o[7]);
        w1.x = pk2(o[8], o[9]); w1.y = pk2(o[10], o[11]); w1.z = pk2(o[12], o[13]); w1.w = pk2(o[14], o[15]);
        *(v4u*)(xb + (size_t)tok * DM + col) = w0; *(v4u*)(xb + (size_t)tok * DM + col + 8) = w1;
        idA = nidA; idB = nidB; gA = ngA; gB = ngB; par ^= 1; tok = ntok;
    }
}

__device__ __forceinline__ void phase_dsa_norm(const Ctx& c, int j) {
    const int gw = c.bid * NWAVES + c.wave, NGW = c.G * NWAVES, lane = c.lane;
    const bf16* RAW = (const bf16*)(c.ws + WS_M + M_RAW);
    bf16* CQ = (bf16*)(c.ws + WS_M + M_CQ); bf16* CKV = (bf16*)(c.ws + WS_M + M_CKV);
    bf16* KIDX = (bf16*)(c.ws + WS_M + M_KIDX); float* WIDX = (float*)(c.ws + WS_M + M_WIDX);
    const float* gq = INP(c, I_A_CQ_GAIN) + j * 256; const float* gkv = INP(c, I_A_CKV_GAIN) + j * 128;
    const float* gk = INP(c, I_A_KIDX_GAIN) + j * 64; const float* bk = INP(c, I_A_KIDX_BIAS) + j * 64;
    for (int tok = gw; tok < T_TOK; tok += NGW) {
        const v4u rw = *(const v4u*)(RAW + (size_t)tok * 512 + 8 * lane);
        float v[8] = {bflo(rw.x), bfhi(rw.x), bflo(rw.y), bfhi(rw.y), bflo(rw.z), bfhi(rw.z), bflo(rw.w), bfhi(rw.w)};
        float ss = 0.f, s = 0.f;
#pragma unroll
        for (int i = 0; i < 8; ++i) { ss += v[i] * v[i]; s += v[i]; }
        const bool isq = lane < 32, iskv = lane >= 32 && lane < 48, isk = lane >= 48 && lane < 56;
        const float ssq_q = wave_sum(isq ? ss : 0.f), ssq_kv = wave_sum(iskv ? ss : 0.f), sum_k = wave_sum(isk ? s : 0.f);
        const float mean_k = sum_k * (1.0f / 64.0f);
        float dv = 0.f;
#pragma unroll
        for (int i = 0; i < 8; ++i) { const float d = v[i] - mean_k; dv += d * d; }
        const float var_k = wave_sum(isk ? dv : 0.f) * (1.0f / 64.0f);
        if (isq) {
            const float r = __builtin_amdgcn_rsqf(ssq_q * (1.0f / 256.0f) + 1e-6f); const float* g = gq + 8 * lane;
            v4u w; w.x = pk2(v[0] * r * g[0], v[1] * r * g[1]); w.y = pk2(v[2] * r * g[2], v[3] * r * g[3]); w.z = pk2(v[4] * r * g[4], v[5] * r * g[5]); w.w = pk2(v[6] * r * g[6], v[7] * r * g[7]);
            *(v4u*)(CQ + (size_t)tok * 256 + 8 * lane) = w;
        } else if (iskv) {
            const int c0 = 8 * (lane - 32); const float r = __builtin_amdgcn_rsqf(ssq_kv * (1.0f / 128.0f) + 1e-6f); const float* g = gkv + c0;
            float o[8];
#pragma unroll
            for (int i = 0; i < 8; ++i) o[i] = v[i] * r * g[i];
            v4u w; w.x = pk2(o[0], o[1]); w.y = pk2(o[2], o[3]); w.z = pk2(o[4], o[5]); w.w = pk2(o[6], o[7]);
            *(v4u*)(CKV + (size_t)tok * 128 + c0) = w;
        } else if (isk) {
            const int c0 = 8 * (lane - 48); const float r = __builtin_amdgcn_rsqf(var_k + 1e-5f);
            float o[8];
#pragma unroll
            for (int i = 0; i < 8; ++i) o[i] = (v[i] - mean_k) * r * gk[c0 + i] + bk[c0 + i];
            v4u w; w.x = pk2(o[0], o[1]); w.y = pk2(o[2], o[3]); w.z = pk2(o[4], o[5]); w.w = pk2(o[6], o[7]);
            *(v4u*)(KIDX + (size_t)tok * 64 + c0) = w;
        } else if (lane == 56) {
            const float sc = 0.35355339059327373f;
            f32x4 o0 = {v[0] * sc, v[1] * sc, v[2] * sc, v[3] * sc}, o1 = {v[4] * sc, v[5] * sc, v[6] * sc, v[7] * sc};
            *(f32x4*)(WIDX + (size_t)tok * 8) = o0; *(f32x4*)(WIDX + (size_t)tok * 8 + 4) = o1;
        }
    }
}

__device__ __forceinline__ unsigned half_sum_u32(unsigned v, int h) {
    auto dpp = [](unsigned x, auto ctrl, auto rmask) { return (unsigned)__builtin_amdgcn_update_dpp(0, (int)x, decltype(ctrl)::value, decltype(rmask)::value, 0xf, false); };
    v += dpp(v, std::integral_constant<int, 0xB1>{}, std::integral_constant<int, 0xf>{});
    v += dpp(v, std::integral_constant<int, 0x4E>{}, std::integral_constant<int, 0xf>{});
    v += dpp(v, std::integral_constant<int, 0x141>{}, std::integral_constant<int, 0xf>{});
    v += dpp(v, std::integral_constant<int, 0x140>{}, std::integral_constant<int, 0xf>{});
    v += dpp(v, std::integral_constant<int, 0x142>{}, std::integral_constant<int, 0xa>{});
    const unsigned t0 = (unsigned)__builtin_amdgcn_readlane((int)v, 31), t1 = (unsigned)__builtin_amdgcn_readlane((int)v, 63);
    return h ? t1 : t0;
}
__device__ __forceinline__ void phase_dsa_index(const Ctx& c) {
    const bf16* KIDX = (const bf16*)(c.ws + WS_M + M_KIDX); const bf16* QIDX = (const bf16*)(c.ws + WS_M + M_QIDX);
    const float* WIDX = (const float*)(c.ws + WS_M + M_WIDX); unsigned* MASK = (unsigned*)(c.ws + WS_M + M_MASK);
    const int lane = c.lane, n = lane & 31, h = lane >> 5;
    const unsigned ltmask = (1u << n) - 1u;
    LAS unsigned* kl = (LAS unsigned*)(c.lds + c.wave * 16384) + lane * 4;
    for (int u = c.bid; u < 2048; u += c.G) {
        const int b = u & 31, rest = u >> 5, qc = rest >> 1, sub = rest & 1;
        const int tw0 = b * 2048 + qc * 64 + sub * 32 + 4 * c.wave;
        const int nt = 2 * (qc + 1), ng = (nt + 3) >> 2;
        if (nt <= 8) {
            if (n == 0) {
                for (int tt = 0; tt < 2; ++tt)
                    for (int tile = 0; tile < nt; ++tile) MASK[(size_t)(tw0 + 2 * h + tt) * 64 + tile] = 0xffffffffu;
            }
            continue;
        }
        const int ti = 2 * ((n >> 2) & 1) + (n >> 4), hd = 4 * ((n >> 3) & 1) + (n & 3);
        bf16x8 Aq[4];
#pragma unroll
        for (int s = 0; s < 4; ++s) Aq[s] = *(const bf16x8*)(QIDX + (size_t)(tw0 + ti) * 512 + hd * 64 + 16 * s + 8 * h);
        float wv[2][8];
#pragma unroll
        for (int tt = 0; tt < 2; ++tt) { const f32x4 w0 = *(const f32x4*)(WIDX + (size_t)(tw0 + 2 * h + tt) * 8), w1 = *(const f32x4*)(WIDX + (size_t)(tw0 + 2 * h + tt) * 8 + 4);
#pragma unroll
            for (int i = 0; i < 4; ++i) { wv[tt][i] = w0[i]; wv[tt][4 + i] = w1[i]; } }
        const bf16* kbase = KIDX + (size_t)(b * 2048 + n) * 64 + 8 * h;
        auto ldgrp = [&](bf16x8 (&Bk)[2][4], int tile0) {
#pragma unroll
            for (int q = 0; q < 2; ++q) if (tile0 + q < nt) { const bf16* kr = kbase + (size_t)(tile0 + q) * 32 * 64;
#pragma unroll
                for (int s = 0; s < 4; ++s) Bk[q][s] = *(const bf16x8*)(kr + 16 * s); } };
        auto scgrp = [&](const bf16x8 (&Bk)[2][4], int tile0) {
#pragma unroll
            for (int q = 0; q < 2; ++q) if (tile0 + q < nt) {
                f32x16 acc;
#pragma unroll
                for (int i = 0; i < 16; ++i) acc[i] = 0.f;
#pragma unroll
                for (int s = 0; s < 4; ++s) acc = __builtin_amdgcn_mfma_f32_32x32x16_bf16(Aq[s], Bk[q][s], acc, 0, 0, 0);
                float sc0 = 0.f, sc1 = 0.f;
#pragma unroll
                for (int jj = 0; jj < 2; ++jj)
#pragma unroll
                    for (int k = 0; k < 4; ++k) { sc0 += wv[0][4 * jj + k] * fmaxf(acc[4 * jj + k], 0.f); sc1 += wv[1][4 * jj + k] * fmaxf(acc[8 + 4 * jj + k], 0.f); }
                kl[((tile0 + q) >> 2) * 256 + ((tile0 + q) & 3)] = (sort_key(sc0) >> 16) | (sort_key(sc1) & 0xffff0000u);
            } };
        bf16x8 BkA[2][4], BkB[2][4];
        ldgrp(BkA, 0);
#pragma unroll 1
        for (int tile0 = 0; tile0 < nt; tile0 += 4) {
            if (tile0 + 2 < nt) ldgrp(BkB, tile0 + 2);
            scgrp(BkA, tile0);
            if (tile0 + 4 < nt) ldgrp(BkA, tile0 + 4);
            if (tile0 + 2 < nt) scgrp(BkB, tile0 + 2);
        }
        if (nt & 2) { kl[(nt >> 2) * 256 + 2] = 0u; kl[(nt >> 2) * 256 + 3] = 0u; }
        LDS_WAIT(); asm volatile("" ::: "memory");
        unsigned v0 = 0u, v1 = 0u, cv0 = 0xffffu, cv1 = 0xffffu;
        for (int bit = 15; bit >= 0; --bit) {
            const unsigned c0 = v0 | (1u << bit), c1 = v1 | (1u << bit); unsigned lt0 = 0u, lt1 = 0u;
            for (int g = 0; g < ng; ++g) { const v4u k4 = *(const LAS v4u*)(kl + g * 256);
#pragma unroll
                for (int j = 0; j < 4; ++j) { lt0 += (unsigned)((int)((k4[j] & 0xffffu) - c0)) >> 31; lt1 += (unsigned)((int)((k4[j] >> 16) - c1)) >> 31; } }
            const unsigned both = half_sum_u32((4u * (unsigned)ng - lt0) | ((4u * (unsigned)ng - lt1) << 16), h);
            const unsigned cnt0 = both & 0xffffu, cnt1 = both >> 16;
            if (cnt0 >= 256u) { v0 = c0; cv0 = cnt0; }
            if (cnt1 >= 256u) { v1 = c1; cv1 = cnt1; }
            if (__all(cv0 == 256u && cv1 == 256u)) break;
        }
        unsigned g0 = 0u, g1 = 0u;
        for (int g = 0; g < ng; ++g) { const v4u k4 = *(const LAS v4u*)(kl + g * 256);
#pragma unroll
            for (int j = 0; j < 4; ++j) { g0 += (unsigned)((int)(v0 - (k4[j] & 0xffffu))) >> 31; g1 += (unsigned)((int)(v1 - (k4[j] >> 16))) >> 31; } }
        const unsigned gboth = half_sum_u32(g0 | (g1 << 16), h);
        const unsigned need0 = 256u - (gboth & 0xffffu), need1 = 256u - (gboth >> 16); unsigned eb0 = 0u, eb1 = 0u;
        for (int tile = 0; tile < nt; ++tile) {
            const unsigned kw = kl[(tile >> 2) * 256 + (tile & 3)]; const unsigned k0 = kw & 0xffffu, k1 = kw >> 16;
            { const bool gt = k0 > v0, eq = k0 == v0; const unsigned em = half_sel(__ballot(eq), h);
              const bool take = gt || (eq && (eb0 + __popc(em & ltmask) < need0)); eb0 += __popc(em);
              const unsigned word = half_sel(__ballot(take), h); if (n == 0) MASK[(size_t)(tw0 + 2 * h) * 64 + tile] = word; }
            { const bool gt = k1 > v1, eq = k1 == v1; const unsigned em = half_sel(__ballot(eq), h);
              const bool take = gt || (eq && (eb1 + __popc(em & ltmask) < need1)); eb1 += __popc(em);
              const unsigned word = half_sel(__ballot(take), h); if (n == 0) MASK[(size_t)(tw0 + 2 * h + 1) * 64 + tile] = word; }
        }
        LDS_WAIT(); asm volatile("" ::: "memory");
    }
}

__device__ __forceinline__ void tr_rd16(unsigned a, v2u (&r)[16]) {
    asm volatile("ds_read_b64_tr_b16 %0, %16\n\tds_read_b64_tr_b16 %1, %16 offset:4352\n\t"
                 "ds_read_b64_tr_b16 %2, %16 offset:32\n\tds_read_b64_tr_b16 %3, %16 offset:4384\n\t"
                 "ds_read_b64_tr_b16 %4, %16 offset:64\n\tds_read_b64_tr_b16 %5, %16 offset:4416\n\t"
                 "ds_read_b64_tr_b16 %6, %16 offset:96\n\tds_read_b64_tr_b16 %7, %16 offset:4448\n\t"
                 "ds_read_b64_tr_b16 %8, %16 offset:128\n\tds_read_b64_tr_b16 %9, %16 offset:4480\n\t"
                 "ds_read_b64_tr_b16 %10, %16 offset:160\n\tds_read_b64_tr_b16 %11, %16 offset:4512\n\t"
                 "ds_read_b64_tr_b16 %12, %16 offset:192\n\tds_read_b64_tr_b16 %13, %16 offset:4544\n\t"
                 "ds_read_b64_tr_b16 %14, %16 offset:224\n\tds_read_b64_tr_b16 %15, %16 offset:4576\n\ts_waitcnt lgkmcnt(0)"
                 : "=&v"(r[0]), "=&v"(r[1]), "=&v"(r[2]), "=&v"(r[3]), "=&v"(r[4]), "=&v"(r[5]), "=&v"(r[6]), "=&v"(r[7]),
                   "=&v"(r[8]), "=&v"(r[9]), "=&v"(r[10]), "=&v"(r[11]), "=&v"(r[12]), "=&v"(r[13]), "=&v"(r[14]), "=&v"(r[15])
                 : "v"(a) : "memory");
}
__device__ __forceinline__ void phase_dsa_attn(const Ctx& c) {
    const bf16* CKV = (const bf16*)(c.ws + WS_M + M_CKV);
    bf16* QLAT = (bf16*)(c.ws + WS_M + M_QLAT); const unsigned* MASK = (const unsigned*)(c.ws + WS_M + M_MASK);
    constexpr int RS = 272, TILE = 32 * RS;
    const int lane = c.lane, l15 = lane & 15, g = lane >> 4;
    LAS unsigned char* T0 = c.lds + c.wave * 17920;
    LAS unsigned short* klist = (LAS unsigned short*)(T0 + 2 * TILE);
    const unsigned lbase = (unsigned)(size_t)T0;
    const int prow = lane >> 4, ppc = lane & 15;
    for (int u = c.bid * NWAVES + c.wave; u < T_TOK; u += c.G * NWAVES) {
        const int tok = u, b = tok >> 11;
        const int qc = (tok & 2047) >> 6; const int nt = 2 * (qc + 1);
        const unsigned mwd = lane < nt ? MASK[(size_t)tok * 64 + lane] : 0u;
        unsigned incl = (unsigned)__popc(mwd);
#pragma unroll
        for (int d = 1; d < 64; d <<= 1) { const unsigned o = __shfl_up(incl, d); if (lane >= d) incl += o; }
        const int nsel = __builtin_amdgcn_readlane((int)incl, 63);
        { unsigned pos = incl - (unsigned)__popc(mwd), w = mwd;
          while (w) { const int bit = __builtin_ctz(w); klist[pos++] = (unsigned short)(32 * lane + bit); w &= w - 1u; } }
        bf16x8 Bq[4];
#pragma unroll
        for (int s = 0; s < 4; ++s) Bq[s] = *(const bf16x8*)(QLAT + (size_t)tok * 2048 + l15 * 128 + 32 * s + 8 * g);
        LDS_WAIT(); asm volatile("" ::: "memory");
        const int nstep = nsel >> 5;
        const bf16* kvb = CKV + (size_t)b * 2048 * 128 + ppc * 8;
        v4u gr[8];
        auto gather = [&](int step) {
#pragma unroll
            for (int j = 0; j < 8; ++j) { const int key = klist[32 * step + 4 * j + prow]; gr[j] = *(const v4u*)(kvb + (size_t)key * 128); } };
        auto lstore = [&](int buf) {
#pragma unroll
            for (int j = 0; j < 8; ++j) *(LAS v4u*)(T0 + buf * TILE + (4 * j + prow) * RS + ppc * 16) = gr[j]; };
        float m_run = -INFINITY, l_run = 0.f;
        f32x4 O[8];
#pragma unroll
        for (int dt = 0; dt < 8; ++dt) O[dt] = (f32x4){0.f, 0.f, 0.f, 0.f};
        gather(0);
#pragma unroll 1
        for (int step = 0; step < nstep; ++step) {
            const int buf = step & 1;
            lstore(buf);
            if (step + 1 < nstep) gather(step + 1);
            LDS_WAIT(); asm volatile("" ::: "memory");
            f32x4 S[2];
#pragma unroll
            for (int kt = 0; kt < 2; ++kt) { S[kt] = (f32x4){0.f, 0.f, 0.f, 0.f};
#pragma unroll
                for (int s = 0; s < 4; ++s) { const bf16x8 Ak = *(const LAS bf16x8*)(T0 + buf * TILE + (16 * kt + l15) * RS + (32 * s + 8 * g) * 2);
                    S[kt] = __builtin_amdgcn_mfma_f32_16x16x32_bf16(Ak, Bq[s], S[kt], 0, 0, 0); } }
            float mx = fmaxf(fmaxf(fmaxf(S[0][0], S[0][1]), fmaxf(S[0][2], S[0][3])), fmaxf(fmaxf(S[1][0], S[1][1]), fmaxf(S[1][2], S[1][3])));
            mx = fmaxf(mx, __shfl_xor(mx, 16)); mx = fmaxf(mx, __shfl_xor(mx, 32));
            const float m_new = fmaxf(m_run, mx);
            const float alpha = __builtin_amdgcn_exp2f(m_run - m_new);
            float p[8], ps = 0.f;
#pragma unroll
            for (int j = 0; j < 8; ++j) { p[j] = __builtin_amdgcn_exp2f(S[j >> 2][j & 3] - m_new); ps += p[j]; }
            l_run = l_run * alpha + ps; m_run = m_new;
            v4u pw; pw.x = pk2(p[0], p[1]); pw.y = pk2(p[2], p[3]); pw.z = pk2(p[4], p[5]); pw.w = pk2(p[6], p[7]);
            const bf16x8 Bp = __builtin_bit_cast(bf16x8, pw);
            const unsigned ta = lbase + buf * TILE + (4 * g + (l15 >> 2)) * RS + (4 * (l15 & 3)) * 2;
            v2u tr[16]; tr_rd16(ta, tr);
#pragma unroll
            for (int dt = 0; dt < 8; ++dt) {
                v4u aw; aw.x = tr[2 * dt].x; aw.y = tr[2 * dt].y; aw.z = tr[2 * dt + 1].x; aw.w = tr[2 * dt + 1].y;
                O[dt] = O[dt] * alpha; O[dt] = __builtin_amdgcn_mfma_f32_16x16x32_bf16(__builtin_bit_cast(bf16x8, aw), Bp, O[dt], 0, 0, 0); }
        }
        const float l_tot = l_run + __shfl_xor(l_run, 16); const float l_all = l_tot + __shfl_xor(l_tot, 32); const float inv = 1.0f / l_all;
#pragma unroll
        for (int dt = 0; dt < 8; ++dt) { v2u w; w.x = pk2(O[dt][0] * inv, O[dt][1] * inv); w.y = pk2(O[dt][2] * inv, O[dt][3] * inv);
            *(v2u*)(QLAT + (size_t)tok * 2048 + l15 * 128 + 16 * dt + 4 * g) = w; }
        LDS_WAIT(); asm volatile("" ::: "memory");
    }
}

__device__ __forceinline__ float neg_expm1_small(float x) {
    const float p = -x * (1.0f + x * 0.5f * (1.0f + x * (1.0f / 3.0f) * (1.0f + x * 0.25f * (1.0f + x * 0.2f * (1.0f + x * (1.0f / 6.0f))))));
    return x < -0.25f ? 1.0f - __expf(x) : p;
}
__device__ __forceinline__ void phase_rglru(const Ctx& c) {
    const bf16* GU = (const bf16*)(c.ws + WS_M + M_GU); bf16* Y = (bf16*)(c.ws + WS_M + M_Y);
    constexpr int CVS = 104;
    LAS float* uT = (LAS float*)c.lds;
    LAS bf16* cvb = (LAS bf16*)(c.lds + 21504);
    LAS bf16* WTa = (LAS bf16*)(c.lds + 34816);
    LAS bf16* WTx = (LAS bf16*)(c.lds + 51456);
    LAS float* a_s = (LAS float*)(c.lds + 68096);
    LAS float* b_s = (LAS float*)(c.lds + 88832);
    LAS bf16* gT = (LAS bf16*)(c.lds + 109568);
    LAS float* cst = (LAS float*)(c.lds + 120064);
    const int tid = c.tid, lane = c.lane, w = c.wave;
    for (int u = c.bid; u < 512; u += c.G) {
        const int b = u >> 4, nb = u & 15, ch0 = nb * 80;
        __syncthreads();
        for (int e = tid; e < 80 * CVS; e += NTHR) { const int d = e / CVS, k = e % CVS;
            WTa[e] = (bf16)(k < 80 ? f2bf(INP(c, I_B_W_A)[(size_t)nb * 6400 + k * 80 + d]) : 0u);
            WTx[e] = (bf16)(k < 80 ? f2bf(INP(c, I_B_W_X)[(size_t)nb * 6400 + k * 80 + d]) : 0u); }
        for (int e = tid; e < 64 * CVS; e += NTHR) cvb[e] = 0;
        if (tid < 80) {
            const int cc = ch0 + tid;
#pragma unroll
            for (int j = 0; j < 4; ++j) cst[j * 80 + tid] = INP(c, I_B_CONV_W)[j * 1280 + cc];
            cst[320 + tid] = INP(c, I_B_CONV_B)[cc]; cst[400 + tid] = INP(c, I_B_B_A)[cc]; cst[480 + tid] = INP(c, I_B_B_X)[cc];
            cst[560 + tid] = log1pf(expf(-INP(c, I_B_LAMBDA)[cc]));
        }
        float carry[10];
#pragma unroll
        for (int q = 0; q < 10; ++q) carry[q] = 0.f;
        v4u ureg[2], greg[2];
        auto issue_loads = [&](int chunk) {
#pragma unroll
            for (int q = 0; q < 2; ++q) { const int e = tid + NTHR * q;
                ureg[q] = (v4u){0u, 0u, 0u, 0u}; greg[q] = (v4u){0u, 0u, 0u, 0u};
                if (e < 670) { const int i = e / 10, cch = e % 10; const int sp = chunk * 64 - 3 + i;
                    if (sp >= 0) ureg[q] = *(const v4u*)(GU + (size_t)(b * 2048 + sp) * 2560 + 1280 + ch0 + cch * 8); }
                if (e < 640) { const int i = e / 10, cch = e % 10;
                    greg[q] = *(const v4u*)(GU + (size_t)(b * 2048 + chunk * 64 + i) * 2560 + ch0 + cch * 8); } }
        };
        issue_loads(0);
#pragma unroll 1
        for (int chunk = 0; chunk < 32; ++chunk) {
            const int t0 = b * 2048 + chunk * 64;
#pragma unroll
            for (int q = 0; q < 2; ++q) { const int e = tid + NTHR * q;
                if (e < 670) { const int i = e / 10, cch = e % 10; LAS float* d = uT + i * 80 + cch * 8;
                    *(LAS f32x4*)d = (f32x4){bflo(ureg[q].x), bfhi(ureg[q].x), bflo(ureg[q].y), bfhi(ureg[q].y)};
                    *(LAS f32x4*)(d + 4) = (f32x4){bflo(ureg[q].z), bfhi(ureg[q].z), bflo(ureg[q].w), bfhi(ureg[q].w)}; }
                if (e < 640) { const int i = e / 10, cch = e % 10; LAS unsigned* d = (LAS unsigned*)(gT + i * 82 + cch * 8);
                    d[0] = greg[q].x; d[1] = greg[q].y; d[2] = greg[q].z; d[3] = greg[q].w; } }
            __syncthreads();
            if (chunk + 1 < 32) issue_loads(chunk + 1);
            for (int e = tid; e < 5120; e += NTHR) { const int t = e / 80, cc = e % 80;
                float s = cst[320 + cc];
#pragma unroll
                for (int j = 0; j < 4; ++j) s += uT[(t + j) * 80 + cc] * cst[j * 80 + cc];
                cvb[t * CVS + cc] = (bf16)f2bf(s); }
            __syncthreads();
            {
                const int tq = w & 3, nt0 = (w >> 2) ? 3 : 0, nt1 = (w >> 2) ? 5 : 3, l15 = lane & 15, g4 = lane >> 4;
                bf16x8 Af[3];
#pragma unroll
                for (int s3 = 0; s3 < 3; ++s3) Af[s3] = *(const LAS bf16x8*)(cvb + (16 * tq + l15) * CVS + 32 * s3 + 8 * g4);
#pragma unroll
                for (int q = 0; q < 3; ++q) { const int nt = nt0 + q;
                    if (nt < nt1) {
                        f32x4 accA = {0.f, 0.f, 0.f, 0.f}, accX = {0.f, 0.f, 0.f, 0.f};
#pragma unroll
                        for (int s3 = 0; s3 < 3; ++s3) {
                            const bf16x8 Ba = *(const LAS bf16x8*)(WTa + (16 * nt + l15) * CVS + 32 * s3 + 8 * g4), Bx = *(const LAS bf16x8*)(WTx + (16 * nt + l15) * CVS + 32 * s3 + 8 * g4);
                            accA = __builtin_amdgcn_mfma_f32_16x16x32_bf16(Af[s3], Ba, accA, 0, 0, 0); accX = __builtin_amdgcn_mfma_f32_16x16x32_bf16(Af[s3], Bx, accX, 0, 0, 0); }
                        const int cc = 16 * nt + l15; const float ba = cst[400 + cc], bx = cst[480 + cc], sp = cst[560 + cc], cb = cst[320 + cc];
                        const float cw0 = cst[cc], cw1 = cst[80 + cc], cw2 = cst[160 + cc], cw3 = cst[240 + cc];
#pragma unroll
                        for (int r4 = 0; r4 < 4; ++r4) { const int t = 16 * tq + 4 * g4 + r4;
                            const float cvf = cb + uT[t * 80 + cc] * cw0 + uT[(t + 1) * 80 + cc] * cw1 + uT[(t + 2) * 80 + cc] * cw2 + uT[(t + 3) * 80 + cc] * cw3;
                            const float r = sigmoidf_(accA[r4] + ba), ig = sigmoidf_(accX[r4] + bx);
                            const float log_a = -8.0f * r * sp; const float a = __expf(log_a);
                            const float bb = __builtin_amdgcn_sqrtf(neg_expm1_small(2.0f * log_a)) * (ig * cvf);
                            a_s[t * 81 + cc] = a; b_s[t * 81 + cc] = bb; }
                    } }
            }
            __syncthreads();
            {
                LAS bf16* yT = (LAS bf16*)uT;
#pragma unroll
                for (int q = 0; q < 10; ++q) { const int cc = w + 8 * q;
                    float a = a_s[lane * 81 + cc], bq = b_s[lane * 81 + cc];
#define RG_STEP(D) { const float ap = __builtin_bit_cast(float, __builtin_amdgcn_update_dpp(0x3f800000, __builtin_bit_cast(int, a), 0x110 + D, 0xf, 0xf, false)); \
                     const float bp = __builtin_bit_cast(float, __builtin_amdgcn_update_dpp(0, __builtin_bit_cast(int, bq), 0x110 + D, 0xf, 0xf, false)); bq = a * bp + bq; a = a * ap; }
                    RG_STEP(1) RG_STEP(2) RG_STEP(4) RG_STEP(8)
#undef RG_STEP
                    { const float A0 = __builtin_bit_cast(float, __builtin_amdgcn_readlane(__builtin_bit_cast(int, a), 15)), B0 = __builtin_bit_cast(float, __builtin_amdgcn_readlane(__builtin_bit_cast(int, bq), 15));
                      const float A1 = __builtin_bit_cast(float, __builtin_amdgcn_readlane(__builtin_bit_cast(int, a), 31)), B1 = __builtin_bit_cast(float, __builtin_amdgcn_readlane(__builtin_bit_cast(int, bq), 31));
                      const float A2 = __builtin_bit_cast(float, __builtin_amdgcn_readlane(__builtin_bit_cast(int, a), 47)), B2 = __builtin_bit_cast(float, __builtin_amdgcn_readlane(__builtin_bit_cast(int, bq), 47));
                      const float C2a = A0 * A1, C2b = A1 * B0 + B1, C3a = C2a * A2, C3b = A2 * C2b + B2;
                      const int row = lane >> 4;
                      const float ca = row == 0 ? 1.0f : (row == 1 ? A0 : (row == 2 ? C2a : C3a)), cb = row == 0 ? 0.0f : (row == 1 ? B0 : (row == 2 ? C2b : C3b));
                      bq = a * cb + bq; a = a * ca; }
                    const float hval = a * carry[q] + bq;
                    carry[q] = __builtin_bit_cast(float, __builtin_amdgcn_readlane(__builtin_bit_cast(int, hval), 63));
                    yT[lane * 82 + cc] = (bf16)f2bf(bf2f(gT[lane * 82 + cc]) * hval); }
            }
            __syncthreads();
            for (int e = tid; e < 2560; e += NTHR) { const int row = e / 40, dw = e % 40;
                ((unsigned*)(Y + (size_t)(t0 + row) * 1280 + ch0))[dw] = ((const LAS unsigned*)uT)[row * 41 + dw]; }
            __syncthreads();
        }
    }
}

template <int OFF0, int OFF1>
__device__ __forceinline__ void tr_read2(unsigned a, v2u& r0, v2u& r1) {
    asm volatile("ds_read_b64_tr_b16 %0, %2 offset:%3\n\tds_read_b64_tr_b16 %1, %2 offset:%4\n\ts_waitcnt lgkmcnt(0)" : "=&v"(r0), "=&v"(r1) : "v"(a), "n"(OFF0), "n"(OFF1) : "memory");
}
template <int B0, int RSb>
__device__ __forceinline__ void tr_read8(unsigned a, v2u (&r)[8]) {
    asm volatile("ds_read_b64_tr_b16 %0, %8 offset:%9\n\tds_read_b64_tr_b16 %1, %8 offset:%10\n\tds_read_b64_tr_b16 %2, %8 offset:%11\n\tds_read_b64_tr_b16 %3, %8 offset:%12\n\t"
                 "ds_read_b64_tr_b16 %4, %8 offset:%13\n\tds_read_b64_tr_b16 %5, %8 offset:%14\n\tds_read_b64_tr_b16 %6, %8 offset:%15\n\tds_read_b64_tr_b16 %7, %8 offset:%16\n\ts_waitcnt lgkmcnt(0)"
                 : "=&v"(r[0]), "=&v"(r[1]), "=&v"(r[2]), "=&v"(r[3]), "=&v"(r[4]), "=&v"(r[5]), "=&v"(r[6]), "=&v"(r[7])
                 : "v"(a), "n"(B0), "n"(B0 + 4 * RSb), "n"(B0 + 16 * RSb), "n"(B0 + 20 * RSb), "n"(B0 + 32 * RSb), "n"(B0 + 36 * RSb), "n"(B0 + 48 * RSb), "n"(B0 + 52 * RSb) : "memory");
}
__device__ __forceinline__ void phase_ret_core(const Ctx& c) {
    const bf16* Qg = (const bf16*)(c.ws + WS_M + M_Q); const bf16* Kg = (const bf16*)(c.ws + WS_M + M_K); bf16* Vg = (bf16*)(c.ws + WS_M + M_V);
    float* STAT = (float*)(c.ws + WS_M + M_STAT);
    constexpr int RS = 528, SS = 144, QS_OFF = 0, KS_OFF = 64 * RS, VS_OFF = 2 * 64 * RS, SS_OFF = 3 * 64 * RS;
    LAS unsigned char* L = c.lds; const unsigned lbase = (unsigned)(size_t)c.lds;
    const int tid0 = c.tid, w = c.wave;
    for (int u = c.bid; u < 256; u += c.G) {
        const int b = u >> 3, hh = (u >> 1) & 3, eh = u & 1;
        const float gam = 1.0f - exp2f(-5.0f - (float)hh); const float lg0 = log2f(gam);
        f32x16 R[8];
#pragma unroll
        for (int dt = 0; dt < 8; ++dt)
#pragma unroll
            for (int i = 0; i < 16; ++i) R[dt][i] = 0.f;
        const float cdec = exp2f(lg0 * 64.0f);
#pragma unroll 1
        for (int chunk = 0; chunk < 32; ++chunk) {
            const int t0 = b * 2048 + chunk * 64;
            float lg = lg0; int tid = tid0; asm volatile("" : "+v"(lg), "+v"(tid));
            const int lane = tid & 63, n = lane & 31, h = lane >> 5, hl = h;
            const int blk = (lane >> 4) & 1, q4 = (lane & 15) >> 2, p4 = lane & 3;
            const unsigned trbK = lbase + (8 * h + q4) * RS + (16 * blk + 4 * p4) * 2;
            const unsigned trbV = trbK + VS_OFF + 64 * w;
            __syncthreads();
#pragma unroll
            for (int i = 0; i < 4; ++i) { const int e = tid + NTHR * i, row = e >> 5, ch = e & 31;
                *(LAS v4u*)(L + QS_OFF + row * RS + ch * 16) = *(const v4u*)(Qg + (size_t)(t0 + row) * 1024 + hh * 256 + ch * 8);
                *(LAS v4u*)(L + KS_OFF + row * RS + ch * 16) = *(const v4u*)(Kg + (size_t)(t0 + row) * 1024 + hh * 256 + ch * 8); }
            asm volatile("" ::: "memory");
#pragma unroll
            for (int i = 0; i < 4; ++i) { const int e = tid + NTHR * i, row = e >> 5, ch = e & 31;
                *(LAS v4u*)(L + VS_OFF + row * RS + ch * 16) = *(const v4u*)(Vg + (size_t)(t0 + row) * 2048 + hh * 512 + eh * 256 + ch * 8); }
            __syncthreads();
            {
                const int i16 = w >> 1, l15 = lane & 15, g4 = lane >> 4; const int l15d = l15, g4d = g4;
                bf16x8 Af[8];
#pragma unroll
                for (int s = 0; s < 8; ++s) Af[s] = *(const LAS bf16x8*)(L + QS_OFF + (16 * i16 + l15) * RS + (32 * s + 8 * g4) * 2);
#pragma unroll
                for (int jj = 0; jj < 2; ++jj) { const int j16 = 2 * (w & 1) + jj;
                    f32x4 acc = {0.f, 0.f, 0.f, 0.f};
                    if (j16 <= i16) {
#pragma unroll
                        for (int s = 0; s < 8; ++s) { const bf16x8 Bf = *(const LAS bf16x8*)(L + KS_OFF + (16 * j16 + l15) * RS + (32 * s + 8 * g4) * 2);
                            acc = __builtin_amdgcn_mfma_f32_16x16x32_bf16(Af[s], Bf, acc, 0, 0, 0); }
                    }
                    const int ja = 16 * j16 + l15, jad = 16 * j16 + l15d;
#pragma unroll
                    for (int r = 0; r < 4; ++r) { const int ia = 16 * i16 + 4 * g4 + r, iad = 16 * i16 + 4 * g4d + r; const float dec = (iad >= jad) ? __builtin_amdgcn_exp2f(lg * (float)(iad - jad)) : 0.f;
                        *(LAS bf16*)(L + SS_OFF + ia * SS + ja * 2) = (bf16)f2bf(acc[r] * dec); }
                }
            }
            __syncthreads();
            bf16x8 Vf[4];
            { v2u tr[8]; tr_read8<0, RS>(trbV, tr);
#pragma unroll
              for (int ks = 0; ks < 4; ++ks) { v4u wv; wv.x = tr[2 * ks].x; wv.y = tr[2 * ks].y; wv.z = tr[2 * ks + 1].x; wv.w = tr[2 * ks + 1].y; Vf[ks] = __builtin_bit_cast(bf16x8, wv); } }
            {
                f32x16 Oa[2];
#pragma unroll
                for (int it = 0; it < 2; ++it)
#pragma unroll
                    for (int i = 0; i < 16; ++i) Oa[it][i] = 0.f;
#pragma unroll
                for (int dt = 0; dt < 8; ++dt)
#pragma unroll
                    for (int s = 0; s < 2; ++s) {
                        v4u bw; bw.x = pk2(R[dt][8 * s + 0], R[dt][8 * s + 1]); bw.y = pk2(R[dt][8 * s + 2], R[dt][8 * s + 3]); bw.z = pk2(R[dt][8 * s + 4], R[dt][8 * s + 5]); bw.w = pk2(R[dt][8 * s + 6], R[dt][8 * s + 7]);
#pragma unroll
                        for (int it = 0; it < 2; ++it) {
                            const LAS unsigned char* qrow = L + QS_OFF + (32 * it + n) * RS;
                            const v2u lo = *(const LAS v2u*)(qrow + (32 * dt + 16 * s + 4 * h) * 2), hi = *(const LAS v2u*)(qrow + (32 * dt + 16 * s + 8 + 4 * h) * 2);
                            v4u aw; aw.x = lo.x; aw.y = lo.y; aw.z = hi.x; aw.w = hi.y;
                            Oa[it] = __builtin_amdgcn_mfma_f32_32x32x16_bf16(__builtin_bit_cast(bf16x8, aw), __builtin_bit_cast(bf16x8, bw), Oa[it], 0, 0, 0);
                        }
                    }
#pragma unroll
                for (int it = 0; it < 2; ++it) {
#pragma unroll
                    for (int i = 0; i < 16; ++i) { const int ia = 32 * it + 8 * (i >> 2) + 4 * h + (i & 3); Oa[it][i] *= __builtin_amdgcn_exp2f(lg * (float)(32 * it + 8 * (i >> 2) + 4 * hl + (i & 3) + 1)); }
#pragma unroll
                    for (int ks = 0; ks < 4; ++ks) if (ks < 2 * (it + 1)) {
                        const bf16x8 Sf = *(const LAS bf16x8*)(L + SS_OFF + (32 * it + n) * SS + (16 * ks + 8 * h) * 2);
                        Oa[it] = __builtin_amdgcn_mfma_f32_32x32x16_bf16(Sf, Vf[ks], Oa[it], 0, 0, 0);
                    }
#pragma unroll
                    for (int i = 0; i < 16; ++i) { const int ia = 32 * it + 8 * (i >> 2) + 4 * h + (i & 3);
                        *(LAS bf16*)(L + VS_OFF + ia * RS + (32 * w + n) * 2) = (bf16)f2bf(Oa[it][i]); }
                }
            }
            bf16x8 Vs2[4];
#pragma unroll
            for (int ks = 0; ks < 4; ++ks) { const v4u wv = __builtin_bit_cast(v4u, Vf[ks]); float f[8] = {bflo(wv.x), bfhi(wv.x), bflo(wv.y), bfhi(wv.y), bflo(wv.z), bfhi(wv.z), bflo(wv.w), bfhi(wv.w)};
#pragma unroll
                for (int j = 0; j < 8; ++j) { const int key = 16 * ks + 8 * hl + j; f[j] *= __builtin_amdgcn_exp2f(lg * (float)(63 - key)); }
                v4u o; o.x = pk2(f[0], f[1]); o.y = pk2(f[2], f[3]); o.z = pk2(f[4], f[5]); o.w = pk2(f[6], f[7]); Vs2[ks] = __builtin_bit_cast(bf16x8, o); }
#define RC_DT(dt) { _Pragma("unroll") for (int i = 0; i < 16; ++i) R[dt][i] *= cdec; v2u tr[8]; tr_read8<KS_OFF + 64 * (dt), RS>(trbK, tr); \
                _Pragma("unroll") for (int ks = 0; ks < 4; ++ks) { v4u aw; aw.x = tr[2 * ks].x; aw.y = tr[2 * ks].y; aw.z = tr[2 * ks + 1].x; aw.w = tr[2 * ks + 1].y; \
                    R[dt] = __builtin_amdgcn_mfma_f32_32x32x16_bf16(__builtin_bit_cast(bf16x8, aw), Vs2[ks], R[dt], 0, 0, 0); } }
            RC_DT(0) RC_DT(1) RC_DT(2) RC_DT(3) RC_DT(4) RC_DT(5) RC_DT(6) RC_DT(7)
#undef RC_DT
            __syncthreads();
#pragma unroll
            for (int i = 0; i < 4; ++i) { const int e = tid + NTHR * i, row = e >> 5, ch = e & 31;
                const v4u ov = *(const LAS v4u*)(L + VS_OFF + row * RS + ch * 16);
                *(v4u*)(Vg + (size_t)(t0 + row) * 2048 + hh * 512 + eh * 256 + ch * 8) = ov;
                const float f[8] = {bflo(ov.x), bfhi(ov.x), bflo(ov.y), bfhi(ov.y), bflo(ov.z), bfhi(ov.z), bflo(ov.w), bfhi(ov.w)};
                float s = 0.f, s2 = 0.f;
#pragma unroll
                for (int j = 0; j < 8; ++j) { s += f[j]; s2 += f[j] * f[j]; }
#pragma unroll
                for (int o = 1; o < 32; o <<= 1) { s += __shfl_xor(s, o); s2 += __shfl_xor(s2, o); }
                if ((tid & 31) == 0) { f32x2 st = {s, s2}; *(f32x2*)(STAT + (size_t)(t0 + row) * 16 + hh * 4 + eh * 2) = st; }
            }
        }
    }
}

__host__ __device__ __forceinline__ bool slot_active(int kind, int s) {
    if (s == 2) return kind != 1;
    if (s == 3 || s == 4) return kind == 0;
    if (s == 10) return false;
    return true;
}

#ifndef MK_EN
#define MK_EN 0xffffffffu
#endif
#define EN(b) ((MK_EN >> (b)) & 1u)
template <int PROBE>
__global__ void __launch_bounds__(NTHR, 2) mk_fwd_t(Params p) {
    extern __shared__ __attribute__((aligned(16))) unsigned char lds_raw[];
    Ctx c;
    c.lds = (LAS unsigned char*)lds_raw; c.tid = threadIdx.x; c.lane = c.tid & 63; c.wave = __builtin_amdgcn_readfirstlane(c.tid >> 6);
    c.bid = blockIdx.x; c.G = gridDim.x; c.in = (InTab)(unsigned long)__builtin_amdgcn_kernarg_segment_ptr(); c.out = p.out; c.ws = p.ws;
    volatile LAS unsigned* MISC = (volatile LAS unsigned*)(c.lds + MISC_OFF);
    for (int u = c.tid; u < (LDS_BYTES - LDSCTL_OFF) / 4; u += NTHR) ((LAS unsigned*)(c.lds + LDSCTL_OFF))[u] = 0u;
    __syncthreads();
    const bool one = (p.flags & 1) != 0;
    XcdBarrier bar; bar.bar = (unsigned*)(p.ws + WS_CTL) + CW_BAR; bar.x = 0; bar.st = MISC + 8;
    if (one) bar = xcd_barrier_post((unsigned*)(p.ws + WS_CTL) + CW_BAR, MISC + 8);
    const int lo = p.ph_lo, hi = p.ph_hi;
#define IN(k) (lo <= (k) && (k) < hi)
#if MK_PROBE
#define STAMP(k) do { if (blockIdx.x == 0 && threadIdx.x == 0) ((unsigned long long*)(p.ws + WS_CTL + 65536))[k] = __builtin_amdgcn_s_memrealtime(); } while (0)
#else
#define STAMP(k) do {} while (0)
#endif
#define LCTX() Ctx cl = c; { unsigned long k_ = (unsigned long)__builtin_amdgcn_kernarg_segment_ptr(); unsigned long w_ = (unsigned long)p.ws, o_ = (unsigned long)p.out; int t_ = threadIdx.x; asm volatile("" : "+s"(k_), "+s"(w_), "+s"(o_), "+v"(t_)); cl.tid = t_; cl.lane = t_ & 63; cl.wave = __builtin_amdgcn_readfirstlane(t_ >> 6); cl.in = (InTab)k_; cl.ws = (unsigned char*)(GAS unsigned char*)w_; cl.out = (float*)(GAS float*)o_; } unsigned char* ws = cl.ws; (void)ws
#define SEAM(k) do { if (one && IN(k) && (k) + 1 < hi) xcd_barrier(bar); } while (0)
    STAMP(0);
    if (EN(0) && IN(0)) { LCTX(); phase_prologue(cl); }
    SEAM(0);
#pragma unroll 1
    for (int layer = 0; layer < 4; ++layer) {
        const int kind = layer % 3, j = layer / 3, base = 1 + layer * NPH_LAYER;
        const size_t xin_off = (layer & 1) ? WS_XB1 : WS_XB0, xnext_off = (layer & 1) ? WS_XB0 : WS_XB1;
#define xin ((const bf16*)(ws + xin_off))
#define xnext ((bf16*)(ws + xnext_off))
        STAMP(base + 0);
        if (IN(base + 0)) { LCTX();
            if (EN(1) && kind == 0) { bf16* RAWb = (bf16*)(ws + WS_M + M_RAW); EpiBf16R<0> E{RAWb, RAWb, RAWb, 512, 512, 512, 1 << 30, 1 << 30};
                run_gemm(cl, xin, (const bf16*)(ws + WS_WAIN) + (size_t)j * 512 * 1024, 512, 1024, E); }
            else if (EN(2) && kind == 1) { bf16* GU = (bf16*)(ws + WS_M + M_GU); EpiBf16R<1> E{GU, GU + 1280, GU + 1280, 2560, 2560, 2560, 1280, 1 << 30};
                run_gemm(cl, xin, (const bf16*)(ws + WS_WBIN), 2560, 1024, E); }
            else if (EN(3) && kind == 2) { EpiRetIn E{(bf16*)(ws + WS_M + M_Q), (bf16*)(ws + WS_M + M_K), (bf16*)(ws + WS_M + M_V), (const float*)(ws + WS_ROT), (const float*)(ws + WS_ROT) + 2048 * 128};
                run_gemm(cl, xin, (const bf16*)(ws + WS_WCIN), 4096, 1024, E); }
        }
        SEAM(base + 0);
        STAMP(base + 1);
        if (IN(base + 1)) { LCTX();
            if (EN(4) && kind == 0) phase_dsa_norm(cl, j);
            else if (EN(5) && kind == 1) phase_rglru(cl);
            else if (EN(6) && kind == 2) phase_ret_core(cl);
        }
        SEAM(base + 1);
        STAMP(base + 2);
        if (IN(base + 2) && kind != 1) { LCTX();
            if (EN(7) && kind == 0) { EpiBf16R<0> E{(bf16*)(ws + WS_M + M_QLAT), (bf16*)(ws + WS_M + M_QIDX), (bf16*)(ws + WS_M + M_QIDX), 2048, 512, 512, 2048, 1 << 30};
                run_gemm(cl, (const bf16*)(ws + WS_M + M_CQ), (const bf16*)(ws + WS_WAQ + j * WAQ_STRIDE), 2560, 256, E); }
            else if (EN(8) && kind == 2) { EpiRetGate E{(bf16*)(ws + WS_M + M_V), (const float*)(ws + WS_M + M_STAT)};
                run_gemm(cl, xin, (const bf16*)(ws + WS_WCIN) + (size_t)4096 * 1024, 2048, 1024, E); }
        }
        if (kind != 1) SEAM(base + 2);
        STAMP(base + 3);
        if (EN(9) && IN(base + 3) && kind == 0) { LCTX(); phase_dsa_index(cl); }
        if (kind == 0) SEAM(base + 3);
        STAMP(base + 4);
        if (EN(10) && IN(base + 4) && kind == 0) { LCTX(); phase_dsa_attn(cl); }
        if (kind == 0) SEAM(base + 4);
        STAMP(base + 5);
        if (EN(11) && IN(base + 5)) { LCTX();
            const bf16* A = (const bf16*)(ws + WS_M + (kind == 0 ? M_QLAT : (kind == 1 ? M_Y : M_V)));
            const bf16* Bt = kind == 0 ? (const bf16*)(ws + WS_WAOV) + (size_t)j * 1024 * 2048 : (kind == 1 ? (const bf16*)(ws + WS_WBO) : (const bf16*)(ws + WS_WCO));
            const int K = kind == 1 ? 1280 : 2048;
            EpiResid E{cl.out, ALPHA_DN, layer == 0 ? INP(cl, I_X) : (const float*)cl.out};
            run_gemm(cl, A, Bt, 1024, K, E);
        }
        SEAM(base + 5);
        STAMP(base + 6);
        if (EN(12) && IN(base + 6)) { LCTX(); phase_ln1(cl, layer); }
        SEAM(base + 6);
        STAMP(base + 7);
        if (EN(13) && IN(base + 7)) { LCTX(); EpiF32T E{(bf16*)(ws + WS_M + M_SC)};
            run_gemm(cl, xin, (const bf16*)(ws + WS_WPEER) + (size_t)layer * 2048 * 1024, 2048, 1024, E);
            bf16* PP = (bf16*)(ws + WS_PP); EpiBf16R<0> E2{PP, PP, PP, 1024, 1024, 1024, 1 << 30, 1 << 30};
            run_gemm(cl, (const bf16*)(ws + WS_M + M_PB), (const bf16*)(ws + WS_WPLEP) + (size_t)layer * 1024 * 256, 1024, 256, E2); }
        SEAM(base + 7);
        STAMP(base + 8);
        if (EN(14) && IN(base + 8)) { LCTX(); phase_peer_topk(cl); }
        SEAM(base + 8);
        STAMP(base + 9);
        if (EN(15) && IN(base + 9)) { LCTX(); phase_peer_gather(cl, layer, [&]() {}); }
        SEAM(base + 9);
        STAMP(base + 11);
        if (EN(17) && IN(base + 11)) { LCTX(); EpiPle E{cl.out, (const bf16*)(ws + WS_PP), xnext, INP(cl, I_PLE_BG) + layer * DM};
            run_gemm(cl, xin, (const bf16*)(ws + WS_WPLEG) + (size_t)layer * 1024 * 1024, 1024, 1024, E); }
        SEAM(base + 11);
    }
#if MK_PROBE
    xcd_barrier(bar);
    STAMP(N_PHASES);
    xcd_barrier(bar);
    {
        const unsigned long long* TS = (const unsigned long long*)(p.ws + WS_CTL + 65536);
        float tA = 0.f, tC = 0.f;
        for (int k = 0; k < N_PHASES; ++k) {
            int type = 0;
            if (k > 0) { const int layer = (k - 1) / NPH_LAYER, s = (k - 1) % NPH_LAYER, kind = layer % 3;
                if (!slot_active(kind, s)) continue;
                type = s == 0 ? 1 + kind : s == 1 ? 4 + kind : s == 2 ? (kind == 0 ? 7 : 8) : s == 3 ? 9 : s == 4 ? 10 : 6 + s; }
            const float us = (float)(TS[k + 1] - TS[k]) * 0.01f;
            if ((MK_PROBE_A >> type) & 1u) tA += us;
            if ((MK_PROBE_C >> type) & 1u) tC += us;
        }
        for (size_t i = (size_t)blockIdx.x * NTHR + threadIdx.x; i < (size_t)T_TOK * DM; i += (size_t)gridDim.x * NTHR) p.out[i] = (i == 0) ? 100.f * tA : tC;
    }
#endif
#undef IN
#undef SEAM
#undef xin
#undef xnext
#undef LCTX
}

#if MK_CHECK
#include "CHECKS_PLACEHOLDER"
#endif

#define mk_fwd mk_fwd_t<0>
extern "C" void kernel_launch(void* const* d_in, const int* in_sizes, int n_in, void* d_out, int out_size, void* d_ws, size_t ws_size, hipStream_t stream) {
    static int grid = 0;
    if (grid == 0) {
        if (n_in != N_IN || out_size != T_TOK * DM || ws_size < WS_END) { fprintf(stderr, "kernel_launch: unexpected shapes (n_in %d out %d ws %zu need %zu)\n", n_in, out_size, ws_size, (size_t)WS_END); grid = -1; return; }
        int dev = 0, cus = 0, per_cu = 0;
        if (hipGetDevice(&dev) != hipSuccess || hipDeviceGetAttribute(&cus, hipDeviceAttributeMultiprocessorCount, dev) != hipSuccess) { grid = -1; return; }
        if (hipFuncSetAttribute((const void*)mk_fwd, hipFuncAttributeMaxDynamicSharedMemorySize, LDS_BYTES) != hipSuccess) { fprintf(stderr, "hipFuncSetAttribute failed\n"); grid = -1; return; }
        if (hipOccupancyMaxActiveBlocksPerMultiprocessor(&per_cu, (const void*)mk_fwd, NTHR, LDS_BYTES) != hipSuccess || per_cu < 1) { fprintf(stderr, "occupancy query: %d\n", per_cu); }
        (void)hipGetLastError();
        grid = cus;
    }
    if (grid < 0) return;
    (void)hipMemsetAsync((char*)d_ws + WS_CTL, 0, CTL_BYTES, stream);
    Params p{};
    for (int i = 0; i < N_IN; ++i) p.in[i] = (const float*)d_in[i];
    p.out = (float*)d_out; p.ws = (unsigned char*)d_ws; p.pad = 0;
#if MK_ONE_LAUNCH
#if MK_REPEAT_K >= 0
    p.ph_lo = 0; p.ph_hi = MK_REPEAT_K + 1; p.flags = 1 | MK_PROBE_FLAGS;
    (void)hipFuncSetAttribute((const void*)mk_fwd_t<MK_PROBE_KERNEL>, hipFuncAttributeMaxDynamicSharedMemorySize, LDS_BYTES);
    hipLaunchKernelGGL(mk_fwd_t<MK_PROBE_KERNEL>, dim3(grid), dim3(NTHR), LDS_BYTES, stream, p);
    (void)hipMemsetAsync((char*)d_ws + WS_CTL, 0, CTL_BYTES, stream);
#endif
    p.ph_lo = 0; p.ph_hi = N_PHASES; p.flags = 1;
    hipLaunchKernelGGL(mk_fwd, dim3(grid), dim3(NTHR), LDS_BYTES, stream, p);
#else
    p.flags = 0;
    for (int ph = 0; ph < N_PHASES; ++ph) {
        if (ph > 0) { const int layer = (ph - 1) / NPH_LAYER, s = (ph - 1) % NPH_LAYER; if (!slot_active(layer % 3, s)) continue; }
        p.ph_lo = ph; p.ph_hi = ph + 1;
#if MK_CHECK
        check_pre(ph, p, grid, stream);
#endif
        hipLaunchKernelGGL(mk_fwd, dim3(grid), dim3(NTHR), LDS_BYTES, stream, p);
#if MK_CHECK
        check_post(ph, p, grid, stream);
#endif
    }
#if MK_CHECK
    check_report(p, stream);
#endif
#endif
}
```

```cpp
#define MK_CHECK 0
#define MK_ONE_LAUNCH 1
#include <cstdio>
#include <cmath>
#include <type_traits>
#include <hip/hip_runtime.h>
namespace pg8 {
#define PG8_LAS __attribute__((address_space(3)))
typedef unsigned short bf16_t;
typedef short bf16x8 __attribute__((ext_vector_type(8)));
typedef float f32x4 __attribute__((ext_vector_type(4)));
typedef unsigned u32x4 __attribute__((ext_vector_type(4)));
constexpr int BM = 256, BK = 64, HALF = 128, HTB = HALF * BK * 2  , STAGE_BYTES = 8 * HTB, NXCD = 8, WGM = 8;

__host__ __device__ __forceinline__ int lds_byte(int r, int c) { const int st = (r >> 4) * 2 + (c >> 5), rr = r & 15, cc = c & 31, ob = rr * 64 + cc * 2; return st * 1024 + (ob ^ (((ob >> 9) & 1) << 5)); }
__host__ __device__ __forceinline__ void stage_rc(int b, int& R, int& C) { const int st = b / 1024, sb = b % 1024, swz = sb ^ (((sb >> 9) & 1) << 5); R = (st >> 1) * 16 + swz / 64; C = (st & 1) * 32 + (swz % 64) / 2; }
__host__ __device__ __forceinline__ int perm32(int rho) { const int n = rho >> 4, i = rho & 15; return 8 * (i >> 2) + 4 * n + (i & 3); }

struct Unit { int pm, pn; };
struct Gemm { const bf16_t* A; const bf16_t* Bt; int M, N, K; };

struct StaticOrder {
    int nM, nN, nwg, G, c;
    __host__ __device__ void init(int M, int N, int G_, int c_) { nM = M / BM; nN = N / BM; nwg = nM * nN; G = G_; c = c_; }
    __host__ __device__ bool next(int i, Unit& u) const {
        const long L = (long)i * G + c; if (L >= nwg) return false;
        int wgid = (int)L; { const int q = nwg / NXCD, r = nwg % NXCD, xcd = wgid % NXCD, off = wgid / NXCD; wgid = (xcd < r ? xcd * (q + 1) : r * (q + 1) + (xcd - r) * q) + off; }
        const int nig = WGM * nN, gid = wgid / nig, fm = gid * WGM, gsz = (nM - fm) < WGM ? (nM - fm) : WGM;
        u.pm = fm + ((wgid % nig) % gsz); u.pn = (wgid % nig) / gsz; return true;
    }
    __device__ __forceinline__ void a_ready(const Unit&) const {}
    __device__ __forceinline__ void done(const Unit&) const {}
};
struct CountedOrder : StaticOrder {
    const unsigned* ready; unsigned need; unsigned* tmo;
    __device__ __forceinline__ void a_ready(const Unit& u) const {
        if (threadIdx.x < 64) {
            const unsigned long long t0 = __builtin_amdgcn_s_memrealtime(); unsigned polls = 0;
            while ((unsigned)__builtin_amdgcn_readfirstlane(__hip_atomic_load(ready + 64 * u.pm, __ATOMIC_RELAXED, __HIP_MEMORY_SCOPE_AGENT)) < need) {
                if ((++polls & 255u) == 0u && __builtin_amdgcn_readfirstlane(__hip_atomic_load(tmo, __ATOMIC_RELAXED, __HIP_MEMORY_SCOPE_AGENT)) != 0u) break;
                if (__builtin_amdgcn_s_memrealtime() - t0 > 2000000ull) {
                    if (threadIdx.x == 0) { unsigned expect = 0u; __hip_atomic_compare_exchange_strong(tmo + 1, &expect, 0x600u | (unsigned)(u.pm & 0xff), __ATOMIC_RELAXED, __ATOMIC_RELAXED, __HIP_MEMORY_SCOPE_AGENT); __hip_atomic_store(tmo, 1u, __ATOMIC_RELAXED, __HIP_MEMORY_SCOPE_AGENT); }
                    break; }
                __builtin_amdgcn_s_sleep(2); }
            __builtin_amdgcn_fence(__ATOMIC_ACQUIRE, "agent");
            asm volatile("s_waitcnt vmcnt(0)" ::: "memory");
        }
#if !defined(BROKEN_HOOK_NO_BARRIER)
        asm volatile("" ::: "memory"); __builtin_amdgcn_s_barrier(); asm volatile("" ::: "memory");
#endif
    }
};

__device__ __forceinline__ unsigned cvt_pk_bf16(float lo, float hi) { unsigned r; asm volatile("v_cvt_pk_bf16_f32 %0, %1, %2" : "=v"(r) : "v"(lo), "v"(hi)); return r; }
typedef float f32x2 __attribute__((ext_vector_type(2)));
__device__ __forceinline__ f32x2 gelu_pk(f32x2 v) {
    const f32x2 av = __builtin_elementwise_abs(v), d = av * 0.2316418882f + 1.0f;
    f32x2 t; t.x = __builtin_amdgcn_rcpf(d.x); t.y = __builtin_amdgcn_rcpf(d.y);
    f32x2 q = t * 0.5307027145f + (-0.7265760135f); q = q * t + 0.7107068705f; q = q * t + (-0.142248368f); q = q * t + 0.127414796f; q = q * t;
    const f32x2 s = (v * v) * (-0.72134752044f);
    f32x2 e; e.x = __builtin_amdgcn_exp2f(s.x); e.y = __builtin_amdgcn_exp2f(s.y);
    const f32x2 m = v * (q * e), r = v - m;
    f32x2 o; o.x = v.x < 0.f ? m.x : r.x; o.y = v.y < 0.f ? m.y : r.y; return o;
}

struct EpiF32 {
    static constexpr bool PERM = false, AFTER_DRAIN = false;
    float* C; int ldc; const float* bias;
    __device__ __forceinline__ void operator()(const f32x4 (&acc)[2][2][4][2], const Unit& u, int wr, int wc, int fr, int fq) const {
        const int row0 = u.pm * BM + wr * 64 + fr, col0 = u.pn * BM + wc * 32 + 4 * fq;
        f32x4 bv[2][2];
#pragma unroll
        for (int bj = 0; bj < 2; ++bj)
#pragma unroll
            for (int n = 0; n < 2; ++n) bv[bj][n] = bias ? *(const f32x4*)(bias + col0 + bj * HALF + n * 16) : (f32x4){0.f, 0.f, 0.f, 0.f};
#pragma unroll
        for (int ai = 0; ai < 2; ++ai)
#pragma unroll
            for (int m = 0; m < 4; ++m) { float* rowp = C + (size_t)(row0 + ai * HALF + m * 16) * ldc + col0;
#pragma unroll
                for (int bj = 0; bj < 2; ++bj)
#pragma unroll
                    for (int n = 0; n < 2; ++n) *(f32x4*)(rowp + bj * HALF + n * 16) = acc[ai][bj][m][n] + bv[bj][n]; }
    }
};
template <int ACT  > struct EpiBf16 {
    static constexpr bool PERM = true, AFTER_DRAIN = false;
    bf16_t* O; int ldc; const float* bias; int split_cols; size_t split_stride;
    __device__ __forceinline__ void operator()(const f32x4 (&acc)[2][2][4][2], const Unit& u, int wr, int wc, int fr, int fq) const {
        const int row0 = u.pm * BM + wr * 64 + fr; int colt = u.pn * BM; bf16_t* base = O;
        if (split_cols) { const int t = colt / split_cols; base += (size_t)t * split_stride; colt -= t * split_cols; }
        const int col0 = colt + wc * 32 + 8 * fq, bcol0 = u.pn * BM + wc * 32 + 8 * fq;
        f32x4 bv[2][2];
#pragma unroll
        for (int bj = 0; bj < 2; ++bj)
#pragma unroll
            for (int n = 0; n < 2; ++n) bv[bj][n] = bias ? *(const f32x4*)(bias + bcol0 + bj * HALF + 4 * n) : (f32x4){0.f, 0.f, 0.f, 0.f};
#pragma unroll
        for (int ai = 0; ai < 2; ++ai)
#pragma unroll
            for (int m = 0; m < 4; ++m) { bf16_t* rowp = base + (size_t)(row0 + ai * HALF + m * 16) * ldc + col0;
#pragma unroll
                for (int bj = 0; bj < 2; ++bj) { f32x4 v0 = acc[ai][bj][m][0] + bv[bj][0], v1 = acc[ai][bj][m][1] + bv[bj][1];
                    if (ACT == 1) { f32x2 a = gelu_pk((f32x2){v0[0], v0[1]}), b = gelu_pk((f32x2){v0[2], v0[3]}), c = gelu_pk((f32x2){v1[0], v1[1]}), d = gelu_pk((f32x2){v1[2], v1[3]});
                        v0 = (f32x4){a.x, a.y, b.x, b.y}; v1 = (f32x4){c.x, c.y, d.x, d.y}; }
                    if (ACT == 2) {
#pragma unroll
                        for (int j = 0; j < 4; ++j) { v0[j] = 0.5f * v0[j] * (1.0f + erff(v0[j] * 0.70710678f)); v1[j] = 0.5f * v1[j] * (1.0f + erff(v1[j] * 0.70710678f)); } }
                    u32x4 w; w.x = cvt_pk_bf16(v0[0], v0[1]); w.y = cvt_pk_bf16(v0[2], v0[3]); w.z = cvt_pk_bf16(v1[0], v1[1]); w.w = cvt_pk_bf16(v1[2], v1[3]);
                    *(u32x4*)(rowp + bj * HALF) = w; } }
    }
};

struct PanelStats {
    unsigned* xbuf;
    unsigned* cnt;
    unsigned* tmo;
    int ntn; float eps;
    unsigned code;
    __device__ __forceinline__ bool run(const f32x4 (&v)[2][2][4][2], const Unit& u, int wr, int wc, int fr, int fq, PG8_LAS unsigned char* lds, int wid, int lane) const {
        typedef float f32x2v __attribute__((ext_vector_type(2)));
        PG8_LAS f32x2v* P = (PG8_LAS f32x2v*)lds;
        PG8_LAS f32x2v* S = (PG8_LAS f32x2v*)(lds + 8192);
        PG8_LAS unsigned* flag = (PG8_LAS unsigned*)(lds + 8192 + 2048);
#pragma unroll
        for (int ai = 0; ai < 2; ++ai)
#pragma unroll
            for (int m = 0; m < 4; ++m) {
                float s = 0.f;
#pragma unroll
                for (int bj = 0; bj < 2; ++bj)
#pragma unroll
                    for (int n = 0; n < 2; ++n) { const f32x4 x = v[ai][bj][m][n]; s += (x[0] + x[1]) + (x[2] + x[3]); }
                s += __shfl_xor(s, 16); s += __shfl_xor(s, 32);
                const float mw = s * (1.0f / 64.0f); float q = 0.f;
#pragma unroll
                for (int bj = 0; bj < 2; ++bj)
#pragma unroll
                    for (int n = 0; n < 2; ++n) { const f32x4 d = v[ai][bj][m][n] - mw; q += (d[0] * d[0] + d[1] * d[1]) + (d[2] * d[2] + d[3] * d[3]); }
                q += __shfl_xor(q, 16); q += __shfl_xor(q, 32);
                if (fq == 0) P[(ai * HALF + wr * 64 + m * 16 + fr) * 4 + wc] = (f32x2v){mw, q};
            }
        asm volatile("s_waitcnt lgkmcnt(0)" ::: "memory"); __builtin_amdgcn_s_barrier(); asm volatile("" ::: "memory");
#if defined(BROKEN_NO_WAIT)
        if (blockIdx.x >= 64) { const long long t0 = clock64(); while (clock64() - t0 < 60000) __builtin_amdgcn_s_sleep(8); }
#endif
        const int row = wid * 32 + (lane & 31);
        if (lane < 32) {
            const f32x2v a = P[row * 4 + 0], b = P[row * 4 + 1], c = P[row * 4 + 2], d = P[row * 4 + 3];
            const float mt = (a.x + b.x + c.x + d.x) * 0.25f;
            const float da = a.x - mt, db = b.x - mt, dc = c.x - mt, dd = d.x - mt;
            const float m2 = (a.y + b.y) + (c.y + d.y) + 64.0f * ((da * da + db * db) + (dc * dc + dd * dd));
            unsigned long long* slot = (unsigned long long*)xbuf + ((size_t)(u.pm * BM + row) * 4 + u.pn);
            __hip_atomic_store(slot, ((unsigned long long)__float_as_uint(m2) << 32) | __float_as_uint(mt), __ATOMIC_RELAXED, __HIP_MEMORY_SCOPE_AGENT);
        }
        asm volatile("s_waitcnt vmcnt(0)" ::: "memory");
        if (lane == 0) __hip_atomic_fetch_add(cnt + 64 * u.pm, 1u, __ATOMIC_RELAXED, __HIP_MEMORY_SCOPE_AGENT);
        if (wid == 0) {
            bool dead = false; const unsigned long long t0 = __builtin_amdgcn_s_memrealtime(); const unsigned want = 8u * (unsigned)ntn;
            for (;;) {
#if defined(BROKEN_NO_WAIT)
                break;
#endif
                if ((unsigned)__builtin_amdgcn_readfirstlane(__hip_atomic_load(cnt + 64 * u.pm, __ATOMIC_RELAXED, __HIP_MEMORY_SCOPE_AGENT)) >= want) break;
                if (__builtin_amdgcn_s_memrealtime() - t0 > 2000000ull) {
                    if (lane == 0) { unsigned expect = 0u; __hip_atomic_compare_exchange_strong(tmo + 1, &expect, code | (unsigned)(u.pm & 0xff), __ATOMIC_RELAXED, __ATOMIC_RELAXED, __HIP_MEMORY_SCOPE_AGENT);
                                     __hip_atomic_store(tmo, 1u, __ATOMIC_RELAXED, __HIP_MEMORY_SCOPE_AGENT); }
                    dead = true; break; }
                __builtin_amdgcn_s_sleep(2);
            }
            __builtin_amdgcn_fence(__ATOMIC_ACQUIRE, "agent");
            if (lane == 0) flag[0] = dead ? 1u : 0u;
        }
        asm volatile("s_waitcnt vmcnt(0) lgkmcnt(0)" ::: "memory"); __builtin_amdgcn_s_barrier(); asm volatile("" ::: "memory");
        const bool bad = flag[0] != 0u;
        if (lane < 32) {
            const unsigned long long* slot = (const unsigned long long*)xbuf + (size_t)(u.pm * BM + row) * 4; float mt[4], m2[4]; float ms = 0.f;
#pragma unroll
            for (int t = 0; t < 4; ++t) { if (t < ntn) { const unsigned long long w = __hip_atomic_load(slot + t, __ATOMIC_RELAXED, __HIP_MEMORY_SCOPE_AGENT); mt[t] = __uint_as_float((unsigned)w); m2[t] = __uint_as_float((unsigned)(w >> 32)); } else { mt[t] = 0.f; m2[t] = 0.f; } ms += mt[t]; }
            const float mean = ms / (float)ntn; float q = 0.f;
#pragma unroll
            for (int t = 0; t < 4; ++t) if (t < ntn) { const float dm = mt[t] - mean; q += m2[t] + 256.0f * dm * dm; }
            S[row] = (f32x2v){mean, 1.0f / sqrtf(q / (256.0f * (float)ntn) + eps)};
        }
        asm volatile("s_waitcnt lgkmcnt(0)" ::: "memory"); __builtin_amdgcn_s_barrier(); asm volatile("" ::: "memory");
        return bad;
    }
};
struct EpiLnRes {
    static constexpr bool PERM = false, AFTER_DRAIN = true;
    const float* base; float* out; int ldc; const float* bias; PanelStats st; unsigned poison;
    __device__ __forceinline__ void refuse(size_t i0, size_t stride, int M, int N) const { const float q = __builtin_nanf(""); for (size_t i = i0; i < (size_t)M * N; i += stride) out[(i / N) * ldc + i % N] = q;
        if (i0 == 0) { unsigned expect = 0u; __hip_atomic_compare_exchange_strong(st.tmo + 1, &expect, 0x7f0u, __ATOMIC_RELAXED, __ATOMIC_RELAXED, __HIP_MEMORY_SCOPE_AGENT); __hip_atomic_store(st.tmo, 1u, __ATOMIC_RELAXED, __HIP_MEMORY_SCOPE_AGENT); } }
    __device__ __forceinline__ void fused(f32x4 (&acc)[2][2][4][2], const Unit& u, int wr, int wc, int fr, int fq, PG8_LAS unsigned char* lds, int wid, int lane) const {
        typedef float f32x2v __attribute__((ext_vector_type(2)));
        const PG8_LAS f32x2v* S = (const PG8_LAS f32x2v*)(lds + 8192);
        const int col0 = u.pn * BM + wc * 32 + 4 * fq;
#pragma unroll
        for (int bj = 0; bj < 2; ++bj)
#pragma unroll
            for (int n = 0; n < 2; ++n) { const f32x4 bv = bias ? *(const f32x4*)(bias + col0 + bj * HALF + n * 16) : (f32x4){0.f, 0.f, 0.f, 0.f};
#pragma unroll
                for (int ai = 0; ai < 2; ++ai)
#pragma unroll
                    for (int m = 0; m < 4; ++m) acc[ai][bj][m][n] += bv; }
        const bool bad = st.run(acc, u, wr, wc, fr, fq, lds, wid, lane) || poison != 0u;
        const float qnan = __builtin_nanf("");
#pragma unroll
        for (int ai = 0; ai < 2; ++ai)
#pragma unroll
            for (int m = 0; m < 4; ++m) { const int r = ai * HALF + wr * 64 + m * 16 + fr; const f32x2v sr = S[r]; const size_t off = (size_t)(u.pm * BM + r) * ldc + col0;
#pragma unroll
                for (int bj = 0; bj < 2; ++bj)
#pragma unroll
                    for (int n = 0; n < 2; ++n) { const f32x4 bs = *(const f32x4*)(base + off + bj * HALF + n * 16); f32x4 o = bs + (acc[ai][bj][m][n] - sr.x) * sr.y;
                        if (bad) o = (f32x4){qnan, qnan, qnan, qnan}; *(f32x4*)(out + off + bj * HALF + n * 16) = o; }
                asm volatile("" ::: "memory"); }
    }
};
struct EpiLnResLn {
    static constexpr bool PERM = false, AFTER_DRAIN = true;
    const float* base; float* out; bf16_t* xn; int ldc; const float* bias; PanelStats st1, st2; unsigned poison;
    __device__ __forceinline__ void refuse(size_t i0, size_t stride, int M, int N) const { const float q = __builtin_nanf(""); for (size_t i = i0; i < (size_t)M * N; i += stride) { const size_t o = (i / N) * ldc + i % N; out[o] = q; xn[o] = (bf16_t)0x7fc0u; }
        if (i0 == 0) { unsigned expect = 0u; __hip_atomic_compare_exchange_strong(st1.tmo + 1, &expect, 0x7f0u, __ATOMIC_RELAXED, __ATOMIC_RELAXED, __HIP_MEMORY_SCOPE_AGENT); __hip_atomic_store(st1.tmo, 1u, __ATOMIC_RELAXED, __HIP_MEMORY_SCOPE_AGENT); } }
    __device__ __forceinline__ void fused(f32x4 (&acc)[2][2][4][2], const Unit& u, int wr, int wc, int fr, int fq, PG8_LAS unsigned char* lds, int wid, int lane) const {
        typedef float f32x2v __attribute__((ext_vector_type(2))); typedef unsigned u32x2v __attribute__((ext_vector_type(2)));
        const PG8_LAS f32x2v* S = (const PG8_LAS f32x2v*)(lds + 8192);
        const int col0 = u.pn * BM + wc * 32 + 4 * fq;
#pragma unroll
        for (int bj = 0; bj < 2; ++bj)
#pragma unroll
            for (int n = 0; n < 2; ++n) { const f32x4 bv = bias ? *(const f32x4*)(bias + col0 + bj * HALF + n * 16) : (f32x4){0.f, 0.f, 0.f, 0.f};
#pragma unroll
                for (int ai = 0; ai < 2; ++ai)
#pragma unroll
                    for (int m = 0; m < 4; ++m) acc[ai][bj][m][n] += bv; }
        bool bad = st1.run(acc, u, wr, wc, fr, fq, lds, wid, lane) || poison != 0u;
        const float qnan = __builtin_nanf("");
#pragma unroll
        for (int ai = 0; ai < 2; ++ai)
#pragma unroll
            for (int m = 0; m < 4; ++m) { const int r = ai * HALF + wr * 64 + m * 16 + fr; const f32x2v sr = S[r]; const size_t off = (size_t)(u.pm * BM + r) * ldc + col0;
#pragma unroll
                for (int bj = 0; bj < 2; ++bj)
#pragma unroll
                    for (int n = 0; n < 2; ++n) { const f32x4 bs = *(const f32x4*)(base + off + bj * HALF + n * 16); acc[ai][bj][m][n] = bs + (acc[ai][bj][m][n] - sr.x) * sr.y; }
                asm volatile("" : "+v"(acc[ai][0][m][0]), "+v"(acc[ai][0][m][1]), "+v"(acc[ai][1][m][0]), "+v"(acc[ai][1][m][1]));
                if (m & 1) asm volatile("" ::: "memory"); }
        const bool bad1 = bad;
        bad = st2.run(acc, u, wr, wc, fr, fq, lds, wid, lane) || bad;
#pragma unroll
        for (int ai = 0; ai < 2; ++ai)
#pragma unroll
            for (int m = 0; m < 4; ++m) { const int r = ai * HALF + wr * 64 + m * 16 + fr; const f32x2v sr = S[r]; const size_t off = (size_t)(u.pm * BM + r) * ldc + col0;
#pragma unroll
                for (int bj = 0; bj < 2; ++bj)
#pragma unroll
                    for (int n = 0; n < 2; ++n) { const f32x4 x1 = acc[ai][bj][m][n]; *(f32x4*)(out + off + bj * HALF + n * 16) = bad1 ? (f32x4){qnan, qnan, qnan, qnan} : x1;
                        const f32x4 o = (x1 - sr.x) * sr.y; u32x2v w; w.x = cvt_pk_bf16(o[0], o[1]); w.y = cvt_pk_bf16(o[2], o[3]);
                        if (bad) { w.x = 0x7fc07fc0u; w.y = 0x7fc07fc0u; } *(u32x2v*)(xn + off + bj * HALF + n * 16) = w; }
                asm volatile("" ::: "memory"); }
    }
};

template <class Epi, class Sched, bool STAMP = false>
__device__ __forceinline__ void gemm_phase(PG8_LAS unsigned char* lds, const Gemm g, const Sched& S, const Epi& E, unsigned long long* stamps) {
    int tid_l = threadIdx.x; asm volatile("" : "+v"(tid_l));
    const int tid = tid_l, wid = __builtin_amdgcn_readfirstlane(tid >> 6), lane = tid & 63, wr = wid >> 2, wc = wid & 3, fr = lane & 15, fq = lane >> 4;
    const int K = g.K, nt = K / BK;
    int ts_lo = 0, ts_hi = 0, nts = 0; const unsigned long long rt_entry = STAMP ? (unsigned long long)wall_clock64() : 0ull;
#define PG8_STAMP() do { if (STAMP && wid == 0 && nts < 64) { const unsigned long long _c = (unsigned long long)clock64(); \
        ts_lo = (lane == nts) ? (int)(unsigned)_c : ts_lo; ts_hi = (lane == nts) ? (int)(unsigned)(_c >> 32) : ts_hi; ++nts; } } while (0)
    PG8_STAMP();
    unsigned voffA[2], voffB[2];
#pragma unroll
    for (int i = 0; i < 2; ++i) { int R, C; stage_rc(tid * 16 + i * 8192, R, C); const int Rb = Epi::PERM ? ((R & ~31) + perm32(R & 31)) : R;
        voffA[i] = (unsigned)(R * K + C) * 2u; voffB[i] = (unsigned)(Rb * K + C) * 2u; }
    const size_t kstep = (size_t)(BK * 2);
    const size_t hstep = (size_t)HALF * K * 2;
    const size_t tstep = 2 * hstep;
    const unsigned ldsw = (unsigned)wid * 1024u;
    const int aoff = lds_byte(wr * 64 + fr, fq * 8), boff = lds_byte(wc * 32 + fr, fq * 8);
#define PG8_SA(b, h) (((b) * 2 + (h)) * HTB)
#define PG8_SB(b, h) ((4 + (b) * 2 + (h)) * HTB)
#define PG8_STAGE(bufoff, gbase, voff) do { _Pragma("unroll") for (int _i = 0; _i < 2; ++_i) \
        __builtin_amdgcn_global_load_lds((const unsigned*)((const char*)(gbase) + (voff)[_i]), (PG8_LAS unsigned*)(lds + (bufoff) + ldsw + _i * 8192), 16, 0, 0); } while (0)
#define PG8_LDA(dst, b, h) do { _Pragma("unroll") for (int m = 0; m < 4; ++m) _Pragma("unroll") for (int k = 0; k < 2; ++k) dst[m][k] = *(const PG8_LAS bf16x8*)(lds + PG8_SA(b, h) + aoff + m * 2048 + k * 1024); } while (0)
#define PG8_LDB(dst, b, h) do { _Pragma("unroll") for (int n = 0; n < 2; ++n) _Pragma("unroll") for (int k = 0; k < 2; ++k) dst[n][k] = *(const PG8_LAS bf16x8*)(lds + PG8_SB(b, h) + boff + n * 2048 + k * 1024); } while (0)
#define PG8_MMA(ai, bj, At, Bt) do { __builtin_amdgcn_s_setprio(1); _Pragma("unroll") for (int m = 0; m < 4; ++m) _Pragma("unroll") for (int n = 0; n < 2; ++n) _Pragma("unroll") for (int k = 0; k < 2; ++k) \
        acc[ai][bj][m][n] = __builtin_amdgcn_mfma_f32_16x16x32_bf16(Bt[n][k], At[m][k], acc[ai][bj][m][n], 0, 0, 0); __builtin_amdgcn_s_setprio(0); } while (0)
#define PG8_WAIT_V(n) asm volatile("s_waitcnt vmcnt(" #n ")" ::: "memory")
#define PG8_WAIT_L(n) asm volatile("s_waitcnt lgkmcnt(" #n ")" ::: "memory")
#define PG8_BAR __builtin_amdgcn_s_barrier()
#define PG8_SCHED __builtin_amdgcn_sched_barrier(0)
    Unit cur, nxt; int ui = 0;
    if (!S.next(0, cur)) return;
    f32x4 acc[2][2][4][2];
#pragma unroll
    for (int a = 0; a < 2; ++a)
#pragma unroll
        for (int b = 0; b < 2; ++b)
#pragma unroll
            for (int m = 0; m < 4; ++m)
#pragma unroll
                for (int n = 0; n < 2; ++n) acc[a][b][m][n] = (f32x4){0.f, 0.f, 0.f, 0.f};
    bf16x8 At[4][2], B0[2][2], B1[2][2];
    const char* cA = (const char*)g.A + (size_t)cur.pm * tstep; const char* cB = (const char*)g.Bt + (size_t)cur.pn * tstep;
    S.a_ready(cur);
    PG8_STAGE(PG8_SB(0, 0), cB, voffB); PG8_STAGE(PG8_SA(0, 0), cA, voffA); PG8_STAGE(PG8_SB(0, 1), cB + hstep, voffB); PG8_STAGE(PG8_SA(0, 1), cA + hstep, voffA);
    if (wr == 1) PG8_BAR;
    PG8_WAIT_V(4); PG8_BAR;
    PG8_STAGE(PG8_SB(1, 0), cB + kstep, voffB); PG8_STAGE(PG8_SA(1, 0), cA + kstep, voffA); PG8_STAGE(PG8_SB(1, 1), cB + hstep + kstep, voffB);
    PG8_WAIT_V(6); PG8_BAR;
    PG8_STAMP();
    for (;;) {
        const bool has_next = S.next(ui + 1, nxt);
        const char* nA = has_next ? (const char*)g.A + (size_t)nxt.pm * tstep : cA; const char* nB = has_next ? (const char*)g.Bt + (size_t)nxt.pn * tstep : cB;
        for (int t = 0; t < nt; t += 2) {
            const bool last = (t == nt - 2);
            const char* a1 = cA + (size_t)(t + 1) * kstep;
            const char* a2 = last ? nA : cA + (size_t)(t + 2) * kstep; const char* b2 = last ? nB : cB + (size_t)(t + 2) * kstep;
            const char* a3 = a2 + kstep; const char* b3 = b2 + kstep;
            if (last && has_next) S.a_ready(nxt);
            PG8_LDB(B0, 0, 0); PG8_SCHED; PG8_LDA(At, 0, 0); PG8_STAGE(PG8_SA(1, 1), a1 + hstep, voffA);
            PG8_WAIT_L(8); PG8_BAR; PG8_WAIT_L(0); PG8_MMA(0, 0, At, B0); PG8_BAR; PG8_SCHED;
            PG8_LDB(B1, 0, 1); PG8_STAGE(PG8_SB(0, 0), b2, voffB);
            PG8_BAR; PG8_WAIT_L(0); PG8_MMA(0, 1, At, B1); PG8_BAR;
            PG8_LDA(At, 0, 1); PG8_STAGE(PG8_SA(0, 0), a2, voffA);
            PG8_BAR; PG8_WAIT_L(0); PG8_MMA(1, 0, At, B0); PG8_BAR; PG8_SCHED;
            PG8_STAGE(PG8_SB(0, 1), b2 + hstep, voffB);
            PG8_WAIT_V(6); PG8_BAR; PG8_MMA(1, 1, At, B1); PG8_BAR;
            PG8_LDB(B0, 1, 0); PG8_SCHED; PG8_LDA(At, 1, 0); PG8_STAGE(PG8_SA(0, 1), a2 + hstep, voffA);
            PG8_WAIT_L(8); PG8_BAR; PG8_WAIT_L(0); PG8_MMA(0, 0, At, B0); PG8_BAR; PG8_SCHED;
            PG8_LDB(B1, 1, 1); PG8_STAGE(PG8_SB(1, 0), b3, voffB);
            PG8_BAR; PG8_WAIT_L(0); PG8_MMA(0, 1, At, B1); PG8_BAR;
            PG8_LDA(At, 1, 1); PG8_STAGE(PG8_SA(1, 0), a3, voffA);
            PG8_BAR; PG8_WAIT_L(0); PG8_MMA(1, 0, At, B0); PG8_BAR; PG8_SCHED;
            PG8_STAGE(PG8_SB(1, 1), b3 + hstep, voffB);
            PG8_WAIT_V(6); PG8_BAR; PG8_MMA(1, 1, At, B1); PG8_BAR;
        }
        PG8_STAMP();
        if constexpr (!Epi::AFTER_DRAIN) { E(acc, cur, wr, wc, fr, fq); S.done(cur); }
        PG8_STAMP();
        if (!has_next) break;
#pragma unroll
        for (int a = 0; a < 2; ++a)
#pragma unroll
            for (int b = 0; b < 2; ++b)
#pragma unroll
                for (int m = 0; m < 4; ++m)
#pragma unroll
                    for (int n = 0; n < 2; ++n) acc[a][b][m][n] = (f32x4){0.f, 0.f, 0.f, 0.f};
        cur = nxt; cA = nA; cB = nB; ++ui;
    }
    PG8_WAIT_V(0);
    if (wr == 0) PG8_BAR;
    PG8_BAR;
    if constexpr (Epi::AFTER_DRAIN) { E.fused(acc, cur, wr, wc, fr, fq, lds, wid, lane); S.done(cur); }
    PG8_STAMP();
    if (STAMP && wid == 0) { stamps[lane] = lane < nts ? (((unsigned long long)(unsigned)ts_hi << 32) | (unsigned)ts_lo) : 0ull;
        if (lane == 62) stamps[62] = rt_entry; if (lane == 63) stamps[63] = (unsigned long long)wall_clock64(); }
#undef PG8_STAMP
#undef PG8_SA
#undef PG8_SB
#undef PG8_STAGE
#undef PG8_LDA
#undef PG8_LDB
#undef PG8_MMA
#undef PG8_WAIT_V
#undef PG8_WAIT_L
#undef PG8_BAR
#undef PG8_SCHED
}
}

#define GAS __attribute__((address_space(1)))
#define LAS __attribute__((address_space(3)))
typedef unsigned short bf16;
typedef unsigned v4u __attribute__((ext_vector_type(4)));
typedef unsigned v2u __attribute__((ext_vector_type(2)));
typedef float f32x4 __attribute__((ext_vector_type(4)));
typedef float f32x2 __attribute__((ext_vector_type(2)));
typedef float f32x16 __attribute__((ext_vector_type(16)));
typedef short bf16x8 __attribute__((ext_vector_type(8)));
typedef short bf16x4 __attribute__((ext_vector_type(4)));

#ifndef MK_CHECK
#define MK_CHECK 0
#endif
#ifndef MK_ONE_LAUNCH
#define MK_ONE_LAUNCH 0
#endif
#ifndef MK_PROBE
#define MK_PROBE 0
#endif
#ifndef MK_DUP10
#define MK_DUP10 0
#endif
#ifndef MK_PROBE_KERNEL
#define MK_PROBE_KERNEL 0
#endif
#ifndef MK_PROBE_FLAGS
#define MK_PROBE_FLAGS 0
#endif
#ifndef MK_REPEAT_K
#define MK_REPEAT_K (-1)
#endif
#ifndef MK_PROBE_A
#define MK_PROBE_A 0u
#endif
#ifndef MK_PROBE_C
#define MK_PROBE_C 0u
#endif

constexpr int T_TOK = 65536, DM = 1024, SEQ = 2048, NBATCH = 32;
constexpr float ALPHA_DN = 1.6817928305074290f;
#ifndef PEER_U4
#define PEER_U4 1
#endif
#ifndef PEER_V4
#define PEER_V4 1
#endif
constexpr float PEER_USCALE = PEER_U4 ? 64.0f : 256.0f, PEER_VSCALE = PEER_V4 ? 12.8f : 32.0f;
constexpr int PEER_UROW = PEER_U4 ? 512 : 1024, PEER_VROW = PEER_V4 ? 512 : 1024;
constexpr int NWAVES = 8, NTHR = 512;
constexpr int NPH_LAYER = 12;
constexpr int N_PHASES = 1 + 4 * NPH_LAYER;

constexpr size_t MiB = 1u << 20;
constexpr size_t WS_CTL = 0, CTL_BYTES = 1 * MiB;
constexpr size_t WS_ROT = 1 * MiB;
constexpr size_t WS_WPEER = 4 * MiB;
constexpr size_t WS_WPLEG = 20 * MiB;
constexpr size_t WS_WPLEP = 28 * MiB;
constexpr size_t WS_WAIN = 30 * MiB;
constexpr size_t WS_WAQ = 32 * MiB;
constexpr size_t WAQ_STRIDE = 2560 * 256 * 2;
constexpr size_t WS_WAOV = 35 * MiB;
constexpr size_t WS_WBIN = 43 * MiB;
constexpr size_t WS_WBO = 48 * MiB;
constexpr size_t WS_WCIN = 51 * MiB;
constexpr size_t WS_WCO = 63 * MiB;
constexpr size_t WS_TABU = 68 * MiB, WS_TABV = 100 * MiB;
constexpr size_t WS_XB0 = 132 * MiB, WS_XB1 = 260 * MiB;
constexpr size_t WS_M = 388 * MiB;
constexpr size_t M_SC = 0, M_IDS = 512 * MiB, M_GATES = 544 * MiB, M_PB = 576 * MiB, M_PP = 0;
constexpr size_t M_RAW = 0, M_CQ = 128 * MiB, M_CKV = 160 * MiB, M_CKVT = 176 * MiB, M_KIDX = 192 * MiB, M_WIDX = 200 * MiB,
                 M_MASK = 202 * MiB, M_QLAT = 218 * MiB, M_QIDX = 474 * MiB;
constexpr size_t M_GU = 0, M_Y = 320 * MiB;
constexpr size_t M_Q = 0, M_K = 128 * MiB, M_V = 256 * MiB, M_STAT = 512 * MiB;
constexpr size_t WS_PP = WS_M + 608 * MiB;
constexpr size_t WS_END = WS_PP + 128 * MiB;
constexpr int CW_DIAG = 64;
constexpr int CW_BAR = 4096;

constexpr int RING_BYTES = 131072, LDS_BYTES = 147456, LDSCTL_OFF = LDS_BYTES - 512, MISC_OFF = LDSCTL_OFF + 320;

enum { I_X = 0, I_P, I_A_W_IN, I_A_CQ_GAIN, I_A_CKV_GAIN, I_A_W_UQ, I_A_W_UK, I_A_W_QIDX, I_A_KIDX_GAIN, I_A_KIDX_BIAS, I_A_W_UV, I_A_W_O,
       I_B_W_IN, I_B_CONV_W, I_B_CONV_B, I_B_W_A, I_B_B_A, I_B_W_X, I_B_B_X, I_B_LAMBDA, I_B_W_O, I_C_W_IN, I_C_W_O,
       I_LN1_G, I_LN1_B, I_PEER_WQ, I_PEER_SK, I_PEER_U, I_PEER_V, I_LN2_G, I_LN2_B, I_PLE_WP, I_PLE_WG, I_PLE_BG, N_IN };

struct Params { const float* in[N_IN]; float* out; unsigned char* ws; int ph_lo, ph_hi, flags, pad; };

typedef const float* const __attribute__((address_space(4)))* InTab;
struct Ctx {
    LAS unsigned char* lds;
    int tid, lane, wave, bid, G;
    InTab in; float* out; unsigned char* ws;
};
#define INP(cx, i) ((const float*)(const GAS float*)((cx).in[i]))

#define LDS_WAIT() asm volatile("s_waitcnt lgkmcnt(0)" ::: "memory")
#define VM_WAIT() asm volatile("s_waitcnt vmcnt(0)" ::: "memory")

typedef __bf16 bf16v2_t __attribute__((ext_vector_type(2)));
__device__ __forceinline__ unsigned pk2(float lo, float hi) { const f32x2 v = {lo, hi}; const bf16v2_t b = __builtin_convertvector(v, bf16v2_t); return __builtin_bit_cast(unsigned, b); }
__device__ __forceinline__ unsigned f2bf(float f) { return (unsigned)__builtin_bit_cast(unsigned short, (__bf16)f); }
__device__ __forceinline__ float bflo(unsigned w) { return __builtin_bit_cast(float, w << 16); }
__device__ __forceinline__ float bfhi(unsigned w) { return __builtin_bit_cast(float, w & 0xffff0000u); }
__device__ __forceinline__ float bf2f(bf16 b) { return __builtin_bit_cast(float, ((unsigned)b) << 16); }
template <int CTRL, int ROWMASK>
__device__ __forceinline__ float dpp_f(float v) { return __builtin_bit_cast(float, __builtin_amdgcn_update_dpp(0, __builtin_bit_cast(int, v), CTRL, ROWMASK, 0xf, false)); }
__device__ __forceinline__ float wave_sum_uniform(float v) {
    v += dpp_f<0xB1, 0xf>(v);
    v += dpp_f<0x4E, 0xf>(v);
    v += dpp_f<0x141, 0xf>(v);
    v += dpp_f<0x140, 0xf>(v);
    v += dpp_f<0x142, 0xa>(v);
    v += dpp_f<0x143, 0xc>(v);
    return __builtin_bit_cast(float, __builtin_amdgcn_readlane(__builtin_bit_cast(int, v), 63));
}
__device__ __forceinline__ float wave_sum(float v) { return wave_sum_uniform(v); }
__device__ __forceinline__ float gelu_tanh(float x) {
    const float u = 0.7978845608028654f * (x + 0.044715f * x * x * x);
    const float e = __expf(2.0f * u);
    const float th = 1.0f - 2.0f * __builtin_amdgcn_rcpf(e + 1.0f);
    return 0.5f * x * (1.0f + th);
}
__device__ __forceinline__ float sigmoidf_(float x) { return __builtin_amdgcn_rcpf(1.0f + __expf(-x)); }

#define XB_TMO      128
#define XB_XCNT(j)  (256  + 64 * (j))
#define XB_XSUB(j)  (1280 + 64 * (j))
#define XB_XGEN(j)  (2304 + 64 * (j))
#define XB_TOP      3328
#define XB_TOPGEN   3392
#define XCD_BAR_WORDS 3456
#define XB_SPIN_CAP (1u << 25)
__device__ __forceinline__ unsigned xb_ld(unsigned* p)              { return __hip_atomic_load(p, __ATOMIC_RELAXED, __HIP_MEMORY_SCOPE_AGENT); }
__device__ __forceinline__ unsigned xb_add(unsigned* p, unsigned v) { return __hip_atomic_fetch_add(p, v, __ATOMIC_RELAXED, __HIP_MEMORY_SCOPE_AGENT); }
__device__ __forceinline__ unsigned xb_xcc_id() { return (unsigned)__builtin_amdgcn_s_getreg((3 << 11) | 20) & 0xFu; }
#define XB_SPIN(cond, bar) do { unsigned _sp = 0; while (cond) { __builtin_amdgcn_s_sleep(1); \
    if ((++_sp & 255u) == 0u) { if (xb_ld(&(bar)[XB_TMO])) break; if (_sp > XB_SPIN_CAP) { atomicAdd(&(bar)[XB_TMO], 1u); break; } } } } while (0)
struct XcdBarrier { unsigned* bar; unsigned x; volatile LAS unsigned* st; };
__device__ __forceinline__ XcdBarrier xcd_barrier_post(unsigned* bar, volatile LAS unsigned* st) {
    XcdBarrier b; b.bar = bar; b.x = xb_xcc_id(); b.st = st;
    if (threadIdx.x == 0) (void)xb_add(&bar[XB_XCNT(b.x)], 1u);
    return b;
}
__device__ __forceinline__ void xcd_barrier_complete(unsigned* bar, unsigned x, unsigned& nloc, unsigned& nx) {
    const unsigned G = gridDim.x * gridDim.y * gridDim.z;
    unsigned sum, cnt, mine, sp = 0u;
    for (;;) {
        sum = 0u; cnt = 0u; mine = 0u;
#pragma unroll
        for (unsigned j = 0; j < 16; ++j) { const unsigned c = xb_ld(&bar[XB_XCNT(j)]); sum += c; cnt += (c > 0u) ? 1u : 0u; mine = (j == x) ? c : mine; }
        if (sum == G) break;
        __builtin_amdgcn_s_sleep(1);
        if ((++sp & 255u) == 0u) { if (xb_ld(&bar[XB_TMO])) break; if (sp > XB_SPIN_CAP) { atomicAdd(&bar[XB_TMO], 1u); break; } }
    }
    nloc = mine > 0u ? mine : 1u; nx = cnt > 0u ? cnt : 1u;
}
__device__ __forceinline__ void xcd_barrier(const XcdBarrier& b) {
    asm volatile("s_waitcnt vmcnt(0)" ::: "memory");
    __syncthreads();
    if (threadIdx.x == 0) {
        unsigned* bar = b.bar;
        __builtin_amdgcn_s_waitcnt(0);
        unsigned nloc = b.st[0], nx = b.st[1];
        if (nloc == 0u) { xcd_barrier_complete(bar, b.x, nloc, nx); b.st[0] = nloc; b.st[1] = nx; }
        const unsigned old = xb_add(&bar[XB_XSUB(b.x)], 1u);
        const unsigned gen = old / nloc;
        if (old + 1u == (gen + 1u) * nloc) {
            __builtin_amdgcn_fence(__ATOMIC_RELEASE, "agent");
            asm volatile("s_waitcnt vmcnt(0)" ::: "memory");
            const unsigned og = xb_add(&bar[XB_TOP], 1u);
            const unsigned tg = og / nx;
            if (og + 1u == (tg + 1u) * nx) xb_add(&bar[XB_TOPGEN], 1u);
            else XB_SPIN(xb_ld(&bar[XB_TOPGEN]) == tg, bar);
            __builtin_amdgcn_fence(__ATOMIC_ACQUIRE, "agent");
            xb_add(&bar[XB_XGEN(b.x)], 1u);
            asm volatile("s_waitcnt vmcnt(0)" ::: "memory");
        } else {
            XB_SPIN(xb_ld(&bar[XB_XGEN(b.x)]) == gen, bar);
            __builtin_amdgcn_fence(__ATOMIC_ACQUIRE, "agent");
            asm volatile("s_waitcnt vmcnt(0)" ::: "memory");
        }
    }
    __syncthreads();
}

__device__ __forceinline__ void p0_transpose_item(const float* W, int K, int N, bf16* WT, int row_off, float scale, LAS float* scr, int item, int lane) {
    const int nblk = N / 32, kb = item / nblk, nb = item % nblk, k0 = 64 * kb, n0 = 32 * nb;
#pragma unroll 8
    for (int i = 0; i < 32; ++i) { const int kk = 2 * i + (lane >> 5); scr[kk * 33 + (lane & 31)] = W[(size_t)(k0 + kk) * N + n0 + (lane & 31)] * scale; }
    LDS_WAIT(); asm volatile("" ::: "memory");
    const int c = lane & 7;
#pragma unroll
    for (int j = 0; j < 4; ++j) { const int n = (lane >> 3) + 8 * j; const LAS float* s = scr + (8 * c) * 33 + n;
        v4u o; o.x = pk2(s[0 * 33], s[1 * 33]); o.y = pk2(s[2 * 33], s[3 * 33]); o.z = pk2(s[4 * 33], s[5 * 33]); o.w = pk2(s[6 * 33], s[7 * 33]);
        *(v4u*)(WT + (size_t)(row_off + n0 + n) * K + k0 + 8 * c) = o; }
    LDS_WAIT(); asm volatile("" ::: "memory");
}

__device__ __forceinline__ void small_gemm_tile(const Ctx& c, const float* A, long sa_n, long sa_d, const float* Bm, long sb_k, long sb_d, int Kd,
                                                bf16* C, int ldc, int n0, int k0, float scale) {
    LAS float* As = (LAS float*)c.lds; LAS float* Bs = As + 128 * 68;
    __syncthreads();
    for (int e = c.tid; e < 64 * Kd; e += NTHR) {
        int r, d;
        if (sa_d == 1) { d = e % Kd; r = e / Kd; } else { r = e & 63; d = e >> 6; }
        As[d * 68 + r] = A[(long)(n0 + r) * sa_n + (long)d * sa_d];
    }
    for (int e = c.tid; e < 64 * Kd; e += NTHR) {
        int r, d;
        if (sb_d == 1) { d = e % Kd; r = e / Kd; } else { r = e & 63; d = e >> 6; }
        Bs[d * 68 + r] = Bm[(long)(k0 + r) * sb_k + (long)d * sb_d];
    }
    __syncthreads();
    {
        const int tn = (c.tid >> 5) * 4, tk = (c.tid & 31) * 2;
        float acc[4][2];
#pragma unroll
        for (int i = 0; i < 4; ++i) { acc[i][0] = 0.f; acc[i][1] = 0.f; }
        for (int d = 0; d < Kd; ++d) {
            const f32x4 a = *(const LAS f32x4*)(As + d * 68 + tn); const f32x2 b = *(const LAS f32x2*)(Bs + d * 68 + tk);
#pragma unroll
            for (int i = 0; i < 4; ++i) { acc[i][0] += a[i] * b[0]; acc[i][1] += a[i] * b[1]; }
        }
#pragma unroll
        for (int i = 0; i < 4; ++i) *(unsigned*)(C + (size_t)(n0 + tn + i) * ldc + k0 + tk) = pk2(acc[i][0] * scale, acc[i][1] * scale);
    }
}

__device__ __forceinline__ void ln_store_row(float (&v)[16], const float* gain, const float* bias, float* of, bf16* ob, int lane) {
    float s = 0.f;
#pragma unroll
    for (int j = 0; j < 16; ++j) s += v[j];
    const float mean = wave_sum(s) * (1.f / 1024.f);
    float s2 = 0.f;
#pragma unroll
    for (int j = 0; j < 16; ++j) { v[j] -= mean; s2 += v[j] * v[j]; }
    const float rstd = __builtin_amdgcn_rsqf(wave_sum(s2) * (1.f / 1024.f) + 1e-5f);
#pragma unroll
    for (int h = 0; h < 2; ++h) {
        const int col = h * 512 + 8 * lane;
        const f32x4 g0 = *(const f32x4*)(gain + col), g1 = *(const f32x4*)(gain + col + 4), b0 = *(const f32x4*)(bias + col), b1 = *(const f32x4*)(bias + col + 4);
        f32x4 o0, o1;
#pragma unroll
        for (int j = 0; j < 4; ++j) { o0[j] = v[h * 8 + j] * rstd * g0[j] + b0[j]; o1[j] = v[h * 8 + 4 + j] * rstd * g1[j] + b1[j]; }
        if (of) { *(f32x4*)(of + col) = o0; *(f32x4*)(of + col + 4) = o1; }
        v4u w; w.x = pk2(o0[0], o0[1]); w.y = pk2(o0[2], o0[3]); w.z = pk2(o1[0], o1[1]); w.w = pk2(o1[2], o1[3]);
        *(v4u*)(ob + col) = w;
    }
}
__device__ __forceinline__ void load_row16(const float* row, float (&v)[16], int lane) {
#pragma unroll
    for (int h = 0; h < 2; ++h) { const f32x4 a = *(const f32x4*)(row + h * 512 + 8 * lane), b = *(const f32x4*)(row + h * 512 + 8 * lane + 4);
#pragma unroll
        for (int j = 0; j < 4; ++j) { v[h * 8 + j] = a[j]; v[h * 8 + 4 + j] = b[j]; } }
}

__device__ __forceinline__ void load_row16c(const float* row, float (&v)[16], int lane) {
#pragma unroll
    for (int q = 0; q < 4; ++q) { const f32x4 a = *(const f32x4*)(row + 16 * lane + 4 * q);
#pragma unroll
        for (int j = 0; j < 4; ++j) v[4 * q + j] = a[j]; }
}
__device__ __forceinline__ void ln_store_row_c(float (&v)[16], const float* gain, const float* bias, float* of, bf16* ob, int lane) {
    float s = 0.f;
#pragma unroll
    for (int j = 0; j < 16; ++j) s += v[j];
    const float mean = wave_sum(s) * (1.f / 1024.f);
    float s2 = 0.f;
#pragma unroll
    for (int j = 0; j < 16; ++j) { v[j] -= mean; s2 += v[j] * v[j]; }
    const float rstd = __builtin_amdgcn_rsqf(wave_sum(s2) * (1.f / 1024.f) + 1e-5f);
    const int col = 16 * lane;
    float o[16];
#pragma unroll
    for (int q = 0; q < 4; ++q) { const f32x4 g = *(const f32x4*)(gain + col + 4 * q), b = *(const f32x4*)(bias + col + 4 * q); f32x4 r;
#pragma unroll
        for (int j = 0; j < 4; ++j) { r[j] = v[4 * q + j] * rstd * g[j] + b[j]; o[4 * q + j] = r[j]; }
        *(f32x4*)(of + col + 4 * q) = r; }
    v4u w0, w1; w0.x = pk2(o[0], o[1]); w0.y = pk2(o[2], o[3]); w0.z = pk2(o[4], o[5]); w0.w = pk2(o[6], o[7]);
    w1.x = pk2(o[8], o[9]); w1.y = pk2(o[10], o[11]); w1.z = pk2(o[12], o[13]); w1.w = pk2(o[14], o[15]);
    *(v4u*)(ob + col) = w0; *(v4u*)(ob + col + 8) = w1;
}

__device__ __forceinline__ void phase_prologue(const Ctx& c) {
    unsigned char* ws = c.ws;
    LAS float* scr = (LAS float*)(c.lds + c.wave * 16384);
    const int gw = c.bid * NWAVES + c.wave, NGW = c.G * NWAVES;
    {
        struct TI { const float* W; int K, N; bf16* WT; int row_off; float scale; };
        int base = 0;
#define TR_ITEMS(Wp, Kv, Nv, WTp, roff, sc) do { const int ni = ((Kv) / 64) * ((Nv) / 32); \
            for (int it = gw; it < ni; it += NGW) p0_transpose_item((Wp), (Kv), (Nv), (WTp), (roff), (sc), scr, it, c.lane); base += ni; } while (0)
        for (int i = 0; i < 4; ++i) {
            TR_ITEMS(INP(c, I_PLE_WG) + (size_t)i * 1024 * 1024, 1024, 1024, (bf16*)(ws + WS_WPLEG) + (size_t)i * 1024 * 1024, 0, 1.0f);
            TR_ITEMS(INP(c, I_PLE_WP) + (size_t)i * 256 * 1024, 256, 1024, (bf16*)(ws + WS_WPLEP) + (size_t)i * 1024 * 256, 0, 1.0f);
        }
        for (int j = 0; j < 2; ++j)
            TR_ITEMS(INP(c, I_A_W_QIDX) + (size_t)j * 256 * 512, 256, 512, (bf16*)(ws + WS_WAQ + j * WAQ_STRIDE), 2048, 0.125f);
        TR_ITEMS(INP(c, I_B_W_IN), 1024, 2560, (bf16*)(ws + WS_WBIN), 0, 1.0f);
        TR_ITEMS(INP(c, I_B_W_O), 1280, 1024, (bf16*)(ws + WS_WBO), 0, 1.0f);
        TR_ITEMS(INP(c, I_C_W_IN), 1024, 6144, (bf16*)(ws + WS_WCIN), 0, 1.0f);
        TR_ITEMS(INP(c, I_C_W_O), 2048, 1024, (bf16*)(ws + WS_WCO), 0, 1.0f);
#undef TR_ITEMS
        (void)base;
    }
    for (int j = 0; j < 2; ++j) {
        const float* W = INP(c, I_A_W_IN) + (size_t)j * 1024 * 456; bf16* WT = (bf16*)(ws + WS_WAIN) + (size_t)j * 512 * 1024;
        for (int e = c.bid * NTHR + c.tid; e < 512 * 1024; e += c.G * NTHR) { const int n = e >> 10, k = e & 1023; WT[e] = (bf16)(n < 456 ? f2bf(W[(size_t)k * 456 + n]) : 0u); }
    }
    {
        float* ct = (float*)(ws + WS_ROT); float* st = ct + 2048 * 128;
        for (int e = c.bid * NTHR + c.tid; e < 2048 * 128; e += c.G * NTHR) {
            const int pos = e >> 7, f = e & 127;
            const float lin = (float)f * (1.0f / 127.0f);
            const float p = (float)pow(10000.0, (double)lin);
            const float invf = 1.0f / p;
            const float ang = (float)pos * invf;
            ct[e] = (float)cos((double)ang); st[e] = (float)sin((double)ang);
        }
    }
    for (int m = gw; m < T_TOK; m += NGW) {
        const float* xr = INP(c, I_X) + (size_t)m * DM; bf16* ob = (bf16*)(ws + WS_XB0) + (size_t)m * DM;
#pragma unroll
        for (int h = 0; h < 2; ++h) { const int col = h * 512 + 8 * c.lane; const f32x4 a = *(const f32x4*)(xr + col), b = *(const f32x4*)(xr + col + 4);
            v4u w; w.x = pk2(a[0], a[1]); w.y = pk2(a[2], a[3]); w.z = pk2(b[0], b[1]); w.w = pk2(b[2], b[3]); *(v4u*)(ob + col) = w; }
    }
    {
        int tbase = 0;
        {
            const int ntile = 4 * 16 * 2 * 16;
            for (int t = c.bid; t < ntile; t += c.G) {
                const int i = t / 512, r = t % 512, hp = r / 32, tt = r % 32, nt = tt / 16, kt = tt % 16;
                const float* A = INP(c, I_PEER_SK) + (size_t)i * 8 * 2 * 128 * 128 + (size_t)hp * 128 * 128;
                const float* Bm = INP(c, I_PEER_WQ) + (size_t)i * 1024 * 2048 + hp * 128;
                bf16* C = (bf16*)(ws + WS_WPEER) + (size_t)i * 2048 * 1024 + (size_t)hp * 128 * 1024;
                small_gemm_tile(c, A, 128, 1, Bm, 2048, 1, 128, C, 1024, nt * 64, kt * 64, 1.0f);
            }
            tbase += ntile;
        }
        {
            const int ntile = 2 * 16 * 2 * 4;
            for (int t = c.bid; t < ntile; t += c.G) {
                const int j = t / 128, r = t % 128, h = r / 8, tt = r % 8, nt = tt / 4, kt = tt % 4;
                const float* A = INP(c, I_A_W_UK) + (size_t)j * 16 * 64 * 128 + (size_t)h * 64 * 128;
                const float* Bm = INP(c, I_A_W_UQ) + (size_t)j * 256 * 1024 + h * 64;
                bf16* C = (bf16*)(ws + WS_WAQ + j * WAQ_STRIDE) + (size_t)h * 128 * 256;
                small_gemm_tile(c, A, 1, 128, Bm, 1024, 1, 64, C, 256, nt * 64, kt * 64, 0.125f * 1.4426950408889634f);
            }
        }
        {
            const int ntile = 2 * 16 * 16 * 2;
            for (int t = c.bid; t < ntile; t += c.G) {
                const int j = t / 512, r = t % 512, h = r / 32, tt = r % 32, nt = tt / 2, kt = tt % 2;
                const float* A = INP(c, I_A_W_O) + (size_t)j * 1024 * 1024 + (size_t)h * 64 * 1024;
                const float* Bm = INP(c, I_A_W_UV) + (size_t)j * 16 * 128 * 64 + (size_t)h * 128 * 64;
                bf16* C = (bf16*)(ws + WS_WAOV) + (size_t)j * 1024 * 2048 + h * 128;
                small_gemm_tile(c, A, 1, 1024, Bm, 64, 1, 64, C, 2048, nt * 64, kt * 64, 1.0f);
            }
        }
        (void)tbase;
    }
}

template <int FP4> __device__ __forceinline__ void peer_pack_row16(const float (&v)[16], unsigned char* dst) {
    if (FP4) { v2u w;
#pragma unroll
        for (int d = 0; d < 2; ++d) { unsigned p = 0u;
            p = __builtin_amdgcn_cvt_scalef32_pk_fp4_f32(p, v[8 * d + 0], v[8 * d + 1], 1.0f, 0); p = __builtin_amdgcn_cvt_scalef32_pk_fp4_f32(p, v[8 * d + 2], v[8 * d + 3], 1.0f, 1);
            p = __builtin_amdgcn_cvt_scalef32_pk_fp4_f32(p, v[8 * d + 4], v[8 * d + 5], 1.0f, 2); p = __builtin_amdgcn_cvt_scalef32_pk_fp4_f32(p, v[8 * d + 6], v[8 * d + 7], 1.0f, 3);
            w[d] = p; }
        *(v2u*)dst = w;
    } else { v4u w;
#pragma unroll
        for (int q = 0; q < 4; ++q) { int pa = 0; pa = __builtin_amdgcn_cvt_pk_fp8_f32(v[4 * q], v[4 * q + 1], pa, false); pa = __builtin_amdgcn_cvt_pk_fp8_f32(v[4 * q + 2], v[4 * q + 3], pa, true); w[q] = (unsigned)pa; }
        *(v4u*)dst = w;
    }
}

__device__ __forceinline__ void phase_ln1(const Ctx& c, int layer) {
    const int gw = c.bid * NWAVES + c.wave, NGW = c.G * NWAVES;
    const float* gain = INP(c, I_LN1_G) + layer * DM; const float* bias = INP(c, I_LN1_B) + layer * DM;
    bf16* xb = (bf16*)(c.ws + ((layer & 1) ? WS_XB1 : WS_XB0));
    for (int m = gw; m < T_TOK; m += NGW) {
        float v[16]; load_row16(c.out + (size_t)m * DM, v, c.lane);
        ln_store_row(v, gain, bias, nullptr, xb + (size_t)m * DM, c.lane);
    }
    {
        const float* U = INP(c, I_PEER_U) + (size_t)layer * 16384 * 1024; const float* V = INP(c, I_PEER_V) + (size_t)layer * 16384 * 1024;
        unsigned char* tu = c.ws + WS_TABU; unsigned char* tv = c.ws + WS_TABV;
        const size_t n16 = (size_t)16384 * 1024 / 16;
        for (size_t e = (size_t)c.bid * NTHR + c.tid; e < n16; e += (size_t)c.G * NTHR) {
            float ua[16], va[16];
#pragma unroll
            for (int q = 0; q < 4; ++q) { const f32x4 a4 = *(const f32x4*)(U + e * 16 + 4 * q) * PEER_USCALE, b4 = *(const f32x4*)(V + e * 16 + 4 * q) * PEER_VSCALE;
#pragma unroll
                for (int j = 0; j < 4; ++j) { ua[4 * q + j] = a4[j]; va[4 * q + j] = b4[j]; } }
            if (PEER_U4 && PEER_V4) {
                const size_t row = e >> 6, l16 = e & 63; peer_pack_row16<1>(ua, tu + row * 1024 + l16 * 8); peer_pack_row16<1>(va, tu + row * 1024 + 512 + l16 * 8);
            } else { peer_pack_row16<PEER_U4>(ua, tu + e * (PEER_UROW / 64)); peer_pack_row16<PEER_V4>(va, tv + e * (PEER_VROW / 64)); }
        }
    }
    {
        const float* P = INP(c, I_P) + (size_t)layer * T_TOK * 256; bf16* pb = (bf16*)(c.ws + WS_M + M_PB);
        const size_t n8 = (size_t)T_TOK * 256 / 8;
        for (size_t e = (size_t)c.bid * NTHR + c.tid; e < n8; e += (size_t)c.G * NTHR) {
            const f32x4 a = *(const f32x4*)(P + e * 8), b = *(const f32x4*)(P + e * 8 + 4);
            v4u w; w.x = pk2(a[0], a[1]); w.y = pk2(a[2], a[3]); w.z = pk2(b[0], b[1]); w.w = pk2(b[2], b[3]); *(v4u*)(pb + e * 8) = w;
        }
    }
}

using pg8::Unit;
constexpr int BMT = 256, HALFT = 128;

struct EpiResid {
    static constexpr bool PERM = false, AFTER_DRAIN = false;
    float* Y1; float alpha; const bf16* Xb;
    __device__ __forceinline__ void operator()(const pg8::f32x4 (&acc)[2][2][4][2], const Unit& u, int wr, int wc, int fr, int fq) const {
        const int row0 = u.pm * BMT + wr * 64 + fr, col0 = u.pn * BMT + wc * 32 + 4 * fq;
#pragma unroll
        for (int ai = 0; ai < 2; ++ai)
#pragma unroll
            for (int m = 0; m < 4; ++m) { const size_t roff = (size_t)(row0 + ai * HALFT + m * 16) * DM + col0; float* rowp = Y1 + roff; const bf16* srcp = Xb + roff;
                v2u xv[2][2];
#pragma unroll
                for (int bj = 0; bj < 2; ++bj)
#pragma unroll
                    for (int n = 0; n < 2; ++n) xv[bj][n] = *(const v2u*)(srcp + bj * HALFT + n * 16);
#pragma unroll
                for (int bj = 0; bj < 2; ++bj)
#pragma unroll
                    for (int n = 0; n < 2; ++n) { const pg8::f32x4 xf = {bflo(xv[bj][n].x), bfhi(xv[bj][n].x), bflo(xv[bj][n].y), bfhi(xv[bj][n].y)};
                        *(pg8::f32x4*)(rowp + bj * HALFT + n * 16) = xf * alpha + acc[ai][bj][m][n]; } }
    }
};

struct EpiF32T {
    static constexpr bool PERM = true, AFTER_DRAIN = false;
    bf16* C;
    __device__ __forceinline__ void operator()(const pg8::f32x4 (&acc)[2][2][4][2], const Unit& u, int wr, int wc, int fr, int fq) const {
        const int row0 = u.pm * BMT + wr * 64 + fr, cg0 = (u.pn * BMT + wc * 32 + 8 * fq) >> 3;
#pragma unroll
        for (int ai = 0; ai < 2; ++ai)
#pragma unroll
            for (int m = 0; m < 4; ++m) { const int r = row0 + ai * HALFT + m * 16; bf16* bp = C + (((size_t)(r >> 6) * 256 + cg0) * 64 + (r & 63)) * 8;
#pragma unroll
                for (int bj = 0; bj < 2; ++bj) { const pg8::f32x4 v0 = acc[ai][bj][m][0], v1 = acc[ai][bj][m][1];
                    v4u w; w.x = pk2(v0[0], v0[1]); w.y = pk2(v0[2], v0[3]); w.z = pk2(v1[0], v1[1]); w.w = pk2(v1[2], v1[3]);
                    *(v4u*)(bp + (size_t)(bj * 16) * 512) = w; } }
    }
};

template <int ACT0  > struct EpiBf16R {
    static constexpr bool PERM = true, AFTER_DRAIN = false;
    bf16 *O0, *O1, *O2; int ld0, ld1, ld2, c1, c2;
    __device__ __forceinline__ void operator()(const pg8::f32x4 (&acc)[2][2][4][2], const Unit& u, int wr, int wc, int fr, int fq) const {
        const int row0 = u.pm * BMT + wr * 64 + fr; int colt = u.pn * BMT; bf16* base; int ld; bool act = false;
        if (colt < c1) { base = O0; ld = ld0; act = (ACT0 == 1); } else if (colt < c2) { base = O1; ld = ld1; colt -= c1; } else { base = O2; ld = ld2; colt -= c2; }
        const int col0 = colt + wc * 32 + 8 * fq;
#pragma unroll
        for (int ai = 0; ai < 2; ++ai)
#pragma unroll
            for (int m = 0; m < 4; ++m) { bf16* rowp = base + (size_t)(row0 + ai * HALFT + m * 16) * ld + col0;
#pragma unroll
                for (int bj = 0; bj < 2; ++bj) { pg8::f32x4 v0 = acc[ai][bj][m][0], v1 = acc[ai][bj][m][1];
                    if (ACT0 == 1 && act) {
#pragma unroll
                        for (int j = 0; j < 4; ++j) { v0[j] = gelu_tanh(v0[j]); v1[j] = gelu_tanh(v1[j]); } }
                    v4u w; w.x = pk2(v0[0], v0[1]); w.y = pk2(v0[2], v0[3]); w.z = pk2(v1[0], v1[1]); w.w = pk2(v1[2], v1[3]);
                    *(v4u*)(rowp + bj * HALFT) = w; } }
    }
};

struct EpiRetIn {
    static constexpr bool PERM = true, AFTER_DRAIN = false;
    bf16 *Q, *K, *V; const float* cs; const float* sn;
    __device__ __forceinline__ void operator()(const pg8::f32x4 (&acc)[2][2][4][2], const Unit& u, int wr, int wc, int fr, int fq) const {
        const int row0 = u.pm * BMT + wr * 64 + fr; const int colt = u.pn * BMT;
        if (colt >= 2048) {
            const int col0 = colt - 2048 + wc * 32 + 8 * fq;
#pragma unroll
            for (int ai = 0; ai < 2; ++ai)
#pragma unroll
                for (int m = 0; m < 4; ++m) { bf16* rowp = V + (size_t)(row0 + ai * HALFT + m * 16) * 2048 + col0;
#pragma unroll
                    for (int bj = 0; bj < 2; ++bj) { const pg8::f32x4 v0 = acc[ai][bj][m][0], v1 = acc[ai][bj][m][1];
                        v4u w; w.x = pk2(v0[0], v0[1]); w.y = pk2(v0[2], v0[3]); w.z = pk2(v1[0], v1[1]); w.w = pk2(v1[2], v1[3]);
                        *(v4u*)(rowp + bj * HALFT) = w; } }
        } else {
            const bool isk = colt >= 1024; bf16* base = isk ? K : Q; const float sc = isk ? 0.0625f : 1.0f;
            const int col0 = (isk ? colt - 1024 : colt) + wc * 32 + 8 * fq; const int f0 = wc * 32 + 8 * fq;
#pragma unroll
            for (int ai = 0; ai < 2; ++ai)
#pragma unroll
                for (int m = 0; m < 4; ++m) { const int row = row0 + ai * HALFT + m * 16; const int pos = row & (SEQ - 1);
                    const pg8::f32x4 c0 = *(const pg8::f32x4*)(cs + pos * 128 + f0), c1 = *(const pg8::f32x4*)(cs + pos * 128 + f0 + 4);
                    const pg8::f32x4 s0 = *(const pg8::f32x4*)(sn + pos * 128 + f0), s1 = *(const pg8::f32x4*)(sn + pos * 128 + f0 + 4);
                    const pg8::f32x4 a0 = acc[ai][0][m][0] * sc, a1 = acc[ai][0][m][1] * sc, b0 = acc[ai][1][m][0] * sc, b1 = acc[ai][1][m][1] * sc;
                    const pg8::f32x4 r0 = a0 * c0 - b0 * s0, r1 = a1 * c1 - b1 * s1, q0 = a0 * s0 + b0 * c0, q1 = a1 * s1 + b1 * c1;
                    bf16* rowp = base + (size_t)row * 1024 + col0;
                    v4u w; w.x = pk2(r0[0], r0[1]); w.y = pk2(r0[2], r0[3]); w.z = pk2(r1[0], r1[1]); w.w = pk2(r1[2], r1[3]); *(v4u*)(rowp) = w;
                    v4u w2; w2.x = pk2(q0[0], q0[1]); w2.y = pk2(q0[2], q0[3]); w2.z = pk2(q1[0], q1[1]); w2.w = pk2(q1[2], q1[3]); *(v4u*)(rowp + HALFT) = w2; }
        }
    }
};

struct EpiRetGate {
    static constexpr bool PERM = true, AFTER_DRAIN = false;
    bf16* O; const float* STAT;
    __device__ __forceinline__ void operator()(const pg8::f32x4 (&acc)[2][2][4][2], const Unit& u, int wr, int wc, int fr, int fq) const {
        const int row0 = u.pm * BMT + wr * 64 + fr; const int head = u.pn >> 1; const int col0 = u.pn * BMT + wc * 32 + 8 * fq;
#pragma unroll
        for (int ai = 0; ai < 2; ++ai)
#pragma unroll
            for (int m = 0; m < 4; ++m) { const int row = row0 + ai * HALFT + m * 16;
                const pg8::f32x4 st = *(const pg8::f32x4*)(STAT + (size_t)row * 16 + head * 4);
                const float mean = (st[0] + st[2]) * (1.0f / 512.0f); const float var = (st[1] + st[3]) * (1.0f / 512.0f) - mean * mean;
                const float rstd = __builtin_amdgcn_rsqf(fmaxf(var, 0.f) + 1e-5f);
                bf16* rowp = O + (size_t)row * 2048 + col0;
#pragma unroll
                for (int bj = 0; bj < 2; ++bj) { const v4u ov = *(const v4u*)(rowp + bj * HALFT);
                    const pg8::f32x4 g0 = acc[ai][bj][m][0], g1 = acc[ai][bj][m][1];
                    float o[8] = {bflo(ov.x), bfhi(ov.x), bflo(ov.y), bfhi(ov.y), bflo(ov.z), bfhi(ov.z), bflo(ov.w), bfhi(ov.w)};
                    float r[8];
#pragma unroll
                    for (int j = 0; j < 8; ++j) { const float g = j < 4 ? g0[j] : g1[j - 4]; r[j] = g * sigmoidf_(g) * (o[j] - mean) * rstd; }
                    v4u w; w.x = pk2(r[0], r[1]); w.y = pk2(r[2], r[3]); w.z = pk2(r[4], r[5]); w.w = pk2(r[6], r[7]);
                    *(v4u*)(rowp + bj * HALFT) = w; } }
    }
};

struct EpiPle {
    static constexpr bool PERM = true, AFTER_DRAIN = false;
    const bf16* Xin; const bf16* PP; bf16* XBo; const float* bg; float* OutF;
    __device__ __forceinline__ void operator()(const pg8::f32x4 (&acc)[2][2][4][2], const Unit& u, int wr, int wc, int fr, int fq) const {
        const int row0 = u.pm * BMT + wr * 64 + fr; const int col0 = u.pn * BMT + wc * 32 + 8 * fq;
        pg8::f32x4 bv[2][2];
#pragma unroll
        for (int bj = 0; bj < 2; ++bj)
#pragma unroll
            for (int n = 0; n < 2; ++n) bv[bj][n] = *(const pg8::f32x4*)(bg + col0 + bj * HALFT + 4 * n);
#pragma unroll
        for (int ai = 0; ai < 2; ++ai)
#pragma unroll
            for (int m = 0; m < 4; ++m) { const size_t off = (size_t)(row0 + ai * HALFT + m * 16) * DM + col0;
#pragma unroll
                for (int bj = 0; bj < 2; ++bj) {
                    const v4u pv = *(const v4u*)(PP + off + bj * HALFT), xv = *(const v4u*)(Xin + off + bj * HALFT);
                    const float pp[8] = {bflo(pv.x), bfhi(pv.x), bflo(pv.y), bfhi(pv.y), bflo(pv.z), bfhi(pv.z), bflo(pv.w), bfhi(pv.w)};
                    const float xx[8] = {bflo(xv.x), bfhi(xv.x), bflo(xv.y), bfhi(xv.y), bflo(xv.z), bfhi(xv.z), bflo(xv.w), bfhi(xv.w)};
                    pg8::f32x4 o0, o1;
#pragma unroll
                    for (int j = 0; j < 4; ++j) { o0[j] = xx[j] + sigmoidf_(acc[ai][bj][m][0][j] + bv[bj][0][j]) * pp[j];
                                                  o1[j] = xx[4 + j] + sigmoidf_(acc[ai][bj][m][1][j] + bv[bj][1][j]) * pp[4 + j]; }
                    if (OutF) { *(pg8::f32x4*)(OutF + off + bj * HALFT) = o0; *(pg8::f32x4*)(OutF + off + bj * HALFT + 4) = o1; }
                    else { v4u w; w.x = pk2(o0[0], o0[1]); w.y = pk2(o0[2], o0[3]); w.z = pk2(o1[0], o1[1]); w.w = pk2(o1[2], o1[3]);
                        *(v4u*)(XBo + off + bj * HALFT) = w; } } }
    }
};

template <class Epi>
__device__ __forceinline__ void run_gemm(const Ctx& c, const bf16* A, const bf16* Bt, int N, int K, const Epi& E) {
    asm volatile("" : "+s"(K), "+s"(N));
    pg8::Gemm g{A, Bt, T_TOK, N, K}; pg8::StaticOrder S; S.init(T_TOK, N, c.G, c.bid);
    pg8::gemm_phase<Epi, pg8::StaticOrder, false>((PG8_LAS unsigned char*)c.lds, g, S, E, nullptr);
}

__device__ __forceinline__ unsigned sort_key(float f) { const unsigned u = __builtin_bit_cast(unsigned, f); return (u & 0x80000000u) ? ~u : (u | 0x80000000u); }
__device__ __forceinline__ unsigned half_sel(unsigned long long m, int half) { return half ? (unsigned)(m >> 32) : (unsigned)m; }

#define PK_CE(i, j) { const unsigned hi_ = b[i] > b[j] ? b[i] : b[j], lo_ = b[i] > b[j] ? b[j] : b[i]; b[i] = hi_; b[j] = lo_; }
__device__ __forceinline__ void sort16_desc(unsigned (&b)[16]) {
#define CE(i, j) PK_CE(i, j)
    CE(0,1) CE(2,3) CE(0,2) CE(1,3) CE(1,2) CE(4,5) CE(6,7) CE(4,6) CE(5,7) CE(5,6) CE(0,4) CE(2,6) CE(2,4) CE(1,5) CE(3,7) CE(3,5) CE(1,2) CE(3,4) CE(5,6) CE(8,9) CE(10,11) CE(8,10) CE(9,11) CE(9,10) CE(12,13) CE(14,15) CE(12,14) CE(13,15) CE(13,14) CE(8,12) CE(10,14) CE(10,12) CE(9,13) CE(11,15) CE(11,13) CE(9,10) CE(11,12) CE(13,14) CE(0,8) CE(4,12) CE(4,8) CE(2,10) CE(6,14) CE(6,10) CE(2,4) CE(6,8) CE(10,12) CE(1,9) CE(5,13) CE(5,9) CE(3,11) CE(7,15) CE(7,11) CE(3,5) CE(7,9) CE(11,13) CE(1,2) CE(3,4) CE(5,6) CE(7,8) CE(9,10) CE(11,12) CE(13,14)
#undef CE
}
__device__ __forceinline__ void merge16_desc(unsigned (&t)[16], const unsigned (&bb)[16]) {
    unsigned b[16];
#pragma unroll
    for (int i = 0; i < 16; ++i) b[i] = t[i] > bb[15 - i] ? t[i] : bb[15 - i];
#pragma unroll
    for (int d = 8; d >= 1; d >>= 1)
#pragma unroll
        for (int i = 0; i < 16; ++i) if ((i & d) == 0) PK_CE(i, i + d)
#pragma unroll
    for (int i = 0; i < 16; ++i) t[i] = b[i];
}
__device__ __forceinline__ void ins16(unsigned (&t)[16], unsigned x) {
#pragma unroll
    for (int p = 0; p < 16; ++p) { const unsigned hi = x > t[p] ? x : t[p], lo = x > t[p] ? t[p] : x; t[p] = hi; x = lo; }
}
__device__ __forceinline__ float unsort_key(unsigned k) { const unsigned u = (k & 0x80000000u) ? (k & 0x7fffffffu) : ~k; return __builtin_bit_cast(float, u); }
__device__ __forceinline__ void phase_peer_topk(const Ctx& c) {
    const int gw = c.bid * NWAVES + c.wave, NGW = c.G * NWAVES, lane = c.lane;
    const bf16* SCT = (const bf16*)(c.ws + WS_M + M_SC); int* IDS = (int*)(c.ws + WS_M + M_IDS); float* GATES = (float*)(c.ws + WS_M + M_GATES);
    LAS unsigned char* lidx = c.lds + c.wave * 2048 + lane * 32;
    for (int wu = gw; wu < 8192; wu += NGW) {
        const int tblk = wu >> 3, hd = wu & 7, tok = tblk * 64 + lane;
        unsigned tA[16], tB[16];
        const v4u* pa = (const v4u*)SCT + ((size_t)tblk * 256 + hd * 32) * 64 + lane; const v4u* pb = pa + 16 * 64;
#pragma unroll 1
        for (int blk = 0; blk < 8; ++blk) {
            unsigned ka[16], kb[16];
#pragma unroll
            for (int gg = 0; gg < 2; ++gg) { const v4u xa = pa[(2 * blk + gg) * 64], xb = pb[(2 * blk + gg) * 64];
#pragma unroll
                for (int j = 0; j < 4; ++j) { const unsigned lo0 = (unsigned)(127 - (16 * blk + 8 * gg + 2 * j)), lo1 = lo0 - 1u;
                    ka[8 * gg + 2 * j] = (sort_key(bflo(xa[j])) & ~127u) | lo0; ka[8 * gg + 2 * j + 1] = (sort_key(bfhi(xa[j])) & ~127u) | lo1;
                    kb[8 * gg + 2 * j] = (sort_key(bflo(xb[j])) & ~127u) | lo0; kb[8 * gg + 2 * j + 1] = (sort_key(bfhi(xb[j])) & ~127u) | lo1; } }
            sort16_desc(ka); sort16_desc(kb);
            if (blk == 0) {
#pragma unroll
                for (int i = 0; i < 16; ++i) { tA[i] = ka[i]; tB[i] = kb[i]; }
            } else { merge16_desc(tA, ka); merge16_desc(tB, kb); }
        }
        float a[16], b[16];
#pragma unroll
        for (int i = 0; i < 16; ++i) { a[i] = unsort_key(tA[i] & ~127u); b[i] = unsort_key(tB[i] & ~127u); lidx[i] = (unsigned char)(127u - (tA[i] & 127u)); lidx[16 + i] = (unsigned char)(127u - (tB[i] & 127u)); }
        unsigned uu[16];
        uu[0] = (sort_key(a[0] + b[0]) & ~255u) | 0u;
        uu[1] = (sort_key(a[0] + b[1]) & ~255u) | 1u;
        uu[2] = (sort_key(a[0] + b[2]) & ~255u) | 2u;
        uu[3] = (sort_key(a[0] + b[3]) & ~255u) | 3u;
        uu[4] = (sort_key(a[0] + b[4]) & ~255u) | 4u;
        uu[5] = (sort_key(a[0] + b[5]) & ~255u) | 5u;
        uu[6] = (sort_key(a[0] + b[6]) & ~255u) | 6u;
        uu[7] = (sort_key(a[0] + b[7]) & ~255u) | 7u;
        uu[8] = (sort_key(a[0] + b[8]) & ~255u) | 8u;
        uu[9] = (sort_key(a[0] + b[9]) & ~255u) | 9u;
        uu[10] = (sort_key(a[0] + b[10]) & ~255u) | 10u;
        uu[11] = (sort_key(a[0] + b[11]) & ~255u) | 11u;
        uu[12] = (sort_key(a[0] + b[12]) & ~255u) | 12u;
        uu[13] = (sort_key(a[0] + b[13]) & ~255u) | 13u;
        uu[14] = (sort_key(a[0] + b[14]) & ~255u) | 14u;
        uu[15] = (sort_key(a[0] + b[15]) & ~255u) | 15u;
        sort16_desc(uu);
        unsigned cb[16];
        cb[0] = (sort_key(a[1] + b[0]) & ~255u) | 16u;
        cb[1] = (sort_key(a[1] + b[1]) & ~255u) | 17u;
        cb[2] = (sort_key(a[1] + b[2]) & ~255u) | 18u;
        cb[3] = (sort_key(a[1] + b[3]) & ~255u) | 19u;
        cb[4] = (sort_key(a[1] + b[4]) & ~255u) | 20u;
        cb[5] = (sort_key(a[1] + b[5]) & ~255u) | 21u;
        cb[6] = (sort_key(a[1] + b[6]) & ~255u) | 22u;
        cb[7] = (sort_key(a[1] + b[7]) & ~255u) | 23u;
        cb[8] = (sort_key(a[2] + b[0]) & ~255u) | 32u;
        cb[9] = (sort_key(a[2] + b[1]) & ~255u) | 33u;
        cb[10] = (sort_key(a[2] + b[2]) & ~255u) | 34u;
        cb[11] = (sort_key(a[2] + b[3]) & ~255u) | 35u;
        cb[12] = (sort_key(a[2] + b[4]) & ~255u) | 36u;
        cb[13] = (sort_key(a[3] + b[0]) & ~255u) | 48u;
        cb[14] = (sort_key(a[3] + b[1]) & ~255u) | 49u;
        cb[15] = (sort_key(a[3] + b[2]) & ~255u) | 50u;
        sort16_desc(cb); merge16_desc(uu, cb);
        cb[0] = (sort_key(a[3] + b[3]) & ~255u) | 51u;
        cb[1] = (sort_key(a[4] + b[0]) & ~255u) | 64u;
        cb[2] = (sort_key(a[4] + b[1]) & ~255u) | 65u;
        cb[3] = (sort_key(a[4] + b[2]) & ~255u) | 66u;
        cb[4] = (sort_key(a[5] + b[0]) & ~255u) | 80u;
        cb[5] = (sort_key(a[5] + b[1]) & ~255u) | 81u;
        cb[6] = (sort_key(a[6] + b[0]) & ~255u) | 96u;
        cb[7] = (sort_key(a[6] + b[1]) & ~255u) | 97u;
        cb[8] = (sort_key(a[7] + b[0]) & ~255u) | 112u;
        cb[9] = (sort_key(a[7] + b[1]) & ~255u) | 113u;
        cb[10] = (sort_key(a[8] + b[0]) & ~255u) | 128u;
        cb[11] = (sort_key(a[9] + b[0]) & ~255u) | 144u;
        cb[12] = (sort_key(a[10] + b[0]) & ~255u) | 160u;
        cb[13] = (sort_key(a[11] + b[0]) & ~255u) | 176u;
        cb[14] = (sort_key(a[12] + b[0]) & ~255u) | 192u;
        cb[15] = (sort_key(a[13] + b[0]) & ~255u) | 208u;
        sort16_desc(cb); merge16_desc(uu, cb);
        cb[0] = (sort_key(a[14] + b[0]) & ~255u) | 224u;
        cb[1] = (sort_key(a[15] + b[0]) & ~255u) | 240u;
        cb[2] = 0u;
        cb[3] = 0u;
        cb[4] = 0u;
        cb[5] = 0u;
        cb[6] = 0u;
        cb[7] = 0u;
        cb[8] = 0u;
        cb[9] = 0u;
        cb[10] = 0u;
        cb[11] = 0u;
        cb[12] = 0u;
        cb[13] = 0u;
        cb[14] = 0u;
        cb[15] = 0u;
        sort16_desc(cb); merge16_desc(uu, cb);
        LDS_WAIT(); asm volatile("" ::: "memory");
        float sc[16], sum = 0.f; int eid[16];
        const float s0 = unsort_key(uu[0] & ~255u);
#pragma unroll
        for (int r = 0; r < 16; ++r) { const float s = unsort_key(uu[r] & ~255u); sc[r] = __expf(s - s0); sum += sc[r];
            const int i = (uu[r] >> 4) & 15, j = uu[r] & 15; eid[r] = (int)lidx[i] * 128 + (int)lidx[16 + j]; }
        const float inv = 1.0f / sum;
#pragma unroll
        for (int q = 0; q < 4; ++q) {
            *(v4u*)(IDS + (size_t)tok * 128 + hd * 16 + 4 * q) = (v4u){(unsigned)eid[4 * q], (unsigned)eid[4 * q + 1], (unsigned)eid[4 * q + 2], (unsigned)eid[4 * q + 3]};
            *(f32x4*)(GATES + (size_t)tok * 128 + hd * 16 + 4 * q) = (f32x4){sc[4 * q] * inv, sc[4 * q + 1] * inv, sc[4 * q + 2] * inv, sc[4 * q + 3] * inv};
        }
        LDS_WAIT(); asm volatile("" ::: "memory");
    }
}

#if !(PEER_U4 && PEER_V4)
#error "this gather expects both expert tables in fp4 (interleaved rows)"
#endif
typedef int v8i_t __attribute__((ext_vector_type(8)));
constexpr float PEER_XSCALE = 8.0f;
struct PeerGroup { v4u ua[8]; float g4[4]; };
__device__ __forceinline__ void peer_load(PeerGroup& B, const unsigned char* TAB, int idv, float gv, int kb, int lane) {
    const int m = lane & 15, kg = lane >> 4;
    const int idm = __builtin_amdgcn_ds_bpermute(4 * (kb + m), idv);
    const unsigned char* up = TAB + (size_t)idm * 1024 + 16 * kg;
#pragma unroll
    for (int cc = 0; cc < 8; ++cc) B.ua[cc] = *(const v4u*)(up + 64 * cc);
#pragma unroll
    for (int r = 0; r < 4; ++r) B.g4[r] = __builtin_bit_cast(float, __builtin_amdgcn_ds_bpermute(4 * (kb + 4 * kg + r), __builtin_bit_cast(int, gv)));
}
template <int J> __device__ __forceinline__ f32x2 fp4_pair(const v4u& w) { return __builtin_amdgcn_cvt_scalef32_pk_f32_fp4(w[J >> 2], 1.0f, J & 3); }
__device__ __forceinline__ void peer_compute(const PeerGroup& B, const unsigned char* TAB, int idv, int kb, const LAS unsigned char* xb8, f32x2 (&y2)[16], int lane) {
    const int hf = lane >> 5, l31 = lane & 31;
    v4u vv[8];
#pragma unroll
    for (int e = 0; e < 8; ++e) {
        const int ida = __builtin_amdgcn_readlane(idv, kb + 2 * e), idb = __builtin_amdgcn_readlane(idv, kb + 2 * e + 1);
        vv[e] = *(const v4u*)(TAB + (size_t)(hf ? idb : ida) * 1024 + 512 + 16 * l31);
    }
    f32x4 d = {0.f, 0.f, 0.f, 0.f};
#pragma unroll
    for (int cc = 0; cc < 8; ++cc) {
        asm volatile("" ::: "memory");
        const v4u b0 = *(const LAS v4u*)(xb8 + 128 * cc), b1 = *(const LAS v4u*)(xb8 + 128 * cc + 64);
        const v8i_t bx = {(int)b0.x, (int)b0.y, (int)b0.z, (int)b0.w, (int)b1.x, (int)b1.y, (int)b1.z, (int)b1.w};
        const v8i_t ax = {(int)B.ua[cc].x, (int)B.ua[cc].y, (int)B.ua[cc].z, (int)B.ua[cc].w, 0, 0, 0, 0};
        d = __builtin_amdgcn_mfma_scale_f32_16x16x128_f8f6f4(ax, bx, d, 4  , 0  , 0, 127, 0, 127);
    }
    float a4[4];
#pragma unroll
    for (int r = 0; r < 4; ++r) a4[r] = gelu_tanh(d[r] * (1.0f / (PEER_USCALE * PEER_XSCALE))) * B.g4[r] * (1.0f / PEER_VSCALE);
#pragma unroll
    for (int e = 0; e < 8; ++e) {
        const int ma = 2 * e, mb = 2 * e + 1;
        const float a0 = __builtin_bit_cast(float, __builtin_amdgcn_readlane(__builtin_bit_cast(int, a4[ma & 3]), 16 * (ma >> 2))), a1 = __builtin_bit_cast(float, __builtin_amdgcn_readlane(__builtin_bit_cast(int, a4[mb & 3]), 16 * (mb >> 2)));
        const float a = hf ? a1 : a0; const f32x2 a2 = {a, a};
#define PEER_AXPY(J) y2[J] = __builtin_elementwise_fma(a2, fp4_pair<J>(vv[e]), y2[J]);
        PEER_AXPY(0) PEER_AXPY(1) PEER_AXPY(2) PEER_AXPY(3) PEER_AXPY(4) PEER_AXPY(5) PEER_AXPY(6) PEER_AXPY(7)
        PEER_AXPY(8) PEER_AXPY(9) PEER_AXPY(10) PEER_AXPY(11) PEER_AXPY(12) PEER_AXPY(13) PEER_AXPY(14) PEER_AXPY(15)
#undef PEER_AXPY
    }
}
template <class BarFn>
__device__ __forceinline__ void phase_peer_gather(const Ctx& c, int layer, const BarFn&) {
    const int gw = c.bid * NWAVES + c.wave, NGW = c.G * NWAVES;
    const int* IDS = (const int*)(c.ws + WS_M + M_IDS); const float* GATES = (const float*)(c.ws + WS_M + M_GATES);
    const unsigned char* TAB = c.ws + WS_TABU;
    const float* gain = INP(c, I_LN2_G) + layer * DM; const float* bias = INP(c, I_LN2_B) + layer * DM;
    bf16* xb = (bf16*)(c.ws + ((layer & 1) ? WS_XB1 : WS_XB0));
    const int lane = c.lane, hf = lane >> 5, l31 = lane & 31;
    LAS unsigned char* xbase = c.lds + c.wave * 3072;
    { unsigned z = 0u; asm volatile("" : "+v"(z));
      *(LAS v4u*)(xbase + 2048 + 16 * lane) = (v4u){z, z, z, z}; }
    const bool col0 = (lane & 15) == 0;
    auto stage_x = [&](int tk, int buf) {
        const bf16* xr = xb + (size_t)tk * DM + 32 * l31; v4u w0, w1;
#pragma unroll
        for (int q = 0; q < 4; ++q) { const v4u xv = *(const v4u*)(xr + 8 * q);
            int pa = 0, pb = 0;
            pa = __builtin_amdgcn_cvt_pk_fp8_f32(bflo(xv.x) * PEER_XSCALE, bfhi(xv.x) * PEER_XSCALE, pa, false); pa = __builtin_amdgcn_cvt_pk_fp8_f32(bflo(xv.y) * PEER_XSCALE, bfhi(xv.y) * PEER_XSCALE, pa, true);
            pb = __builtin_amdgcn_cvt_pk_fp8_f32(bflo(xv.z) * PEER_XSCALE, bfhi(xv.z) * PEER_XSCALE, pb, false); pb = __builtin_amdgcn_cvt_pk_fp8_f32(bflo(xv.w) * PEER_XSCALE, bfhi(xv.w) * PEER_XSCALE, pb, true);
            if (q < 2) { w0[2 * q] = (unsigned)pa; w0[2 * q + 1] = (unsigned)pb; } else { w1[2 * q - 4] = (unsigned)pa; w1[2 * q - 3] = (unsigned)pb; } }
        if (hf == 0) { *(LAS v4u*)(xbase + 1024 * buf + 32 * l31) = w0; *(LAS v4u*)(xbase + 1024 * buf + 32 * l31 + 16) = w1; } };
    int tok = gw, par = 0;
    int idA = 0, idB = 0; float gA = 0.f, gB = 0.f;
    PeerGroup G0, G1;
    if (tok < T_TOK) {
        idA = IDS[(size_t)tok * 128 + lane]; idB = IDS[(size_t)tok * 128 + 64 + lane]; gA = GATES[(size_t)tok * 128 + lane]; gB = GATES[(size_t)tok * 128 + 64 + lane];
        stage_x(tok, 0);
        peer_load(G0, TAB, idA, gA, 0, lane);
    }
#pragma unroll 1
    while (tok < T_TOK) {
        const int ntok = tok + NGW; const bool has_next = ntok < T_TOK;
        int nidA = 0, nidB = 0; float ngA = 0.f, ngB = 0.f;
        if (has_next) { nidA = IDS[(size_t)ntok * 128 + lane]; nidB = IDS[(size_t)ntok * 128 + 64 + lane]; ngA = GATES[(size_t)ntok * 128 + lane]; ngB = GATES[(size_t)ntok * 128 + 64 + lane]; }
        const LAS unsigned char* xb8 = col0 ? (xbase + 1024 * par + 16 * (lane >> 4)) : (xbase + 2048);
        f32x2 y2[16];
#pragma unroll
        for (int j = 0; j < 16; ++j) y2[j] = (f32x2){0.f, 0.f};
        v4u xres[2] = {(v4u){0u, 0u, 0u, 0u}, (v4u){0u, 0u, 0u, 0u}};
        LDS_WAIT(); asm volatile("" ::: "memory");
#define PEER_LD(Gx, g) peer_load(Gx, TAB, ((g) >= 4) ? idB : idA, ((g) >= 4) ? gB : gA, ((g) & 3) * 16, lane)
#define PEER_CP(Gx, g) peer_compute(Gx, TAB, ((g) >= 4) ? idB : idA, ((g) & 3) * 16, xb8, y2, lane)
#pragma unroll 1
        for (int g = 0; g < 8; g += 2) {
            PEER_LD(G1, g + 1); PEER_CP(G0, g);
            if (g == 2 && has_next) stage_x(ntok, par ^ 1);
            if (g + 2 < 8) PEER_LD(G0, g + 2); else if (has_next) peer_load(G0, TAB, nidA, ngA, 0, lane);
            if (g == 6) { xres[0] = *(const v4u*)(xb + (size_t)tok * DM + 32 * l31 + 16 * hf); xres[1] = *(const v4u*)(xb + (size_t)tok * DM + 32 * l31 + 16 * hf + 8); }
            PEER_CP(G1, g + 1);
        }
#undef PEER_LD
#undef PEER_CP
        float z[16];
#pragma unroll
        for (int j = 0; j < 16; ++j) { const float tx = y2[j].x + __shfl_xor(y2[j].x, 32), ty = y2[j].y + __shfl_xor(y2[j].y, 32); y2[j] = (f32x2){tx, ty}; }
#pragma unroll
        for (int j = 0; j < 8; ++j) { const unsigned xw = xres[j >> 2][j & 3]; z[2 * j] = (hf ? y2[8 + j].x : y2[j].x) + ALPHA_DN * bflo(xw); z[2 * j + 1] = (hf ? y2[8 + j].y : y2[j].y) + ALPHA_DN * bfhi(xw); }
        float s = 0.f;
#pragma unroll
        for (int j = 0; j < 16; ++j) s += z[j];
        const float mean = wave_sum(s) * (1.f / 1024.f);
        float s2 = 0.f;
#pragma unroll
        for (int j = 0; j < 16; ++j) { z[j] -= mean; s2 += z[j] * z[j]; }
        const float rstd = __builtin_amdgcn_rsqf(wave_sum(s2) * (1.f / 1024.f) + 1e-5f);
        const int col = 32 * l31 + 16 * hf; float o[16];
#pragma unroll
        for (int q = 0; q < 4; ++q) { const f32x4 gq = *(const f32x4*)(gain + col + 4 * q), bq = *(const f32x4*)(bias + col + 4 * q); f32x4 r;
#pragma unroll
            for (int j = 0; j < 4; ++j) { r[j] = z[4 * q + j] * rstd * gq[j] + bq[j]; o[4 * q + j] = r[j]; } }
        v4u w0, w1; w0.x = pk2(o[0], o[1]); w0.y = pk2(o[2], o[3]); w0.z = pk2(o[4], o[5]); w0.w = pk2(o[6], o[7]);
        w1.x = pk2(o[8], o[9]); w1.y = pk2(o[10], o[11]); w1.z = pk2(o[12], o[13]); w1.w = pk2(o[14], o[15]);
        *(v4u*)(xb + (size_t)tok * DM + col) = w0; *(v4u*)(xb + (size_t)tok * DM + col + 8) = w1;
        idA = nidA; idB = nidB; gA = ngA; gB = ngB; par ^= 1; tok = ntok;
    }
}

__device__ __forceinline__ void phase_dsa_norm(const Ctx& c, int j) {
    const int gw = c.bid * NWAVES + c.wave, NGW = c.G * NWAVES, lane = c.lane;
    const bf16* RAW = (const bf16*)(c.ws + WS_M + M_RAW);
    bf16* CQ = (bf16*)(c.ws + WS_M + M_CQ); bf16* CKV = (bf16*)(c.ws + WS_M + M_CKV);
    bf16* KIDX = (bf16*)(c.ws + WS_M + M_KIDX); float* WIDX = (float*)(c.ws + WS_M + M_WIDX);
    const float* gq = INP(c, I_A_CQ_GAIN) + j * 256; const float* gkv = INP(c, I_A_CKV_GAIN) + j * 128;
    const float* gk = INP(c, I_A_KIDX_GAIN) + j * 64; const float* bk = INP(c, I_A_KIDX_BIAS) + j * 64;
    for (int tok = gw; tok < T_TOK; tok += NGW) {
        const v4u rw = *(const v4u*)(RAW + (size_t)tok * 512 + 8 * lane);
        float v[8] = {bflo(rw.x), bfhi(rw.x), bflo(rw.y), bfhi(rw.y), bflo(rw.z), bfhi(rw.z), bflo(rw.w), bfhi(rw.w)};
        float ss = 0.f, s = 0.f;
#pragma unroll
        for (int i = 0; i < 8; ++i) { ss += v[i] * v[i]; s += v[i]; }
        const bool isq = lane < 32, iskv = lane >= 32 && lane < 48, isk = lane >= 48 && lane < 56;
        const float ssq_q = wave_sum(isq ? ss : 0.f), ssq_kv = wave_sum(iskv ? ss : 0.f), sum_k = wave_sum(isk ? s : 0.f);
        const float mean_k = sum_k * (1.0f / 64.0f);
        float dv = 0.f;
#pragma unroll
        for (int i = 0; i < 8; ++i) { const float d = v[i] - mean_k; dv += d * d; }
        const float var_k = wave_sum(isk ? dv : 0.f) * (1.0f / 64.0f);
        if (isq) {
            const float r = __builtin_amdgcn_rsqf(ssq_q * (1.0f / 256.0f) + 1e-6f); const float* g = gq + 8 * lane;
            v4u w; w.x = pk2(v[0] * r * g[0], v[1] * r * g[1]); w.y = pk2(v[2] * r * g[2], v[3] * r * g[3]); w.z = pk2(v[4] * r * g[4], v[5] * r * g[5]); w.w = pk2(v[6] * r * g[6], v[7] * r * g[7]);
            *(v4u*)(CQ + (size_t)tok * 256 + 8 * lane) = w;
        } else if (iskv) {
            const int c0 = 8 * (lane - 32); const float r = __builtin_amdgcn_rsqf(ssq_kv * (1.0f / 128.0f) + 1e-6f); const float* g = gkv + c0;
            float o[8];
#pragma unroll
            for (int i = 0; i < 8; ++i) o[i] = v[i] * r * g[i];
            v4u w; w.x = pk2(o[0], o[1]); w.y = pk2(o[2], o[3]); w.z = pk2(o[4], o[5]); w.w = pk2(o[6], o[7]);
            *(v4u*)(CKV + (size_t)tok * 128 + c0) = w;
        } else if (isk) {
            const int c0 = 8 * (lane - 48); const float r = __builtin_amdgcn_rsqf(var_k + 1e-5f);
            float o[8];
#pragma unroll
            for (int i = 0; i < 8; ++i) o[i] = (v[i] - mean_k) * r * gk[c0 + i] + bk[c0 + i];
            v4u w; w.x = pk2(o[0], o[1]); w.y = pk2(o[2], o[3]); w.z = pk2(o[4], o[5]); w.w = pk2(o[6], o[7]);
            *(v4u*)(KIDX + (size_t)tok * 64 + c0) = w;
        } else if (lane == 56) {
            const float sc = 0.35355339059327373f;
            f32x4 o0 = {v[0] * sc, v[1] * sc, v[2] * sc, v[3] * sc}, o1 = {v[4] * sc, v[5] * sc, v[6] * sc, v[7] * sc};
            *(f32x4*)(WIDX + (size_t)tok * 8) = o0; *(f32x4*)(WIDX + (size_t)tok * 8 + 4) = o1;
        }
    }
}

__device__ __forceinline__ unsigned half_sum_u32(unsigned v, int h) {
    auto dpp = [](unsigned x, auto ctrl, auto rmask) { return (unsigned)__builtin_amdgcn_update_dpp(0, (int)x, decltype(ctrl)::value, decltype(rmask)::value, 0xf, false); };
    v += dpp(v, std::integral_constant<int, 0xB1>{}, std::integral_constant<int, 0xf>{});
    v += dpp(v, std::integral_constant<int, 0x4E>{}, std::integral_constant<int, 0xf>{});
    v += dpp(v, std::integral_constant<int, 0x141>{}, std::integral_constant<int, 0xf>{});
    v += dpp(v, std::integral_constant<int, 0x140>{}, std::integral_constant<int, 0xf>{});
    v += dpp(v, std::integral_constant<int, 0x142>{}, std::integral_constant<int, 0xa>{});
    const unsigned t0 = (unsigned)__builtin_amdgcn_readlane((int)v, 31), t1 = (unsigned)__builtin_amdgcn_readlane((int)v, 63);
    return h ? t1 : t0;
}
__device__ __forceinline__ void phase_dsa_index(const Ctx& c) {
    const bf16* KIDX = (const bf16*)(c.ws + WS_M + M_KIDX); const bf16* QIDX = (const bf16*)(c.ws + WS_M + M_QIDX);
    const float* WIDX = (const float*)(c.ws + WS_M + M_WIDX); unsigned* MASK = (unsigned*)(c.ws + WS_M + M_MASK);
    const int lane = c.lane, n = lane & 31, h = lane >> 5;
    const unsigned ltmask = (1u << n) - 1u;
    LAS unsigned* kl = (LAS unsigned*)(c.lds + c.wave * 16384) + lane * 4;
    for (int u = c.bid; u < 2048; u += c.G) {
        const int b = u & 31, rest = u >> 5, qc = rest >> 1, sub = rest & 1;
        const int tw0 = b * 2048 + qc * 64 + sub * 32 + 4 * c.wave;
        const int nt = 2 * (qc + 1), ng = (nt + 3) >> 2;
        if (nt <= 8) {
            if (n == 0) {
                for (int tt = 0; tt < 2; ++tt)
                    for (int tile = 0; tile < nt; ++tile) MASK[(size_t)(tw0 + 2 * h + tt) * 64 + tile] = 0xffffffffu;
            }
            continue;
        }
        const int ti = 2 * ((n >> 2) & 1) + (n >> 4), hd = 4 * ((n >> 3) & 1) + (n & 3);
        bf16x8 Aq[4];
#pragma unroll
        for (int s = 0; s < 4; ++s) Aq[s] = *(const bf16x8*)(QIDX + (size_t)(tw0 + ti) * 512 + hd * 64 + 16 * s + 8 * h);
        float wv[2][8];
#pragma unroll
        for (int tt = 0; tt < 2; ++tt) { const f32x4 w0 = *(const f32x4*)(WIDX + (size_t)(tw0 + 2 * h + tt) * 8), w1 = *(const f32x4*)(WIDX + (size_t)(tw0 + 2 * h + tt) * 8 + 4);
#pragma unroll
            for (int i = 0; i < 4; ++i) { wv[tt][i] = w0[i]; wv[tt][4 + i] = w1[i]; } }
        const bf16* kbase = KIDX + (size_t)(b * 2048 + n) * 64 + 8 * h;
        auto ldgrp = [&](bf16x8 (&Bk)[2][4], int tile0) {
#pragma unroll
            for (int q = 0; q < 2; ++q) if (tile0 + q < nt) { const bf16* kr = kbase + (size_t)(tile0 + q) * 32 * 64;
#pragma unroll
                for (int s = 0; s < 4; ++s) Bk[q][s] = *(const bf16x8*)(kr + 16 * s); } };
        auto scgrp = [&](const bf16x8 (&Bk)[2][4], int tile0) {
#pragma unroll
            for (int q = 0; q < 2; ++q) if (tile0 + q < nt) {
                f32x16 acc;
#pragma unroll
                for (int i = 0; i < 16; ++i) acc[i] = 0.f;
#pragma unroll
                for (int s = 0; s < 4; ++s) acc = __builtin_amdgcn_mfma_f32_32x32x16_bf16(Aq[s], Bk[q][s], acc, 0, 0, 0);
                float sc0 = 0.f, sc1 = 0.f;
#pragma unroll
                for (int jj = 0; jj < 2; ++jj)
#pragma unroll
                    for (int k = 0; k < 4; ++k) { sc0 += wv[0][4 * jj + k] * fmaxf(acc[4 * jj + k], 0.f); sc1 += wv[1][4 * jj + k] * fmaxf(acc[8 + 4 * jj + k], 0.f); }
                kl[((tile0 + q) >> 2) * 256 + ((tile0 + q) & 3)] = (sort_key(sc0) >> 16) | (sort_key(sc1) & 0xffff0000u);
            } };
        bf16x8 BkA[2][4], BkB[2][4];
        ldgrp(BkA, 0);
#pragma unroll 1
        for (int tile0 = 0; tile0 < nt; tile0 += 4) {
            if (tile0 + 2 < nt) ldgrp(BkB, tile0 + 2);
            scgrp(BkA, tile0);
            if (tile0 + 4 < nt) ldgrp(BkA, tile0 + 4);
            if (tile0 + 2 < nt) scgrp(BkB, tile0 + 2);
        }
        if (nt & 2) { kl[(nt >> 2) * 256 + 2] = 0u; kl[(nt >> 2) * 256 + 3] = 0u; }
        LDS_WAIT(); asm volatile("" ::: "memory");
        unsigned v0 = 0u, v1 = 0u, cv0 = 0xffffu, cv1 = 0xffffu;
        for (int bit = 15; bit >= 0; --bit) {
            const unsigned c0 = v0 | (1u << bit), c1 = v1 | (1u << bit); unsigned lt0 = 0u, lt1 = 0u;
            for (int g = 0; g < ng; ++g) { const v4u k4 = *(const LAS v4u*)(kl + g * 256);
#pragma unroll
                for (int j = 0; j < 4; ++j) { lt0 += (unsigned)((int)((k4[j] & 0xffffu) - c0)) >> 31; lt1 += (unsigned)((int)((k4[j] >> 16) - c1)) >> 31; } }
            const unsigned both = half_sum_u32((4u * (unsigned)ng - lt0) | ((4u * (unsigned)ng - lt1) << 16), h);
            const unsigned cnt0 = both & 0xffffu, cnt1 = both >> 16;
            if (cnt0 >= 256u) { v0 = c0; cv0 = cnt0; }
            if (cnt1 >= 256u) { v1 = c1; cv1 = cnt1; }
            if (__all(cv0 == 256u && cv1 == 256u)) break;
        }
        unsigned g0 = 0u, g1 = 0u;
        for (int g = 0; g < ng; ++g) { const v4u k4 = *(const LAS v4u*)(kl + g * 256);
#pragma unroll
            for (int j = 0; j < 4; ++j) { g0 += (unsigned)((int)(v0 - (k4[j] & 0xffffu))) >> 31; g1 += (unsigned)((int)(v1 - (k4[j] >> 16))) >> 31; } }
        const unsigned gboth = half_sum_u32(g0 | (g1 << 16), h);
        const unsigned need0 = 256u - (gboth & 0xffffu), need1 = 256u - (gboth >> 16); unsigned eb0 = 0u, eb1 = 0u;
        for (int tile = 0; tile < nt; ++tile) {
            const unsigned kw = kl[(tile >> 2) * 256 + (tile & 3)]; const unsigned k0 = kw & 0xffffu, k1 = kw >> 16;
            { const bool gt = k0 > v0, eq = k0 == v0; const unsigned em = half_sel(__ballot(eq), h);
              const bool take = gt || (eq && (eb0 + __popc(em & ltmask) < need0)); eb0 += __popc(em);
              const unsigned word = half_sel(__ballot(take), h); if (n == 0) MASK[(size_t)(tw0 + 2 * h) * 64 + tile] = word; }
            { const bool gt = k1 > v1, eq = k1 == v1; const unsigned em = half_sel(__ballot(eq), h);
              const bool take = gt || (eq && (eb1 + __popc(em & ltmask) < need1)); eb1 += __popc(em);
              const unsigned word = half_sel(__ballot(take), h); if (n == 0) MASK[(size_t)(tw0 + 2 * h + 1) * 64 + tile] = word; }
        }
        LDS_WAIT(); asm volatile("" ::: "memory");
    }
}

__device__ __forceinline__ void tr_rd16(unsigned a, v2u (&r)[16]) {
    asm volatile("ds_read_b64_tr_b16 %0, %16\n\tds_read_b64_tr_b16 %1, %16 offset:4352\n\t"
                 "ds_read_b64_tr_b16 %2, %16 offset:32\n\tds_read_b64_tr_b16 %3, %16 offset:4384\n\t"
                 "ds_read_b64_tr_b16 %4, %16 offset:64\n\tds_read_b64_tr_b16 %5, %16 offset:4416\n\t"
                 "ds_read_b64_tr_b16 %6, %16 offset:96\n\tds_read_b64_tr_b16 %7, %16 offset:4448\n\t"
                 "ds_read_b64_tr_b16 %8, %16 offset:128\n\tds_read_b64_tr_b16 %9, %16 offset:4480\n\t"
                 "ds_read_b64_tr_b16 %10, %16 offset:160\n\tds_read_b64_tr_b16 %11, %16 offset:4512\n\t"
                 "ds_read_b64_tr_b16 %12, %16 offset:192\n\tds_read_b64_tr_b16 %13, %16 offset:4544\n\t"
                 "ds_read_b64_tr_b16 %14, %16 offset:224\n\tds_read_b64_tr_b16 %15, %16 offset:4576\n\ts_waitcnt lgkmcnt(0)"
                 : "=&v"(r[0]), "=&v"(r[1]), "=&v"(r[2]), "=&v"(r[3]), "=&v"(r[4]), "=&v"(r[5]), "=&v"(r[6]), "=&v"(r[7]),
                   "=&v"(r[8]), "=&v"(r[9]), "=&v"(r[10]), "=&v"(r[11]), "=&v"(r[12]), "=&v"(r[13]), "=&v"(r[14]), "=&v"(r[15])
                 : "v"(a) : "memory");
}
__device__ __forceinline__ void phase_dsa_attn(const Ctx& c) {
    const bf16* CKV = (const bf16*)(c.ws + WS_M + M_CKV);
    bf16* QLAT = (bf16*)(c.ws + WS_M + M_QLAT); const unsigned* MASK = (const unsigned*)(c.ws + WS_M + M_MASK);
    constexpr int RS = 272, TILE = 32 * RS;
    const int lane = c.lane, l15 = lane & 15, g = lane >> 4;
    LAS unsigned char* T0 = c.lds + c.wave * 17920;
    LAS unsigned short* klist = (LAS unsigned short*)(T0 + 2 * TILE);
    const unsigned lbase = (unsigned)(size_t)T0;
    const int prow = lane >> 4, ppc = lane & 15;
    for (int u = c.bid * NWAVES + c.wave; u < T_TOK; u += c.G * NWAVES) {
        const int tok = u, b = tok >> 11;
        const int qc = (tok & 2047) >> 6; const int nt = 2 * (qc + 1);
        const unsigned mwd = lane < nt ? MASK[(size_t)tok * 64 + lane] : 0u;
        unsigned incl = (unsigned)__popc(mwd);
#pragma unroll
        for (int d = 1; d < 64; d <<= 1) { const unsigned o = __shfl_up(incl, d); if (lane >= d) incl += o; }
        const int nsel = __builtin_amdgcn_readlane((int)incl, 63);
        { unsigned pos = incl - (unsigned)__popc(mwd), w = mwd;
          while (w) { const int bit = __builtin_ctz(w); klist[pos++] = (unsigned short)(32 * lane + bit); w &= w - 1u; } }
        bf16x8 Bq[4];
#pragma unroll
        for (int s = 0; s < 4; ++s) Bq[s] = *(const bf16x8*)(QLAT + (size_t)tok * 2048 + l15 * 128 + 32 * s + 8 * g);
        LDS_WAIT(); asm volatile("" ::: "memory");
        const int nstep = nsel >> 5;
        const bf16* kvb = CKV + (size_t)b * 2048 * 128 + ppc * 8;
        v4u gr[8];
        auto gather = [&](int step) {
#pragma unroll
            for (int j = 0; j < 8; ++j) { const int key = klist[32 * step + 4 * j + prow]; gr[j] = *(const v4u*)(kvb + (size_t)key * 128); } };
        auto lstore = [&](int buf) {
#pragma unroll
            for (int j = 0; j < 8; ++j) *(LAS v4u*)(T0 + buf * TILE + (4 * j + prow) * RS + ppc * 16) = gr[j]; };
        float m_run = -INFINITY, l_run = 0.f;
        f32x4 O[8];
#pragma unroll
        for (int dt = 0; dt < 8; ++dt) O[dt] = (f32x4){0.f, 0.f, 0.f, 0.f};
        gather(0);
#pragma unroll 1
        for (int step = 0; step < nstep; ++step) {
            const int buf = step & 1;
            lstore(buf);
            if (step + 1 < nstep) gather(step + 1);
            LDS_WAIT(); asm volatile("" ::: "memory");
            f32x4 S[2];
#pragma unroll
            for (int kt = 0; kt < 2; ++kt) { S[kt] = (f32x4){0.f, 0.f, 0.f, 0.f};
#pragma unroll
                for (int s = 0; s < 4; ++s) { const bf16x8 Ak = *(const LAS bf16x8*)(T0 + buf * TILE + (16 * kt + l15) * RS + (32 * s + 8 * g) * 2);
                    S[kt] = __builtin_amdgcn_mfma_f32_16x16x32_bf16(Ak, Bq[s], S[kt], 0, 0, 0); } }
            float mx = fmaxf(fmaxf(fmaxf(S[0][0], S[0][1]), fmaxf(S[0][2], S[0][3])), fmaxf(fmaxf(S[1][0], S[1][1]), fmaxf(S[1][2], S[1][3])));
            mx = fmaxf(mx, __shfl_xor(mx, 16)); mx = fmaxf(mx, __shfl_xor(mx, 32));
            const float m_new = fmaxf(m_run, mx);
            const float alpha = __builtin_amdgcn_exp2f(m_run - m_new);
            float p[8], ps = 0.f;
#pragma unroll
            for (int j = 0; j < 8; ++j) { p[j] = __builtin_amdgcn_exp2f(S[j >> 2][j & 3] - m_new); ps += p[j]; }
            l_run = l_run * alpha + ps; m_run = m_new;
            v4u pw; pw.x = pk2(p[0], p[1]); pw.y = pk2(p[2], p[3]); pw.z = pk2(p[4], p[5]); pw.w = pk2(p[6], p[7]);
            const bf16x8 Bp = __builtin_bit_cast(bf16x8, pw);
            const unsigned ta = lbase + buf * TILE + (4 * g + (l15 >> 2)) * RS + (4 * (l15 & 3)) * 2;
            v2u tr[16]; tr_rd16(ta, tr);
#pragma unroll
            for (int dt = 0; dt < 8; ++dt) {
                v4u aw; aw.x = tr[2 * dt].x; aw.y = tr[2 * dt].y; aw.z = tr[2 * dt + 1].x; aw.w = tr[2 * dt + 1].y;
                O[dt] = O[dt] * alpha; O[dt] = __builtin_amdgcn_mfma_f32_16x16x32_bf16(__builtin_bit_cast(bf16x8, aw), Bp, O[dt], 0, 0, 0); }
        }
        const float l_tot = l_run + __shfl_xor(l_run, 16); const float l_all = l_tot + __shfl_xor(l_tot, 32); const float inv = 1.0f / l_all;
#pragma unroll
        for (int dt = 0; dt < 8; ++dt) { v2u w; w.x = pk2(O[dt][0] * inv, O[dt][1] * inv); w.y = pk2(O[dt][2] * inv, O[dt][3] * inv);
            *(v2u*)(QLAT + (size_t)tok * 2048 + l15 * 128 + 16 * dt + 4 * g) = w; }
        LDS_WAIT(); asm volatile("" ::: "memory");
    }
}

__device__ __forceinline__ float neg_expm1_small(float x) {
    const float p = -x * (1.0f + x * 0.5f * (1.0f + x * (1.0f / 3.0f) * (1.0f + x * 0.25f * (1.0f + x * 0.2f * (1.0f + x * (1.0f / 6.0f))))));
    return x < -0.25f ? 1.0f - __expf(x) : p;
}
__device__ __forceinline__ void phase_rglru(const Ctx& c) {
    const bf16* GU = (const bf16*)(c.ws + WS_M + M_GU); bf16* Y = (bf16*)(c.ws + WS_M + M_Y);
    constexpr int CVS = 104;
    LAS float* uT = (LAS float*)c.lds;
    LAS bf16* cvb = (LAS bf16*)(c.lds + 21504);
    LAS bf16* WTa = (LAS bf16*)(c.lds + 34816);
    LAS bf16* WTx = (LAS bf16*)(c.lds + 51456);
    LAS float* a_s = (LAS float*)(c.lds + 68096);
    LAS float* b_s = (LAS float*)(c.lds + 88832);
    LAS bf16* gT = (LAS bf16*)(c.lds + 109568);
    LAS float* cst = (LAS float*)(c.lds + 120064);
    const int tid = c.tid, lane = c.lane, w = c.wave;
    for (int u = c.bid; u < 512; u += c.G) {
        const int b = u >> 4, nb = u & 15, ch0 = nb * 80;
        __syncthreads();
        for (int e = tid; e < 80 * CVS; e += NTHR) { const int d = e / CVS, k = e % CVS;
            WTa[e] = (bf16)(k < 80 ? f2bf(INP(c, I_B_W_A)[(size_t)nb * 6400 + k * 80 + d]) : 0u);
            WTx[e] = (bf16)(k < 80 ? f2bf(INP(c, I_B_W_X)[(size_t)nb * 6400 + k * 80 + d]) : 0u); }
        for (int e = tid; e < 64 * CVS; e += NTHR) cvb[e] = 0;
        if (tid < 80) {
            const int cc = ch0 + tid;
#pragma unroll
            for (int j = 0; j < 4; ++j) cst[j * 80 + tid] = INP(c, I_B_CONV_W)[j * 1280 + cc];
            cst[320 + tid] = INP(c, I_B_CONV_B)[cc]; cst[400 + tid] = INP(c, I_B_B_A)[cc]; cst[480 + tid] = INP(c, I_B_B_X)[cc];
            cst[560 + tid] = log1pf(expf(-INP(c, I_B_LAMBDA)[cc]));
        }
        float carry[10];
#pragma unroll
        for (int q = 0; q < 10; ++q) carry[q] = 0.f;
        v4u ureg[2], greg[2];
        auto issue_loads = [&](int chunk) {
#pragma unroll
            for (int q = 0; q < 2; ++q) { const int e = tid + NTHR * q;
                ureg[q] = (v4u){0u, 0u, 0u, 0u}; greg[q] = (v4u){0u, 0u, 0u, 0u};
                if (e < 670) { const int i = e / 10, cch = e % 10; const int sp = chunk * 64 - 3 + i;
                    if (sp >= 0) ureg[q] = *(const v4u*)(GU + (size_t)(b * 2048 + sp) * 2560 + 1280 + ch0 + cch * 8); }
                if (e < 640) { const int i = e / 10, cch = e % 10;
                    greg[q] = *(const v4u*)(GU + (size_t)(b * 2048 + chunk * 64 + i) * 2560 + ch0 + cch * 8); } }
        };
        issue_loads(0);
#pragma unroll 1
        for (int chunk = 0; chunk < 32; ++chunk) {
            const int t0 = b * 2048 + chunk * 64;
#pragma unroll
            for (int q = 0; q < 2; ++q) { const int e = tid + NTHR * q;
                if (e < 670) { const int i = e / 10, cch = e % 10; LAS float* d = uT + i * 80 + cch * 8;
                    *(LAS f32x4*)d = (f32x4){bflo(ureg[q].x), bfhi(ureg[q].x), bflo(ureg[q].y), bfhi(ureg[q].y)};
                    *(LAS f32x4*)(d + 4) = (f32x4){bflo(ureg[q].z), bfhi(ureg[q].z), bflo(ureg[q].w), bfhi(ureg[q].w)}; }
                if (e < 640) { const int i = e / 10, cch = e % 10; LAS unsigned* d = (LAS unsigned*)(gT + i * 82 + cch * 8);
                    d[0] = greg[q].x; d[1] = greg[q].y; d[2] = greg[q].z; d[3] = greg[q].w; } }
            __syncthreads();
            if (chunk + 1 < 32) issue_loads(chunk + 1);
            for (int e = tid; e < 5120; e += NTHR) { const int t = e / 80, cc = e % 80;
                float s = cst[320 + cc];
#pragma unroll
                for (int j = 0; j < 4; ++j) s += uT[(t + j) * 80 + cc] * cst[j * 80 + cc];
                cvb[t * CVS + cc] = (bf16)f2bf(s); }
            __syncthreads();
            {
                const int tq = w & 3, nt0 = (w >> 2) ? 3 : 0, nt1 = (w >> 2) ? 5 : 3, l15 = lane & 15, g4 = lane >> 4;
                bf16x8 Af[3];
#pragma unroll
                for (int s3 = 0; s3 < 3; ++s3) Af[s3] = *(const LAS bf16x8*)(cvb + (16 * tq + l15) * CVS + 32 * s3 + 8 * g4);
#pragma unroll
                for (int q = 0; q < 3; ++q) { const int nt = nt0 + q;
                    if (nt < nt1) {
                        f32x4 accA = {0.f, 0.f, 0.f, 0.f}, accX = {0.f, 0.f, 0.f, 0.f};
#pragma unroll
                        for (int s3 = 0; s3 < 3; ++s3) {
                            const bf16x8 Ba = *(const LAS bf16x8*)(WTa + (16 * nt + l15) * CVS + 32 * s3 + 8 * g4), Bx = *(const LAS bf16x8*)(WTx + (16 * nt + l15) * CVS + 32 * s3 + 8 * g4);
                            accA = __builtin_amdgcn_mfma_f32_16x16x32_bf16(Af[s3], Ba, accA, 0, 0, 0); accX = __builtin_amdgcn_mfma_f32_16x16x32_bf16(Af[s3], Bx, accX, 0, 0, 0); }
                        const int cc = 16 * nt + l15; const float ba = cst[400 + cc], bx = cst[480 + cc], sp = cst[560 + cc], cb = cst[320 + cc];
                        const float cw0 = cst[cc], cw1 = cst[80 + cc], cw2 = cst[160 + cc], cw3 = cst[240 + cc];
#pragma unroll
                        for (int r4 = 0; r4 < 4; ++r4) { const int t = 16 * tq + 4 * g4 + r4;
                            const float cvf = cb + uT[t * 80 + cc] * cw0 + uT[(t + 1) * 80 + cc] * cw1 + uT[(t + 2) * 80 + cc] * cw2 + uT[(t + 3) * 80 + cc] * cw3;
                            const float r = sigmoidf_(accA[r4] + ba), ig = sigmoidf_(accX[r4] + bx);
                            const float log_a = -8.0f * r * sp; const float a = __expf(log_a);
                            const float bb = __builtin_amdgcn_sqrtf(neg_expm1_small(2.0f * log_a)) * (ig * cvf);
                            a_s[t * 81 + cc] = a; b_s[t * 81 + cc] = bb; }
                    } }
            }
            __syncthreads();
            {
                LAS bf16* yT = (LAS bf16*)uT;
#pragma unroll
                for (int q = 0; q < 10; ++q) { const int cc = w + 8 * q;
                    float a = a_s[lane * 81 + cc], bq = b_s[lane * 81 + cc];
#define RG_STEP(D) { const float ap = __builtin_bit_cast(float, __builtin_amdgcn_update_dpp(0x3f800000, __builtin_bit_cast(int, a), 0x110 + D, 0xf, 0xf, false)); \
                     const float bp = __builtin_bit_cast(float, __builtin_amdgcn_update_dpp(0, __builtin_bit_cast(int, bq), 0x110 + D, 0xf, 0xf, false)); bq = a * bp + bq; a = a * ap; }
                    RG_STEP(1) RG_STEP(2) RG_STEP(4) RG_STEP(8)
#undef RG_STEP
                    { const float A0 = __builtin_bit_cast(float, __builtin_amdgcn_readlane(__builtin_bit_cast(int, a), 15)), B0 = __builtin_bit_cast(float, __builtin_amdgcn_readlane(__builtin_bit_cast(int, bq), 15));
                      const float A1 = __builtin_bit_cast(float, __builtin_amdgcn_readlane(__builtin_bit_cast(int, a), 31)), B1 = __builtin_bit_cast(float, __builtin_amdgcn_readlane(__builtin_bit_cast(int, bq), 31));
                      const float A2 = __builtin_bit_cast(float, __builtin_amdgcn_readlane(__builtin_bit_cast(int, a), 47)), B2 = __builtin_bit_cast(float, __builtin_amdgcn_readlane(__builtin_bit_cast(int, bq), 47));
                      const float C2a = A0 * A1, C2b = A1 * B0 + B1, C3a = C2a * A2, C3b = A2 * C2b + B2;
                      const int row = lane >> 4;
                      const float ca = row == 0 ? 1.0f : (row == 1 ? A0 : (row == 2 ? C2a : C3a)), cb = row == 0 ? 0.0f : (row == 1 ? B0 : (row == 2 ? C2b : C3b));
                      bq = a * cb + bq; a = a * ca; }
                    const float hval = a * carry[q] + bq;
                    carry[q] = __builtin_bit_cast(float, __builtin_amdgcn_readlane(__builtin_bit_cast(int, hval), 63));
                    yT[lane * 82 + cc] = (bf16)f2bf(bf2f(gT[lane * 82 + cc]) * hval); }
            }
            __syncthreads();
            for (int e = tid; e < 2560; e += NTHR) { const int row = e / 40, dw = e % 40;
                ((unsigned*)(Y + (size_t)(t0 + row) * 1280 + ch0))[dw] = ((const LAS unsigned*)uT)[row * 41 + dw]; }
            __syncthreads();
        }
    }
}

template <int OFF0, int OFF1>
__device__ __forceinline__ void tr_read2(unsigned a, v2u& r0, v2u& r1) {
    asm volatile("ds_read_b64_tr_b16 %0, %2 offset:%3\n\tds_read_b64_tr_b16 %1, %2 offset:%4\n\ts_waitcnt lgkmcnt(0)" : "=&v"(r0), "=&v"(r1) : "v"(a), "n"(OFF0), "n"(OFF1) : "memory");
}
template <int B0, int RSb>
__device__ __forceinline__ void tr_read8(unsigned a, v2u (&r)[8]) {
    asm volatile("ds_read_b64_tr_b16 %0, %8 offset:%9\n\tds_read_b64_tr_b16 %1, %8 offset:%10\n\tds_read_b64_tr_b16 %2, %8 offset:%11\n\tds_read_b64_tr_b16 %3, %8 offset:%12\n\t"
                 "ds_read_b64_tr_b16 %4, %8 offset:%13\n\tds_read_b64_tr_b16 %5, %8 offset:%14\n\tds_read_b64_tr_b16 %6, %8 offset:%15\n\tds_read_b64_tr_b16 %7, %8 offset:%16\n\ts_waitcnt lgkmcnt(0)"
                 : "=&v"(r[0]), "=&v"(r[1]), "=&v"(r[2]), "=&v"(r[3]), "=&v"(r[4]), "=&v"(r[5]), "=&v"(r[6]), "=&v"(r[7])
                 : "v"(a), "n"(B0), "n"(B0 + 4 * RSb), "n"(B0 + 16 * RSb), "n"(B0 + 20 * RSb), "n"(B0 + 32 * RSb), "n"(B0 + 36 * RSb), "n"(B0 + 48 * RSb), "n"(B0 + 52 * RSb) : "memory");
}
__device__ __forceinline__ void phase_ret_core(const Ctx& c) {
    const bf16* Qg = (const bf16*)(c.ws + WS_M + M_Q); const bf16* Kg = (const bf16*)(c.ws + WS_M + M_K); bf16* Vg = (bf16*)(c.ws + WS_M + M_V);
    float* STAT = (float*)(c.ws + WS_M + M_STAT);
    constexpr int RS = 528, SS = 144, QS_OFF = 0, KS_OFF = 64 * RS, VS_OFF = 2 * 64 * RS, SS_OFF = 3 * 64 * RS;
    LAS unsigned char* L = c.lds; const unsigned lbase = (unsigned)(size_t)c.lds;
    const int tid0 = c.tid, w = c.wave;
    for (int u = c.bid; u < 256; u += c.G) {
        const int b = u >> 3, hh = (u >> 1) & 3, eh = u & 1;
        const float gam = 1.0f - exp2f(-5.0f - (float)hh); const float lg0 = log2f(gam);
        f32x16 R[8];
#pragma unroll
        for (int dt = 0; dt < 8; ++dt)
#pragma unroll
            for (int i = 0; i < 16; ++i) R[dt][i] = 0.f;
        const float cdec = exp2f(lg0 * 64.0f);
#pragma unroll 1
        for (int chunk = 0; chunk < 32; ++chunk) {
            const int t0 = b * 2048 + chunk * 64;
            float lg = lg0; int tid = tid0; asm volatile("" : "+v"(lg), "+v"(tid));
            const int lane = tid & 63, n = lane & 31, h = lane >> 5, hl = h;
            const int blk = (lane >> 4) & 1, q4 = (lane & 15) >> 2, p4 = lane & 3;
            const unsigned trbK = lbase + (8 * h + q4) * RS + (16 * blk + 4 * p4) * 2;
            const unsigned trbV = trbK + VS_OFF + 64 * w;
            __syncthreads();
#pragma unroll
            for (int i = 0; i < 4; ++i) { const int e = tid + NTHR * i, row = e >> 5, ch = e & 31;
                *(LAS v4u*)(L + QS_OFF + row * RS + ch * 16) = *(const v4u*)(Qg + (size_t)(t0 + row) * 1024 + hh * 256 + ch * 8);
                *(LAS v4u*)(L + KS_OFF + row * RS + ch * 16) = *(const v4u*)(Kg + (size_t)(t0 + row) * 1024 + hh * 256 + ch * 8); }
            asm volatile("" ::: "memory");
#pragma unroll
            for (int i = 0; i < 4; ++i) { const int e = tid + NTHR * i, row = e >> 5, ch = e & 31;
                *(LAS v4u*)(L + VS_OFF + row * RS + ch * 16) = *(const v4u*)(Vg + (size_t)(t0 + row) * 2048 + hh * 512 + eh * 256 + ch * 8); }
            __syncthreads();
            {
                const int i16 = w >> 1, l15 = lane & 15, g4 = lane >> 4; const int l15d = l15, g4d = g4;
                bf16x8 Af[8];
#pragma unroll
                for (int s = 0; s < 8; ++s) Af[s] = *(const LAS bf16x8*)(L + QS_OFF + (16 * i16 + l15) * RS + (32 * s + 8 * g4) * 2);
#pragma unroll
                for (int jj = 0; jj < 2; ++jj) { const int j16 = 2 * (w & 1) + jj;
                    f32x4 acc = {0.f, 0.f, 0.f, 0.f};
                    if (j16 <= i16) {
#pragma unroll
                        for (int s = 0; s < 8; ++s) { const bf16x8 Bf = *(const LAS bf16x8*)(L + KS_OFF + (16 * j16 + l15) * RS + (32 * s + 8 * g4) * 2);
                            acc = __builtin_amdgcn_mfma_f32_16x16x32_bf16(Af[s], Bf, acc, 0, 0, 0); }
                    }
                    const int ja = 16 * j16 + l15, jad = 16 * j16 + l15d;
#pragma unroll
                    for (int r = 0; r < 4; ++r) { const int ia = 16 * i16 + 4 * g4 + r, iad = 16 * i16 + 4 * g4d + r; const float dec = (iad >= jad) ? __builtin_amdgcn_exp2f(lg * (float)(iad - jad)) : 0.f;
                        *(LAS bf16*)(L + SS_OFF + ia * SS + ja * 2) = (bf16)f2bf(acc[r] * dec); }
                }
            }
            __syncthreads();
            bf16x8 Vf[4];
            { v2u tr[8]; tr_read8<0, RS>(trbV, tr);
#pragma unroll
              for (int ks = 0; ks < 4; ++ks) { v4u wv; wv.x = tr[2 * ks].x; wv.y = tr[2 * ks].y; wv.z = tr[2 * ks + 1].x; wv.w = tr[2 * ks + 1].y; Vf[ks] = __builtin_bit_cast(bf16x8, wv); } }
            {
                f32x16 Oa[2];
#pragma unroll
                for (int it = 0; it < 2; ++it)
#pragma unroll
                    for (int i = 0; i < 16; ++i) Oa[it][i] = 0.f;
#pragma unroll
                for (int dt = 0; dt < 8; ++dt)
#pragma unroll
                    for (int s = 0; s < 2; ++s) {
                        v4u bw; bw.x = pk2(R[dt][8 * s + 0], R[dt][8 * s + 1]); bw.y = pk2(R[dt][8 * s + 2], R[dt][8 * s + 3]); bw.z = pk2(R[dt][8 * s + 4], R[dt][8 * s + 5]); bw.w = pk2(R[dt][8 * s + 6], R[dt][8 * s + 7]);
#pragma unroll
                        for (int it = 0; it < 2; ++it) {
                            const LAS unsigned char* qrow = L + QS_OFF + (32 * it + n) * RS;
                            const v2u lo = *(const LAS v2u*)(qrow + (32 * dt + 16 * s + 4 * h) * 2), hi = *(const LAS v2u*)(qrow + (32 * dt + 16 * s + 8 + 4 * h) * 2);
                            v4u aw; aw.x = lo.x; aw.y = lo.y; aw.z = hi.x; aw.w = hi.y;
                            Oa[it] = __builtin_amdgcn_mfma_f32_32x32x16_bf16(__builtin_bit_cast(bf16x8, aw), __builtin_bit_cast(bf16x8, bw), Oa[it], 0, 0, 0);
                        }
                    }
#pragma unroll
                for (int it = 0; it < 2; ++it) {
#pragma unroll
                    for (int i = 0; i < 16; ++i) { const int ia = 32 * it + 8 * (i >> 2) + 4 * h + (i & 3); Oa[it][i] *= __builtin_amdgcn_exp2f(lg * (float)(32 * it + 8 * (i >> 2) + 4 * hl + (i & 3) + 1)); }
#pragma unroll
                    for (int ks = 0; ks < 4; ++ks) if (ks < 2 * (it + 1)) {
                        const bf16x8 Sf = *(const LAS bf16x8*)(L + SS_OFF + (32 * it + n) * SS + (16 * ks + 8 * h) * 2);
                        Oa[it] = __builtin_amdgcn_mfma_f32_32x32x16_bf16(Sf, Vf[ks], Oa[it], 0, 0, 0);
                    }
#pragma unroll
                    for (int i = 0; i < 16; ++i) { const int ia = 32 * it + 8 * (i >> 2) + 4 * h + (i & 3);
                        *(LAS bf16*)(L + VS_OFF + ia * RS + (32 * w + n) * 2) = (bf16)f2bf(Oa[it][i]); }
                }
            }
            bf16x8 Vs2[4];
#pragma unroll
            for (int ks = 0; ks < 4; ++ks) { const v4u wv = __builtin_bit_cast(v4u, Vf[ks]); float f[8] = {bflo(wv.x), bfhi(wv.x), bflo(wv.y), bfhi(wv.y), bflo(wv.z), bfhi(wv.z), bflo(wv.w), bfhi(wv.w)};
#pragma unroll
                for (int j = 0; j < 8; ++j) { const int key = 16 * ks + 8 * hl + j; f[j] *= __builtin_amdgcn_exp2f(lg * (float)(63 - key)); }
                v4u o; o.x = pk2(f[0], f[1]); o.y = pk2(f[2], f[3]); o.z = pk2(f[4], f[5]); o.w = pk2(f[6], f[7]); Vs2[ks] = __builtin_bit_cast(bf16x8, o); }
#define RC_DT(dt) { _Pragma("unroll") for (int i = 0; i < 16; ++i) R[dt][i] *= cdec; v2u tr[8]; tr_read8<KS_OFF + 64 * (dt), RS>(trbK, tr); \
                _Pragma("unroll") for (int ks = 0; ks < 4; ++ks) { v4u aw; aw.x = tr[2 * ks].x; aw.y = tr[2 * ks].y; aw.z = tr[2 * ks + 1].x; aw.w = tr[2 * ks + 1].y; \
                    R[dt] = __builtin_amdgcn_mfma_f32_32x32x16_bf16(__builtin_bit_cast(bf16x8, aw), Vs2[ks], R[dt], 0, 0, 0); } }
            RC_DT(0) RC_DT(1) RC_DT(2) RC_DT(3) RC_DT(4) RC_DT(5) RC_DT(6) RC_DT(7)
#undef RC_DT
            __syncthreads();
#pragma unroll
            for (int i = 0; i < 4; ++i) { const int e = tid + NTHR * i, row = e >> 5, ch = e & 31;
                const v4u ov = *(const LAS v4u*)(L + VS_OFF + row * RS + ch * 16);
                *(v4u*)(Vg + (size_t)(t0 + row) * 2048 + hh * 512 + eh * 256 + ch * 8) = ov;
                const float f[8] = {bflo(ov.x), bfhi(ov.x), bflo(ov.y), bfhi(ov.y), bflo(ov.z), bfhi(ov.z), bflo(ov.w), bfhi(ov.w)};
                float s = 0.f, s2 = 0.f;
#pragma unroll
                for (int j = 0; j < 8; ++j) { s += f[j]; s2 += f[j] * f[j]; }
#pragma unroll
                for (int o = 1; o < 32; o <<= 1) { s += __shfl_xor(s, o); s2 += __shfl_xor(s2, o); }
                if ((tid & 31) == 0) { f32x2 st = {s, s2}; *(f32x2*)(STAT + (size_t)(t0 + row) * 16 + hh * 4 + eh * 2) = st; }
            }
        }
    }
}

__host__ __device__ __forceinline__ bool slot_active(int kind, int s) {
    if (s == 2) return kind != 1;
    if (s == 3 || s == 4) return kind == 0;
    if (s == 10) return false;
    return true;
}

#ifndef MK_EN
#define MK_EN 0xffffffffu
#endif
#define EN(b) ((MK_EN >> (b)) & 1u)
template <int PROBE>
__global__ void __launch_bounds__(NTHR, 2) mk_fwd_t(Params p) {
    extern __shared__ __attribute__((aligned(16))) unsigned char lds_raw[];
    Ctx c;
    c.lds = (LAS unsigned char*)lds_raw; c.tid = threadIdx.x; c.lane = c.tid & 63; c.wave = __builtin_amdgcn_readfirstlane(c.tid >> 6);
    c.bid = blockIdx.x; c.G = gridDim.x; c.in = (InTab)(unsigned long)__builtin_amdgcn_kernarg_segment_ptr(); c.out = p.out; c.ws = p.ws;
    volatile LAS unsigned* MISC = (volatile LAS unsigned*)(c.lds + MISC_OFF);
    for (int u = c.tid; u < (LDS_BYTES - LDSCTL_OFF) / 4; u += NTHR) ((LAS unsigned*)(c.lds + LDSCTL_OFF))[u] = 0u;
    __syncthreads();
    const bool one = (p.flags & 1) != 0;
    XcdBarrier bar; bar.bar = (unsigned*)(p.ws + WS_CTL) + CW_BAR; bar.x = 0; bar.st = MISC + 8;
    if (one) bar = xcd_barrier_post((unsigned*)(p.ws + WS_CTL) + CW_BAR, MISC + 8);
    const int lo = p.ph_lo, hi = p.ph_hi;
#define IN(k) (lo <= (k) && (k) < hi)
#if MK_PROBE
#define STAMP(k) do { if (blockIdx.x == 0 && threadIdx.x == 0) ((unsigned long long*)(p.ws + WS_CTL + 65536))[k] = __builtin_amdgcn_s_memrealtime(); } while (0)
#else
#define STAMP(k) do {} while (0)
#endif
#define LCTX() Ctx cl = c; { unsigned long k_ = (unsigned long)__builtin_amdgcn_kernarg_segment_ptr(); unsigned long w_ = (unsigned long)p.ws, o_ = (unsigned long)p.out; int t_ = threadIdx.x; asm volatile("" : "+s"(k_), "+s"(w_), "+s"(o_), "+v"(t_)); cl.tid = t_; cl.lane = t_ & 63; cl.wave = __builtin_amdgcn_readfirstlane(t_ >> 6); cl.in = (InTab)k_; cl.ws = (unsigned char*)(GAS unsigned char*)w_; cl.out = (float*)(GAS float*)o_; } unsigned char* ws = cl.ws; (void)ws
#define SEAM(k) do { if (one && IN(k) && (k) + 1 < hi) xcd_barrier(bar); } while (0)
    STAMP(0);
    if (EN(0) && IN(0)) { LCTX(); phase_prologue(cl); }
    SEAM(0);
#pragma unroll 1
    for (int layer = 0; layer < 4; ++layer) {
        const int kind = layer % 3, j = layer / 3, base = 1 + layer * NPH_LAYER;
        const size_t xin_off = (layer & 1) ? WS_XB1 : WS_XB0, xnext_off = (layer & 1) ? WS_XB0 : WS_XB1;
#define xin ((const bf16*)(ws + xin_off))
#define xnext ((bf16*)(ws + xnext_off))
        STAMP(base + 0);
        if (IN(base + 0)) { LCTX();
            if (EN(1) && kind == 0) { bf16* RAWb = (bf16*)(ws + WS_M + M_RAW); EpiBf16R<0> E{RAWb, RAWb, RAWb, 512, 512, 512, 1 << 30, 1 << 30};
                run_gemm(cl, xin, (const bf16*)(ws + WS_WAIN) + (size_t)j * 512 * 1024, 512, 1024, E); }
            else if (EN(2) && kind == 1) { bf16* GU = (bf16*)(ws + WS_M + M_GU); EpiBf16R<1> E{GU, GU + 1280, GU + 1280, 2560, 2560, 2560, 1280, 1 << 30};
                run_gemm(cl, xin, (const bf16*)(ws + WS_WBIN), 2560, 1024, E); }
            else if (EN(3) && kind == 2) { EpiRetIn E{(bf16*)(ws + WS_M + M_Q), (bf16*)(ws + WS_M + M_K), (bf16*)(ws + WS_M + M_V), (const float*)(ws + WS_ROT), (const float*)(ws + WS_ROT) + 2048 * 128};
                run_gemm(cl, xin, (const bf16*)(ws + WS_WCIN), 4096, 1024, E); }
        }
        SEAM(base + 0);
        STAMP(base + 1);
        if (IN(base + 1)) { LCTX();
            if (EN(4) && kind == 0) phase_dsa_norm(cl, j);
            else if (EN(5) && kind == 1) phase_rglru(cl);
            else if (EN(6) && kind == 2) phase_ret_core(cl);
        }
        SEAM(base + 1);
        STAMP(base + 2);
        if (IN(base + 2) && kind != 1) { LCTX();
            if (EN(7) && kind == 0) { EpiBf16R<0> E{(bf16*)(ws + WS_M + M_QLAT), (bf16*)(ws + WS_M + M_QIDX), (bf16*)(ws + WS_M + M_QIDX), 2048, 512, 512, 2048, 1 << 30};
                run_gemm(cl, (const bf16*)(ws + WS_M + M_CQ), (const bf16*)(ws + WS_WAQ + j * WAQ_STRIDE), 2560, 256, E); }
            else if (EN(8) && kind == 2) { EpiRetGate E{(bf16*)(ws + WS_M + M_V), (const float*)(ws + WS_M + M_STAT)};
                run_gemm(cl, xin, (const bf16*)(ws + WS_WCIN) + (size_t)4096 * 1024, 2048, 1024, E); }
        }
        if (kind != 1) SEAM(base + 2);
        STAMP(base + 3);
        if (EN(9) && IN(base + 3) && kind == 0) { LCTX(); phase_dsa_index(cl); }
        if (kind == 0) SEAM(base + 3);
        STAMP(base + 4);
        if (EN(10) && IN(base + 4) && kind == 0) { LCTX(); phase_dsa_attn(cl); }
        if (kind == 0) SEAM(base + 4);
        STAMP(base + 5);
        if (EN(11) && IN(base + 5)) { LCTX();
            const bf16* A = (const bf16*)(ws + WS_M + (kind == 0 ? M_QLAT : (kind == 1 ? M_Y : M_V)));
            const bf16* Bt = kind == 0 ? (const bf16*)(ws + WS_WAOV) + (size_t)j * 1024 * 2048 : (kind == 1 ? (const bf16*)(ws + WS_WBO) : (const bf16*)(ws + WS_WCO));
            const int K = kind == 1 ? 1280 : 2048;
            EpiResid E{cl.out, ALPHA_DN, xin};
            run_gemm(cl, A, Bt, 1024, K, E);
        }
        SEAM(base + 5);
        STAMP(base + 6);
        if (EN(12) && IN(base + 6)) { LCTX(); phase_ln1(cl, layer); }
        SEAM(base + 6);
        STAMP(base + 7);
        if (EN(13) && IN(base + 7)) { LCTX(); EpiF32T E{(bf16*)(ws + WS_M + M_SC)};
            run_gemm(cl, xin, (const bf16*)(ws + WS_WPEER) + (size_t)layer * 2048 * 1024, 2048, 1024, E);
            bf16* PP = (bf16*)(ws + WS_PP); EpiBf16R<0> E2{PP, PP, PP, 1024, 1024, 1024, 1 << 30, 1 << 30};
            run_gemm(cl, (const bf16*)(ws + WS_M + M_PB), (const bf16*)(ws + WS_WPLEP) + (size_t)layer * 1024 * 256, 1024, 256, E2); }
        SEAM(base + 7);
        STAMP(base + 8);
        if (EN(14) && IN(base + 8)) { LCTX(); phase_peer_topk(cl); }
        SEAM(base + 8);
        STAMP(base + 9);
        if (EN(15) && IN(base + 9)) { LCTX(); phase_peer_gather(cl, layer, [&]() {}); }
        SEAM(base + 9);
        STAMP(base + 11);
        if (EN(17) && IN(base + 11)) { LCTX(); EpiPle E{xin, (const bf16*)(ws + WS_PP), xnext, INP(cl, I_PLE_BG) + layer * DM, layer == 3 ? cl.out : nullptr};
            run_gemm(cl, xin, (const bf16*)(ws + WS_WPLEG) + (size_t)layer * 1024 * 1024, 1024, 1024, E); }
        SEAM(base + 11);
    }
#if MK_PROBE
    xcd_barrier(bar);
    STAMP(N_PHASES);
    xcd_barrier(bar);
    {
        const unsigned long long* TS = (const unsigned long long*)(p.ws + WS_CTL + 65536);
        float tA = 0.f, tC = 0.f;
        for (int k = 0; k < N_PHASES; ++k) {
            int type = 0;
            if (k > 0) { const int layer = (k - 1) / NPH_LAYER, s = (k - 1) % NPH_LAYER, kind = layer % 3;
                if (!slot_active(kind, s)) continue;
                type = s == 0 ? 1 + kind : s == 1 ? 4 + kind : s == 2 ? (kind == 0 ? 7 : 8) : s == 3 ? 9 : s == 4 ? 10 : 6 + s; }
            const float us = (float)(TS[k + 1] - TS[k]) * 0.01f;
            if ((MK_PROBE_A >> type) & 1u) tA += us;
            if ((MK_PROBE_C >> type) & 1u) tC += us;
        }
        for (size_t i = (size_t)blockIdx.x * NTHR + threadIdx.x; i < (size_t)T_TOK * DM; i += (size_t)gridDim.x * NTHR) p.out[i] = (i == 0) ? 100.f * tA : tC;
    }
#endif
#undef IN
#undef SEAM
#undef xin
#undef xnext
#undef LCTX
}

#if MK_CHECK
#include "CHECKS_PLACEHOLDER"
#endif

#define mk_fwd mk_fwd_t<0>
extern "C" void kernel_launch(void* const* d_in, const int* in_sizes, int n_in, void* d_out, int out_size, void* d_ws, size_t ws_size, hipStream_t stream) {
    static int grid = 0;
    if (grid == 0) {
        if (n_in != N_IN || out_size != T_TOK * DM || ws_size < WS_END) { fprintf(stderr, "kernel_launch: unexpected shapes (n_in %d out %d ws %zu need %zu)\n", n_in, out_size, ws_size, (size_t)WS_END); grid = -1; return; }
        int dev = 0, cus = 0, per_cu = 0;
        if (hipGetDevice(&dev) != hipSuccess || hipDeviceGetAttribute(&cus, hipDeviceAttributeMultiprocessorCount, dev) != hipSuccess) { grid = -1; return; }
        if (hipFuncSetAttribute((const void*)mk_fwd, hipFuncAttributeMaxDynamicSharedMemorySize, LDS_BYTES) != hipSuccess) { fprintf(stderr, "hipFuncSetAttribute failed\n"); grid = -1; return; }
        if (hipOccupancyMaxActiveBlocksPerMultiprocessor(&per_cu, (const void*)mk_fwd, NTHR, LDS_BYTES) != hipSuccess || per_cu < 1) { fprintf(stderr, "occupancy query: %d\n", per_cu); }
        (void)hipGetLastError();
        grid = cus;
    }
    if (grid < 0) return;
    (void)hipMemsetAsync((char*)d_ws + WS_CTL, 0, CTL_BYTES, stream);
    Params p{};
    for (int i = 0; i < N_IN; ++i) p.in[i] = (const float*)d_in[i];
    p.out = (float*)d_out; p.ws = (unsigned char*)d_ws; p.pad = 0;
#if MK_ONE_LAUNCH
#if MK_REPEAT_K >= 0
    p.ph_lo = 0; p.ph_hi = MK_REPEAT_K + 1; p.flags = 1 | MK_PROBE_FLAGS;
    (void)hipFuncSetAttribute((const void*)mk_fwd_t<MK_PROBE_KERNEL>, hipFuncAttributeMaxDynamicSharedMemorySize, LDS_BYTES);
    hipLaunchKernelGGL(mk_fwd_t<MK_PROBE_KERNEL>, dim3(grid), dim3(NTHR), LDS_BYTES, stream, p);
    (void)hipMemsetAsync((char*)d_ws + WS_CTL, 0, CTL_BYTES, stream);
#endif
    p.ph_lo = 0; p.ph_hi = N_PHASES; p.flags = 1;
    hipLaunchKernelGGL(mk_fwd, dim3(grid), dim3(NTHR), LDS_BYTES, stream, p);
#else
    p.flags = 0;
    for (int ph = 0; ph < N_PHASES; ++ph) {
        if (ph > 0) { const int layer = (ph - 1) / NPH_LAYER, s = (ph - 1) % NPH_LAYER; if (!slot_active(layer % 3, s)) continue; }
        p.ph_lo = ph; p.ph_hi = ph + 1;
#if MK_CHECK
        check_pre(ph, p, grid, stream);
#endif
        hipLaunchKernelGGL(mk_fwd, dim3(grid), dim3(NTHR), LDS_BYTES, stream, p);
#if MK_CHECK
        check_post(ph, p, grid, stream);
#endif
    }
#if MK_CHECK
    check_report(p, stream);
#endif
#endif
}
```

```cpp
#define MK_CHECK 0
#define MK_ONE_LAUNCH 1
#include <cstdio>
#include <cmath>
#include <type_traits>
#include <hip/hip_runtime.h>
namespace pg8 {
#define PG8_LAS __attribute__((address_space(3)))
typedef unsigned short bf16_t;
typedef short bf16x8 __attribute__((ext_vector_type(8)));
typedef float f32x4 __attribute__((ext_vector_type(4)));
typedef unsigned u32x4 __attribute__((ext_vector_type(4)));
constexpr int BM = 256, BK = 64, HALF = 128, HTB = HALF * BK * 2  , STAGE_BYTES = 8 * HTB, NXCD = 8, WGM = 8;

__host__ __device__ __forceinline__ int lds_byte(int r, int c) { const int st = (r >> 4) * 2 + (c >> 5), rr = r & 15, cc = c & 31, ob = rr * 64 + cc * 2; return st * 1024 + (ob ^ (((ob >> 9) & 1) << 5)); }
__host__ __device__ __forceinline__ void stage_rc(int b, int& R, int& C) { const int st = b / 1024, sb = b % 1024, swz = sb ^ (((sb >> 9) & 1) << 5); R = (st >> 1) * 16 + swz / 64; C = (st & 1) * 32 + (swz % 64) / 2; }
__host__ __device__ __forceinline__ int perm32(int rho) { const int n = rho >> 4, i = rho & 15; return 8 * (i >> 2) + 4 * n + (i & 3); }

struct Unit { int pm, pn; };
struct Gemm { const bf16_t* A; const bf16_t* Bt; int M, N, K; };

struct StaticOrder {
    int nM, nN, nwg, G, c;
    __host__ __device__ void init(int M, int N, int G_, int c_) { nM = M / BM; nN = N / BM; nwg = nM * nN; G = G_; c = c_; }
    __host__ __device__ bool next(int i, Unit& u) const {
        const long L = (long)i * G + c; if (L >= nwg) return false;
        int wgid = (int)L; { const int q = nwg / NXCD, r = nwg % NXCD, xcd = wgid % NXCD, off = wgid / NXCD; wgid = (xcd < r ? xcd * (q + 1) : r * (q + 1) + (xcd - r) * q) + off; }
        const int nig = WGM * nN, gid = wgid / nig, fm = gid * WGM, gsz = (nM - fm) < WGM ? (nM - fm) : WGM;
        u.pm = fm + ((wgid % nig) % gsz); u.pn = (wgid % nig) / gsz; return true;
    }
    __device__ __forceinline__ void a_ready(const Unit&) const {}
    __device__ __forceinline__ void done(const Unit&) const {}
};
struct CountedOrder : StaticOrder {
    const unsigned* ready; unsigned need; unsigned* tmo;
    __device__ __forceinline__ void a_ready(const Unit& u) const {
        if (threadIdx.x < 64) {
            const unsigned long long t0 = __builtin_amdgcn_s_memrealtime(); unsigned polls = 0;
            while ((unsigned)__builtin_amdgcn_readfirstlane(__hip_atomic_load(ready + 64 * u.pm, __ATOMIC_RELAXED, __HIP_MEMORY_SCOPE_AGENT)) < need) {
                if ((++polls & 255u) == 0u && __builtin_amdgcn_readfirstlane(__hip_atomic_load(tmo, __ATOMIC_RELAXED, __HIP_MEMORY_SCOPE_AGENT)) != 0u) break;
                if (__builtin_amdgcn_s_memrealtime() - t0 > 2000000ull) {
                    if (threadIdx.x == 0) { unsigned expect = 0u; __hip_atomic_compare_exchange_strong(tmo + 1, &expect, 0x600u | (unsigned)(u.pm & 0xff), __ATOMIC_RELAXED, __ATOMIC_RELAXED, __HIP_MEMORY_SCOPE_AGENT); __hip_atomic_store(tmo, 1u, __ATOMIC_RELAXED, __HIP_MEMORY_SCOPE_AGENT); }
                    break; }
                __builtin_amdgcn_s_sleep(2); }
            __builtin_amdgcn_fence(__ATOMIC_ACQUIRE, "agent");
            asm volatile("s_waitcnt vmcnt(0)" ::: "memory");
        }
#if !defined(BROKEN_HOOK_NO_BARRIER)
        asm volatile("" ::: "memory"); __builtin_amdgcn_s_barrier(); asm volatile("" ::: "memory");
#endif
    }
};

__device__ __forceinline__ unsigned cvt_pk_bf16(float lo, float hi) { unsigned r; asm volatile("v_cvt_pk_bf16_f32 %0, %1, %2" : "=v"(r) : "v"(lo), "v"(hi)); return r; }
typedef float f32x2 __attribute__((ext_vector_type(2)));
__device__ __forceinline__ f32x2 gelu_pk(f32x2 v) {
    const f32x2 av = __builtin_elementwise_abs(v), d = av * 0.2316418882f + 1.0f;
    f32x2 t; t.x = __builtin_amdgcn_rcpf(d.x); t.y = __builtin_amdgcn_rcpf(d.y);
    f32x2 q = t * 0.5307027145f + (-0.7265760135f); q = q * t + 0.7107068705f; q = q * t + (-0.142248368f); q = q * t + 0.127414796f; q = q * t;
    const f32x2 s = (v * v) * (-0.72134752044f);
    f32x2 e; e.x = __builtin_amdgcn_exp2f(s.x); e.y = __builtin_amdgcn_exp2f(s.y);
    const f32x2 m = v * (q * e), r = v - m;
    f32x2 o; o.x = v.x < 0.f ? m.x : r.x; o.y = v.y < 0.f ? m.y : r.y; return o;
}

struct EpiF32 {
    static constexpr bool PERM = false, AFTER_DRAIN = false;
    float* C; int ldc; const float* bias;
    __device__ __forceinline__ void operator()(const f32x4 (&acc)[2][2][4][2], const Unit& u, int wr, int wc, int fr, int fq) const {
        const int row0 = u.pm * BM + wr * 64 + fr, col0 = u.pn * BM + wc * 32 + 4 * fq;
        f32x4 bv[2][2];
#pragma unroll
        for (int bj = 0; bj < 2; ++bj)
#pragma unroll
            for (int n = 0; n < 2; ++n) bv[bj][n] = bias ? *(const f32x4*)(bias + col0 + bj * HALF + n * 16) : (f32x4){0.f, 0.f, 0.f, 0.f};
#pragma unroll
        for (int ai = 0; ai < 2; ++ai)
#pragma unroll
            for (int m = 0; m < 4; ++m) { float* rowp = C + (size_t)(row0 + ai * HALF + m * 16) * ldc + col0;
#pragma unroll
                for (int bj = 0; bj < 2; ++bj)
#pragma unroll
                    for (int n = 0; n < 2; ++n) *(f32x4*)(rowp + bj * HALF + n * 16) = acc[ai][bj][m][n] + bv[bj][n]; }
    }
};
template <int ACT  > struct EpiBf16 {
    static constexpr bool PERM = true, AFTER_DRAIN = false;
    bf16_t* O; int ldc; const float* bias; int split_cols; size_t split_stride;
    __device__ __forceinline__ void operator()(const f32x4 (&acc)[2][2][4][2], const Unit& u, int wr, int wc, int fr, int fq) const {
        const int row0 = u.pm * BM + wr * 64 + fr; int colt = u.pn * BM; bf16_t* base = O;
        if (split_cols) { const int t = colt / split_cols; base += (size_t)t * split_stride; colt -= t * split_cols; }
        const int col0 = colt + wc * 32 + 8 * fq, bcol0 = u.pn * BM + wc * 32 + 8 * fq;
        f32x4 bv[2][2];
#pragma unroll
        for (int bj = 0; bj < 2; ++bj)
#pragma unroll
            for (int n = 0; n < 2; ++n) bv[bj][n] = bias ? *(const f32x4*)(bias + bcol0 + bj * HALF + 4 * n) : (f32x4){0.f, 0.f, 0.f, 0.f};
#pragma unroll
        for (int ai = 0; ai < 2; ++ai)
#pragma unroll
            for (int m = 0; m < 4; ++m) { bf16_t* rowp = base + (size_t)(row0 + ai * HALF + m * 16) * ldc + col0;
#pragma unroll
                for (int bj = 0; bj < 2; ++bj) { f32x4 v0 = acc[ai][bj][m][0] + bv[bj][0], v1 = acc[ai][bj][m][1] + bv[bj][1];
                    if (ACT == 1) { f32x2 a = gelu_pk((f32x2){v0[0], v0[1]}), b = gelu_pk((f32x2){v0[2], v0[3]}), c = gelu_pk((f32x2){v1[0], v1[1]}), d = gelu_pk((f32x2){v1[2], v1[3]});
                        v0 = (f32x4){a.x, a.y, b.x, b.y}; v1 = (f32x4){c.x, c.y, d.x, d.y}; }
                    if (ACT == 2) {
#pragma unroll
                        for (int j = 0; j < 4; ++j) { v0[j] = 0.5f * v0[j] * (1.0f + erff(v0[j] * 0.70710678f)); v1[j] = 0.5f * v1[j] * (1.0f + erff(v1[j] * 0.70710678f)); } }
                    u32x4 w; w.x = cvt_pk_bf16(v0[0], v0[1]); w.y = cvt_pk_bf16(v0[2], v0[3]); w.z = cvt_pk_bf16(v1[0], v1[1]); w.w = cvt_pk_bf16(v1[2], v1[3]);
                    *(u32x4*)(rowp + bj * HALF) = w; } }
    }
};

struct PanelStats {
    unsigned* xbuf;
    unsigned* cnt;
    unsigned* tmo;
    int ntn; float eps;
    unsigned code;
    __device__ __forceinline__ bool run(const f32x4 (&v)[2][2][4][2], const Unit& u, int wr, int wc, int fr, int fq, PG8_LAS unsigned char* lds, int wid, int lane) const {
        typedef float f32x2v __attribute__((ext_vector_type(2)));
        PG8_LAS f32x2v* P = (PG8_LAS f32x2v*)lds;
        PG8_LAS f32x2v* S = (PG8_LAS f32x2v*)(lds + 8192);
        PG8_LAS unsigned* flag = (PG8_LAS unsigned*)(lds + 8192 + 2048);
#pragma unroll
        for (int ai = 0; ai < 2; ++ai)
#pragma unroll
            for (int m = 0; m < 4; ++m) {
                float s = 0.f;
#pragma unroll
                for (int bj = 0; bj < 2; ++bj)
#pragma unroll
                    for (int n = 0; n < 2; ++n) { const f32x4 x = v[ai][bj][m][n]; s += (x[0] + x[1]) + (x[2] + x[3]); }
                s += __shfl_xor(s, 16); s += __shfl_xor(s, 32);
                const float mw = s * (1.0f / 64.0f); float q = 0.f;
#pragma unroll
                for (int bj = 0; bj < 2; ++bj)
#pragma unroll
                    for (int n = 0; n < 2; ++n) { const f32x4 d = v[ai][bj][m][n] - mw; q += (d[0] * d[0] + d[1] * d[1]) + (d[2] * d[2] + d[3] * d[3]); }
                q += __shfl_xor(q, 16); q += __shfl_xor(q, 32);
                if (fq == 0) P[(ai * HALF + wr * 64 + m * 16 + fr) * 4 + wc] = (f32x2v){mw, q};
            }
        asm volatile("s_waitcnt lgkmcnt(0)" ::: "memory"); __builtin_amdgcn_s_barrier(); asm volatile("" ::: "memory");
#if defined(BROKEN_NO_WAIT)
        if (blockIdx.x >= 64) { const long long t0 = clock64(); while (clock64() - t0 < 60000) __builtin_amdgcn_s_sleep(8); }
#endif
        const int row = wid * 32 + (lane & 31);
        if (lane < 32) {
            const f32x2v a = P[row * 4 + 0], b = P[row * 4 + 1], c = P[row * 4 + 2], d = P[row * 4 + 3];
            const float mt = (a.x + b.x + c.x + d.x) * 0.25f;
            const float da = a.x - mt, db = b.x - mt, dc = c.x - mt, dd = d.x - mt;
            const float m2 = (a.y + b.y) + (c.y + d.y) + 64.0f * ((da * da + db * db) + (dc * dc + dd * dd));
            unsigned long long* slot = (unsigned long long*)xbuf + ((size_t)(u.pm * BM + row) * 4 + u.pn);
            __hip_atomic_store(slot, ((unsigned long long)__float_as_uint(m2) << 32) | __float_as_uint(mt), __ATOMIC_RELAXED, __HIP_MEMORY_SCOPE_AGENT);
        }
        asm volatile("s_waitcnt vmcnt(0)" ::: "memory");
        if (lane == 0) __hip_atomic_fetch_add(cnt + 64 * u.pm, 1u, __ATOMIC_RELAXED, __HIP_MEMORY_SCOPE_AGENT);
        if (wid == 0) {
            bool dead = false; const unsigned long long t0 = __builtin_amdgcn_s_memrealtime(); const unsigned want = 8u * (unsigned)ntn;
            for (;;) {
#if defined(BROKEN_NO_WAIT)
                break;
#endif
                if ((unsigned)__builtin_amdgcn_readfirstlane(__hip_atomic_load(cnt + 64 * u.pm, __ATOMIC_RELAXED, __HIP_MEMORY_SCOPE_AGENT)) >= want) break;
                if (__builtin_amdgcn_s_memrealtime() - t0 > 2000000ull) {
                    if (lane == 0) { unsigned expect = 0u; __hip_atomic_compare_exchange_strong(tmo + 1, &expect, code | (unsigned)(u.pm & 0xff), __ATOMIC_RELAXED, __ATOMIC_RELAXED, __HIP_MEMORY_SCOPE_AGENT);
                                     __hip_atomic_store(tmo, 1u, __ATOMIC_RELAXED, __HIP_MEMORY_SCOPE_AGENT); }
                    dead = true; break; }
                __builtin_amdgcn_s_sleep(2);
            }
            __builtin_amdgcn_fence(__ATOMIC_ACQUIRE, "agent");
            if (lane == 0) flag[0] = dead ? 1u : 0u;
        }
        asm volatile("s_waitcnt vmcnt(0) lgkmcnt(0)" ::: "memory"); __builtin_amdgcn_s_barrier(); asm volatile("" ::: "memory");
        const bool bad = flag[0] != 0u;
        if (lane < 32) {
            const unsigned long long* slot = (const unsigned long long*)xbuf + (size_t)(u.pm * BM + row) * 4; float mt[4], m2[4]; float ms = 0.f;
#pragma unroll
            for (int t = 0; t < 4; ++t) { if (t < ntn) { const unsigned long long w = __hip_atomic_load(slot + t, __ATOMIC_RELAXED, __HIP_MEMORY_SCOPE_AGENT); mt[t] = __uint_as_float((unsigned)w); m2[t] = __uint_as_float((unsigned)(w >> 32)); } else { mt[t] = 0.f; m2[t] = 0.f; } ms += mt[t]; }
            const float mean = ms / (float)ntn; float q = 0.f;
#pragma unroll
            for (int t = 0; t < 4; ++t) if (t < ntn) { const float dm = mt[t] - mean; q += m2[t] + 256.0f * dm * dm; }
            S[row] = (f32x2v){mean, 1.0f / sqrtf(q / (256.0f * (float)ntn) + eps)};
        }
        asm volatile("s_waitcnt lgkmcnt(0)" ::: "memory"); __builtin_amdgcn_s_barrier(); asm volatile("" ::: "memory");
        return bad;
    }
};
struct EpiLnRes {
    static constexpr bool PERM = false, AFTER_DRAIN = true;
    const float* base; float* out; int ldc; const float* bias; PanelStats st; unsigned poison;
    __device__ __forceinline__ void refuse(size_t i0, size_t stride, int M, int N) const { const float q = __builtin_nanf(""); for (size_t i = i0; i < (size_t)M * N; i += stride) out[(i / N) * ldc + i % N] = q;
        if (i0 == 0) { unsigned expect = 0u; __hip_atomic_compare_exchange_strong(st.tmo + 1, &expect, 0x7f0u, __ATOMIC_RELAXED, __ATOMIC_RELAXED, __HIP_MEMORY_SCOPE_AGENT); __hip_atomic_store(st.tmo, 1u, __ATOMIC_RELAXED, __HIP_MEMORY_SCOPE_AGENT); } }
    __device__ __forceinline__ void fused(f32x4 (&acc)[2][2][4][2], const Unit& u, int wr, int wc, int fr, int fq, PG8_LAS unsigned char* lds, int wid, int lane) const {
        typedef float f32x2v __attribute__((ext_vector_type(2)));
        const PG8_LAS f32x2v* S = (const PG8_LAS f32x2v*)(lds + 8192);
        const int col0 = u.pn * BM + wc * 32 + 4 * fq;
#pragma unroll
        for (int bj = 0; bj < 2; ++bj)
#pragma unroll
            for (int n = 0; n < 2; ++n) { const f32x4 bv = bias ? *(const f32x4*)(bias + col0 + bj * HALF + n * 16) : (f32x4){0.f, 0.f, 0.f, 0.f};
#pragma unroll
                for (int ai = 0; ai < 2; ++ai)
#pragma unroll
                    for (int m = 0; m < 4; ++m) acc[ai][bj][m][n] += bv; }
        const bool bad = st.run(acc, u, wr, wc, fr, fq, lds, wid, lane) || poison != 0u;
        const float qnan = __builtin_nanf("");
#pragma unroll
        for (int ai = 0; ai < 2; ++ai)
#pragma unroll
            for (int m = 0; m < 4; ++m) { const int r = ai * HALF + wr * 64 + m * 16 + fr; const f32x2v sr = S[r]; const size_t off = (size_t)(u.pm * BM + r) * ldc + col0;
#pragma unroll
                for (int bj = 0; bj < 2; ++bj)
#pragma unroll
                    for (int n = 0; n < 2; ++n) { const f32x4 bs = *(const f32x4*)(base + off + bj * HALF + n * 16); f32x4 o = bs + (acc[ai][bj][m][n] - sr.x) * sr.y;
                        if (bad) o = (f32x4){qnan, qnan, qnan, qnan}; *(f32x4*)(out + off + bj * HALF + n * 16) = o; }
                asm volatile("" ::: "memory"); }
    }
};
struct EpiLnResLn {
    static constexpr bool PERM = false, AFTER_DRAIN = true;
    const float* base; float* out; bf16_t* xn; int ldc; const float* bias; PanelStats st1, st2; unsigned poison;
    __device__ __forceinline__ void refuse(size_t i0, size_t stride, int M, int N) const { const float q = __builtin_nanf(""); for (size_t i = i0; i < (size_t)M * N; i += stride) { const size_t o = (i / N) * ldc + i % N; out[o] = q; xn[o] = (bf16_t)0x7fc0u; }
        if (i0 == 0) { unsigned expect = 0u; __hip_atomic_compare_exchange_strong(st1.tmo + 1, &expect, 0x7f0u, __ATOMIC_RELAXED, __ATOMIC_RELAXED, __HIP_MEMORY_SCOPE_AGENT); __hip_atomic_store(st1.tmo, 1u, __ATOMIC_RELAXED, __HIP_MEMORY_SCOPE_AGENT); } }
    __device__ __forceinline__ void fused(f32x4 (&acc)[2][2][4][2], const Unit& u, int wr, int wc, int fr, int fq, PG8_LAS unsigned char* lds, int wid, int lane) const {
        typedef float f32x2v __attribute__((ext_vector_type(2))); typedef unsigned u32x2v __attribute__((ext_vector_type(2)));
        const PG8_LAS f32x2v* S = (const PG8_LAS f32x2v*)(lds + 8192);
        const int col0 = u.pn * BM + wc * 32 + 4 * fq;
#pragma unroll
        for (int bj = 0; bj < 2; ++bj)
#pragma unroll
            for (int n = 0; n < 2; ++n) { const f32x4 bv = bias ? *(const f32x4*)(bias + col0 + bj * HALF + n * 16) : (f32x4){0.f, 0.f, 0.f, 0.f};
#pragma unroll
                for (int ai = 0; ai < 2; ++ai)
#pragma unroll
                    for (int m = 0; m < 4; ++m) acc[ai][bj][m][n] += bv; }
        bool bad = st1.run(acc, u, wr, wc, fr, fq, lds, wid, lane) || poison != 0u;
        const float qnan = __builtin_nanf("");
#pragma unroll
        for (int ai = 0; ai < 2; ++ai)
#pragma unroll
            for (int m = 0; m < 4; ++m) { const int r = ai * HALF + wr * 64 + m * 16 + fr; const f32x2v sr = S[r]; const size_t off = (size_t)(u.pm * BM + r) * ldc + col0;
#pragma unroll
                for (int bj = 0; bj < 2; ++bj)
#pragma unroll
                    for (int n = 0; n < 2; ++n) { const f32x4 bs = *(const f32x4*)(base + off + bj * HALF + n * 16); acc[ai][bj][m][n] = bs + (acc[ai][bj][m][n] - sr.x) * sr.y; }
                asm volatile("" : "+v"(acc[ai][0][m][0]), "+v"(acc[ai][0][m][1]), "+v"(acc[ai][1][m][0]), "+v"(acc[ai][1][m][1]));
                if (m & 1) asm volatile("" ::: "memory"); }
        const bool bad1 = bad;
        bad = st2.run(acc, u, wr, wc, fr, fq, lds, wid, lane) || bad;
#pragma unroll
        for (int ai = 0; ai < 2; ++ai)
#pragma unroll
            for (int m = 0; m < 4; ++m) { const int r = ai * HALF + wr * 64 + m * 16 + fr; const f32x2v sr = S[r]; const size_t off = (size_t)(u.pm * BM + r) * ldc + col0;
#pragma unroll
                for (int bj = 0; bj < 2; ++bj)
#pragma unroll
                    for (int n = 0; n < 2; ++n) { const f32x4 x1 = acc[ai][bj][m][n]; *(f32x4*)(out + off + bj * HALF + n * 16) = bad1 ? (f32x4){qnan, qnan, qnan, qnan} : x1;
                        const f32x4 o = (x1 - sr.x) * sr.y; u32x2v w; w.x = cvt_pk_bf16(o[0], o[1]); w.y = cvt_pk_bf16(o[2], o[3]);
                        if (bad) { w.x = 0x7fc07fc0u; w.y = 0x7fc07fc0u; } *(u32x2v*)(xn + off + bj * HALF + n * 16) = w; }
                asm volatile("" ::: "memory"); }
    }
};

template <class Epi, class Sched, bool STAMP = false>
__device__ __forceinline__ void gemm_phase(PG8_LAS unsigned char* lds, const Gemm g, const Sched& S, const Epi& E, unsigned long long* stamps) {
    int tid_l = threadIdx.x; asm volatile("" : "+v"(tid_l));
    const int tid = tid_l, wid = __builtin_amdgcn_readfirstlane(tid >> 6), lane = tid & 63, wr = wid >> 2, wc = wid & 3, fr = lane & 15, fq = lane >> 4;
    const int K = g.K, nt = K / BK;
    int ts_lo = 0, ts_hi = 0, nts = 0; const unsigned long long rt_entry = STAMP ? (unsigned long long)wall_clock64() : 0ull;
#define PG8_STAMP() do { if (STAMP && wid == 0 && nts < 64) { const unsigned long long _c = (unsigned long long)clock64(); \
        ts_lo = (lane == nts) ? (int)(unsigned)_c : ts_lo; ts_hi = (lane == nts) ? (int)(unsigned)(_c >> 32) : ts_hi; ++nts; } } while (0)
    PG8_STAMP();
    unsigned voffA[2], voffB[2];
#pragma unroll
    for (int i = 0; i < 2; ++i) { int R, C; stage_rc(tid * 16 + i * 8192, R, C); const int Rb = Epi::PERM ? ((R & ~31) + perm32(R & 31)) : R;
        voffA[i] = (unsigned)(R * K + C) * 2u; voffB[i] = (unsigned)(Rb * K + C) * 2u; }
    const size_t kstep = (size_t)(BK * 2);
    const size_t hstep = (size_t)HALF * K * 2;
    const size_t tstep = 2 * hstep;
    const unsigned ldsw = (unsigned)wid * 1024u;
    const int aoff = lds_byte(wr * 64 + fr, fq * 8), boff = lds_byte(wc * 32 + fr, fq * 8);
#define PG8_SA(b, h) (((b) * 2 + (h)) * HTB)
#define PG8_SB(b, h) ((4 + (b) * 2 + (h)) * HTB)
#define PG8_STAGE(bufoff, gbase, voff) do { _Pragma("unroll") for (int _i = 0; _i < 2; ++_i) \
        __builtin_amdgcn_global_load_lds((const unsigned*)((const char*)(gbase) + (voff)[_i]), (PG8_LAS unsigned*)(lds + (bufoff) + ldsw + _i * 8192), 16, 0, 0); } while (0)
#define PG8_LDA(dst, b, h) do { _Pragma("unroll") for (int m = 0; m < 4; ++m) _Pragma("unroll") for (int k = 0; k < 2; ++k) dst[m][k] = *(const PG8_LAS bf16x8*)(lds + PG8_SA(b, h) + aoff + m * 2048 + k * 1024); } while (0)
#define PG8_LDB(dst, b, h) do { _Pragma("unroll") for (int n = 0; n < 2; ++n) _Pragma("unroll") for (int k = 0; k < 2; ++k) dst[n][k] = *(const PG8_LAS bf16x8*)(lds + PG8_SB(b, h) + boff + n * 2048 + k * 1024); } while (0)
#define PG8_MMA(ai, bj, At, Bt) do { __builtin_amdgcn_s_setprio(1); _Pragma("unroll") for (int m = 0; m < 4; ++m) _Pragma("unroll") for (int n = 0; n < 2; ++n) _Pragma("unroll") for (int k = 0; k < 2; ++k) \
        acc[ai][bj][m][n] = __builtin_amdgcn_mfma_f32_16x16x32_bf16(Bt[n][k], At[m][k], acc[ai][bj][m][n], 0, 0, 0); __builtin_amdgcn_s_setprio(0); } while (0)
#define PG8_WAIT_V(n) asm volatile("s_waitcnt vmcnt(" #n ")" ::: "memory")
#define PG8_WAIT_L(n) asm volatile("s_waitcnt lgkmcnt(" #n ")" ::: "memory")
#define PG8_BAR __builtin_amdgcn_s_barrier()
#define PG8_SCHED __builtin_amdgcn_sched_barrier(0)
    Unit cur, nxt; int ui = 0;
    if (!S.next(0, cur)) return;
    f32x4 acc[2][2][4][2];
#pragma unroll
    for (int a = 0; a < 2; ++a)
#pragma unroll
        for (int b = 0; b < 2; ++b)
#pragma unroll
            for (int m = 0; m < 4; ++m)
#pragma unroll
                for (int n = 0; n < 2; ++n) acc[a][b][m][n] = (f32x4){0.f, 0.f, 0.f, 0.f};
    bf16x8 At[4][2], B0[2][2], B1[2][2];
    const char* cA = (const char*)g.A + (size_t)cur.pm * tstep; const char* cB = (const char*)g.Bt + (size_t)cur.pn * tstep;
    S.a_ready(cur);
    PG8_STAGE(PG8_SB(0, 0), cB, voffB); PG8_STAGE(PG8_SA(0, 0), cA, voffA); PG8_STAGE(PG8_SB(0, 1), cB + hstep, voffB); PG8_STAGE(PG8_SA(0, 1), cA + hstep, voffA);
    if (wr == 1) PG8_BAR;
    PG8_WAIT_V(4); PG8_BAR;
    PG8_STAGE(PG8_SB(1, 0), cB + kstep, voffB); PG8_STAGE(PG8_SA(1, 0), cA + kstep, voffA); PG8_STAGE(PG8_SB(1, 1), cB + hstep + kstep, voffB);
    PG8_WAIT_V(6); PG8_BAR;
    PG8_STAMP();
    for (;;) {
        const bool has_next = S.next(ui + 1, nxt);
        const char* nA = has_next ? (const char*)g.A + (size_t)nxt.pm * tstep : cA; const char* nB = has_next ? (const char*)g.Bt + (size_t)nxt.pn * tstep : cB;
        for (int t = 0; t < nt; t += 2) {
            const bool last = (t == nt - 2);
            const char* a1 = cA + (size_t)(t + 1) * kstep;
            const char* a2 = last ? nA : cA + (size_t)(t + 2) * kstep; const char* b2 = last ? nB : cB + (size_t)(t + 2) * kstep;
            const char* a3 = a2 + kstep; const char* b3 = b2 + kstep;
            if (last && has_next) S.a_ready(nxt);
            PG8_LDB(B0, 0, 0); PG8_SCHED; PG8_LDA(At, 0, 0); PG8_STAGE(PG8_SA(1, 1), a1 + hstep, voffA);
            PG8_WAIT_L(8); PG8_BAR; PG8_WAIT_L(0); PG8_MMA(0, 0, At, B0); PG8_BAR; PG8_SCHED;
            PG8_LDB(B1, 0, 1); PG8_STAGE(PG8_SB(0, 0), b2, voffB);
            PG8_BAR; PG8_WAIT_L(0); PG8_MMA(0, 1, At, B1); PG8_BAR;
            PG8_LDA(At, 0, 1); PG8_STAGE(PG8_SA(0, 0), a2, voffA);
            PG8_BAR; PG8_WAIT_L(0); PG8_MMA(1, 0, At, B0); PG8_BAR; PG8_SCHED;
            PG8_STAGE(PG8_SB(0, 1), b2 + hstep, voffB);
            PG8_WAIT_V(6); PG8_BAR; PG8_MMA(1, 1, At, B1); PG8_BAR;
            PG8_LDB(B0, 1, 0); PG8_SCHED; PG8_LDA(At, 1, 0); PG8_STAGE(PG8_SA(0, 1), a2 + hstep, voffA);
            PG8_WAIT_L(8); PG8_BAR; PG8_WAIT_L(0); PG8_MMA(0, 0, At, B0); PG8_BAR; PG8_SCHED;
            PG8_LDB(B1, 1, 1); PG8_STAGE(PG8_SB(1, 0), b3, voffB);
            PG8_BAR; PG8_WAIT_L(0); PG8_MMA(0, 1, At, B1); PG8_BAR;
            PG8_LDA(At, 1, 1); PG8_STAGE(PG8_SA(1, 0), a3, voffA);
            PG8_BAR; PG8_WAIT_L(0); PG8_MMA(1, 0, At, B0); PG8_BAR; PG8_SCHED;
            PG8_STAGE(PG8_SB(1, 1), b3 + hstep, voffB);
            PG8_WAIT_V(6); PG8_BAR; PG8_MMA(1, 1, At, B1); PG8_BAR;
        }
        PG8_STAMP();
        if constexpr (!Epi::AFTER_DRAIN) { E(acc, cur, wr, wc, fr, fq); S.done(cur); }
        PG8_STAMP();
        if (!has_next) break;
#pragma unroll
        for (int a = 0; a < 2; ++a)
#pragma unroll
            for (int b = 0; b < 2; ++b)
#pragma unroll
                for (int m = 0; m < 4; ++m)
#pragma unroll
                    for (int n = 0; n < 2; ++n) acc[a][b][m][n] = (f32x4){0.f, 0.f, 0.f, 0.f};
        cur = nxt; cA = nA; cB = nB; ++ui;
    }
    PG8_WAIT_V(0);
    if (wr == 0) PG8_BAR;
    PG8_BAR;
    if constexpr (Epi::AFTER_DRAIN) { E.fused(acc, cur, wr, wc, fr, fq, lds, wid, lane); S.done(cur); }
    PG8_STAMP();
    if (STAMP && wid == 0) { stamps[lane] = lane < nts ? (((unsigned long long)(unsigned)ts_hi << 32) | (unsigned)ts_lo) : 0ull;
        if (lane == 62) stamps[62] = rt_entry; if (lane == 63) stamps[63] = (unsigned long long)wall_clock64(); }
#undef PG8_STAMP
#undef PG8_SA
#undef PG8_SB
#undef PG8_STAGE
#undef PG8_LDA
#undef PG8_LDB
#undef PG8_MMA
#undef PG8_WAIT_V
#undef PG8_WAIT_L
#undef PG8_BAR
#undef PG8_SCHED
}
}

#define GAS __attribute__((address_space(1)))
#define LAS __attribute__((address_space(3)))
typedef unsigned short bf16;
typedef unsigned v4u __attribute__((ext_vector_type(4)));
typedef unsigned v2u __attribute__((ext_vector_type(2)));
typedef float f32x4 __attribute__((ext_vector_type(4)));
typedef float f32x2 __attribute__((ext_vector_type(2)));
typedef float f32x16 __attribute__((ext_vector_type(16)));
typedef short bf16x8 __attribute__((ext_vector_type(8)));
typedef short bf16x4 __attribute__((ext_vector_type(4)));

#ifndef MK_CHECK
#define MK_CHECK 0
#endif
#ifndef MK_ONE_LAUNCH
#define MK_ONE_LAUNCH 0
#endif
#ifndef MK_PROBE
#define MK_PROBE 0
#endif
#ifndef MK_DUP10
#define MK_DUP10 0
#endif
#ifndef MK_PROBE_KERNEL
#define MK_PROBE_KERNEL 0
#endif
#ifndef MK_PROBE_FLAGS
#define MK_PROBE_FLAGS 0
#endif
#ifndef MK_REPEAT_K
#define MK_REPEAT_K (-1)
#endif
#ifndef MK_PROBE_A
#define MK_PROBE_A 0u
#endif
#ifndef MK_PROBE_C
#define MK_PROBE_C 0u
#endif

constexpr int T_TOK = 65536, DM = 1024, SEQ = 2048, NBATCH = 32;
constexpr float ALPHA_DN = 1.6817928305074290f;
#ifndef PEER_U4
#define PEER_U4 1
#endif
#ifndef PEER_V4
#define PEER_V4 1
#endif
constexpr float PEER_USCALE = PEER_U4 ? 64.0f : 256.0f, PEER_VSCALE = PEER_V4 ? 12.8f : 32.0f;
constexpr int PEER_UROW = PEER_U4 ? 512 : 1024, PEER_VROW = PEER_V4 ? 512 : 1024;
constexpr int NWAVES = 8, NTHR = 512;
constexpr int NPH_LAYER = 12;
constexpr int N_PHASES = 1 + 4 * NPH_LAYER;

constexpr size_t MiB = 1u << 20;
constexpr size_t WS_CTL = 0, CTL_BYTES = 1 * MiB;
constexpr size_t WS_ROT = 1 * MiB;
constexpr size_t WS_WPEER = 4 * MiB;
constexpr size_t WS_WPLEG = 20 * MiB;
constexpr size_t WS_WPLEP = 28 * MiB;
constexpr size_t WS_WAIN = 30 * MiB;
constexpr size_t WS_WAQ = 32 * MiB;
constexpr size_t WAQ_STRIDE = 2560 * 256 * 2;
constexpr size_t WS_WAOV = 35 * MiB;
constexpr size_t WS_WBIN = 43 * MiB;
constexpr size_t WS_WBO = 48 * MiB;
constexpr size_t WS_WCIN = 51 * MiB;
constexpr size_t WS_WCO = 63 * MiB;
constexpr size_t WS_TABU = 68 * MiB, WS_TABV = 100 * MiB;
constexpr size_t WS_XB0 = 132 * MiB, WS_XB1 = 260 * MiB;
constexpr size_t WS_M = 388 * MiB;
constexpr size_t M_SC = 0, M_IDS = 512 * MiB, M_GATES = 544 * MiB, M_PB = 576 * MiB, M_PP = 0;
constexpr size_t M_RAW = 0, M_CQ = 128 * MiB, M_CKV = 160 * MiB, M_CKVT = 176 * MiB, M_KIDX = 192 * MiB, M_WIDX = 200 * MiB,
                 M_MASK = 202 * MiB, M_QLAT = 218 * MiB, M_QIDX = 474 * MiB;
constexpr size_t M_GU = 0, M_Y = 320 * MiB;
constexpr size_t M_Q = 0, M_K = 128 * MiB, M_V = 256 * MiB, M_STAT = 512 * MiB;
constexpr size_t WS_PP = WS_M + 608 * MiB;
constexpr size_t WS_END = WS_PP + 128 * MiB;
constexpr int CW_DIAG = 64;
constexpr int CW_BAR = 4096;

constexpr int RING_BYTES = 131072, LDS_BYTES = 147456, LDSCTL_OFF = LDS_BYTES - 512, MISC_OFF = LDSCTL_OFF + 320;

enum { I_X = 0, I_P, I_A_W_IN, I_A_CQ_GAIN, I_A_CKV_GAIN, I_A_W_UQ, I_A_W_UK, I_A_W_QIDX, I_A_KIDX_GAIN, I_A_KIDX_BIAS, I_A_W_UV, I_A_W_O,
       I_B_W_IN, I_B_CONV_W, I_B_CONV_B, I_B_W_A, I_B_B_A, I_B_W_X, I_B_B_X, I_B_LAMBDA, I_B_W_O, I_C_W_IN, I_C_W_O,
       I_LN1_G, I_LN1_B, I_PEER_WQ, I_PEER_SK, I_PEER_U, I_PEER_V, I_LN2_G, I_LN2_B, I_PLE_WP, I_PLE_WG, I_PLE_BG, N_IN };

struct Params { const float* in[N_IN]; float* out; unsigned char* ws; int ph_lo, ph_hi, flags, pad; };

typedef const float* const __attribute__((address_space(4)))* InTab;
struct Ctx {
    LAS unsigned char* lds;
    int tid, lane, wave, bid, G;
    InTab in; float* out; unsigned char* ws;
};
#define INP(cx, i) ((const float*)(const GAS float*)((cx).in[i]))

#define LDS_WAIT() asm volatile("s_waitcnt lgkmcnt(0)" ::: "memory")
#define VM_WAIT() asm volatile("s_waitcnt vmcnt(0)" ::: "memory")

typedef __bf16 bf16v2_t __attribute__((ext_vector_type(2)));
__device__ __forceinline__ unsigned pk2(float lo, float hi) { const f32x2 v = {lo, hi}; const bf16v2_t b = __builtin_convertvector(v, bf16v2_t); return __builtin_bit_cast(unsigned, b); }
__device__ __forceinline__ unsigned f2bf(float f) { return (unsigned)__builtin_bit_cast(unsigned short, (__bf16)f); }
__device__ __forceinline__ float bflo(unsigned w) { return __builtin_bit_cast(float, w << 16); }
__device__ __forceinline__ float bfhi(unsigned w) { return __builtin_bit_cast(float, w & 0xffff0000u); }
__device__ __forceinline__ float bf2f(bf16 b) { return __builtin_bit_cast(float, ((unsigned)b) << 16); }
template <int CTRL, int ROWMASK>
__device__ __forceinline__ float dpp_f(float v) { return __builtin_bit_cast(float, __builtin_amdgcn_update_dpp(0, __builtin_bit_cast(int, v), CTRL, ROWMASK, 0xf, false)); }
__device__ __forceinline__ float wave_sum_uniform(float v) {
    v += dpp_f<0xB1, 0xf>(v);
    v += dpp_f<0x4E, 0xf>(v);
    v += dpp_f<0x141, 0xf>(v);
    v += dpp_f<0x140, 0xf>(v);
    v += dpp_f<0x142, 0xa>(v);
    v += dpp_f<0x143, 0xc>(v);
    return __builtin_bit_cast(float, __builtin_amdgcn_readlane(__builtin_bit_cast(int, v), 63));
}
__device__ __forceinline__ float wave_sum(float v) { return wave_sum_uniform(v); }
__device__ __forceinline__ float gelu_tanh(float x) {
    const float u = 0.7978845608028654f * (x + 0.044715f * x * x * x);
    const float e = __expf(2.0f * u);
    const float th = 1.0f - 2.0f * __builtin_amdgcn_rcpf(e + 1.0f);
    return 0.5f * x * (1.0f + th);
}
__device__ __forceinline__ float sigmoidf_(float x) { return __builtin_amdgcn_rcpf(1.0f + __expf(-x)); }

#define XB_TMO      128
#define XB_XCNT(j)  (256  + 64 * (j))
#define XB_XSUB(j)  (1280 + 64 * (j))
#define XB_XGEN(j)  (2304 + 64 * (j))
#define XB_TOP      3328
#define XB_TOPGEN   3392
#define XCD_BAR_WORDS 3456
#define XB_SPIN_CAP (1u << 25)
__device__ __forceinline__ unsigned xb_ld(unsigned* p)              { return __hip_atomic_load(p, __ATOMIC_RELAXED, __HIP_MEMORY_SCOPE_AGENT); }
__device__ __forceinline__ unsigned xb_add(unsigned* p, unsigned v) { return __hip_atomic_fetch_add(p, v, __ATOMIC_RELAXED, __HIP_MEMORY_SCOPE_AGENT); }
__device__ __forceinline__ unsigned xb_xcc_id() { return (unsigned)__builtin_amdgcn_s_getreg((3 << 11) | 20) & 0xFu; }
#define XB_SPIN(cond, bar) do { unsigned _sp = 0; while (cond) { __builtin_amdgcn_s_sleep(1); \
    if ((++_sp & 255u) == 0u) { if (xb_ld(&(bar)[XB_TMO])) break; if (_sp > XB_SPIN_CAP) { atomicAdd(&(bar)[XB_TMO], 1u); break; } } } } while (0)
struct XcdBarrier { unsigned* bar; unsigned x; volatile LAS unsigned* st; };
__device__ __forceinline__ XcdBarrier xcd_barrier_post(unsigned* bar, volatile LAS unsigned* st) {
    XcdBarrier b; b.bar = bar; b.x = xb_xcc_id(); b.st = st;
    if (threadIdx.x == 0) (void)xb_add(&bar[XB_XCNT(b.x)], 1u);
    return b;
}
__device__ __forceinline__ void xcd_barrier_complete(unsigned* bar, unsigned x, unsigned& nloc, unsigned& nx) {
    const unsigned G = gridDim.x * gridDim.y * gridDim.z;
    unsigned sum, cnt, mine, sp = 0u;
    for (;;) {
        sum = 0u; cnt = 0u; mine = 0u;
#pragma unroll
        for (unsigned j = 0; j < 16; ++j) { const unsigned c = xb_ld(&bar[XB_XCNT(j)]); sum += c; cnt += (c > 0u) ? 1u : 0u; mine = (j == x) ? c : mine; }
        if (sum == G) break;
        __builtin_amdgcn_s_sleep(1);
        if ((++sp & 255u) == 0u) { if (xb_ld(&bar[XB_TMO])) break; if (sp > XB_SPIN_CAP) { atomicAdd(&bar[XB_TMO], 1u); break; } }
    }
    nloc = mine > 0u ? mine : 1u; nx = cnt > 0u ? cnt : 1u;
}
__device__ __forceinline__ void xcd_barrier(const XcdBarrier& b) {
    asm volatile("s_waitcnt vmcnt(0)" ::: "memory");
    __syncthreads();
    if (threadIdx.x == 0) {
        unsigned* bar = b.bar;
        __builtin_amdgcn_s_waitcnt(0);
        unsigned nloc = b.st[0], nx = b.st[1];
        if (nloc == 0u) { xcd_barrier_complete(bar, b.x, nloc, nx); b.st[0] = nloc; b.st[1] = nx; }
        const unsigned old = xb_add(&bar[XB_XSUB(b.x)], 1u);
        const unsigned gen = old / nloc;
        if (old + 1u == (gen + 1u) * nloc) {
            __builtin_amdgcn_fence(__ATOMIC_RELEASE, "agent");
            asm volatile("s_waitcnt vmcnt(0)" ::: "memory");
            const unsigned og = xb_add(&bar[XB_TOP], 1u);
            const unsigned tg = og / nx;
            if (og + 1u == (tg + 1u) * nx) xb_add(&bar[XB_TOPGEN], 1u);
            else XB_SPIN(xb_ld(&bar[XB_TOPGEN]) == tg, bar);
            __builtin_amdgcn_fence(__ATOMIC_ACQUIRE, "agent");
            xb_add(&bar[XB_XGEN(b.x)], 1u);
            asm volatile("s_waitcnt vmcnt(0)" ::: "memory");
        } else {
            XB_SPIN(xb_ld(&bar[XB_XGEN(b.x)]) == gen, bar);
            __builtin_amdgcn_fence(__ATOMIC_ACQUIRE, "agent");
            asm volatile("s_waitcnt vmcnt(0)" ::: "memory");
        }
    }
    __syncthreads();
}

__device__ __forceinline__ void p0_transpose_item(const float* W, int K, int N, bf16* WT, int row_off, float scale, LAS float* scr, int item, int lane) {
    const int nblk = N / 32, kb = item / nblk, nb = item % nblk, k0 = 64 * kb, n0 = 32 * nb;
#pragma unroll 8
    for (int i = 0; i < 32; ++i) { const int kk = 2 * i + (lane >> 5); scr[kk * 33 + (lane & 31)] = W[(size_t)(k0 + kk) * N + n0 + (lane & 31)] * scale; }
    LDS_WAIT(); asm volatile("" ::: "memory");
    const int c = lane & 7;
#pragma unroll
    for (int j = 0; j < 4; ++j) { const int n = (lane >> 3) + 8 * j; const LAS float* s = scr + (8 * c) * 33 + n;
        v4u o; o.x = pk2(s[0 * 33], s[1 * 33]); o.y = pk2(s[2 * 33], s[3 * 33]); o.z = pk2(s[4 * 33], s[5 * 33]); o.w = pk2(s[6 * 33], s[7 * 33]);
        *(v4u*)(WT + (size_t)(row_off + n0 + n) * K + k0 + 8 * c) = o; }
    LDS_WAIT(); asm volatile("" ::: "memory");
}

__device__ __forceinline__ void small_gemm_tile(const Ctx& c, const float* A, long sa_n, long sa_d, const float* Bm, long sb_k, long sb_d, int Kd,
                                                bf16* C, int ldc, int n0, int k0, float scale) {
    LAS float* As = (LAS float*)c.lds; LAS float* Bs = As + 128 * 68;
    __syncthreads();
    for (int e = c.tid; e < 64 * Kd; e += NTHR) {
        int r, d;
        if (sa_d == 1) { d = e % Kd; r = e / Kd; } else { r = e & 63; d = e >> 6; }
        As[d * 68 + r] = A[(long)(n0 + r) * sa_n + (long)d * sa_d];
    }
    for (int e = c.tid; e < 64 * Kd; e += NTHR) {
        int r, d;
        if (sb_d == 1) { d = e % Kd; r = e / Kd; } else { r = e & 63; d = e >> 6; }
        Bs[d * 68 + r] = Bm[(long)(k0 + r) * sb_k + (long)d * sb_d];
    }
    __syncthreads();
    {
        const int tn = (c.tid >> 5) * 4, tk = (c.tid & 31) * 2;
        float acc[4][2];
#pragma unroll
        for (int i = 0; i < 4; ++i) { acc[i][0] = 0.f; acc[i][1] = 0.f; }
        for (int d = 0; d < Kd; ++d) {
            const f32x4 a = *(const LAS f32x4*)(As + d * 68 + tn); const f32x2 b = *(const LAS f32x2*)(Bs + d * 68 + tk);
#pragma unroll
            for (int i = 0; i < 4; ++i) { acc[i][0] += a[i] * b[0]; acc[i][1] += a[i] * b[1]; }
        }
#pragma unroll
        for (int i = 0; i < 4; ++i) *(unsigned*)(C + (size_t)(n0 + tn + i) * ldc + k0 + tk) = pk2(acc[i][0] * scale, acc[i][1] * scale);
    }
}

__device__ __forceinline__ void ln_store_row(float (&v)[16], const float* gain, const float* bias, float* of, bf16* ob, int lane) {
    float s = 0.f;
#pragma unroll
    for (int j = 0; j < 16; ++j) s += v[j];
    const float mean = wave_sum(s) * (1.f / 1024.f);
    float s2 = 0.f;
#pragma unroll
    for (int j = 0; j < 16; ++j) { v[j] -= mean; s2 += v[j] * v[j]; }
    const float rstd = __builtin_amdgcn_rsqf(wave_sum(s2) * (1.f / 1024.f) + 1e-5f);
#pragma unroll
    for (int h = 0; h < 2; ++h) {
        const int col = h * 512 + 8 * lane;
        const f32x4 g0 = *(const f32x4*)(gain + col), g1 = *(const f32x4*)(gain + col + 4), b0 = *(const f32x4*)(bias + col), b1 = *(const f32x4*)(bias + col + 4);
        f32x4 o0, o1;
#pragma unroll
        for (int j = 0; j < 4; ++j) { o0[j] = v[h * 8 + j] * rstd * g0[j] + b0[j]; o1[j] = v[h * 8 + 4 + j] * rstd * g1[j] + b1[j]; }
        if (of) { *(f32x4*)(of + col) = o0; *(f32x4*)(of + col + 4) = o1; }
        v4u w; w.x = pk2(o0[0], o0[1]); w.y = pk2(o0[2], o0[3]); w.z = pk2(o1[0], o1[1]); w.w = pk2(o1[2], o1[3]);
        *(v4u*)(ob + col) = w;
    }
}
__device__ __forceinline__ void load_row16(const float* row, float (&v)[16], int lane) {
#pragma unroll
    for (int h = 0; h < 2; ++h) { const f32x4 a = *(const f32x4*)(row + h * 512 + 8 * lane), b = *(const f32x4*)(row + h * 512 + 8 * lane + 4);
#pragma unroll
        for (int j = 0; j < 4; ++j) { v[h * 8 + j] = a[j]; v[h * 8 + 4 + j] = b[j]; } }
}

__device__ __forceinline__ void load_row16_bf(const bf16* row, float (&v)[16], int lane) {
#pragma unroll
    for (int h = 0; h < 2; ++h) { const v4u w = *(const v4u*)(row + h * 512 + 8 * lane);
        v[h * 8 + 0] = bflo(w.x); v[h * 8 + 1] = bfhi(w.x); v[h * 8 + 2] = bflo(w.y); v[h * 8 + 3] = bfhi(w.y);
        v[h * 8 + 4] = bflo(w.z); v[h * 8 + 5] = bfhi(w.z); v[h * 8 + 6] = bflo(w.w); v[h * 8 + 7] = bfhi(w.w); }
}

__device__ __forceinline__ void load_row16c(const float* row, float (&v)[16], int lane) {
#pragma unroll
    for (int q = 0; q < 4; ++q) { const f32x4 a = *(const f32x4*)(row + 16 * lane + 4 * q);
#pragma unroll
        for (int j = 0; j < 4; ++j) v[4 * q + j] = a[j]; }
}
__device__ __forceinline__ void ln_store_row_c(float (&v)[16], const float* gain, const float* bias, float* of, bf16* ob, int lane) {
    float s = 0.f;
#pragma unroll
    for (int j = 0; j < 16; ++j) s += v[j];
    const float mean = wave_sum(s) * (1.f / 1024.f);
    float s2 = 0.f;
#pragma unroll
    for (int j = 0; j < 16; ++j) { v[j] -= mean; s2 += v[j] * v[j]; }
    const float rstd = __builtin_amdgcn_rsqf(wave_sum(s2) * (1.f / 1024.f) + 1e-5f);
    const int col = 16 * lane;
    float o[16];
#pragma unroll
    for (int q = 0; q < 4; ++q) { const f32x4 g = *(const f32x4*)(gain + col + 4 * q), b = *(const f32x4*)(bias + col + 4 * q); f32x4 r;
#pragma unroll
        for (int j = 0; j < 4; ++j) { r[j] = v[4 * q + j] * rstd * g[j] + b[j]; o[4 * q + j] = r[j]; }
        *(f32x4*)(of + col + 4 * q) = r; }
    v4u w0, w1; w0.x = pk2(o[0], o[1]); w0.y = pk2(o[2], o[3]); w0.z = pk2(o[4], o[5]); w0.w = pk2(o[6], o[7]);
    w1.x = pk2(o[8], o[9]); w1.y = pk2(o[10], o[11]); w1.z = pk2(o[12], o[13]); w1.w = pk2(o[14], o[15]);
    *(v4u*)(ob + col) = w0; *(v4u*)(ob + col + 8) = w1;
}

__device__ __forceinline__ void phase_prologue(const Ctx& c) {
    unsigned char* ws = c.ws;
    LAS float* scr = (LAS float*)(c.lds + c.wave * 16384);
    const int gw = c.bid * NWAVES + c.wave, NGW = c.G * NWAVES;
    {
        struct TI { const float* W; int K, N; bf16* WT; int row_off; float scale; };
        int base = 0;
#define TR_ITEMS(Wp, Kv, Nv, WTp, roff, sc) do { const int ni = ((Kv) / 64) * ((Nv) / 32); \
            for (int it = gw; it < ni; it += NGW) p0_transpose_item((Wp), (Kv), (Nv), (WTp), (roff), (sc), scr, it, c.lane); base += ni; } while (0)
        for (int i = 0; i < 4; ++i) {
            TR_ITEMS(INP(c, I_PLE_WG) + (size_t)i * 1024 * 1024, 1024, 1024, (bf16*)(ws + WS_WPLEG) + (size_t)i * 1024 * 1024, 0, 1.0f);
            TR_ITEMS(INP(c, I_PLE_WP) + (size_t)i * 256 * 1024, 256, 1024, (bf16*)(ws + WS_WPLEP) + (size_t)i * 1024 * 256, 0, 1.0f);
        }
        for (int j = 0; j < 2; ++j)
            TR_ITEMS(INP(c, I_A_W_QIDX) + (size_t)j * 256 * 512, 256, 512, (bf16*)(ws + WS_WAQ + j * WAQ_STRIDE), 2048, 0.125f);
        TR_ITEMS(INP(c, I_B_W_IN), 1024, 2560, (bf16*)(ws + WS_WBIN), 0, 1.0f);
        TR_ITEMS(INP(c, I_B_W_O), 1280, 1024, (bf16*)(ws + WS_WBO), 0, 1.0f);
        TR_ITEMS(INP(c, I_C_W_IN), 1024, 6144, (bf16*)(ws + WS_WCIN), 0, 1.0f);
        TR_ITEMS(INP(c, I_C_W_O), 2048, 1024, (bf16*)(ws + WS_WCO), 0, 1.0f);
#undef TR_ITEMS
        (void)base;
    }
    for (int j = 0; j < 2; ++j) {
        const float* W = INP(c, I_A_W_IN) + (size_t)j * 1024 * 456; bf16* WT = (bf16*)(ws + WS_WAIN) + (size_t)j * 512 * 1024;
        for (int e = c.bid * NTHR + c.tid; e < 512 * 1024; e += c.G * NTHR) { const int n = e >> 10, k = e & 1023; WT[e] = (bf16)(n < 456 ? f2bf(W[(size_t)k * 456 + n]) : 0u); }
    }
    {
        float* ct = (float*)(ws + WS_ROT); float* st = ct + 2048 * 128;
        for (int e = c.bid * NTHR + c.tid; e < 2048 * 128; e += c.G * NTHR) {
            const int pos = e >> 7, f = e & 127;
            const float lin = (float)f * (1.0f / 127.0f);
            const float p = (float)pow(10000.0, (double)lin);
            const float invf = 1.0f / p;
            const float ang = (float)pos * invf;
            ct[e] = (float)cos((double)ang); st[e] = (float)sin((double)ang);
        }
    }
    for (int m = gw; m < T_TOK; m += NGW) {
        const float* xr = INP(c, I_X) + (size_t)m * DM; bf16* ob = (bf16*)(ws + WS_XB0) + (size_t)m * DM;
#pragma unroll
        for (int h = 0; h < 2; ++h) { const int col = h * 512 + 8 * c.lane; const f32x4 a = *(const f32x4*)(xr + col), b = *(const f32x4*)(xr + col + 4);
            v4u w; w.x = pk2(a[0], a[1]); w.y = pk2(a[2], a[3]); w.z = pk2(b[0], b[1]); w.w = pk2(b[2], b[3]); *(v4u*)(ob + col) = w; }
    }
    {
        int tbase = 0;
        {
            const int ntile = 4 * 16 * 2 * 16;
            for (int t = c.bid; t < ntile; t += c.G) {
                const int i = t / 512, r = t % 512, hp = r / 32, tt = r % 32, nt = tt / 16, kt = tt % 16;
                const float* A = INP(c, I_PEER_SK) + (size_t)i * 8 * 2 * 128 * 128 + (size_t)hp * 128 * 128;
                const float* Bm = INP(c, I_PEER_WQ) + (size_t)i * 1024 * 2048 + hp * 128;
                bf16* C = (bf16*)(ws + WS_WPEER) + (size_t)i * 2048 * 1024 + (size_t)hp * 128 * 1024;
                small_gemm_tile(c, A, 128, 1, Bm, 2048, 1, 128, C, 1024, nt * 64, kt * 64, 1.0f);
            }
            tbase += ntile;
        }
        {
            const int ntile = 2 * 16 * 2 * 4;
            for (int t = c.bid; t < ntile; t += c.G) {
                const int j = t / 128, r = t % 128, h = r / 8, tt = r % 8, nt = tt / 4, kt = tt % 4;
                const float* A = INP(c, I_A_W_UK) + (size_t)j * 16 * 64 * 128 + (size_t)h * 64 * 128;
                const float* Bm = INP(c, I_A_W_UQ) + (size_t)j * 256 * 1024 + h * 64;
                bf16* C = (bf16*)(ws + WS_WAQ + j * WAQ_STRIDE) + (size_t)h * 128 * 256;
                small_gemm_tile(c, A, 1, 128, Bm, 1024, 1, 64, C, 256, nt * 64, kt * 64, 0.125f * 1.4426950408889634f);
            }
        }
        {
            const int ntile = 2 * 16 * 16 * 2;
            for (int t = c.bid; t < ntile; t += c.G) {
                const int j = t / 512, r = t % 512, h = r / 32, tt = r % 32, nt = tt / 2, kt = tt % 2;
                const float* A = INP(c, I_A_W_O) + (size_t)j * 1024 * 1024 + (size_t)h * 64 * 1024;
                const float* Bm = INP(c, I_A_W_UV) + (size_t)j * 16 * 128 * 64 + (size_t)h * 128 * 64;
                bf16* C = (bf16*)(ws + WS_WAOV) + (size_t)j * 1024 * 2048 + h * 128;
                small_gemm_tile(c, A, 1, 1024, Bm, 64, 1, 64, C, 2048, nt * 64, kt * 64, 1.0f);
            }
        }
        (void)tbase;
    }
}

template <int FP4> __device__ __forceinline__ void peer_pack_row16(const float (&v)[16], unsigned char* dst) {
    if (FP4) { v2u w;
#pragma unroll
        for (int d = 0; d < 2; ++d) { unsigned p = 0u;
            p = __builtin_amdgcn_cvt_scalef32_pk_fp4_f32(p, v[8 * d + 0], v[8 * d + 1], 1.0f, 0); p = __builtin_amdgcn_cvt_scalef32_pk_fp4_f32(p, v[8 * d + 2], v[8 * d + 3], 1.0f, 1);
            p = __builtin_amdgcn_cvt_scalef32_pk_fp4_f32(p, v[8 * d + 4], v[8 * d + 5], 1.0f, 2); p = __builtin_amdgcn_cvt_scalef32_pk_fp4_f32(p, v[8 * d + 6], v[8 * d + 7], 1.0f, 3);
            w[d] = p; }
        *(v2u*)dst = w;
    } else { v4u w;
#pragma unroll
        for (int q = 0; q < 4; ++q) { int pa = 0; pa = __builtin_amdgcn_cvt_pk_fp8_f32(v[4 * q], v[4 * q + 1], pa, false); pa = __builtin_amdgcn_cvt_pk_fp8_f32(v[4 * q + 2], v[4 * q + 3], pa, true); w[q] = (unsigned)pa; }
        *(v4u*)dst = w;
    }
}

__device__ __forceinline__ void phase_ln1(const Ctx& c, int layer) {
    const int gw = c.bid * NWAVES + c.wave, NGW = c.G * NWAVES;
    const float* gain = INP(c, I_LN1_G) + layer * DM; const float* bias = INP(c, I_LN1_B) + layer * DM;
    bf16* xb = (bf16*)(c.ws + ((layer & 1) ? WS_XB1 : WS_XB0));
    for (int m = gw; m < T_TOK; m += NGW) {
        float v[16]; load_row16_bf(xb + (size_t)m * DM, v, c.lane);
        ln_store_row(v, gain, bias, nullptr, xb + (size_t)m * DM, c.lane);
    }
    {
        const float* U = INP(c, I_PEER_U) + (size_t)layer * 16384 * 1024; const float* V = INP(c, I_PEER_V) + (size_t)layer * 16384 * 1024;
        unsigned char* tu = c.ws + WS_TABU; unsigned char* tv = c.ws + WS_TABV;
        const size_t n16 = (size_t)16384 * 1024 / 16;
        for (size_t e = (size_t)c.bid * NTHR + c.tid; e < n16; e += (size_t)c.G * NTHR) {
            float ua[16], va[16];
#pragma unroll
            for (int q = 0; q < 4; ++q) { const f32x4 a4 = *(const f32x4*)(U + e * 16 + 4 * q) * PEER_USCALE, b4 = *(const f32x4*)(V + e * 16 + 4 * q) * PEER_VSCALE;
#pragma unroll
                for (int j = 0; j < 4; ++j) { ua[4 * q + j] = a4[j]; va[4 * q + j] = b4[j]; } }
            if (PEER_U4 && PEER_V4) {
                const size_t row = e >> 6, l16 = e & 63; peer_pack_row16<1>(ua, tu + row * 1024 + l16 * 8); peer_pack_row16<1>(va, tu + row * 1024 + 512 + l16 * 8);
            } else { peer_pack_row16<PEER_U4>(ua, tu + e * (PEER_UROW / 64)); peer_pack_row16<PEER_V4>(va, tv + e * (PEER_VROW / 64)); }
        }
    }
    {
        const float* P = INP(c, I_P) + (size_t)layer * T_TOK * 256; bf16* pb = (bf16*)(c.ws + WS_M + M_PB);
        const size_t n8 = (size_t)T_TOK * 256 / 8;
        for (size_t e = (size_t)c.bid * NTHR + c.tid; e < n8; e += (size_t)c.G * NTHR) {
            const f32x4 a = *(const f32x4*)(P + e * 8), b = *(const f32x4*)(P + e * 8 + 4);
            v4u w; w.x = pk2(a[0], a[1]); w.y = pk2(a[2], a[3]); w.z = pk2(b[0], b[1]); w.w = pk2(b[2], b[3]); *(v4u*)(pb + e * 8) = w;
        }
    }
}

using pg8::Unit;
constexpr int BMT = 256, HALFT = 128;

struct EpiResid {
    static constexpr bool PERM = false, AFTER_DRAIN = false;
    bf16* Y1; float alpha; const bf16* Xb;
    __device__ __forceinline__ void operator()(const pg8::f32x4 (&acc)[2][2][4][2], const Unit& u, int wr, int wc, int fr, int fq) const {
        const int row0 = u.pm * BMT + wr * 64 + fr, col0 = u.pn * BMT + wc * 32 + 4 * fq;
#pragma unroll
        for (int ai = 0; ai < 2; ++ai)
#pragma unroll
            for (int m = 0; m < 4; ++m) { const size_t roff = (size_t)(row0 + ai * HALFT + m * 16) * DM + col0; bf16* rowp = Y1 + roff; const bf16* srcp = Xb + roff;
                v2u xv[2][2];
#pragma unroll
                for (int bj = 0; bj < 2; ++bj)
#pragma unroll
                    for (int n = 0; n < 2; ++n) xv[bj][n] = *(const v2u*)(srcp + bj * HALFT + n * 16);
#pragma unroll
                for (int bj = 0; bj < 2; ++bj)
#pragma unroll
                    for (int n = 0; n < 2; ++n) { const pg8::f32x4 xf = {bflo(xv[bj][n].x), bfhi(xv[bj][n].x), bflo(xv[bj][n].y), bfhi(xv[bj][n].y)};
                        const pg8::f32x4 y = xf * alpha + acc[ai][bj][m][n];
                        v2u w; w.x = pk2(y[0], y[1]); w.y = pk2(y[2], y[3]); *(v2u*)(rowp + bj * HALFT + n * 16) = w; } }
    }
};

struct EpiF32T {
    static constexpr bool PERM = true, AFTER_DRAIN = false;
    bf16* C;
    __device__ __forceinline__ void operator()(const pg8::f32x4 (&acc)[2][2][4][2], const Unit& u, int wr, int wc, int fr, int fq) const {
        const int row0 = u.pm * BMT + wr * 64 + fr, cg0 = (u.pn * BMT + wc * 32 + 8 * fq) >> 3;
#pragma unroll
        for (int ai = 0; ai < 2; ++ai)
#pragma unroll
            for (int m = 0; m < 4; ++m) { const int r = row0 + ai * HALFT + m * 16; bf16* bp = C + (((size_t)(r >> 6) * 256 + cg0) * 64 + (r & 63)) * 8;
#pragma unroll
                for (int bj = 0; bj < 2; ++bj) { const pg8::f32x4 v0 = acc[ai][bj][m][0], v1 = acc[ai][bj][m][1];
                    v4u w; w.x = pk2(v0[0], v0[1]); w.y = pk2(v0[2], v0[3]); w.z = pk2(v1[0], v1[1]); w.w = pk2(v1[2], v1[3]);
                    *(v4u*)(bp + (size_t)(bj * 16) * 512) = w; } }
    }
};

template <int ACT0  > struct EpiBf16R {
    static constexpr bool PERM = true, AFTER_DRAIN = false;
    bf16 *O0, *O1, *O2; int ld0, ld1, ld2, c1, c2;
    __device__ __forceinline__ void operator()(const pg8::f32x4 (&acc)[2][2][4][2], const Unit& u, int wr, int wc, int fr, int fq) const {
        const int row0 = u.pm * BMT + wr * 64 + fr; int colt = u.pn * BMT; bf16* base; int ld; bool act = false;
        if (colt < c1) { base = O0; ld = ld0; act = (ACT0 == 1); } else if (colt < c2) { base = O1; ld = ld1; colt -= c1; } else { base = O2; ld = ld2; colt -= c2; }
        const int col0 = colt + wc * 32 + 8 * fq;
#pragma unroll
        for (int ai = 0; ai < 2; ++ai)
#pragma unroll
            for (int m = 0; m < 4; ++m) { bf16* rowp = base + (size_t)(row0 + ai * HALFT + m * 16) * ld + col0;
#pragma unroll
                for (int bj = 0; bj < 2; ++bj) { pg8::f32x4 v0 = acc[ai][bj][m][0], v1 = acc[ai][bj][m][1];
                    if (ACT0 == 1 && act) {
#pragma unroll
                        for (int j = 0; j < 4; ++j) { v0[j] = gelu_tanh(v0[j]); v1[j] = gelu_tanh(v1[j]); } }
                    v4u w; w.x = pk2(v0[0], v0[1]); w.y = pk2(v0[2], v0[3]); w.z = pk2(v1[0], v1[1]); w.w = pk2(v1[2], v1[3]);
                    *(v4u*)(rowp + bj * HALFT) = w; } }
    }
};

struct EpiRetIn {
    static constexpr bool PERM = true, AFTER_DRAIN = false;
    bf16 *Q, *K, *V; const float* cs; const float* sn;
    __device__ __forceinline__ void operator()(const pg8::f32x4 (&acc)[2][2][4][2], const Unit& u, int wr, int wc, int fr, int fq) const {
        const int row0 = u.pm * BMT + wr * 64 + fr; const int colt = u.pn * BMT;
        if (colt >= 2048) {
            const int col0 = colt - 2048 + wc * 32 + 8 * fq;
#pragma unroll
            for (int ai = 0; ai < 2; ++ai)
#pragma unroll
                for (int m = 0; m < 4; ++m) { bf16* rowp = V + (size_t)(row0 + ai * HALFT + m * 16) * 2048 + col0;
#pragma unroll
                    for (int bj = 0; bj < 2; ++bj) { const pg8::f32x4 v0 = acc[ai][bj][m][0], v1 = acc[ai][bj][m][1];
                        v4u w; w.x = pk2(v0[0], v0[1]); w.y = pk2(v0[2], v0[3]); w.z = pk2(v1[0], v1[1]); w.w = pk2(v1[2], v1[3]);
                        *(v4u*)(rowp + bj * HALFT) = w; } }
        } else {
            const bool isk = colt >= 1024; bf16* base = isk ? K : Q; const float sc = isk ? 0.0625f : 1.0f;
            const int col0 = (isk ? colt - 1024 : colt) + wc * 32 + 8 * fq; const int f0 = wc * 32 + 8 * fq;
#pragma unroll
            for (int ai = 0; ai < 2; ++ai)
#pragma unroll
                for (int m = 0; m < 4; ++m) { const int row = row0 + ai * HALFT + m * 16; const int pos = row & (SEQ - 1);
                    const pg8::f32x4 c0 = *(const pg8::f32x4*)(cs + pos * 128 + f0), c1 = *(const pg8::f32x4*)(cs + pos * 128 + f0 + 4);
                    const pg8::f32x4 s0 = *(const pg8::f32x4*)(sn + pos * 128 + f0), s1 = *(const pg8::f32x4*)(sn + pos * 128 + f0 + 4);
                    const pg8::f32x4 a0 = acc[ai][0][m][0] * sc, a1 = acc[ai][0][m][1] * sc, b0 = acc[ai][1][m][0] * sc, b1 = acc[ai][1][m][1] * sc;
                    const pg8::f32x4 r0 = a0 * c0 - b0 * s0, r1 = a1 * c1 - b1 * s1, q0 = a0 * s0 + b0 * c0, q1 = a1 * s1 + b1 * c1;
                    bf16* rowp = base + (size_t)row * 1024 + col0;
                    v4u w; w.x = pk2(r0[0], r0[1]); w.y = pk2(r0[2], r0[3]); w.z = pk2(r1[0], r1[1]); w.w = pk2(r1[2], r1[3]); *(v4u*)(rowp) = w;
                    v4u w2; w2.x = pk2(q0[0], q0[1]); w2.y = pk2(q0[2], q0[3]); w2.z = pk2(q1[0], q1[1]); w2.w = pk2(q1[2], q1[3]); *(v4u*)(rowp + HALFT) = w2; }
        }
    }
};

struct EpiRetGate {
    static constexpr bool PERM = true, AFTER_DRAIN = false;
    bf16* O; const float* STAT;
    __device__ __forceinline__ void operator()(const pg8::f32x4 (&acc)[2][2][4][2], const Unit& u, int wr, int wc, int fr, int fq) const {
        const int row0 = u.pm * BMT + wr * 64 + fr; const int head = u.pn >> 1; const int col0 = u.pn * BMT + wc * 32 + 8 * fq;
#pragma unroll
        for (int ai = 0; ai < 2; ++ai)
#pragma unroll
            for (int m = 0; m < 4; ++m) { const int row = row0 + ai * HALFT + m * 16;
                const pg8::f32x4 st = *(const pg8::f32x4*)(STAT + (size_t)row * 16 + head * 4);
                const float mean = (st[0] + st[2]) * (1.0f / 512.0f); const float var = (st[1] + st[3]) * (1.0f / 512.0f) - mean * mean;
                const float rstd = __builtin_amdgcn_rsqf(fmaxf(var, 0.f) + 1e-5f);
                bf16* rowp = O + (size_t)row * 2048 + col0;
#pragma unroll
                for (int bj = 0; bj < 2; ++bj) { const v4u ov = *(const v4u*)(rowp + bj * HALFT);
                    const pg8::f32x4 g0 = acc[ai][bj][m][0], g1 = acc[ai][bj][m][1];
                    float o[8] = {bflo(ov.x), bfhi(ov.x), bflo(ov.y), bfhi(ov.y), bflo(ov.z), bfhi(ov.z), bflo(ov.w), bfhi(ov.w)};
                    float r[8];
#pragma unroll
                    for (int j = 0; j < 8; ++j) { const float g = j < 4 ? g0[j] : g1[j - 4]; r[j] = g * sigmoidf_(g) * (o[j] - mean) * rstd; }
                    v4u w; w.x = pk2(r[0], r[1]); w.y = pk2(r[2], r[3]); w.z = pk2(r[4], r[5]); w.w = pk2(r[6], r[7]);
                    *(v4u*)(rowp + bj * HALFT) = w; } }
    }
};

struct EpiPle {
    static constexpr bool PERM = true, AFTER_DRAIN = false;
    const bf16* Xin; const bf16* PP; bf16* XBo; const float* bg; float* OutF;
    __device__ __forceinline__ void operator()(const pg8::f32x4 (&acc)[2][2][4][2], const Unit& u, int wr, int wc, int fr, int fq) const {
        const int row0 = u.pm * BMT + wr * 64 + fr; const int col0 = u.pn * BMT + wc * 32 + 8 * fq;
        pg8::f32x4 bv[2][2];
#pragma unroll
        for (int bj = 0; bj < 2; ++bj)
#pragma unroll
            for (int n = 0; n < 2; ++n) bv[bj][n] = *(const pg8::f32x4*)(bg + col0 + bj * HALFT + 4 * n);
#pragma unroll
        for (int ai = 0; ai < 2; ++ai)
#pragma unroll
            for (int m = 0; m < 4; ++m) { const size_t off = (size_t)(row0 + ai * HALFT + m * 16) * DM + col0;
#pragma unroll
                for (int bj = 0; bj < 2; ++bj) {
                    const v4u pv = *(const v4u*)(PP + off + bj * HALFT), xv = *(const v4u*)(Xin + off + bj * HALFT);
                    const float pp[8] = {bflo(pv.x), bfhi(pv.x), bflo(pv.y), bfhi(pv.y), bflo(pv.z), bfhi(pv.z), bflo(pv.w), bfhi(pv.w)};
                    const float xx[8] = {bflo(xv.x), bfhi(xv.x), bflo(xv.y), bfhi(xv.y), bflo(xv.z), bfhi(xv.z), bflo(xv.w), bfhi(xv.w)};
                    pg8::f32x4 o0, o1;
#pragma unroll
                    for (int j = 0; j < 4; ++j) { o0[j] = xx[j] + sigmoidf_(acc[ai][bj][m][0][j] + bv[bj][0][j]) * pp[j];
                                                  o1[j] = xx[4 + j] + sigmoidf_(acc[ai][bj][m][1][j] + bv[bj][1][j]) * pp[4 + j]; }
                    if (OutF) { *(pg8::f32x4*)(OutF + off + bj * HALFT) = o0; *(pg8::f32x4*)(OutF + off + bj * HALFT + 4) = o1; }
                    else { v4u w; w.x = pk2(o0[0], o0[1]); w.y = pk2(o0[2], o0[3]); w.z = pk2(o1[0], o1[1]); w.w = pk2(o1[2], o1[3]);
                        *(v4u*)(XBo + off + bj * HALFT) = w; } } }
    }
};

template <class Epi>
__device__ __forceinline__ void run_gemm(const Ctx& c, const bf16* A, const bf16* Bt, int N, int K, const Epi& E) {
    asm volatile("" : "+s"(K), "+s"(N));
    pg8::Gemm g{A, Bt, T_TOK, N, K}; pg8::StaticOrder S; S.init(T_TOK, N, c.G, c.bid);
    pg8::gemm_phase<Epi, pg8::StaticOrder, false>((PG8_LAS unsigned char*)c.lds, g, S, E, nullptr);
}

__device__ __forceinline__ unsigned sort_key(float f) { const unsigned u = __builtin_bit_cast(unsigned, f); return (u & 0x80000000u) ? ~u : (u | 0x80000000u); }
__device__ __forceinline__ unsigned half_sel(unsigned long long m, int half) { return half ? (unsigned)(m >> 32) : (unsigned)m; }

#define PK_CE(i, j) { const unsigned hi_ = b[i] > b[j] ? b[i] : b[j], lo_ = b[i] > b[j] ? b[j] : b[i]; b[i] = hi_; b[j] = lo_; }
__device__ __forceinline__ void sort16_desc(unsigned (&b)[16]) {
#define CE(i, j) PK_CE(i, j)
    CE(0,1) CE(2,3) CE(0,2) CE(1,3) CE(1,2) CE(4,5) CE(6,7) CE(4,6) CE(5,7) CE(5,6) CE(0,4) CE(2,6) CE(2,4) CE(1,5) CE(3,7) CE(3,5) CE(1,2) CE(3,4) CE(5,6) CE(8,9) CE(10,11) CE(8,10) CE(9,11) CE(9,10) CE(12,13) CE(14,15) CE(12,14) CE(13,15) CE(13,14) CE(8,12) CE(10,14) CE(10,12) CE(9,13) CE(11,15) CE(11,13) CE(9,10) CE(11,12) CE(13,14) CE(0,8) CE(4,12) CE(4,8) CE(2,10) CE(6,14) CE(6,10) CE(2,4) CE(6,8) CE(10,12) CE(1,9) CE(5,13) CE(5,9) CE(3,11) CE(7,15) CE(7,11) CE(3,5) CE(7,9) CE(11,13) CE(1,2) CE(3,4) CE(5,6) CE(7,8) CE(9,10) CE(11,12) CE(13,14)
#undef CE
}
__device__ __forceinline__ void merge16_desc(unsigned (&t)[16], const unsigned (&bb)[16]) {
    unsigned b[16];
#pragma unroll
    for (int i = 0; i < 16; ++i) b[i] = t[i] > bb[15 - i] ? t[i] : bb[15 - i];
#pragma unroll
    for (int d = 8; d >= 1; d >>= 1)
#pragma unroll
        for (int i = 0; i < 16; ++i) if ((i & d) == 0) PK_CE(i, i + d)
#pragma unroll
    for (int i = 0; i < 16; ++i) t[i] = b[i];
}
__device__ __forceinline__ void ins16(unsigned (&t)[16], unsigned x) {
#pragma unroll
    for (int p = 0; p < 16; ++p) { const unsigned hi = x > t[p] ? x : t[p], lo = x > t[p] ? t[p] : x; t[p] = hi; x = lo; }
}
__device__ __forceinline__ float unsort_key(unsigned k) { const unsigned u = (k & 0x80000000u) ? (k & 0x7fffffffu) : ~k; return __builtin_bit_cast(float, u); }
__device__ __forceinline__ void phase_peer_topk(const Ctx& c) {
    const int gw = c.bid * NWAVES + c.wave, NGW = c.G * NWAVES, lane = c.lane;
    const bf16* SCT = (const bf16*)(c.ws + WS_M + M_SC); int* IDS = (int*)(c.ws + WS_M + M_IDS); float* GATES = (float*)(c.ws + WS_M + M_GATES);
    LAS unsigned char* lidx = c.lds + c.wave * 2048 + lane * 32;
    for (int wu = gw; wu < 8192; wu += NGW) {
        const int tblk = wu >> 3, hd = wu & 7, tok = tblk * 64 + lane;
        unsigned tA[16], tB[16];
        const v4u* pa = (const v4u*)SCT + ((size_t)tblk * 256 + hd * 32) * 64 + lane; const v4u* pb = pa + 16 * 64;
#pragma unroll 1
        for (int blk = 0; blk < 8; ++blk) {
            unsigned ka[16], kb[16];
#pragma unroll
            for (int gg = 0; gg < 2; ++gg) { const v4u xa = pa[(2 * blk + gg) * 64], xb = pb[(2 * blk + gg) * 64];
#pragma unroll
                for (int j = 0; j < 4; ++j) { const unsigned lo0 = (unsigned)(127 - (16 * blk + 8 * gg + 2 * j)), lo1 = lo0 - 1u;
                    ka[8 * gg + 2 * j] = (sort_key(bflo(xa[j])) & ~127u) | lo0; ka[8 * gg + 2 * j + 1] = (sort_key(bfhi(xa[j])) & ~127u) | lo1;
                    kb[8 * gg + 2 * j] = (sort_key(bflo(xb[j])) & ~127u) | lo0; kb[8 * gg + 2 * j + 1] = (sort_key(bfhi(xb[j])) & ~127u) | lo1; } }
            sort16_desc(ka); sort16_desc(kb);
            if (blk == 0) {
#pragma unroll
                for (int i = 0; i < 16; ++i) { tA[i] = ka[i]; tB[i] = kb[i]; }
            } else { merge16_desc(tA, ka); merge16_desc(tB, kb); }
        }
        float a[16], b[16];
#pragma unroll
        for (int i = 0; i < 16; ++i) { a[i] = unsort_key(tA[i] & ~127u); b[i] = unsort_key(tB[i] & ~127u); lidx[i] = (unsigned char)(127u - (tA[i] & 127u)); lidx[16 + i] = (unsigned char)(127u - (tB[i] & 127u)); }
        unsigned uu[16];
        uu[0] = (sort_key(a[0] + b[0]) & ~255u) | 0u;
        uu[1] = (sort_key(a[0] + b[1]) & ~255u) | 1u;
        uu[2] = (sort_key(a[0] + b[2]) & ~255u) | 2u;
        uu[3] = (sort_key(a[0] + b[3]) & ~255u) | 3u;
        uu[4] = (sort_key(a[0] + b[4]) & ~255u) | 4u;
        uu[5] = (sort_key(a[0] + b[5]) & ~255u) | 5u;
        uu[6] = (sort_key(a[0] + b[6]) & ~255u) | 6u;
        uu[7] = (sort_key(a[0] + b[7]) & ~255u) | 7u;
        uu[8] = (sort_key(a[0] + b[8]) & ~255u) | 8u;
        uu[9] = (sort_key(a[0] + b[9]) & ~255u) | 9u;
        uu[10] = (sort_key(a[0] + b[10]) & ~255u) | 10u;
        uu[11] = (sort_key(a[0] + b[11]) & ~255u) | 11u;
        uu[12] = (sort_key(a[0] + b[12]) & ~255u) | 12u;
        uu[13] = (sort_key(a[0] + b[13]) & ~255u) | 13u;
        uu[14] = (sort_key(a[0] + b[14]) & ~255u) | 14u;
        uu[15] = (sort_key(a[0] + b[15]) & ~255u) | 15u;
        sort16_desc(uu);
        unsigned cb[16];
        cb[0] = (sort_key(a[1] + b[0]) & ~255u) | 16u;
        cb[1] = (sort_key(a[1] + b[1]) & ~255u) | 17u;
        cb[2] = (sort_key(a[1] + b[2]) & ~255u) | 18u;
        cb[3] = (sort_key(a[1] + b[3]) & ~255u) | 19u;
        cb[4] = (sort_key(a[1] + b[4]) & ~255u) | 20u;
        cb[5] = (sort_key(a[1] + b[5]) & ~255u) | 21u;
        cb[6] = (sort_key(a[1] + b[6]) & ~255u) | 22u;
        cb[7] = (sort_key(a[1] + b[7]) & ~255u) | 23u;
        cb[8] = (sort_key(a[2] + b[0]) & ~255u) | 32u;
        cb[9] = (sort_key(a[2] + b[1]) & ~255u) | 33u;
        cb[10] = (sort_key(a[2] + b[2]) & ~255u) | 34u;
        cb[11] = (sort_key(a[2] + b[3]) & ~255u) | 35u;
        cb[12] = (sort_key(a[2] + b[4]) & ~255u) | 36u;
        cb[13] = (sort_key(a[3] + b[0]) & ~255u) | 48u;
        cb[14] = (sort_key(a[3] + b[1]) & ~255u) | 49u;
        cb[15] = (sort_key(a[3] + b[2]) & ~255u) | 50u;
        sort16_desc(cb); merge16_desc(uu, cb);
        cb[0] = (sort_key(a[3] + b[3]) & ~255u) | 51u;
        cb[1] = (sort_key(a[4] + b[0]) & ~255u) | 64u;
        cb[2] = (sort_key(a[4] + b[1]) & ~255u) | 65u;
        cb[3] = (sort_key(a[4] + b[2]) & ~255u) | 66u;
        cb[4] = (sort_key(a[5] + b[0]) & ~255u) | 80u;
        cb[5] = (sort_key(a[5] + b[1]) & ~255u) | 81u;
        cb[6] = (sort_key(a[6] + b[0]) & ~255u) | 96u;
        cb[7] = (sort_key(a[6] + b[1]) & ~255u) | 97u;
        cb[8] = (sort_key(a[7] + b[0]) & ~255u) | 112u;
        cb[9] = (sort_key(a[7] + b[1]) & ~255u) | 113u;
        cb[10] = (sort_key(a[8] + b[0]) & ~255u) | 128u;
        cb[11] = (sort_key(a[9] + b[0]) & ~255u) | 144u;
        cb[12] = (sort_key(a[10] + b[0]) & ~255u) | 160u;
        cb[13] = (sort_key(a[11] + b[0]) & ~255u) | 176u;
        cb[14] = (sort_key(a[12] + b[0]) & ~255u) | 192u;
        cb[15] = (sort_key(a[13] + b[0]) & ~255u) | 208u;
        sort16_desc(cb); merge16_desc(uu, cb);
        cb[0] = (sort_key(a[14] + b[0]) & ~255u) | 224u;
        cb[1] = (sort_key(a[15] + b[0]) & ~255u) | 240u;
        cb[2] = 0u;
        cb[3] = 0u;
        cb[4] = 0u;
        cb[5] = 0u;
        cb[6] = 0u;
        cb[7] = 0u;
        cb[8] = 0u;
        cb[9] = 0u;
        cb[10] = 0u;
        cb[11] = 0u;
        cb[12] = 0u;
        cb[13] = 0u;
        cb[14] = 0u;
        cb[15] = 0u;
        sort16_desc(cb); merge16_desc(uu, cb);
        LDS_WAIT(); asm volatile("" ::: "memory");
        float sc[16], sum = 0.f; int eid[16];
        const float s0 = unsort_key(uu[0] & ~255u);
#pragma unroll
        for (int r = 0; r < 16; ++r) { const float s = unsort_key(uu[r] & ~255u); sc[r] = __expf(s - s0); sum += sc[r];
            const int i = (uu[r] >> 4) & 15, j = uu[r] & 15; eid[r] = (int)lidx[i] * 128 + (int)lidx[16 + j]; }
        const float inv = 1.0f / sum;
#pragma unroll
        for (int q = 0; q < 4; ++q) {
            *(v4u*)(IDS + (size_t)tok * 128 + hd * 16 + 4 * q) = (v4u){(unsigned)eid[4 * q], (unsigned)eid[4 * q + 1], (unsigned)eid[4 * q + 2], (unsigned)eid[4 * q + 3]};
            *(f32x4*)(GATES + (size_t)tok * 128 + hd * 16 + 4 * q) = (f32x4){sc[4 * q] * inv, sc[4 * q + 1] * inv, sc[4 * q + 2] * inv, sc[4 * q + 3] * inv};
        }
        LDS_WAIT(); asm volatile("" ::: "memory");
    }
}

#if !(PEER_U4 && PEER_V4)
#error "this gather expects both expert tables in fp4 (interleaved rows)"
#endif
typedef int v8i_t __attribute__((ext_vector_type(8)));
constexpr float PEER_XSCALE = 8.0f;
struct PeerGroup { v4u ua[8]; float g4[4]; };
__device__ __forceinline__ void peer_load(PeerGroup& B, const unsigned char* TAB, int idv, float gv, int kb, int lane) {
    const int m = lane & 15, kg = lane >> 4;
    const int idm = __builtin_amdgcn_ds_bpermute(4 * (kb + m), idv);
    const unsigned char* up = TAB + (size_t)idm * 1024 + 16 * kg;
#pragma unroll
    for (int cc = 0; cc < 8; ++cc) B.ua[cc] = *(const v4u*)(up + 64 * cc);
#pragma unroll
    for (int r = 0; r < 4; ++r) B.g4[r] = __builtin_bit_cast(float, __builtin_amdgcn_ds_bpermute(4 * (kb + 4 * kg + r), __builtin_bit_cast(int, gv)));
}
template <int J> __device__ __forceinline__ f32x2 fp4_pair(const v4u& w) { return __builtin_amdgcn_cvt_scalef32_pk_f32_fp4(w[J >> 2], 1.0f, J & 3); }
__device__ __forceinline__ void peer_compute(const PeerGroup& B, const unsigned char* TAB, int idv, int kb, const LAS unsigned char* xb8, f32x2 (&y2)[16], int lane) {
    const int hf = lane >> 5, l31 = lane & 31;
    v4u vv[8];
#pragma unroll
    for (int e = 0; e < 8; ++e) {
        const int ida = __builtin_amdgcn_readlane(idv, kb + 2 * e), idb = __builtin_amdgcn_readlane(idv, kb + 2 * e + 1);
        vv[e] = *(const v4u*)(TAB + (size_t)(hf ? idb : ida) * 1024 + 512 + 16 * l31);
    }
    f32x4 d = {0.f, 0.f, 0.f, 0.f};
#pragma unroll
    for (int cc = 0; cc < 8; ++cc) {
        asm volatile("" ::: "memory");
        const v4u b0 = *(const LAS v4u*)(xb8 + 128 * cc), b1 = *(const LAS v4u*)(xb8 + 128 * cc + 64);
        const v8i_t bx = {(int)b0.x, (int)b0.y, (int)b0.z, (int)b0.w, (int)b1.x, (int)b1.y, (int)b1.z, (int)b1.w};
        const v8i_t ax = {(int)B.ua[cc].x, (int)B.ua[cc].y, (int)B.ua[cc].z, (int)B.ua[cc].w, 0, 0, 0, 0};
        d = __builtin_amdgcn_mfma_scale_f32_16x16x128_f8f6f4(ax, bx, d, 4  , 0  , 0, 127, 0, 127);
    }
    float a4[4];
#pragma unroll
    for (int r = 0; r < 4; ++r) a4[r] = gelu_tanh(d[r] * (1.0f / (PEER_USCALE * PEER_XSCALE))) * B.g4[r] * (1.0f / PEER_VSCALE);
#pragma unroll
    for (int e = 0; e < 8; ++e) {
        const int ma = 2 * e, mb = 2 * e + 1;
        const float a0 = __builtin_bit_cast(float, __builtin_amdgcn_readlane(__builtin_bit_cast(int, a4[ma & 3]), 16 * (ma >> 2))), a1 = __builtin_bit_cast(float, __builtin_amdgcn_readlane(__builtin_bit_cast(int, a4[mb & 3]), 16 * (mb >> 2)));
        const float a = hf ? a1 : a0; const f32x2 a2 = {a, a};
#define PEER_AXPY(J) y2[J] = __builtin_elementwise_fma(a2, fp4_pair<J>(vv[e]), y2[J]);
        PEER_AXPY(0) PEER_AXPY(1) PEER_AXPY(2) PEER_AXPY(3) PEER_AXPY(4) PEER_AXPY(5) PEER_AXPY(6) PEER_AXPY(7)
        PEER_AXPY(8) PEER_AXPY(9) PEER_AXPY(10) PEER_AXPY(11) PEER_AXPY(12) PEER_AXPY(13) PEER_AXPY(14) PEER_AXPY(15)
#undef PEER_AXPY
    }
}
template <class BarFn>
__device__ __forceinline__ void phase_peer_gather(const Ctx& c, int layer, const BarFn&) {
    const int gw = c.bid * NWAVES + c.wave, NGW = c.G * NWAVES;
    const int* IDS = (const int*)(c.ws + WS_M + M_IDS); const float* GATES = (const float*)(c.ws + WS_M + M_GATES);
    const unsigned char* TAB = c.ws + WS_TABU;
    const float* gain = INP(c, I_LN2_G) + layer * DM; const float* bias = INP(c, I_LN2_B) + layer * DM;
    bf16* xb = (bf16*)(c.ws + ((layer & 1) ? WS_XB1 : WS_XB0));
    const int lane = c.lane, hf = lane >> 5, l31 = lane & 31;
    LAS unsigned char* xbase = c.lds + c.wave * 3072;
    { unsigned z = 0u; asm volatile("" : "+v"(z));
      *(LAS v4u*)(xbase + 2048 + 16 * lane) = (v4u){z, z, z, z}; }
    const bool col0 = (lane & 15) == 0;
    auto stage_x = [&](int tk, int buf) {
        const bf16* xr = xb + (size_t)tk * DM + 32 * l31; v4u w0, w1;
#pragma unroll
        for (int q = 0; q < 4; ++q) { const v4u xv = *(const v4u*)(xr + 8 * q);
            int pa = 0, pb = 0;
            pa = __builtin_amdgcn_cvt_pk_fp8_f32(bflo(xv.x) * PEER_XSCALE, bfhi(xv.x) * PEER_XSCALE, pa, false); pa = __builtin_amdgcn_cvt_pk_fp8_f32(bflo(xv.y) * PEER_XSCALE, bfhi(xv.y) * PEER_XSCALE, pa, true);
            pb = __builtin_amdgcn_cvt_pk_fp8_f32(bflo(xv.z) * PEER_XSCALE, bfhi(xv.z) * PEER_XSCALE, pb, false); pb = __builtin_amdgcn_cvt_pk_fp8_f32(bflo(xv.w) * PEER_XSCALE, bfhi(xv.w) * PEER_XSCALE, pb, true);
            if (q < 2) { w0[2 * q] = (unsigned)pa; w0[2 * q + 1] = (unsigned)pb; } else { w1[2 * q - 4] = (unsigned)pa; w1[2 * q - 3] = (unsigned)pb; } }
        if (hf == 0) { *(LAS v4u*)(xbase + 1024 * buf + 32 * l31) = w0; *(LAS v4u*)(xbase + 1024 * buf + 32 * l31 + 16) = w1; } };
    int tok = gw, par = 0;
    int idA = 0, idB = 0; float gA = 0.f, gB = 0.f;
    PeerGroup G0, G1;
    if (tok < T_TOK) {
        idA = IDS[(size_t)tok * 128 + lane]; idB = IDS[(size_t)tok * 128 + 64 + lane]; gA = GATES[(size_t)tok * 128 + lane]; gB = GATES[(size_t)tok * 128 + 64 + lane];
        stage_x(tok, 0);
        peer_load(G0, TAB, idA, gA, 0, lane);
    }
#pragma unroll 1
    while (tok < T_TOK) {
        const int ntok = tok + NGW; const bool has_next = ntok < T_TOK;
        int nidA = 0, nidB = 0; float ngA = 0.f, ngB = 0.f;
        if (has_next) { nidA = IDS[(size_t)ntok * 128 + lane]; nidB = IDS[(size_t)ntok * 128 + 64 + lane]; ngA = GATES[(size_t)ntok * 128 + lane]; ngB = GATES[(size_t)ntok * 128 + 64 + lane]; }
        const LAS unsigned char* xb8 = col0 ? (xbase + 1024 * par + 16 * (lane >> 4)) : (xbase + 2048);
        f32x2 y2[16];
#pragma unroll
        for (int j = 0; j < 16; ++j) y2[j] = (f32x2){0.f, 0.f};
        v4u xres[2] = {(v4u){0u, 0u, 0u, 0u}, (v4u){0u, 0u, 0u, 0u}};
        LDS_WAIT(); asm volatile("" ::: "memory");
#define PEER_LD(Gx, g) peer_load(Gx, TAB, ((g) >= 4) ? idB : idA, ((g) >= 4) ? gB : gA, ((g) & 3) * 16, lane)
#define PEER_CP(Gx, g) peer_compute(Gx, TAB, ((g) >= 4) ? idB : idA, ((g) & 3) * 16, xb8, y2, lane)
#pragma unroll 1
        for (int g = 0; g < 8; g += 2) {
            PEER_LD(G1, g + 1); PEER_CP(G0, g);
            if (g == 2 && has_next) stage_x(ntok, par ^ 1);
            if (g + 2 < 8) PEER_LD(G0, g + 2); else if (has_next) peer_load(G0, TAB, nidA, ngA, 0, lane);
            if (g == 6) { xres[0] = *(const v4u*)(xb + (size_t)tok * DM + 32 * l31 + 16 * hf); xres[1] = *(const v4u*)(xb + (size_t)tok * DM + 32 * l31 + 16 * hf + 8); }
            PEER_CP(G1, g + 1);
        }
#undef PEER_LD
#undef PEER_CP
        float z[16];
#pragma unroll
        for (int j = 0; j < 16; ++j) { const float tx = y2[j].x + __shfl_xor(y2[j].x, 32), ty = y2[j].y + __shfl_xor(y2[j].y, 32); y2[j] = (f32x2){tx, ty}; }
#pragma unroll
        for (int j = 0; j < 8; ++j) { const unsigned xw = xres[j >> 2][j & 3]; z[2 * j] = (hf ? y2[8 + j].x : y2[j].x) + ALPHA_DN * bflo(xw); z[2 * j + 1] = (hf ? y2[8 + j].y : y2[j].y) + ALPHA_DN * bfhi(xw); }
        float s = 0.f;
#pragma unroll
        for (int j = 0; j < 16; ++j) s += z[j];
        const float mean = wave_sum(s) * (1.f / 1024.f);
        float s2 = 0.f;
#pragma unroll
        for (int j = 0; j < 16; ++j) { z[j] -= mean; s2 += z[j] * z[j]; }
        const float rstd = __builtin_amdgcn_rsqf(wave_sum(s2) * (1.f / 1024.f) + 1e-5f);
        const int col = 32 * l31 + 16 * hf; float o[16];
#pragma unroll
        for (int q = 0; q < 4; ++q) { const f32x4 gq = *(const f32x4*)(gain + col + 4 * q), bq = *(const f32x4*)(bias + col + 4 * q); f32x4 r;
#pragma unroll
            for (int j = 0; j < 4; ++j) { r[j] = z[4 * q + j] * rstd * gq[j] + bq[j]; o[4 * q + j] = r[j]; } }
        v4u w0, w1; w0.x = pk2(o[0], o[1]); w0.y = pk2(o[2], o[3]); w0.z = pk2(o[4], o[5]); w0.w = pk2(o[6], o[7]);
        w1.x = pk2(o[8], o[9]); w1.y = pk2(o[10], o[11]); w1.z = pk2(o[12], o[13]); w1.w = pk2(o[14], o[15]);
        *(v4u*)(xb + (size_t)tok * DM + col) = w0; *(v4u*)(xb + (size_t)tok * DM + col + 8) = w1;
        idA = nidA; idB = nidB; gA = ngA; gB = ngB; par ^= 1; tok = ntok;
    }
}

__device__ __forceinline__ void phase_dsa_norm(const Ctx& c, int j) {
    const int gw = c.bid * NWAVES + c.wave, NGW = c.G * NWAVES, lane = c.lane;
    const bf16* RAW = (const bf16*)(c.ws + WS_M + M_RAW);
    bf16* CQ = (bf16*)(c.ws + WS_M + M_CQ); bf16* CKV = (bf16*)(c.ws + WS_M + M_CKV);
    bf16* KIDX = (bf16*)(c.ws + WS_M + M_KIDX); float* WIDX = (float*)(c.ws + WS_M + M_WIDX);
    const float* gq = INP(c, I_A_CQ_GAIN) + j * 256; const float* gkv = INP(c, I_A_CKV_GAIN) + j * 128;
    const float* gk = INP(c, I_A_KIDX_GAIN) + j * 64; const float* bk = INP(c, I_A_KIDX_BIAS) + j * 64;
    for (int tok = gw; tok < T_TOK; tok += NGW) {
        const v4u rw = *(const v4u*)(RAW + (size_t)tok * 512 + 8 * lane);
        float v[8] = {bflo(rw.x), bfhi(rw.x), bflo(rw.y), bfhi(rw.y), bflo(rw.z), bfhi(rw.z), bflo(rw.w), bfhi(rw.w)};
        float ss = 0.f, s = 0.f;
#pragma unroll
        for (int i = 0; i < 8; ++i) { ss += v[i] * v[i]; s += v[i]; }
        const bool isq = lane < 32, iskv = lane >= 32 && lane < 48, isk = lane >= 48 && lane < 56;
        const float ssq_q = wave_sum(isq ? ss : 0.f), ssq_kv = wave_sum(iskv ? ss : 0.f), sum_k = wave_sum(isk ? s : 0.f);
        const float mean_k = sum_k * (1.0f / 64.0f);
        float dv = 0.f;
#pragma unroll
        for (int i = 0; i < 8; ++i) { const float d = v[i] - mean_k; dv += d * d; }
        const float var_k = wave_sum(isk ? dv : 0.f) * (1.0f / 64.0f);
        if (isq) {
            const float r = __builtin_amdgcn_rsqf(ssq_q * (1.0f / 256.0f) + 1e-6f); const float* g = gq + 8 * lane;
            v4u w; w.x = pk2(v[0] * r * g[0], v[1] * r * g[1]); w.y = pk2(v[2] * r * g[2], v[3] * r * g[3]); w.z = pk2(v[4] * r * g[4], v[5] * r * g[5]); w.w = pk2(v[6] * r * g[6], v[7] * r * g[7]);
            *(v4u*)(CQ + (size_t)tok * 256 + 8 * lane) = w;
        } else if (iskv) {
            const int c0 = 8 * (lane - 32); const float r = __builtin_amdgcn_rsqf(ssq_kv * (1.0f / 128.0f) + 1e-6f); const float* g = gkv + c0;
            float o[8];
#pragma unroll
            for (int i = 0; i < 8; ++i) o[i] = v[i] * r * g[i];
            v4u w; w.x = pk2(o[0], o[1]); w.y = pk2(o[2], o[3]); w.z = pk2(o[4], o[5]); w.w = pk2(o[6], o[7]);
            *(v4u*)(CKV + (size_t)tok * 128 + c0) = w;
        } else if (isk) {
            const int c0 = 8 * (lane - 48); const float r = __builtin_amdgcn_rsqf(var_k + 1e-5f);
            float o[8];
#pragma unroll
            for (int i = 0; i < 8; ++i) o[i] = (v[i] - mean_k) * r * gk[c0 + i] + bk[c0 + i];
            v4u w; w.x = pk2(o[0], o[1]); w.y = pk2(o[2], o[3]); w.z = pk2(o[4], o[5]); w.w = pk2(o[6], o[7]);
            *(v4u*)(KIDX + (size_t)tok * 64 + c0) = w;
        } else if (lane == 56) {
            const float sc = 0.35355339059327373f;
            f32x4 o0 = {v[0] * sc, v[1] * sc, v[2] * sc, v[3] * sc}, o1 = {v[4] * sc, v[5] * sc, v[6] * sc, v[7] * sc};
            *(f32x4*)(WIDX + (size_t)tok * 8) = o0; *(f32x4*)(WIDX + (size_t)tok * 8 + 4) = o1;
        }
    }
}

__device__ __forceinline__ unsigned half_sum_u32(unsigned v, int h) {
    auto dpp = [](unsigned x, auto ctrl, auto rmask) { return (unsigned)__builtin_amdgcn_update_dpp(0, (int)x, decltype(ctrl)::value, decltype(rmask)::value, 0xf, false); };
    v += dpp(v, std::integral_constant<int, 0xB1>{}, std::integral_constant<int, 0xf>{});
    v += dpp(v, std::integral_constant<int, 0x4E>{}, std::integral_constant<int, 0xf>{});
    v += dpp(v, std::integral_constant<int, 0x141>{}, std::integral_constant<int, 0xf>{});
    v += dpp(v, std::integral_constant<int, 0x140>{}, std::integral_constant<int, 0xf>{});
    v += dpp(v, std::integral_constant<int, 0x142>{}, std::integral_constant<int, 0xa>{});
    const unsigned t0 = (unsigned)__builtin_amdgcn_readlane((int)v, 31), t1 = (unsigned)__builtin_amdgcn_readlane((int)v, 63);
    return h ? t1 : t0;
}
__device__ __forceinline__ void phase_dsa_index(const Ctx& c) {
    const bf16* KIDX = (const bf16*)(c.ws + WS_M + M_KIDX); const bf16* QIDX = (const bf16*)(c.ws + WS_M + M_QIDX);
    const float* WIDX = (const float*)(c.ws + WS_M + M_WIDX); unsigned* MASK = (unsigned*)(c.ws + WS_M + M_MASK);
    const int lane = c.lane, n = lane & 31, h = lane >> 5;
    const unsigned ltmask = (1u << n) - 1u;
    LAS unsigned* kl = (LAS unsigned*)(c.lds + c.wave * 16384) + lane * 4;
    for (int u = c.bid; u < 2048; u += c.G) {
        const int b = u & 31, rest = u >> 5, qc = rest >> 1, sub = rest & 1;
        const int tw0 = b * 2048 + qc * 64 + sub * 32 + 4 * c.wave;
        const int nt = 2 * (qc + 1), ng = (nt + 3) >> 2;
        if (nt <= 8) {
            if (n == 0) {
                for (int tt = 0; tt < 2; ++tt)
                    for (int tile = 0; tile < nt; ++tile) MASK[(size_t)(tw0 + 2 * h + tt) * 64 + tile] = 0xffffffffu;
            }
            continue;
        }
        const int ti = 2 * ((n >> 2) & 1) + (n >> 4), hd = 4 * ((n >> 3) & 1) + (n & 3);
        bf16x8 Aq[4];
#pragma unroll
        for (int s = 0; s < 4; ++s) Aq[s] = *(const bf16x8*)(QIDX + (size_t)(tw0 + ti) * 512 + hd * 64 + 16 * s + 8 * h);
        float wv[2][8];
#pragma unroll
        for (int tt = 0; tt < 2; ++tt) { const f32x4 w0 = *(const f32x4*)(WIDX + (size_t)(tw0 + 2 * h + tt) * 8), w1 = *(const f32x4*)(WIDX + (size_t)(tw0 + 2 * h + tt) * 8 + 4);
#pragma unroll
            for (int i = 0; i < 4; ++i) { wv[tt][i] = w0[i]; wv[tt][4 + i] = w1[i]; } }
        const bf16* kbase = KIDX + (size_t)(b * 2048 + n) * 64 + 8 * h;
        auto ldgrp = [&](bf16x8 (&Bk)[2][4], int tile0) {
#pragma unroll
            for (int q = 0; q < 2; ++q) if (tile0 + q < nt) { const bf16* kr = kbase + (size_t)(tile0 + q) * 32 * 64;
#pragma unroll
                for (int s = 0; s < 4; ++s) Bk[q][s] = *(const bf16x8*)(kr + 16 * s); } };
        auto scgrp = [&](const bf16x8 (&Bk)[2][4], int tile0) {
#pragma unroll
            for (int q = 0; q < 2; ++q) if (tile0 + q < nt) {
                f32x16 acc;
#pragma unroll
                for (int i = 0; i < 16; ++i) acc[i] = 0.f;
#pragma unroll
                for (int s = 0; s < 4; ++s) acc = __builtin_amdgcn_mfma_f32_32x32x16_bf16(Aq[s], Bk[q][s], acc, 0, 0, 0);
                float sc0 = 0.f, sc1 = 0.f;
#pragma unroll
                for (int jj = 0; jj < 2; ++jj)
#pragma unroll
                    for (int k = 0; k < 4; ++k) { sc0 += wv[0][4 * jj + k] * fmaxf(acc[4 * jj + k], 0.f); sc1 += wv[1][4 * jj + k] * fmaxf(acc[8 + 4 * jj + k], 0.f); }
                kl[((tile0 + q) >> 2) * 256 + ((tile0 + q) & 3)] = (sort_key(sc0) >> 16) | (sort_key(sc1) & 0xffff0000u);
            } };
        bf16x8 BkA[2][4], BkB[2][4];
        ldgrp(BkA, 0);
#pragma unroll 1
        for (int tile0 = 0; tile0 < nt; tile0 += 4) {
            if (tile0 + 2 < nt) ldgrp(BkB, tile0 + 2);
            scgrp(BkA, tile0);
            if (tile0 + 4 < nt) ldgrp(BkA, tile0 + 4);
            if (tile0 + 2 < nt) scgrp(BkB, tile0 + 2);
        }
        if (nt & 2) { kl[(nt >> 2) * 256 + 2] = 0u; kl[(nt >> 2) * 256 + 3] = 0u; }
        LDS_WAIT(); asm volatile("" ::: "memory");
        unsigned v0 = 0u, v1 = 0u, cv0 = 0xffffu, cv1 = 0xffffu;
        for (int bit = 15; bit >= 0; --bit) {
            const unsigned c0 = v0 | (1u << bit), c1 = v1 | (1u << bit); unsigned lt0 = 0u, lt1 = 0u;
            for (int g = 0; g < ng; ++g) { const v4u k4 = *(const LAS v4u*)(kl + g * 256);
#pragma unroll
                for (int j = 0; j < 4; ++j) { lt0 += (unsigned)((int)((k4[j] & 0xffffu) - c0)) >> 31; lt1 += (unsigned)((int)((k4[j] >> 16) - c1)) >> 31; } }
            const unsigned both = half_sum_u32((4u * (unsigned)ng - lt0) | ((4u * (unsigned)ng - lt1) << 16), h);
            const unsigned cnt0 = both & 0xffffu, cnt1 = both >> 16;
            if (cnt0 >= 256u) { v0 = c0; cv0 = cnt0; }
            if (cnt1 >= 256u) { v1 = c1; cv1 = cnt1; }
            if (__all(cv0 == 256u && cv1 == 256u)) break;
        }
        unsigned g0 = 0u, g1 = 0u;
        for (int g = 0; g < ng; ++g) { const v4u k4 = *(const LAS v4u*)(kl + g * 256);
#pragma unroll
            for (int j = 0; j < 4; ++j) { g0 += (unsigned)((int)(v0 - (k4[j] & 0xffffu))) >> 31; g1 += (unsigned)((int)(v1 - (k4[j] >> 16))) >> 31; } }
        const unsigned gboth = half_sum_u32(g0 | (g1 << 16), h);
        const unsigned need0 = 256u - (gboth & 0xffffu), need1 = 256u - (gboth >> 16); unsigned eb0 = 0u, eb1 = 0u;
        for (int tile = 0; tile < nt; ++tile) {
            const unsigned kw = kl[(tile >> 2) * 256 + (tile & 3)]; const unsigned k0 = kw & 0xffffu, k1 = kw >> 16;
            { const bool gt = k0 > v0, eq = k0 == v0; const unsigned em = half_sel(__ballot(eq), h);
              const bool take = gt || (eq && (eb0 + __popc(em & ltmask) < need0)); eb0 += __popc(em);
              const unsigned word = half_sel(__ballot(take), h); if (n == 0) MASK[(size_t)(tw0 + 2 * h) * 64 + tile] = word; }
            { const bool gt = k1 > v1, eq = k1 == v1; const unsigned em = half_sel(__ballot(eq), h);
              const bool take = gt || (eq && (eb1 + __popc(em & ltmask) < need1)); eb1 += __popc(em);
              const unsigned word = half_sel(__ballot(take), h); if (n == 0) MASK[(size_t)(tw0 + 2 * h + 1) * 64 + tile] = word; }
        }
        LDS_WAIT(); asm volatile("" ::: "memory");
    }
}

__device__ __forceinline__ void tr_rd16(unsigned a, v2u (&r)[16]) {
    asm volatile("ds_read_b64_tr_b16 %0, %16\n\tds_read_b64_tr_b16 %1, %16 offset:4352\n\t"
                 "ds_read_b64_tr_b16 %2, %16 offset:32\n\tds_read_b64_tr_b16 %3, %16 offset:4384\n\t"
                 "ds_read_b64_tr_b16 %4, %16 offset:64\n\tds_read_b64_tr_b16 %5, %16 offset:4416\n\t"
                 "ds_read_b64_tr_b16 %6, %16 offset:96\n\tds_read_b64_tr_b16 %7, %16 offset:4448\n\t"
                 "ds_read_b64_tr_b16 %8, %16 offset:128\n\tds_read_b64_tr_b16 %9, %16 offset:4480\n\t"
                 "ds_read_b64_tr_b16 %10, %16 offset:160\n\tds_read_b64_tr_b16 %11, %16 offset:4512\n\t"
                 "ds_read_b64_tr_b16 %12, %16 offset:192\n\tds_read_b64_tr_b16 %13, %16 offset:4544\n\t"
                 "ds_read_b64_tr_b16 %14, %16 offset:224\n\tds_read_b64_tr_b16 %15, %16 offset:4576\n\ts_waitcnt lgkmcnt(0)"
                 : "=&v"(r[0]), "=&v"(r[1]), "=&v"(r[2]), "=&v"(r[3]), "=&v"(r[4]), "=&v"(r[5]), "=&v"(r[6]), "=&v"(r[7]),
                   "=&v"(r[8]), "=&v"(r[9]), "=&v"(r[10]), "=&v"(r[11]), "=&v"(r[12]), "=&v"(r[13]), "=&v"(r[14]), "=&v"(r[15])
                 : "v"(a) : "memory");
}
__device__ __forceinline__ void phase_dsa_attn(const Ctx& c) {
    const bf16* CKV = (const bf16*)(c.ws + WS_M + M_CKV);
    bf16* QLAT = (bf16*)(c.ws + WS_M + M_QLAT); const unsigned* MASK = (const unsigned*)(c.ws + WS_M + M_MASK);
    constexpr int RS = 272, TILE = 32 * RS;
    const int lane = c.lane, l15 = lane & 15, g = lane >> 4;
    LAS unsigned char* T0 = c.lds + c.wave * 17920;
    LAS unsigned short* klist = (LAS unsigned short*)(T0 + 2 * TILE);
    const unsigned lbase = (unsigned)(size_t)T0;
    const int prow = lane >> 4, ppc = lane & 15;
    for (int u = c.bid * NWAVES + c.wave; u < T_TOK; u += c.G * NWAVES) {
        const int tok = u, b = tok >> 11;
        const int qc = (tok & 2047) >> 6; const int nt = 2 * (qc + 1);
        const unsigned mwd = lane < nt ? MASK[(size_t)tok * 64 + lane] : 0u;
        unsigned incl = (unsigned)__popc(mwd);
#pragma unroll
        for (int d = 1; d < 64; d <<= 1) { const unsigned o = __shfl_up(incl, d); if (lane >= d) incl += o; }
        const int nsel = __builtin_amdgcn_readlane((int)incl, 63);
        { unsigned pos = incl - (unsigned)__popc(mwd), w = mwd;
          while (w) { const int bit = __builtin_ctz(w); klist[pos++] = (unsigned short)(32 * lane + bit); w &= w - 1u; } }
        bf16x8 Bq[4];
#pragma unroll
        for (int s = 0; s < 4; ++s) Bq[s] = *(const bf16x8*)(QLAT + (size_t)tok * 2048 + l15 * 128 + 32 * s + 8 * g);
        LDS_WAIT(); asm volatile("" ::: "memory");
        const int nstep = nsel >> 5;
        const bf16* kvb = CKV + (size_t)b * 2048 * 128 + ppc * 8;
        v4u gr[8];
        auto gather = [&](int step) {
#pragma unroll
            for (int j = 0; j < 8; ++j) { const int key = klist[32 * step + 4 * j + prow]; gr[j] = *(const v4u*)(kvb + (size_t)key * 128); } };
        auto lstore = [&](int buf) {
#pragma unroll
            for (int j = 0; j < 8; ++j) *(LAS v4u*)(T0 + buf * TILE + (4 * j + prow) * RS + ppc * 16) = gr[j]; };
        float m_run = -INFINITY, l_run = 0.f;
        f32x4 O[8];
#pragma unroll
        for (int dt = 0; dt < 8; ++dt) O[dt] = (f32x4){0.f, 0.f, 0.f, 0.f};
        gather(0);
#pragma unroll 1
        for (int step = 0; step < nstep; ++step) {
            const int buf = step & 1;
            lstore(buf);
            if (step + 1 < nstep) gather(step + 1);
            LDS_WAIT(); asm volatile("" ::: "memory");
            f32x4 S[2];
#pragma unroll
            for (int kt = 0; kt < 2; ++kt) { S[kt] = (f32x4){0.f, 0.f, 0.f, 0.f};
#pragma unroll
                for (int s = 0; s < 4; ++s) { const bf16x8 Ak = *(const LAS bf16x8*)(T0 + buf * TILE + (16 * kt + l15) * RS + (32 * s + 8 * g) * 2);
                    S[kt] = __builtin_amdgcn_mfma_f32_16x16x32_bf16(Ak, Bq[s], S[kt], 0, 0, 0); } }
            float mx = fmaxf(fmaxf(fmaxf(S[0][0], S[0][1]), fmaxf(S[0][2], S[0][3])), fmaxf(fmaxf(S[1][0], S[1][1]), fmaxf(S[1][2], S[1][3])));
            mx = fmaxf(mx, __shfl_xor(mx, 16)); mx = fmaxf(mx, __shfl_xor(mx, 32));
            const float m_new = fmaxf(m_run, mx);
            const float alpha = __builtin_amdgcn_exp2f(m_run - m_new);
            float p[8], ps = 0.f;
#pragma unroll
            for (int j = 0; j < 8; ++j) { p[j] = __builtin_amdgcn_exp2f(S[j >> 2][j & 3] - m_new); ps += p[j]; }
            l_run = l_run * alpha + ps; m_run = m_new;
            v4u pw; pw.x = pk2(p[0], p[1]); pw.y = pk2(p[2], p[3]); pw.z = pk2(p[4], p[5]); pw.w = pk2(p[6], p[7]);
            const bf16x8 Bp = __builtin_bit_cast(bf16x8, pw);
            const unsigned ta = lbase + buf * TILE + (4 * g + (l15 >> 2)) * RS + (4 * (l15 & 3)) * 2;
            v2u tr[16]; tr_rd16(ta, tr);
#pragma unroll
            for (int dt = 0; dt < 8; ++dt) {
                v4u aw; aw.x = tr[2 * dt].x; aw.y = tr[2 * dt].y; aw.z = tr[2 * dt + 1].x; aw.w = tr[2 * dt + 1].y;
                O[dt] = O[dt] * alpha; O[dt] = __builtin_amdgcn_mfma_f32_16x16x32_bf16(__builtin_bit_cast(bf16x8, aw), Bp, O[dt], 0, 0, 0); }
        }
        const float l_tot = l_run + __shfl_xor(l_run, 16); const float l_all = l_tot + __shfl_xor(l_tot, 32); const float inv = 1.0f / l_all;
#pragma unroll
        for (int dt = 0; dt < 8; ++dt) { v2u w; w.x = pk2(O[dt][0] * inv, O[dt][1] * inv); w.y = pk2(O[dt][2] * inv, O[dt][3] * inv);
            *(v2u*)(QLAT + (size_t)tok * 2048 + l15 * 128 + 16 * dt + 4 * g) = w; }
        LDS_WAIT(); asm volatile("" ::: "memory");
    }
}

__device__ __forceinline__ float neg_expm1_small(float x) {
    const float p = -x * (1.0f + x * 0.5f * (1.0f + x * (1.0f / 3.0f) * (1.0f + x * 0.25f * (1.0f + x * 0.2f * (1.0f + x * (1.0f / 6.0f))))));
    return x < -0.25f ? 1.0f - __expf(x) : p;
}
__device__ __forceinline__ void phase_rglru(const Ctx& c) {
    const bf16* GU = (const bf16*)(c.ws + WS_M + M_GU); bf16* Y = (bf16*)(c.ws + WS_M + M_Y);
    constexpr int CVS = 104;
    LAS float* uT = (LAS float*)c.lds;
    LAS bf16* cvb = (LAS bf16*)(c.lds + 21504);
    LAS bf16* WTa = (LAS bf16*)(c.lds + 34816);
    LAS bf16* WTx = (LAS bf16*)(c.lds + 51456);
    LAS float* a_s = (LAS float*)(c.lds + 68096);
    LAS float* b_s = (LAS float*)(c.lds + 88832);
    LAS bf16* gT = (LAS bf16*)(c.lds + 109568);
    LAS float* cst = (LAS float*)(c.lds + 120064);
    const int tid = c.tid, lane = c.lane, w = c.wave;
    for (int u = c.bid; u < 512; u += c.G) {
        const int b = u >> 4, nb = u & 15, ch0 = nb * 80;
        __syncthreads();
        for (int e = tid; e < 80 * CVS; e += NTHR) { const int d = e / CVS, k = e % CVS;
            WTa[e] = (bf16)(k < 80 ? f2bf(INP(c, I_B_W_A)[(size_t)nb * 6400 + k * 80 + d]) : 0u);
            WTx[e] = (bf16)(k < 80 ? f2bf(INP(c, I_B_W_X)[(size_t)nb * 6400 + k * 80 + d]) : 0u); }
        for (int e = tid; e < 64 * CVS; e += NTHR) cvb[e] = 0;
        if (tid < 80) {
            const int cc = ch0 + tid;
#pragma unroll
            for (int j = 0; j < 4; ++j) cst[j * 80 + tid] = INP(c, I_B_CONV_W)[j * 1280 + cc];
            cst[320 + tid] = INP(c, I_B_CONV_B)[cc]; cst[400 + tid] = INP(c, I_B_B_A)[cc]; cst[480 + tid] = INP(c, I_B_B_X)[cc];
            cst[560 + tid] = log1pf(expf(-INP(c, I_B_LAMBDA)[cc]));
        }
        float carry[10];
#pragma unroll
        for (int q = 0; q < 10; ++q) carry[q] = 0.f;
        v4u ureg[2], greg[2];
        auto issue_loads = [&](int chunk) {
#pragma unroll
            for (int q = 0; q < 2; ++q) { const int e = tid + NTHR * q;
                ureg[q] = (v4u){0u, 0u, 0u, 0u}; greg[q] = (v4u){0u, 0u, 0u, 0u};
                if (e < 670) { const int i = e / 10, cch = e % 10; const int sp = chunk * 64 - 3 + i;
                    if (sp >= 0) ureg[q] = *(const v4u*)(GU + (size_t)(b * 2048 + sp) * 2560 + 1280 + ch0 + cch * 8); }
                if (e < 640) { const int i = e / 10, cch = e % 10;
                    greg[q] = *(const v4u*)(GU + (size_t)(b * 2048 + chunk * 64 + i) * 2560 + ch0 + cch * 8); } }
        };
        issue_loads(0);
#pragma unroll 1
        for (int chunk = 0; chunk < 32; ++chunk) {
            const int t0 = b * 2048 + chunk * 64;
#pragma unroll
            for (int q = 0; q < 2; ++q) { const int e = tid + NTHR * q;
                if (e < 670) { const int i = e / 10, cch = e % 10; LAS float* d = uT + i * 80 + cch * 8;
                    *(LAS f32x4*)d = (f32x4){bflo(ureg[q].x), bfhi(ureg[q].x), bflo(ureg[q].y), bfhi(ureg[q].y)};
                    *(LAS f32x4*)(d + 4) = (f32x4){bflo(ureg[q].z), bfhi(ureg[q].z), bflo(ureg[q].w), bfhi(ureg[q].w)}; }
                if (e < 640) { const int i = e / 10, cch = e % 10; LAS unsigned* d = (LAS unsigned*)(gT + i * 82 + cch * 8);
                    d[0] = greg[q].x; d[1] = greg[q].y; d[2] = greg[q].z; d[3] = greg[q].w; } }
            __syncthreads();
            if (chunk + 1 < 32) issue_loads(chunk + 1);
            for (int e = tid; e < 5120; e += NTHR) { const int t = e / 80, cc = e % 80;
                float s = cst[320 + cc];
#pragma unroll
                for (int j = 0; j < 4; ++j) s += uT[(t + j) * 80 + cc] * cst[j * 80 + cc];
                cvb[t * CVS + cc] = (bf16)f2bf(s); }
            __syncthreads();
            {
                const int tq = w & 3, nt0 = (w >> 2) ? 3 : 0, nt1 = (w >> 2) ? 5 : 3, l15 = lane & 15, g4 = lane >> 4;
                bf16x8 Af[3];
#pragma unroll
                for (int s3 = 0; s3 < 3; ++s3) Af[s3] = *(const LAS bf16x8*)(cvb + (16 * tq + l15) * CVS + 32 * s3 + 8 * g4);
#pragma unroll
                for (int q = 0; q < 3; ++q) { const int nt = nt0 + q;
                    if (nt < nt1) {
                        f32x4 accA = {0.f, 0.f, 0.f, 0.f}, accX = {0.f, 0.f, 0.f, 0.f};
#pragma unroll
                        for (int s3 = 0; s3 < 3; ++s3) {
                            const bf16x8 Ba = *(const LAS bf16x8*)(WTa + (16 * nt + l15) * CVS + 32 * s3 + 8 * g4), Bx = *(const LAS bf16x8*)(WTx + (16 * nt + l15) * CVS + 32 * s3 + 8 * g4);
                            accA = __builtin_amdgcn_mfma_f32_16x16x32_bf16(Af[s3], Ba, accA, 0, 0, 0); accX = __builtin_amdgcn_mfma_f32_16x16x32_bf16(Af[s3], Bx, accX, 0, 0, 0); }
                        const int cc = 16 * nt + l15; const float ba = cst[400 + cc], bx = cst[480 + cc], sp = cst[560 + cc], cb = cst[320 + cc];
                        const float cw0 = cst[cc], cw1 = cst[80 + cc], cw2 = cst[160 + cc], cw3 = cst[240 + cc];
#pragma unroll
                        for (int r4 = 0; r4 < 4; ++r4) { const int t = 16 * tq + 4 * g4 + r4;
                            const float cvf = cb + uT[t * 80 + cc] * cw0 + uT[(t + 1) * 80 + cc] * cw1 + uT[(t + 2) * 80 + cc] * cw2 + uT[(t + 3) * 80 + cc] * cw3;
                            const float r = sigmoidf_(accA[r4] + ba), ig = sigmoidf_(accX[r4] + bx);
                            const float log_a = -8.0f * r * sp; const float a = __expf(log_a);
                            const float bb = __builtin_amdgcn_sqrtf(neg_expm1_small(2.0f * log_a)) * (ig * cvf);
                            a_s[t * 81 + cc] = a; b_s[t * 81 + cc] = bb; }
                    } }
            }
            __syncthreads();
            {
                LAS bf16* yT = (LAS bf16*)uT;
#pragma unroll
                for (int q = 0; q < 10; ++q) { const int cc = w + 8 * q;
                    float a = a_s[lane * 81 + cc], bq = b_s[lane * 81 + cc];
#define RG_STEP(D) { const float ap = __builtin_bit_cast(float, __builtin_amdgcn_update_dpp(0x3f800000, __builtin_bit_cast(int, a), 0x110 + D, 0xf, 0xf, false)); \
                     const float bp = __builtin_bit_cast(float, __builtin_amdgcn_update_dpp(0, __builtin_bit_cast(int, bq), 0x110 + D, 0xf, 0xf, false)); bq = a * bp + bq; a = a * ap; }
                    RG_STEP(1) RG_STEP(2) RG_STEP(4) RG_STEP(8)
#undef RG_STEP
                    { const float A0 = __builtin_bit_cast(float, __builtin_amdgcn_readlane(__builtin_bit_cast(int, a), 15)), B0 = __builtin_bit_cast(float, __builtin_amdgcn_readlane(__builtin_bit_cast(int, bq), 15));
                      const float A1 = __builtin_bit_cast(float, __builtin_amdgcn_readlane(__builtin_bit_cast(int, a), 31)), B1 = __builtin_bit_cast(float, __builtin_amdgcn_readlane(__builtin_bit_cast(int, bq), 31));
                      const float A2 = __builtin_bit_cast(float, __builtin_amdgcn_readlane(__builtin_bit_cast(int, a), 47)), B2 = __builtin_bit_cast(float, __builtin_amdgcn_readlane(__builtin_bit_cast(int, bq), 47));
                      const float C2a = A0 * A1, C2b = A1 * B0 + B1, C3a = C2a * A2, C3b = A2 * C2b + B2;
                      const int row = lane >> 4;
                      const float ca = row == 0 ? 1.0f : (row == 1 ? A0 : (row == 2 ? C2a : C3a)), cb = row == 0 ? 0.0f : (row == 1 ? B0 : (row == 2 ? C2b : C3b));
                      bq = a * cb + bq; a = a * ca; }
                    const float hval = a * carry[q] + bq;
                    carry[q] = __builtin_bit_cast(float, __builtin_amdgcn_readlane(__builtin_bit_cast(int, hval), 63));
                    yT[lane * 82 + cc] = (bf16)f2bf(bf2f(gT[lane * 82 + cc]) * hval); }
            }
            __syncthreads();
            for (int e = tid; e < 2560; e += NTHR) { const int row = e / 40, dw = e % 40;
                ((unsigned*)(Y + (size_t)(t0 + row) * 1280 + ch0))[dw] = ((const LAS unsigned*)uT)[row * 41 + dw]; }
            __syncthreads();
        }
    }
}

template <int OFF0, int OFF1>
__device__ __forceinline__ void tr_read2(unsigned a, v2u& r0, v2u& r1) {
    asm volatile("ds_read_b64_tr_b16 %0, %2 offset:%3\n\tds_read_b64_tr_b16 %1, %2 offset:%4\n\ts_waitcnt lgkmcnt(0)" : "=&v"(r0), "=&v"(r1) : "v"(a), "n"(OFF0), "n"(OFF1) : "memory");
}
template <int B0, int RSb>
__device__ __forceinline__ void tr_read8(unsigned a, v2u (&r)[8]) {
    asm volatile("ds_read_b64_tr_b16 %0, %8 offset:%9\n\tds_read_b64_tr_b16 %1, %8 offset:%10\n\tds_read_b64_tr_b16 %2, %8 offset:%11\n\tds_read_b64_tr_b16 %3, %8 offset:%12\n\t"
                 "ds_read_b64_tr_b16 %4, %8 offset:%13\n\tds_read_b64_tr_b16 %5, %8 offset:%14\n\tds_read_b64_tr_b16 %6, %8 offset:%15\n\tds_read_b64_tr_b16 %7, %8 offset:%16\n\ts_waitcnt lgkmcnt(0)"
                 : "=&v"(r[0]), "=&v"(r[1]), "=&v"(r[2]), "=&v"(r[3]), "=&v"(r[4]), "=&v"(r[5]), "=&v"(r[6]), "=&v"(r[7])
                 : "v"(a), "n"(B0), "n"(B0 + 4 * RSb), "n"(B0 + 16 * RSb), "n"(B0 + 20 * RSb), "n"(B0 + 32 * RSb), "n"(B0 + 36 * RSb), "n"(B0 + 48 * RSb), "n"(B0 + 52 * RSb) : "memory");
}
__device__ __forceinline__ void phase_ret_core(const Ctx& c) {
    const bf16* Qg = (const bf16*)(c.ws + WS_M + M_Q); const bf16* Kg = (const bf16*)(c.ws + WS_M + M_K); bf16* Vg = (bf16*)(c.ws + WS_M + M_V);
    float* STAT = (float*)(c.ws + WS_M + M_STAT);
    constexpr int RS = 528, SS = 144, QS_OFF = 0, KS_OFF = 64 * RS, VS_OFF = 2 * 64 * RS, SS_OFF = 3 * 64 * RS;
    LAS unsigned char* L = c.lds; const unsigned lbase = (unsigned)(size_t)c.lds;
    const int tid0 = c.tid, w = c.wave;
    for (int u = c.bid; u < 256; u += c.G) {
        const int b = u >> 3, hh = (u >> 1) & 3, eh = u & 1;
        const float gam = 1.0f - exp2f(-5.0f - (float)hh); const float lg0 = log2f(gam);
        f32x16 R[8];
#pragma unroll
        for (int dt = 0; dt < 8; ++dt)
#pragma unroll
            for (int i = 0; i < 16; ++i) R[dt][i] = 0.f;
        const float cdec = exp2f(lg0 * 64.0f);
#pragma unroll 1
        for (int chunk = 0; chunk < 32; ++chunk) {
            const int t0 = b * 2048 + chunk * 64;
            float lg = lg0; int tid = tid0; asm volatile("" : "+v"(lg), "+v"(tid));
            const int lane = tid & 63, n = lane & 31, h = lane >> 5, hl = h;
            const int blk = (lane >> 4) & 1, q4 = (lane & 15) >> 2, p4 = lane & 3;
            const unsigned trbK = lbase + (8 * h + q4) * RS + (16 * blk + 4 * p4) * 2;
            const unsigned trbV = trbK + VS_OFF + 64 * w;
            __syncthreads();
#pragma unroll
            for (int i = 0; i < 4; ++i) { const int e = tid + NTHR * i, row = e >> 5, ch = e & 31;
                *(LAS v4u*)(L + QS_OFF + row * RS + ch * 16) = *(const v4u*)(Qg + (size_t)(t0 + row) * 1024 + hh * 256 + ch * 8);
                *(LAS v4u*)(L + KS_OFF + row * RS + ch * 16) = *(const v4u*)(Kg + (size_t)(t0 + row) * 1024 + hh * 256 + ch * 8); }
            asm volatile("" ::: "memory");
#pragma unroll
            for (int i = 0; i < 4; ++i) { const int e = tid + NTHR * i, row = e >> 5, ch = e & 31;
                *(LAS v4u*)(L + VS_OFF + row * RS + ch * 16) = *(const v4u*)(Vg + (size_t)(t0 + row) * 2048 + hh * 512 + eh * 256 + ch * 8); }
            __syncthreads();
            {
                const int i16 = w >> 1, l15 = lane & 15, g4 = lane >> 4; const int l15d = l15, g4d = g4;
                bf16x8 Af[8];
#pragma unroll
                for (int s = 0; s < 8; ++s) Af[s] = *(const LAS bf16x8*)(L + QS_OFF + (16 * i16 + l15) * RS + (32 * s + 8 * g4) * 2);
#pragma unroll
                for (int jj = 0; jj < 2; ++jj) { const int j16 = 2 * (w & 1) + jj;
                    f32x4 acc = {0.f, 0.f, 0.f, 0.f};
                    if (j16 <= i16) {
#pragma unroll
                        for (int s = 0; s < 8; ++s) { const bf16x8 Bf = *(const LAS bf16x8*)(L + KS_OFF + (16 * j16 + l15) * RS + (32 * s + 8 * g4) * 2);
                            acc = __builtin_amdgcn_mfma_f32_16x16x32_bf16(Af[s], Bf, acc, 0, 0, 0); }
                    }
                    const int ja = 16 * j16 + l15, jad = 16 * j16 + l15d;
#pragma unroll
                    for (int r = 0; r < 4; ++r) { const int ia = 16 * i16 + 4 * g4 + r, iad = 16 * i16 + 4 * g4d + r; const float dec = (iad >= jad) ? __builtin_amdgcn_exp2f(lg * (float)(iad - jad)) : 0.f;
                        *(LAS bf16*)(L + SS_OFF + ia * SS + ja * 2) = (bf16)f2bf(acc[r] * dec); }
                }
            }
            __syncthreads();
            bf16x8 Vf[4];
            { v2u tr[8]; tr_read8<0, RS>(trbV, tr);
#pragma unroll
              for (int ks = 0; ks < 4; ++ks) { v4u wv; wv.x = tr[2 * ks].x; wv.y = tr[2 * ks].y; wv.z = tr[2 * ks + 1].x; wv.w = tr[2 * ks + 1].y; Vf[ks] = __builtin_bit_cast(bf16x8, wv); } }
            {
                f32x16 Oa[2];
#pragma unroll
                for (int it = 0; it < 2; ++it)
#pragma unroll
                    for (int i = 0; i < 16; ++i) Oa[it][i] = 0.f;
#pragma unroll
                for (int dt = 0; dt < 8; ++dt)
#pragma unroll
                    for (int s = 0; s < 2; ++s) {
                        v4u bw; bw.x = pk2(R[dt][8 * s + 0], R[dt][8 * s + 1]); bw.y = pk2(R[dt][8 * s + 2], R[dt][8 * s + 3]); bw.z = pk2(R[dt][8 * s + 4], R[dt][8 * s + 5]); bw.w = pk2(R[dt][8 * s + 6], R[dt][8 * s + 7]);
#pragma unroll
                        for (int it = 0; it < 2; ++it) {
                            const LAS unsigned char* qrow = L + QS_OFF + (32 * it + n) * RS;
                            const v2u lo = *(const LAS v2u*)(qrow + (32 * dt + 16 * s + 4 * h) * 2), hi = *(const LAS v2u*)(qrow + (32 * dt + 16 * s + 8 + 4 * h) * 2);
                            v4u aw; aw.x = lo.x; aw.y = lo.y; aw.z = hi.x; aw.w = hi.y;
                            Oa[it] = __builtin_amdgcn_mfma_f32_32x32x16_bf16(__builtin_bit_cast(bf16x8, aw), __builtin_bit_cast(bf16x8, bw), Oa[it], 0, 0, 0);
                        }
                    }
#pragma unroll
                for (int it = 0; it < 2; ++it) {
#pragma unroll
                    for (int i = 0; i < 16; ++i) { const int ia = 32 * it + 8 * (i >> 2) + 4 * h + (i & 3); Oa[it][i] *= __builtin_amdgcn_exp2f(lg * (float)(32 * it + 8 * (i >> 2) + 4 * hl + (i & 3) + 1)); }
#pragma unroll
                    for (int ks = 0; ks < 4; ++ks) if (ks < 2 * (it + 1)) {
                        const bf16x8 Sf = *(const LAS bf16x8*)(L + SS_OFF + (32 * it + n) * SS + (16 * ks + 8 * h) * 2);
                        Oa[it] = __builtin_amdgcn_mfma_f32_32x32x16_bf16(Sf, Vf[ks], Oa[it], 0, 0, 0);
                    }
#pragma unroll
                    for (int i = 0; i < 16; ++i) { const int ia = 32 * it + 8 * (i >> 2) + 4 * h + (i & 3);
                        *(LAS bf16*)(L + VS_OFF + ia * RS + (32 * w + n) * 2) = (bf16)f2bf(Oa[it][i]); }
                }
            }
            bf16x8 Vs2[4];
#pragma unroll
            for (int ks = 0; ks < 4; ++ks) { const v4u wv = __builtin_bit_cast(v4u, Vf[ks]); float f[8] = {bflo(wv.x), bfhi(wv.x), bflo(wv.y), bfhi(wv.y), bflo(wv.z), bfhi(wv.z), bflo(wv.w), bfhi(wv.w)};
#pragma unroll
                for (int j = 0; j < 8; ++j) { const int key = 16 * ks + 8 * hl + j; f[j] *= __builtin_amdgcn_exp2f(lg * (float)(63 - key)); }
                v4u o; o.x = pk2(f[0], f[1]); o.y = pk2(f[2], f[3]); o.z = pk2(f[4], f[5]); o.w = pk2(f[6], f[7]); Vs2[ks] = __builtin_bit_cast(bf16x8, o); }
#define RC_DT(dt) { _Pragma("unroll") for (int i = 0; i < 16; ++i) R[dt][i] *= cdec; v2u tr[8]; tr_read8<KS_OFF + 64 * (dt), RS>(trbK, tr); \
                _Pragma("unroll") for (int ks = 0; ks < 4; ++ks) { v4u aw; aw.x = tr[2 * ks].x; aw.y = tr[2 * ks].y; aw.z = tr[2 * ks + 1].x; aw.w = tr[2 * ks + 1].y; \
                    R[dt] = __builtin_amdgcn_mfma_f32_32x32x16_bf16(__builtin_bit_cast(bf16x8, aw), Vs2[ks], R[dt], 0, 0, 0); } }
            RC_DT(0) RC_DT(1) RC_DT(2) RC_DT(3) RC_DT(4) RC_DT(5) RC_DT(6) RC_DT(7)
#undef RC_DT
            __syncthreads();
#pragma unroll
            for (int i = 0; i < 4; ++i) { const int e = tid + NTHR * i, row = e >> 5, ch = e & 31;
                const v4u ov = *(const LAS v4u*)(L + VS_OFF + row * RS + ch * 16);
                *(v4u*)(Vg + (size_t)(t0 + row) * 2048 + hh * 512 + eh * 256 + ch * 8) = ov;
                const float f[8] = {bflo(ov.x), bfhi(ov.x), bflo(ov.y), bfhi(ov.y), bflo(ov.z), bfhi(ov.z), bflo(ov.w), bfhi(ov.w)};
                float s = 0.f, s2 = 0.f;
#pragma unroll
                for (int j = 0; j < 8; ++j) { s += f[j]; s2 += f[j] * f[j]; }
#pragma unroll
                for (int o = 1; o < 32; o <<= 1) { s += __shfl_xor(s, o); s2 += __shfl_xor(s2, o); }
                if ((tid & 31) == 0) { f32x2 st = {s, s2}; *(f32x2*)(STAT + (size_t)(t0 + row) * 16 + hh * 4 + eh * 2) = st; }
            }
        }
    }
}

__host__ __device__ __forceinline__ bool slot_active(int kind, int s) {
    if (s == 2) return kind != 1;
    if (s == 3 || s == 4) return kind == 0;
    if (s == 10) return false;
    return true;
}

#ifndef MK_EN
#define MK_EN 0xffffffffu
#endif
#define EN(b) ((MK_EN >> (b)) & 1u)
template <int PROBE>
__global__ void __launch_bounds__(NTHR, 2) mk_fwd_t(Params p) {
    extern __shared__ __attribute__((aligned(16))) unsigned char lds_raw[];
    Ctx c;
    c.lds = (LAS unsigned char*)lds_raw; c.tid = threadIdx.x; c.lane = c.tid & 63; c.wave = __builtin_amdgcn_readfirstlane(c.tid >> 6);
    c.bid = blockIdx.x; c.G = gridDim.x; c.in = (InTab)(unsigned long)__builtin_amdgcn_kernarg_segment_ptr(); c.out = p.out; c.ws = p.ws;
    volatile LAS unsigned* MISC = (volatile LAS unsigned*)(c.lds + MISC_OFF);
    for (int u = c.tid; u < (LDS_BYTES - LDSCTL_OFF) / 4; u += NTHR) ((LAS unsigned*)(c.lds + LDSCTL_OFF))[u] = 0u;
    __syncthreads();
    const bool one = (p.flags & 1) != 0;
    XcdBarrier bar; bar.bar = (unsigned*)(p.ws + WS_CTL) + CW_BAR; bar.x = 0; bar.st = MISC + 8;
    if (one) bar = xcd_barrier_post((unsigned*)(p.ws + WS_CTL) + CW_BAR, MISC + 8);
    const int lo = p.ph_lo, hi = p.ph_hi;
#define IN(k) (lo <= (k) && (k) < hi)
#if MK_PROBE
#define STAMP(k) do { if (blockIdx.x == 0 && threadIdx.x == 0) ((unsigned long long*)(p.ws + WS_CTL + 65536))[k] = __builtin_amdgcn_s_memrealtime(); } while (0)
#else
#define STAMP(k) do {} while (0)
#endif
#define LCTX() Ctx cl = c; { unsigned long k_ = (unsigned long)__builtin_amdgcn_kernarg_segment_ptr(); unsigned long w_ = (unsigned long)p.ws, o_ = (unsigned long)p.out; int t_ = threadIdx.x; asm volatile("" : "+s"(k_), "+s"(w_), "+s"(o_), "+v"(t_)); cl.tid = t_; cl.lane = t_ & 63; cl.wave = __builtin_amdgcn_readfirstlane(t_ >> 6); cl.in = (InTab)k_; cl.ws = (unsigned char*)(GAS unsigned char*)w_; cl.out = (float*)(GAS float*)o_; } unsigned char* ws = cl.ws; (void)ws
#define SEAM(k) do { if (one && IN(k) && (k) + 1 < hi) xcd_barrier(bar); } while (0)
    STAMP(0);
    if (EN(0) && IN(0)) { LCTX(); phase_prologue(cl); }
    SEAM(0);
#pragma unroll 1
    for (int layer = 0; layer < 4; ++layer) {
        const int kind = layer % 3, j = layer / 3, base = 1 + layer * NPH_LAYER;
        const size_t xin_off = (layer & 1) ? WS_XB1 : WS_XB0, xnext_off = (layer & 1) ? WS_XB0 : WS_XB1;
#define xin ((const bf16*)(ws + xin_off))
#define xnext ((bf16*)(ws + xnext_off))
        STAMP(base + 0);
        if (IN(base + 0)) { LCTX();
            if (EN(1) && kind == 0) { bf16* RAWb = (bf16*)(ws + WS_M + M_RAW); EpiBf16R<0> E{RAWb, RAWb, RAWb, 512, 512, 512, 1 << 30, 1 << 30};
                run_gemm(cl, xin, (const bf16*)(ws + WS_WAIN) + (size_t)j * 512 * 1024, 512, 1024, E); }
            else if (EN(2) && kind == 1) { bf16* GU = (bf16*)(ws + WS_M + M_GU); EpiBf16R<1> E{GU, GU + 1280, GU + 1280, 2560, 2560, 2560, 1280, 1 << 30};
                run_gemm(cl, xin, (const bf16*)(ws + WS_WBIN), 2560, 1024, E); }
            else if (EN(3) && kind == 2) { EpiRetIn E{(bf16*)(ws + WS_M + M_Q), (bf16*)(ws + WS_M + M_K), (bf16*)(ws + WS_M + M_V), (const float*)(ws + WS_ROT), (const float*)(ws + WS_ROT) + 2048 * 128};
                run_gemm(cl, xin, (const bf16*)(ws + WS_WCIN), 4096, 1024, E); }
        }
        SEAM(base + 0);
        STAMP(base + 1);
        if (IN(base + 1)) { LCTX();
            if (EN(4) && kind == 0) phase_dsa_norm(cl, j);
            else if (EN(5) && kind == 1) phase_rglru(cl);
            else if (EN(6) && kind == 2) phase_ret_core(cl);
        }
        SEAM(base + 1);
        STAMP(base + 2);
        if (IN(base + 2) && kind != 1) { LCTX();
            if (EN(7) && kind == 0) { EpiBf16R<0> E{(bf16*)(ws + WS_M + M_QLAT), (bf16*)(ws + WS_M + M_QIDX), (bf16*)(ws + WS_M + M_QIDX), 2048, 512, 512, 2048, 1 << 30};
                run_gemm(cl, (const bf16*)(ws + WS_M + M_CQ), (const bf16*)(ws + WS_WAQ + j * WAQ_STRIDE), 2560, 256, E); }
            else if (EN(8) && kind == 2) { EpiRetGate E{(bf16*)(ws + WS_M + M_V), (const float*)(ws + WS_M + M_STAT)};
                run_gemm(cl, xin, (const bf16*)(ws + WS_WCIN) + (size_t)4096 * 1024, 2048, 1024, E); }
        }
        if (kind != 1) SEAM(base + 2);
        STAMP(base + 3);
        if (EN(9) && IN(base + 3) && kind == 0) { LCTX(); phase_dsa_index(cl); }
        if (kind == 0) SEAM(base + 3);
        STAMP(base + 4);
        if (EN(10) && IN(base + 4) && kind == 0) { LCTX(); phase_dsa_attn(cl); }
        if (kind == 0) SEAM(base + 4);
        STAMP(base + 5);
        if (EN(11) && IN(base + 5)) { LCTX();
            const bf16* A = (const bf16*)(ws + WS_M + (kind == 0 ? M_QLAT : (kind == 1 ? M_Y : M_V)));
            const bf16* Bt = kind == 0 ? (const bf16*)(ws + WS_WAOV) + (size_t)j * 1024 * 2048 : (kind == 1 ? (const bf16*)(ws + WS_WBO) : (const bf16*)(ws + WS_WCO));
            const int K = kind == 1 ? 1280 : 2048;
            EpiResid E{(bf16*)xin, ALPHA_DN, xin};
            run_gemm(cl, A, Bt, 1024, K, E);
        }
        SEAM(base + 5);
        STAMP(base + 6);
        if (EN(12) && IN(base + 6)) { LCTX(); phase_ln1(cl, layer); }
        SEAM(base + 6);
        STAMP(base + 7);
        if (EN(13) && IN(base + 7)) { LCTX(); EpiF32T E{(bf16*)(ws + WS_M + M_SC)};
            run_gemm(cl, xin, (const bf16*)(ws + WS_WPEER) + (size_t)layer * 2048 * 1024, 2048, 1024, E);
            bf16* PP = (bf16*)(ws + WS_PP); EpiBf16R<0> E2{PP, PP, PP, 1024, 1024, 1024, 1 << 30, 1 << 30};
            run_gemm(cl, (const bf16*)(ws + WS_M + M_PB), (const bf16*)(ws + WS_WPLEP) + (size_t)layer * 1024 * 256, 1024, 256, E2); }
        SEAM(base + 7);
        STAMP(base + 8);
        if (EN(14) && IN(base + 8)) { LCTX(); phase_peer_topk(cl); }
        SEAM(base + 8);
        STAMP(base + 9);
        if (EN(15) && IN(base + 9)) { LCTX(); phase_peer_gather(cl, layer, [&]() {}); }
        SEAM(base + 9);
        STAMP(base + 11);
        if (EN(17) && IN(base + 11)) { LCTX(); EpiPle E{xin, (const bf16*)(ws + WS_PP), xnext, INP(cl, I_PLE_BG) + layer * DM, layer == 3 ? cl.out : nullptr};
            run_gemm(cl, xin, (const bf16*)(ws + WS_WPLEG) + (size_t)layer * 1024 * 1024, 1024, 1024, E); }
        SEAM(base + 11);
    }
#if MK_PROBE
    xcd_barrier(bar);
    STAMP(N_PHASES);
    xcd_barrier(bar);
    {
        const unsigned long long* TS = (const unsigned long long*)(p.ws + WS_CTL + 65536);
        float tA = 0.f, tC = 0.f;
        for (int k = 0; k < N_PHASES; ++k) {
            int type = 0;
            if (k > 0) { const int layer = (k - 1) / NPH_LAYER, s = (k - 1) % NPH_LAYER, kind = layer % 3;
                if (!slot_active(kind, s)) continue;
                type = s == 0 ? 1 + kind : s == 1 ? 4 + kind : s == 2 ? (kind == 0 ? 7 : 8) : s == 3 ? 9 : s == 4 ? 10 : 6 + s; }
            const float us = (float)(TS[k + 1] - TS[k]) * 0.01f;
            if ((MK_PROBE_A >> type) & 1u) tA += us;
            if ((MK_PROBE_C >> type) & 1u) tC += us;
        }
        for (size_t i = (size_t)blockIdx.x * NTHR + threadIdx.x; i < (size_t)T_TOK * DM; i += (size_t)gridDim.x * NTHR) p.out[i] = (i == 0) ? 100.f * tA : tC;
    }
#endif
#undef IN
#undef SEAM
#undef xin
#undef xnext
#undef LCTX
}

#if MK_CHECK
#include "CHECKS_PLACEHOLDER"
#endif

#define mk_fwd mk_fwd_t<0>
extern "C" void kernel_launch(void* const* d_in, const int* in_sizes, int n_in, void* d_out, int out_size, void* d_ws, size_t ws_size, hipStream_t stream) {
    static int grid = 0;
    if (grid == 0) {
        if (n_in != N_IN || out_size != T_TOK * DM || ws_size < WS_END) { fprintf(stderr, "kernel_launch: unexpected shapes (n_in %d out %d ws %zu need %zu)\n", n_in, out_size, ws_size, (size_t)WS_END); grid = -1; return; }
        int dev = 0, cus = 0, per_cu = 0;
        if (hipGetDevice(&dev) != hipSuccess || hipDeviceGetAttribute(&cus, hipDeviceAttributeMultiprocessorCount, dev) != hipSuccess) { grid = -1; return; }
        if (hipFuncSetAttribute((const void*)mk_fwd, hipFuncAttributeMaxDynamicSharedMemorySize, LDS_BYTES) != hipSuccess) { fprintf(stderr, "hipFuncSetAttribute failed\n"); grid = -1; return; }
        if (hipOccupancyMaxActiveBlocksPerMultiprocessor(&per_cu, (const void*)mk_fwd, NTHR, LDS_BYTES) != hipSuccess || per_cu < 1) { fprintf(stderr, "occupancy query: %d\n", per_cu); }
        (void)hipGetLastError();
        grid = cus;
    }
    if (grid < 0) return;
    (void)hipMemsetAsync((char*)d_ws + WS_CTL, 0, CTL_BYTES, stream);
    Params p{};
    for (int i = 0; i < N_IN; ++i) p.in[i] = (const float*)d_in[i];
    p.out = (float*)d_out; p.ws = (unsigned char*)d_ws; p.pad = 0;
#if MK_ONE_LAUNCH
#if MK_REPEAT_K >= 0
    p.ph_lo = 0; p.ph_hi = MK_REPEAT_K + 1; p.flags = 1 | MK_PROBE_FLAGS;
    (void)hipFuncSetAttribute((const void*)mk_fwd_t<MK_PROBE_KERNEL>, hipFuncAttributeMaxDynamicSharedMemorySize, LDS_BYTES);
    hipLaunchKernelGGL(mk_fwd_t<MK_PROBE_KERNEL>, dim3(grid), dim3(NTHR), LDS_BYTES, stream, p);
    (void)hipMemsetAsync((char*)d_ws + WS_CTL, 0, CTL_BYTES, stream);
#endif
    p.ph_lo = 0; p.ph_hi = N_PHASES; p.flags = 1;
    hipLaunchKernelGGL(mk_fwd, dim3(grid), dim3(NTHR), LDS_BYTES, stream, p);
#else
    p.flags = 0;
    for (int ph = 0; ph < N_PHASES; ++ph) {
        if (ph > 0) { const int layer = (ph - 1) / NPH_LAYER, s = (ph - 1) % NPH_LAYER; if (!slot_active(layer % 3, s)) continue; }
        p.ph_lo = ph; p.ph_hi = ph + 1;
#if MK_CHECK
        check_pre(ph, p, grid, stream);
#endif
        hipLaunchKernelGGL(mk_fwd, dim3(grid), dim3(NTHR), LDS_BYTES, stream, p);
#if MK_CHECK
        check_post(ph, p, grid, stream);
#endif
    }
#if MK_CHECK
    check_report(p, stream);
#endif
#endif
}
```

```cpp
#define MK_CHECK 0
#define MK_ONE_LAUNCH 1
#include <cstdio>
#include <cmath>
#include <type_traits>
#include <hip/hip_runtime.h>
namespace pg8 {
#define PG8_LAS __attribute__((address_space(3)))
typedef unsigned short bf16_t;
typedef short bf16x8 __attribute__((ext_vector_type(8)));
typedef float f32x4 __attribute__((ext_vector_type(4)));
typedef unsigned u32x4 __attribute__((ext_vector_type(4)));
constexpr int BM = 256, BK = 64, HALF = 128, HTB = HALF * BK * 2  , STAGE_BYTES = 8 * HTB, NXCD = 8, WGM = 8;

__host__ __device__ __forceinline__ int lds_byte(int r, int c) { const int st = (r >> 4) * 2 + (c >> 5), rr = r & 15, cc = c & 31, ob = rr * 64 + cc * 2; return st * 1024 + (ob ^ (((ob >> 9) & 1) << 5)); }
__host__ __device__ __forceinline__ void stage_rc(int b, int& R, int& C) { const int st = b / 1024, sb = b % 1024, swz = sb ^ (((sb >> 9) & 1) << 5); R = (st >> 1) * 16 + swz / 64; C = (st & 1) * 32 + (swz % 64) / 2; }
__host__ __device__ __forceinline__ int perm32(int rho) { const int n = rho >> 4, i = rho & 15; return 8 * (i >> 2) + 4 * n + (i & 3); }

struct Unit { int pm, pn; };
struct Gemm { const bf16_t* A; const bf16_t* Bt; int M, N, K; };

struct StaticOrder {
    int nM, nN, nwg, G, c;
    __host__ __device__ void init(int M, int N, int G_, int c_) { nM = M / BM; nN = N / BM; nwg = nM * nN; G = G_; c = c_; }
    __host__ __device__ bool next(int i, Unit& u) const {
        const long L = (long)i * G + c; if (L >= nwg) return false;
        int wgid = (int)L; { const int q = nwg / NXCD, r = nwg % NXCD, xcd = wgid % NXCD, off = wgid / NXCD; wgid = (xcd < r ? xcd * (q + 1) : r * (q + 1) + (xcd - r) * q) + off; }
        const int nig = WGM * nN, gid = wgid / nig, fm = gid * WGM, gsz = (nM - fm) < WGM ? (nM - fm) : WGM;
        u.pm = fm + ((wgid % nig) % gsz); u.pn = (wgid % nig) / gsz; return true;
    }
    __device__ __forceinline__ void a_ready(const Unit&) const {}
    __device__ __forceinline__ void done(const Unit&) const {}
};
struct CountedOrder : StaticOrder {
    const unsigned* ready; unsigned need; unsigned* tmo;
    __device__ __forceinline__ void a_ready(const Unit& u) const {
        if (threadIdx.x < 64) {
            const unsigned long long t0 = __builtin_amdgcn_s_memrealtime(); unsigned polls = 0;
            while ((unsigned)__builtin_amdgcn_readfirstlane(__hip_atomic_load(ready + 64 * u.pm, __ATOMIC_RELAXED, __HIP_MEMORY_SCOPE_AGENT)) < need) {
                if ((++polls & 255u) == 0u && __builtin_amdgcn_readfirstlane(__hip_atomic_load(tmo, __ATOMIC_RELAXED, __HIP_MEMORY_SCOPE_AGENT)) != 0u) break;
                if (__builtin_amdgcn_s_memrealtime() - t0 > 2000000ull) {
                    if (threadIdx.x == 0) { unsigned expect = 0u; __hip_atomic_compare_exchange_strong(tmo + 1, &expect, 0x600u | (unsigned)(u.pm & 0xff), __ATOMIC_RELAXED, __ATOMIC_RELAXED, __HIP_MEMORY_SCOPE_AGENT); __hip_atomic_store(tmo, 1u, __ATOMIC_RELAXED, __HIP_MEMORY_SCOPE_AGENT); }
                    break; }
                __builtin_amdgcn_s_sleep(2); }
            __builtin_amdgcn_fence(__ATOMIC_ACQUIRE, "agent");
            asm volatile("s_waitcnt vmcnt(0)" ::: "memory");
        }
#if !defined(BROKEN_HOOK_NO_BARRIER)
        asm volatile("" ::: "memory"); __builtin_amdgcn_s_barrier(); asm volatile("" ::: "memory");
#endif
    }
};

__device__ __forceinline__ unsigned cvt_pk_bf16(float lo, float hi) { unsigned r; asm volatile("v_cvt_pk_bf16_f32 %0, %1, %2" : "=v"(r) : "v"(lo), "v"(hi)); return r; }
typedef float f32x2 __attribute__((ext_vector_type(2)));
__device__ __forceinline__ f32x2 gelu_pk(f32x2 v) {
    const f32x2 av = __builtin_elementwise_abs(v), d = av * 0.2316418882f + 1.0f;
    f32x2 t; t.x = __builtin_amdgcn_rcpf(d.x); t.y = __builtin_amdgcn_rcpf(d.y);
    f32x2 q = t * 0.5307027145f + (-0.7265760135f); q = q * t + 0.7107068705f; q = q * t + (-0.142248368f); q = q * t + 0.127414796f; q = q * t;
    const f32x2 s = (v * v) * (-0.72134752044f);
    f32x2 e; e.x = __builtin_amdgcn_exp2f(s.x); e.y = __builtin_amdgcn_exp2f(s.y);
    const f32x2 m = v * (q * e), r = v - m;
    f32x2 o; o.x = v.x < 0.f ? m.x : r.x; o.y = v.y < 0.f ? m.y : r.y; return o;
}

struct EpiF32 {
    static constexpr bool PERM = false, AFTER_DRAIN = false;
    float* C; int ldc; const float* bias;
    __device__ __forceinline__ void operator()(const f32x4 (&acc)[2][2][4][2], const Unit& u, int wr, int wc, int fr, int fq) const {
        const int row0 = u.pm * BM + wr * 64 + fr, col0 = u.pn * BM + wc * 32 + 4 * fq;
        f32x4 bv[2][2];
#pragma unroll
        for (int bj = 0; bj < 2; ++bj)
#pragma unroll
            for (int n = 0; n < 2; ++n) bv[bj][n] = bias ? *(const f32x4*)(bias + col0 + bj * HALF + n * 16) : (f32x4){0.f, 0.f, 0.f, 0.f};
#pragma unroll
        for (int ai = 0; ai < 2; ++ai)
#pragma unroll
            for (int m = 0; m < 4; ++m) { float* rowp = C + (size_t)(row0 + ai * HALF + m * 16) * ldc + col0;
#pragma unroll
                for (int bj = 0; bj < 2; ++bj)
#pragma unroll
                    for (int n = 0; n < 2; ++n) *(f32x4*)(rowp + bj * HALF + n * 16) = acc[ai][bj][m][n] + bv[bj][n]; }
    }
};
template <int ACT  > struct EpiBf16 {
    static constexpr bool PERM = true, AFTER_DRAIN = false;
    bf16_t* O; int ldc; const float* bias; int split_cols; size_t split_stride;
    __device__ __forceinline__ void operator()(const f32x4 (&acc)[2][2][4][2], const Unit& u, int wr, int wc, int fr, int fq) const {
        const int row0 = u.pm * BM + wr * 64 + fr; int colt = u.pn * BM; bf16_t* base = O;
        if (split_cols) { const int t = colt / split_cols; base += (size_t)t * split_stride; colt -= t * split_cols; }
        const int col0 = colt + wc * 32 + 8 * fq, bcol0 = u.pn * BM + wc * 32 + 8 * fq;
        f32x4 bv[2][2];
#pragma unroll
        for (int bj = 0; bj < 2; ++bj)
#pragma unroll
            for (int n = 0; n < 2; ++n) bv[bj][n] = bias ? *(const f32x4*)(bias + bcol0 + bj * HALF + 4 * n) : (f32x4){0.f, 0.f, 0.f, 0.f};
#pragma unroll
        for (int ai = 0; ai < 2; ++ai)
#pragma unroll
            for (int m = 0; m < 4; ++m) { bf16_t* rowp = base + (size_t)(row0 + ai * HALF + m * 16) * ldc + col0;
#pragma unroll
                for (int bj = 0; bj < 2; ++bj) { f32x4 v0 = acc[ai][bj][m][0] + bv[bj][0], v1 = acc[ai][bj][m][1] + bv[bj][1];
                    if (ACT == 1) { f32x2 a = gelu_pk((f32x2){v0[0], v0[1]}), b = gelu_pk((f32x2){v0[2], v0[3]}), c = gelu_pk((f32x2){v1[0], v1[1]}), d = gelu_pk((f32x2){v1[2], v1[3]});
                        v0 = (f32x4){a.x, a.y, b.x, b.y}; v1 = (f32x4){c.x, c.y, d.x, d.y}; }
                    if (ACT == 2) {
#pragma unroll
                        for (int j = 0; j < 4; ++j) { v0[j] = 0.5f * v0[j] * (1.0f + erff(v0[j] * 0.70710678f)); v1[j] = 0.5f * v1[j] * (1.0f + erff(v1[j] * 0.70710678f)); } }
                    u32x4 w; w.x = cvt_pk_bf16(v0[0], v0[1]); w.y = cvt_pk_bf16(v0[2], v0[3]); w.z = cvt_pk_bf16(v1[0], v1[1]); w.w = cvt_pk_bf16(v1[2], v1[3]);
                    *(u32x4*)(rowp + bj * HALF) = w; } }
    }
};

struct PanelStats {
    unsigned* xbuf;
    unsigned* cnt;
    unsigned* tmo;
    int ntn; float eps;
    unsigned code;
    __device__ __forceinline__ bool run(const f32x4 (&v)[2][2][4][2], const Unit& u, int wr, int wc, int fr, int fq, PG8_LAS unsigned char* lds, int wid, int lane) const {
        typedef float f32x2v __attribute__((ext_vector_type(2)));
        PG8_LAS f32x2v* P = (PG8_LAS f32x2v*)lds;
        PG8_LAS f32x2v* S = (PG8_LAS f32x2v*)(lds + 8192);
        PG8_LAS unsigned* flag = (PG8_LAS unsigned*)(lds + 8192 + 2048);
#pragma unroll
        for (int ai = 0; ai < 2; ++ai)
#pragma unroll
            for (int m = 0; m < 4; ++m) {
                float s = 0.f;
#pragma unroll
                for (int bj = 0; bj < 2; ++bj)
#pragma unroll
                    for (int n = 0; n < 2; ++n) { const f32x4 x = v[ai][bj][m][n]; s += (x[0] + x[1]) + (x[2] + x[3]); }
                s += __shfl_xor(s, 16); s += __shfl_xor(s, 32);
                const float mw = s * (1.0f / 64.0f); float q = 0.f;
#pragma unroll
                for (int bj = 0; bj < 2; ++bj)
#pragma unroll
                    for (int n = 0; n < 2; ++n) { const f32x4 d = v[ai][bj][m][n] - mw; q += (d[0] * d[0] + d[1] * d[1]) + (d[2] * d[2] + d[3] * d[3]); }
                q += __shfl_xor(q, 16); q += __shfl_xor(q, 32);
                if (fq == 0) P[(ai * HALF + wr * 64 + m * 16 + fr) * 4 + wc] = (f32x2v){mw, q};
            }
        asm volatile("s_waitcnt lgkmcnt(0)" ::: "memory"); __builtin_amdgcn_s_barrier(); asm volatile("" ::: "memory");
#if defined(BROKEN_NO_WAIT)
        if (blockIdx.x >= 64) { const long long t0 = clock64(); while (clock64() - t0 < 60000) __builtin_amdgcn_s_sleep(8); }
#endif
        const int row = wid * 32 + (lane & 31);
        if (lane < 32) {
            const f32x2v a = P[row * 4 + 0], b = P[row * 4 + 1], c = P[row * 4 + 2], d = P[row * 4 + 3];
            const float mt = (a.x + b.x + c.x + d.x) * 0.25f;
            const float da = a.x - mt, db = b.x - mt, dc = c.x - mt, dd = d.x - mt;
            const float m2 = (a.y + b.y) + (c.y + d.y) + 64.0f * ((da * da + db * db) + (dc * dc + dd * dd));
            unsigned long long* slot = (unsigned long long*)xbuf + ((size_t)(u.pm * BM + row) * 4 + u.pn);
            __hip_atomic_store(slot, ((unsigned long long)__float_as_uint(m2) << 32) | __float_as_uint(mt), __ATOMIC_RELAXED, __HIP_MEMORY_SCOPE_AGENT);
        }
        asm volatile("s_waitcnt vmcnt(0)" ::: "memory");
        if (lane == 0) __hip_atomic_fetch_add(cnt + 64 * u.pm, 1u, __ATOMIC_RELAXED, __HIP_MEMORY_SCOPE_AGENT);
        if (wid == 0) {
            bool dead = false; const unsigned long long t0 = __builtin_amdgcn_s_memrealtime(); const unsigned want = 8u * (unsigned)ntn;
            for (;;) {
#if defined(BROKEN_NO_WAIT)
                break;
#endif
                if ((unsigned)__builtin_amdgcn_readfirstlane(__hip_atomic_load(cnt + 64 * u.pm, __ATOMIC_RELAXED, __HIP_MEMORY_SCOPE_AGENT)) >= want) break;
                if (__builtin_amdgcn_s_memrealtime() - t0 > 2000000ull) {
                    if (lane == 0) { unsigned expect = 0u; __hip_atomic_compare_exchange_strong(tmo + 1, &expect, code | (unsigned)(u.pm & 0xff), __ATOMIC_RELAXED, __ATOMIC_RELAXED, __HIP_MEMORY_SCOPE_AGENT);
                                     __hip_atomic_store(tmo, 1u, __ATOMIC_RELAXED, __HIP_MEMORY_SCOPE_AGENT); }
                    dead = true; break; }
                __builtin_amdgcn_s_sleep(2);
            }
            __builtin_amdgcn_fence(__ATOMIC_ACQUIRE, "agent");
            if (lane == 0) flag[0] = dead ? 1u : 0u;
        }
        asm volatile("s_waitcnt vmcnt(0) lgkmcnt(0)" ::: "memory"); __builtin_amdgcn_s_barrier(); asm volatile("" ::: "memory");
        const bool bad = flag[0] != 0u;
        if (lane < 32) {
            const unsigned long long* slot = (const unsigned long long*)xbuf + (size_t)(u.pm * BM + row) * 4; float mt[4], m2[4]; float ms = 0.f;
#pragma unroll
            for (int t = 0; t < 4; ++t) { if (t < ntn) { const unsigned long long w = __hip_atomic_load(slot + t, __ATOMIC_RELAXED, __HIP_MEMORY_SCOPE_AGENT); mt[t] = __uint_as_float((unsigned)w); m2[t] = __uint_as_float((unsigned)(w >> 32)); } else { mt[t] = 0.f; m2[t] = 0.f; } ms += mt[t]; }
            const float mean = ms / (float)ntn; float q = 0.f;
#pragma unroll
            for (int t = 0; t < 4; ++t) if (t < ntn) { const float dm = mt[t] - mean; q += m2[t] + 256.0f * dm * dm; }
            S[row] = (f32x2v){mean, 1.0f / sqrtf(q / (256.0f * (float)ntn) + eps)};
        }
        asm volatile("s_waitcnt lgkmcnt(0)" ::: "memory"); __builtin_amdgcn_s_barrier(); asm volatile("" ::: "memory");
        return bad;
    }
};
struct EpiLnRes {
    static constexpr bool PERM = false, AFTER_DRAIN = true;
    const float* base; float* out; int ldc; const float* bias; PanelStats st; unsigned poison;
    __device__ __forceinline__ void refuse(size_t i0, size_t stride, int M, int N) const { const float q = __builtin_nanf(""); for (size_t i = i0; i < (size_t)M * N; i += stride) out[(i / N) * ldc + i % N] = q;
        if (i0 == 0) { unsigned expect = 0u; __hip_atomic_compare_exchange_strong(st.tmo + 1, &expect, 0x7f0u, __ATOMIC_RELAXED, __ATOMIC_RELAXED, __HIP_MEMORY_SCOPE_AGENT); __hip_atomic_store(st.tmo, 1u, __ATOMIC_RELAXED, __HIP_MEMORY_SCOPE_AGENT); } }
    __device__ __forceinline__ void fused(f32x4 (&acc)[2][2][4][2], const Unit& u, int wr, int wc, int fr, int fq, PG8_LAS unsigned char* lds, int wid, int lane) const {
        typedef float f32x2v __attribute__((ext_vector_type(2)));
        const PG8_LAS f32x2v* S = (const PG8_LAS f32x2v*)(lds + 8192);
        const int col0 = u.pn * BM + wc * 32 + 4 * fq;
#pragma unroll
        for (int bj = 0; bj < 2; ++bj)
#pragma unroll
            for (int n = 0; n < 2; ++n) { const f32x4 bv = bias ? *(const f32x4*)(bias + col0 + bj * HALF + n * 16) : (f32x4){0.f, 0.f, 0.f, 0.f};
#pragma unroll
                for (int ai = 0; ai < 2; ++ai)
#pragma unroll
                    for (int m = 0; m < 4; ++m) acc[ai][bj][m][n] += bv; }
        const bool bad = st.run(acc, u, wr, wc, fr, fq, lds, wid, lane) || poison != 0u;
        const float qnan = __builtin_nanf("");
#pragma unroll
        for (int ai = 0; ai < 2; ++ai)
#pragma unroll
            for (int m = 0; m < 4; ++m) { const int r = ai * HALF + wr * 64 + m * 16 + fr; const f32x2v sr = S[r]; const size_t off = (size_t)(u.pm * BM + r) * ldc + col0;
#pragma unroll
                for (int bj = 0; bj < 2; ++bj)
#pragma unroll
                    for (int n = 0; n < 2; ++n) { const f32x4 bs = *(const f32x4*)(base + off + bj * HALF + n * 16); f32x4 o = bs + (acc[ai][bj][m][n] - sr.x) * sr.y;
                        if (bad) o = (f32x4){qnan, qnan, qnan, qnan}; *(f32x4*)(out + off + bj * HALF + n * 16) = o; }
                asm volatile("" ::: "memory"); }
    }
};
struct EpiLnResLn {
    static constexpr bool PERM = false, AFTER_DRAIN = true;
    const float* base; float* out; bf16_t* xn; int ldc; const float* bias; PanelStats st1, st2; unsigned poison;
    __device__ __forceinline__ void refuse(size_t i0, size_t stride, int M, int N) const { const float q = __builtin_nanf(""); for (size_t i = i0; i < (size_t)M * N; i += stride) { const size_t o = (i / N) * ldc + i % N; out[o] = q; xn[o] = (bf16_t)0x7fc0u; }
        if (i0 == 0) { unsigned expect = 0u; __hip_atomic_compare_exchange_strong(st1.tmo + 1, &expect, 0x7f0u, __ATOMIC_RELAXED, __ATOMIC_RELAXED, __HIP_MEMORY_SCOPE_AGENT); __hip_atomic_store(st1.tmo, 1u, __ATOMIC_RELAXED, __HIP_MEMORY_SCOPE_AGENT); } }
    __device__ __forceinline__ void fused(f32x4 (&acc)[2][2][4][2], const Unit& u, int wr, int wc, int fr, int fq, PG8_LAS unsigned char* lds, int wid, int lane) const {
        typedef float f32x2v __attribute__((ext_vector_type(2))); typedef unsigned u32x2v __attribute__((ext_vector_type(2)));
        const PG8_LAS f32x2v* S = (const PG8_LAS f32x2v*)(lds + 8192);
        const int col0 = u.pn * BM + wc * 32 + 4 * fq;
#pragma unroll
        for (int bj = 0; bj < 2; ++bj)
#pragma unroll
            for (int n = 0; n < 2; ++n) { const f32x4 bv = bias ? *(const f32x4*)(bias + col0 + bj * HALF + n * 16) : (f32x4){0.f, 0.f, 0.f, 0.f};
#pragma unroll
                for (int ai = 0; ai < 2; ++ai)
#pragma unroll
                    for (int m = 0; m < 4; ++m) acc[ai][bj][m][n] += bv; }
        bool bad = st1.run(acc, u, wr, wc, fr, fq, lds, wid, lane) || poison != 0u;
        const float qnan = __builtin_nanf("");
#pragma unroll
        for (int ai = 0; ai < 2; ++ai)
#pragma unroll
            for (int m = 0; m < 4; ++m) { const int r = ai * HALF + wr * 64 + m * 16 + fr; const f32x2v sr = S[r]; const size_t off = (size_t)(u.pm * BM + r) * ldc + col0;
#pragma unroll
                for (int bj = 0; bj < 2; ++bj)
#pragma unroll
                    for (int n = 0; n < 2; ++n) { const f32x4 bs = *(const f32x4*)(base + off + bj * HALF + n * 16); acc[ai][bj][m][n] = bs + (acc[ai][bj][m][n] - sr.x) * sr.y; }
                asm volatile("" : "+v"(acc[ai][0][m][0]), "+v"(acc[ai][0][m][1]), "+v"(acc[ai][1][m][0]), "+v"(acc[ai][1][m][1]));
                if (m & 1) asm volatile("" ::: "memory"); }
        const bool bad1 = bad;
        bad = st2.run(acc, u, wr, wc, fr, fq, lds, wid, lane) || bad;
#pragma unroll
        for (int ai = 0; ai < 2; ++ai)
#pragma unroll
            for (int m = 0; m < 4; ++m) { const int r = ai * HALF + wr * 64 + m * 16 + fr; const f32x2v sr = S[r]; const size_t off = (size_t)(u.pm * BM + r) * ldc + col0;
#pragma unroll
                for (int bj = 0; bj < 2; ++bj)
#pragma unroll
                    for (int n = 0; n < 2; ++n) { const f32x4 x1 = acc[ai][bj][m][n]; *(f32x4*)(out + off + bj * HALF + n * 16) = bad1 ? (f32x4){qnan, qnan, qnan, qnan} : x1;
                        const f32x4 o = (x1 - sr.x) * sr.y; u32x2v w; w.x = cvt_pk_bf16(o[0], o[1]); w.y = cvt_pk_bf16(o[2], o[3]);
                        if (bad) { w.x = 0x7fc07fc0u; w.y = 0x7fc07fc0u; } *(u32x2v*)(xn + off + bj * HALF + n * 16) = w; }
                asm volatile("" ::: "memory"); }
    }
};

template <class Epi, class Sched, bool STAMP = false>
__device__ __forceinline__ void gemm_phase(PG8_LAS unsigned char* lds, const Gemm g, const Sched& S, const Epi& E, unsigned long long* stamps) {
    int tid_l = threadIdx.x; asm volatile("" : "+v"(tid_l));
    const int tid = tid_l, wid = __builtin_amdgcn_readfirstlane(tid >> 6), lane = tid & 63, wr = wid >> 2, wc = wid & 3, fr = lane & 15, fq = lane >> 4;
    const int K = g.K, nt = K / BK;
    int ts_lo = 0, ts_hi = 0, nts = 0; const unsigned long long rt_entry = STAMP ? (unsigned long long)wall_clock64() : 0ull;
#define PG8_STAMP() do { if (STAMP && wid == 0 && nts < 64) { const unsigned long long _c = (unsigned long long)clock64(); \
        ts_lo = (lane == nts) ? (int)(unsigned)_c : ts_lo; ts_hi = (lane == nts) ? (int)(unsigned)(_c >> 32) : ts_hi; ++nts; } } while (0)
    PG8_STAMP();
    unsigned voffA[2], voffB[2];
#pragma unroll
    for (int i = 0; i < 2; ++i) { int R, C; stage_rc(tid * 16 + i * 8192, R, C); const int Rb = Epi::PERM ? ((R & ~31) + perm32(R & 31)) : R;
        voffA[i] = (unsigned)(R * K + C) * 2u; voffB[i] = (unsigned)(Rb * K + C) * 2u; }
    const size_t kstep = (size_t)(BK * 2);
    const size_t hstep = (size_t)HALF * K * 2;
    const size_t tstep = 2 * hstep;
    const unsigned ldsw = (unsigned)wid * 1024u;
    const int aoff = lds_byte(wr * 64 + fr, fq * 8), boff = lds_byte(wc * 32 + fr, fq * 8);
#define PG8_SA(b, h) (((b) * 2 + (h)) * HTB)
#define PG8_SB(b, h) ((4 + (b) * 2 + (h)) * HTB)
#define PG8_STAGE(bufoff, gbase, voff) do { _Pragma("unroll") for (int _i = 0; _i < 2; ++_i) \
        __builtin_amdgcn_global_load_lds((const unsigned*)((const char*)(gbase) + (voff)[_i]), (PG8_LAS unsigned*)(lds + (bufoff) + ldsw + _i * 8192), 16, 0, 0); } while (0)
#define PG8_LDA(dst, b, h) do { _Pragma("unroll") for (int m = 0; m < 4; ++m) _Pragma("unroll") for (int k = 0; k < 2; ++k) dst[m][k] = *(const PG8_LAS bf16x8*)(lds + PG8_SA(b, h) + aoff + m * 2048 + k * 1024); } while (0)
#define PG8_LDB(dst, b, h) do { _Pragma("unroll") for (int n = 0; n < 2; ++n) _Pragma("unroll") for (int k = 0; k < 2; ++k) dst[n][k] = *(const PG8_LAS bf16x8*)(lds + PG8_SB(b, h) + boff + n * 2048 + k * 1024); } while (0)
#define PG8_MMA(ai, bj, At, Bt) do { __builtin_amdgcn_s_setprio(1); _Pragma("unroll") for (int m = 0; m < 4; ++m) _Pragma("unroll") for (int n = 0; n < 2; ++n) _Pragma("unroll") for (int k = 0; k < 2; ++k) \
        acc[ai][bj][m][n] = __builtin_amdgcn_mfma_f32_16x16x32_bf16(Bt[n][k], At[m][k], acc[ai][bj][m][n], 0, 0, 0); __builtin_amdgcn_s_setprio(0); } while (0)
#define PG8_WAIT_V(n) asm volatile("s_waitcnt vmcnt(" #n ")" ::: "memory")
#define PG8_WAIT_L(n) asm volatile("s_waitcnt lgkmcnt(" #n ")" ::: "memory")
#define PG8_BAR __builtin_amdgcn_s_barrier()
#define PG8_SCHED __builtin_amdgcn_sched_barrier(0)
    Unit cur, nxt; int ui = 0;
    if (!S.next(0, cur)) return;
    f32x4 acc[2][2][4][2];
#pragma unroll
    for (int a = 0; a < 2; ++a)
#pragma unroll
        for (int b = 0; b < 2; ++b)
#pragma unroll
            for (int m = 0; m < 4; ++m)
#pragma unroll
                for (int n = 0; n < 2; ++n) acc[a][b][m][n] = (f32x4){0.f, 0.f, 0.f, 0.f};
    bf16x8 At[4][2], B0[2][2], B1[2][2];
    const char* cA = (const char*)g.A + (size_t)cur.pm * tstep; const char* cB = (const char*)g.Bt + (size_t)cur.pn * tstep;
    S.a_ready(cur);
    PG8_STAGE(PG8_SB(0, 0), cB, voffB); PG8_STAGE(PG8_SA(0, 0), cA, voffA); PG8_STAGE(PG8_SB(0, 1), cB + hstep, voffB); PG8_STAGE(PG8_SA(0, 1), cA + hstep, voffA);
    if (wr == 1) PG8_BAR;
    PG8_WAIT_V(4); PG8_BAR;
    PG8_STAGE(PG8_SB(1, 0), cB + kstep, voffB); PG8_STAGE(PG8_SA(1, 0), cA + kstep, voffA); PG8_STAGE(PG8_SB(1, 1), cB + hstep + kstep, voffB);
    PG8_WAIT_V(6); PG8_BAR;
    PG8_STAMP();
    for (;;) {
        const bool has_next = S.next(ui + 1, nxt);
        const char* nA = has_next ? (const char*)g.A + (size_t)nxt.pm * tstep : cA; const char* nB = has_next ? (const char*)g.Bt + (size_t)nxt.pn * tstep : cB;
        for (int t = 0; t < nt; t += 2) {
            const bool last = (t == nt - 2);
            const char* a1 = cA + (size_t)(t + 1) * kstep;
            const char* a2 = last ? nA : cA + (size_t)(t + 2) * kstep; const char* b2 = last ? nB : cB + (size_t)(t + 2) * kstep;
            const char* a3 = a2 + kstep; const char* b3 = b2 + kstep;
            if (last && has_next) S.a_ready(nxt);
            PG8_LDB(B0, 0, 0); PG8_SCHED; PG8_LDA(At, 0, 0); PG8_STAGE(PG8_SA(1, 1), a1 + hstep, voffA);
            PG8_WAIT_L(8); PG8_BAR; PG8_WAIT_L(0); PG8_MMA(0, 0, At, B0); PG8_BAR; PG8_SCHED;
            PG8_LDB(B1, 0, 1); PG8_STAGE(PG8_SB(0, 0), b2, voffB);
            PG8_BAR; PG8_WAIT_L(0); PG8_MMA(0, 1, At, B1); PG8_BAR;
            PG8_LDA(At, 0, 1); PG8_STAGE(PG8_SA(0, 0), a2, voffA);
            PG8_BAR; PG8_WAIT_L(0); PG8_MMA(1, 0, At, B0); PG8_BAR; PG8_SCHED;
            PG8_STAGE(PG8_SB(0, 1), b2 + hstep, voffB);
            PG8_WAIT_V(6); PG8_BAR; PG8_MMA(1, 1, At, B1); PG8_BAR;
            PG8_LDB(B0, 1, 0); PG8_SCHED; PG8_LDA(At, 1, 0); PG8_STAGE(PG8_SA(0, 1), a2 + hstep, voffA);
            PG8_WAIT_L(8); PG8_BAR; PG8_WAIT_L(0); PG8_MMA(0, 0, At, B0); PG8_BAR; PG8_SCHED;
            PG8_LDB(B1, 1, 1); PG8_STAGE(PG8_SB(1, 0), b3, voffB);
            PG8_BAR; PG8_WAIT_L(0); PG8_MMA(0, 1, At, B1); PG8_BAR;
            PG8_LDA(At, 1, 1); PG8_STAGE(PG8_SA(1, 0), a3, voffA);
            PG8_BAR; PG8_WAIT_L(0); PG8_MMA(1, 0, At, B0); PG8_BAR; PG8_SCHED;
            PG8_STAGE(PG8_SB(1, 1), b3 + hstep, voffB);
            PG8_WAIT_V(6); PG8_BAR; PG8_MMA(1, 1, At, B1); PG8_BAR;
        }
        PG8_STAMP();
        if constexpr (!Epi::AFTER_DRAIN) { E(acc, cur, wr, wc, fr, fq); S.done(cur); }
        PG8_STAMP();
        if (!has_next) break;
#pragma unroll
        for (int a = 0; a < 2; ++a)
#pragma unroll
            for (int b = 0; b < 2; ++b)
#pragma unroll
                for (int m = 0; m < 4; ++m)
#pragma unroll
                    for (int n = 0; n < 2; ++n) acc[a][b][m][n] = (f32x4){0.f, 0.f, 0.f, 0.f};
        cur = nxt; cA = nA; cB = nB; ++ui;
    }
    PG8_WAIT_V(0);
    if (wr == 0) PG8_BAR;
    PG8_BAR;
    if constexpr (Epi::AFTER_DRAIN) { E.fused(acc, cur, wr, wc, fr, fq, lds, wid, lane); S.done(cur); }
    PG8_STAMP();
    if (STAMP && wid == 0) { stamps[lane] = lane < nts ? (((unsigned long long)(unsigned)ts_hi << 32) | (unsigned)ts_lo) : 0ull;
        if (lane == 62) stamps[62] = rt_entry; if (lane == 63) stamps[63] = (unsigned long long)wall_clock64(); }
#undef PG8_STAMP
#undef PG8_SA
#undef PG8_SB
#undef PG8_STAGE
#undef PG8_LDA
#undef PG8_LDB
#undef PG8_MMA
#undef PG8_WAIT_V
#undef PG8_WAIT_L
#undef PG8_BAR
#undef PG8_SCHED
}
}

#define GAS __attribute__((address_space(1)))
#define LAS __attribute__((address_space(3)))
typedef unsigned short bf16;
typedef unsigned v4u __attribute__((ext_vector_type(4)));
typedef unsigned v2u __attribute__((ext_vector_type(2)));
typedef float f32x4 __attribute__((ext_vector_type(4)));
typedef float f32x2 __attribute__((ext_vector_type(2)));
typedef float f32x16 __attribute__((ext_vector_type(16)));
typedef short bf16x8 __attribute__((ext_vector_type(8)));
typedef short bf16x4 __attribute__((ext_vector_type(4)));

#ifndef MK_CHECK
#define MK_CHECK 0
#endif
#ifndef MK_ONE_LAUNCH
#define MK_ONE_LAUNCH 0
#endif
#ifndef MK_PROBE
#define MK_PROBE 0
#endif
#ifndef MK_DUP10
#define MK_DUP10 0
#endif
#ifndef MK_PROBE_KERNEL
#define MK_PROBE_KERNEL 0
#endif
#ifndef MK_PROBE_FLAGS
#define MK_PROBE_FLAGS 0
#endif
#ifndef MK_REPEAT_K
#define MK_REPEAT_K (-1)
#endif
#ifndef MK_PROBE_A
#define MK_PROBE_A 0u
#endif
#ifndef MK_PROBE_C
#define MK_PROBE_C 0u
#endif

constexpr int T_TOK = 65536, DM = 1024, SEQ = 2048, NBATCH = 32;
constexpr float ALPHA_DN = 1.6817928305074290f;
#ifndef PEER_U4
#define PEER_U4 1
#endif
#ifndef PEER_V4
#define PEER_V4 1
#endif
constexpr float PEER_USCALE = PEER_U4 ? 64.0f : 256.0f, PEER_VSCALE = PEER_V4 ? 12.8f : 32.0f;
constexpr int PEER_UROW = PEER_U4 ? 512 : 1024, PEER_VROW = PEER_V4 ? 512 : 1024;
constexpr int NWAVES = 8, NTHR = 512;
constexpr int NPH_LAYER = 12;
constexpr int N_PHASES = 1 + 4 * NPH_LAYER;

constexpr size_t MiB = 1u << 20;
constexpr size_t WS_CTL = 0, CTL_BYTES = 1 * MiB;
constexpr size_t WS_ROT = 1 * MiB;
constexpr size_t WS_WPEER = 4 * MiB;
constexpr size_t WS_WPLEG = 20 * MiB;
constexpr size_t WS_WPLEP = 28 * MiB;
constexpr size_t WS_WAIN = 30 * MiB;
constexpr size_t WS_WAQ = 32 * MiB;
constexpr size_t WAQ_STRIDE = 2560 * 256 * 2;
constexpr size_t WS_WAOV = 35 * MiB;
constexpr size_t WS_WBIN = 43 * MiB;
constexpr size_t WS_WBO = 48 * MiB;
constexpr size_t WS_WCIN = 51 * MiB;
constexpr size_t WS_WCO = 63 * MiB;
constexpr size_t WS_TABU = 68 * MiB, WS_TABV = 100 * MiB;
constexpr size_t WS_XB0 = 132 * MiB, WS_XB1 = 260 * MiB;
constexpr size_t WS_M = 388 * MiB;
constexpr size_t M_SC = 0, M_IDS = 512 * MiB, M_GATES = 544 * MiB, M_PB = 576 * MiB, M_PP = 0;
constexpr size_t M_RAW = 0, M_CQ = 128 * MiB, M_CKV = 160 * MiB, M_CKVT = 176 * MiB, M_KIDX = 192 * MiB, M_WIDX = 200 * MiB,
                 M_MASK = 202 * MiB, M_QLAT = 218 * MiB, M_QIDX = 474 * MiB;
constexpr size_t M_GU = 0, M_Y = 320 * MiB;
constexpr size_t M_Q = 0, M_K = 128 * MiB, M_V = 256 * MiB, M_STAT = 512 * MiB;
constexpr size_t WS_PP = WS_M + 608 * MiB;
constexpr size_t WS_END = WS_PP + 128 * MiB;
constexpr int CW_DIAG = 64;
constexpr int CW_BAR = 4096;

constexpr int RING_BYTES = 131072, LDS_BYTES = 147456, LDSCTL_OFF = LDS_BYTES - 512, MISC_OFF = LDSCTL_OFF + 320;

enum { I_X = 0, I_P, I_A_W_IN, I_A_CQ_GAIN, I_A_CKV_GAIN, I_A_W_UQ, I_A_W_UK, I_A_W_QIDX, I_A_KIDX_GAIN, I_A_KIDX_BIAS, I_A_W_UV, I_A_W_O,
       I_B_W_IN, I_B_CONV_W, I_B_CONV_B, I_B_W_A, I_B_B_A, I_B_W_X, I_B_B_X, I_B_LAMBDA, I_B_W_O, I_C_W_IN, I_C_W_O,
       I_LN1_G, I_LN1_B, I_PEER_WQ, I_PEER_SK, I_PEER_U, I_PEER_V, I_LN2_G, I_LN2_B, I_PLE_WP, I_PLE_WG, I_PLE_BG, N_IN };

struct Params { const float* in[N_IN]; float* out; unsigned char* ws; int ph_lo, ph_hi, flags, pad; };

typedef const float* const __attribute__((address_space(4)))* InTab;
struct Ctx {
    LAS unsigned char* lds;
    int tid, lane, wave, bid, G;
    InTab in; float* out; unsigned char* ws;
};
#define INP(cx, i) ((const float*)(const GAS float*)((cx).in[i]))

#define LDS_WAIT() asm volatile("s_waitcnt lgkmcnt(0)" ::: "memory")
#define VM_WAIT() asm volatile("s_waitcnt vmcnt(0)" ::: "memory")

typedef __bf16 bf16v2_t __attribute__((ext_vector_type(2)));
__device__ __forceinline__ unsigned pk2(float lo, float hi) { const f32x2 v = {lo, hi}; const bf16v2_t b = __builtin_convertvector(v, bf16v2_t); return __builtin_bit_cast(unsigned, b); }
__device__ __forceinline__ unsigned f2bf(float f) { return (unsigned)__builtin_bit_cast(unsigned short, (__bf16)f); }
__device__ __forceinline__ float bflo(unsigned w) { return __builtin_bit_cast(float, w << 16); }
__device__ __forceinline__ float bfhi(unsigned w) { return __builtin_bit_cast(float, w & 0xffff0000u); }
__device__ __forceinline__ float bf2f(bf16 b) { return __builtin_bit_cast(float, ((unsigned)b) << 16); }
template <int CTRL, int ROWMASK>
__device__ __forceinline__ float dpp_f(float v) { return __builtin_bit_cast(float, __builtin_amdgcn_update_dpp(0, __builtin_bit_cast(int, v), CTRL, ROWMASK, 0xf, false)); }
__device__ __forceinline__ float wave_sum_uniform(float v) {
    v += dpp_f<0xB1, 0xf>(v);
    v += dpp_f<0x4E, 0xf>(v);
    v += dpp_f<0x141, 0xf>(v);
    v += dpp_f<0x140, 0xf>(v);
    v += dpp_f<0x142, 0xa>(v);
    v += dpp_f<0x143, 0xc>(v);
    return __builtin_bit_cast(float, __builtin_amdgcn_readlane(__builtin_bit_cast(int, v), 63));
}
__device__ __forceinline__ float wave_sum(float v) { return wave_sum_uniform(v); }
__device__ __forceinline__ float gelu_tanh(float x) {
    const float u = 0.7978845608028654f * (x + 0.044715f * x * x * x);
    const float e = __expf(2.0f * u);
    const float th = 1.0f - 2.0f * __builtin_amdgcn_rcpf(e + 1.0f);
    return 0.5f * x * (1.0f + th);
}
__device__ __forceinline__ float sigmoidf_(float x) { return __builtin_amdgcn_rcpf(1.0f + __expf(-x)); }

#define XB_TMO      128
#define XB_XCNT(j)  (256  + 64 * (j))
#define XB_XSUB(j)  (1280 + 64 * (j))
#define XB_XGEN(j)  (2304 + 64 * (j))
#define XB_TOP      3328
#define XB_TOPGEN   3392
#define XCD_BAR_WORDS 3456
#define XB_SPIN_CAP (1u << 25)
__device__ __forceinline__ unsigned xb_ld(unsigned* p)              { return __hip_atomic_load(p, __ATOMIC_RELAXED, __HIP_MEMORY_SCOPE_AGENT); }
__device__ __forceinline__ unsigned xb_add(unsigned* p, unsigned v) { return __hip_atomic_fetch_add(p, v, __ATOMIC_RELAXED, __HIP_MEMORY_SCOPE_AGENT); }
__device__ __forceinline__ unsigned xb_xcc_id() { return (unsigned)__builtin_amdgcn_s_getreg((3 << 11) | 20) & 0xFu; }
#define XB_SPIN(cond, bar) do { unsigned _sp = 0; while (cond) { __builtin_amdgcn_s_sleep(1); \
    if ((++_sp & 255u) == 0u) { if (xb_ld(&(bar)[XB_TMO])) break; if (_sp > XB_SPIN_CAP) { atomicAdd(&(bar)[XB_TMO], 1u); break; } } } } while (0)
struct XcdBarrier { unsigned* bar; unsigned x; volatile LAS unsigned* st; };
__device__ __forceinline__ XcdBarrier xcd_barrier_post(unsigned* bar, volatile LAS unsigned* st) {
    XcdBarrier b; b.bar = bar; b.x = xb_xcc_id(); b.st = st;
    if (threadIdx.x == 0) (void)xb_add(&bar[XB_XCNT(b.x)], 1u);
    return b;
}
__device__ __forceinline__ void xcd_barrier_complete(unsigned* bar, unsigned x, unsigned& nloc, unsigned& nx) {
    const unsigned G = gridDim.x * gridDim.y * gridDim.z;
    unsigned sum, cnt, mine, sp = 0u;
    for (;;) {
        sum = 0u; cnt = 0u; mine = 0u;
#pragma unroll
        for (unsigned j = 0; j < 16; ++j) { const unsigned c = xb_ld(&bar[XB_XCNT(j)]); sum += c; cnt += (c > 0u) ? 1u : 0u; mine = (j == x) ? c : mine; }
        if (sum == G) break;
        __builtin_amdgcn_s_sleep(1);
        if ((++sp & 255u) == 0u) { if (xb_ld(&bar[XB_TMO])) break; if (sp > XB_SPIN_CAP) { atomicAdd(&bar[XB_TMO], 1u); break; } }
    }
    nloc = mine > 0u ? mine : 1u; nx = cnt > 0u ? cnt : 1u;
}
__device__ __forceinline__ void xcd_barrier(const XcdBarrier& b) {
    asm volatile("s_waitcnt vmcnt(0)" ::: "memory");
    __syncthreads();
    if (threadIdx.x == 0) {
        unsigned* bar = b.bar;
        __builtin_amdgcn_s_waitcnt(0);
        unsigned nloc = b.st[0], nx = b.st[1];
        if (nloc == 0u) { xcd_barrier_complete(bar, b.x, nloc, nx); b.st[0] = nloc; b.st[1] = nx; }
        const unsigned old = xb_add(&bar[XB_XSUB(b.x)], 1u);
        const unsigned gen = old / nloc;
        if (old + 1u == (gen + 1u) * nloc) {
            __builtin_amdgcn_fence(__ATOMIC_RELEASE, "agent");
            asm volatile("s_waitcnt vmcnt(0)" ::: "memory");
            const unsigned og = xb_add(&bar[XB_TOP], 1u);
            const unsigned tg = og / nx;
            if (og + 1u == (tg + 1u) * nx) xb_add(&bar[XB_TOPGEN], 1u);
            else XB_SPIN(xb_ld(&bar[XB_TOPGEN]) == tg, bar);
            __builtin_amdgcn_fence(__ATOMIC_ACQUIRE, "agent");
            xb_add(&bar[XB_XGEN(b.x)], 1u);
            asm volatile("s_waitcnt vmcnt(0)" ::: "memory");
        } else {
            XB_SPIN(xb_ld(&bar[XB_XGEN(b.x)]) == gen, bar);
            __builtin_amdgcn_fence(__ATOMIC_ACQUIRE, "agent");
            asm volatile("s_waitcnt vmcnt(0)" ::: "memory");
        }
    }
    __syncthreads();
}

__device__ __forceinline__ void p0_transpose_item(const float* W, int K, int N, bf16* WT, int row_off, float scale, LAS float* scr, int item, int lane) {
    const int nblk = N / 32, kb = item / nblk, nb = item % nblk, k0 = 64 * kb, n0 = 32 * nb;
#pragma unroll 8
    for (int i = 0; i < 32; ++i) { const int kk = 2 * i + (lane >> 5); scr[kk * 33 + (lane & 31)] = W[(size_t)(k0 + kk) * N + n0 + (lane & 31)] * scale; }
    LDS_WAIT(); asm volatile("" ::: "memory");
    const int c = lane & 7;
#pragma unroll
    for (int j = 0; j < 4; ++j) { const int n = (lane >> 3) + 8 * j; const LAS float* s = scr + (8 * c) * 33 + n;
        v4u o; o.x = pk2(s[0 * 33], s[1 * 33]); o.y = pk2(s[2 * 33], s[3 * 33]); o.z = pk2(s[4 * 33], s[5 * 33]); o.w = pk2(s[6 * 33], s[7 * 33]);
        *(v4u*)(WT + (size_t)(row_off + n0 + n) * K + k0 + 8 * c) = o; }
    LDS_WAIT(); asm volatile("" ::: "memory");
}

__device__ __forceinline__ void small_gemm_tile(const Ctx& c, const float* A, long sa_n, long sa_d, const float* Bm, long sb_k, long sb_d, int Kd,
                                                bf16* C, int ldc, int n0, int k0, float scale) {
    LAS float* As = (LAS float*)c.lds; LAS float* Bs = As + 128 * 68;
    __syncthreads();
    for (int e = c.tid; e < 64 * Kd; e += NTHR) {
        int r, d;
        if (sa_d == 1) { d = e % Kd; r = e / Kd; } else { r = e & 63; d = e >> 6; }
        As[d * 68 + r] = A[(long)(n0 + r) * sa_n + (long)d * sa_d];
    }
    for (int e = c.tid; e < 64 * Kd; e += NTHR) {
        int r, d;
        if (sb_d == 1) { d = e % Kd; r = e / Kd; } else { r = e & 63; d = e >> 6; }
        Bs[d * 68 + r] = Bm[(long)(k0 + r) * sb_k + (long)d * sb_d];
    }
    __syncthreads();
    {
        const int tn = (c.tid >> 5) * 4, tk = (c.tid & 31) * 2;
        float acc[4][2];
#pragma unroll
        for (int i = 0; i < 4; ++i) { acc[i][0] = 0.f; acc[i][1] = 0.f; }
        for (int d = 0; d < Kd; ++d) {
            const f32x4 a = *(const LAS f32x4*)(As + d * 68 + tn); const f32x2 b = *(const LAS f32x2*)(Bs + d * 68 + tk);
#pragma unroll
            for (int i = 0; i < 4; ++i) { acc[i][0] += a[i] * b[0]; acc[i][1] += a[i] * b[1]; }
        }
#pragma unroll
        for (int i = 0; i < 4; ++i) *(unsigned*)(C + (size_t)(n0 + tn + i) * ldc + k0 + tk) = pk2(acc[i][0] * scale, acc[i][1] * scale);
    }
}

__device__ __forceinline__ void ln_store_row(float (&v)[16], const float* gain, const float* bias, float* of, bf16* ob, int lane) {
    float s = 0.f;
#pragma unroll
    for (int j = 0; j < 16; ++j) s += v[j];
    const float mean = wave_sum(s) * (1.f / 1024.f);
    float s2 = 0.f;
#pragma unroll
    for (int j = 0; j < 16; ++j) { v[j] -= mean; s2 += v[j] * v[j]; }
    const float rstd = __builtin_amdgcn_rsqf(wave_sum(s2) * (1.f / 1024.f) + 1e-5f);
#pragma unroll
    for (int h = 0; h < 2; ++h) {
        const int col = h * 512 + 8 * lane;
        const f32x4 g0 = *(const f32x4*)(gain + col), g1 = *(const f32x4*)(gain + col + 4), b0 = *(const f32x4*)(bias + col), b1 = *(const f32x4*)(bias + col + 4);
        f32x4 o0, o1;
#pragma unroll
        for (int j = 0; j < 4; ++j) { o0[j] = v[h * 8 + j] * rstd * g0[j] + b0[j]; o1[j] = v[h * 8 + 4 + j] * rstd * g1[j] + b1[j]; }
        if (of) { *(f32x4*)(of + col) = o0; *(f32x4*)(of + col + 4) = o1; }
        v4u w; w.x = pk2(o0[0], o0[1]); w.y = pk2(o0[2], o0[3]); w.z = pk2(o1[0], o1[1]); w.w = pk2(o1[2], o1[3]);
        *(v4u*)(ob + col) = w;
    }
}
__device__ __forceinline__ void load_row16(const float* row, float (&v)[16], int lane) {
#pragma unroll
    for (int h = 0; h < 2; ++h) { const f32x4 a = *(const f32x4*)(row + h * 512 + 8 * lane), b = *(const f32x4*)(row + h * 512 + 8 * lane + 4);
#pragma unroll
        for (int j = 0; j < 4; ++j) { v[h * 8 + j] = a[j]; v[h * 8 + 4 + j] = b[j]; } }
}

__device__ __forceinline__ void load_row16_bf(const bf16* row, float (&v)[16], int lane) {
#pragma unroll
    for (int h = 0; h < 2; ++h) { const v4u w = *(const v4u*)(row + h * 512 + 8 * lane);
        v[h * 8 + 0] = bflo(w.x); v[h * 8 + 1] = bfhi(w.x); v[h * 8 + 2] = bflo(w.y); v[h * 8 + 3] = bfhi(w.y);
        v[h * 8 + 4] = bflo(w.z); v[h * 8 + 5] = bfhi(w.z); v[h * 8 + 6] = bflo(w.w); v[h * 8 + 7] = bfhi(w.w); }
}

__device__ __forceinline__ void load_row16c(const float* row, float (&v)[16], int lane) {
#pragma unroll
    for (int q = 0; q < 4; ++q) { const f32x4 a = *(const f32x4*)(row + 16 * lane + 4 * q);
#pragma unroll
        for (int j = 0; j < 4; ++j) v[4 * q + j] = a[j]; }
}
__device__ __forceinline__ void ln_store_row_c(float (&v)[16], const float* gain, const float* bias, float* of, bf16* ob, int lane) {
    float s = 0.f;
#pragma unroll
    for (int j = 0; j < 16; ++j) s += v[j];
    const float mean = wave_sum(s) * (1.f / 1024.f);
    float s2 = 0.f;
#pragma unroll
    for (int j = 0; j < 16; ++j) { v[j] -= mean; s2 += v[j] * v[j]; }
    const float rstd = __builtin_amdgcn_rsqf(wave_sum(s2) * (1.f / 1024.f) + 1e-5f);
    const int col = 16 * lane;
    float o[16];
#pragma unroll
    for (int q = 0; q < 4; ++q) { const f32x4 g = *(const f32x4*)(gain + col + 4 * q), b = *(const f32x4*)(bias + col + 4 * q); f32x4 r;
#pragma unroll
        for (int j = 0; j < 4; ++j) { r[j] = v[4 * q + j] * rstd * g[j] + b[j]; o[4 * q + j] = r[j]; }
        *(f32x4*)(of + col + 4 * q) = r; }
    v4u w0, w1; w0.x = pk2(o[0], o[1]); w0.y = pk2(o[2], o[3]); w0.z = pk2(o[4], o[5]); w0.w = pk2(o[6], o[7]);
    w1.x = pk2(o[8], o[9]); w1.y = pk2(o[10], o[11]); w1.z = pk2(o[12], o[13]); w1.w = pk2(o[14], o[15]);
    *(v4u*)(ob + col) = w0; *(v4u*)(ob + col + 8) = w1;
}

__device__ __forceinline__ void phase_prologue(const Ctx& c) {
    unsigned char* ws = c.ws;
    LAS float* scr = (LAS float*)(c.lds + c.wave * 16384);
    const int gw = c.bid * NWAVES + c.wave, NGW = c.G * NWAVES;
    {
        struct TI { const float* W; int K, N; bf16* WT; int row_off; float scale; };
        int base = 0;
#define TR_ITEMS(Wp, Kv, Nv, WTp, roff, sc) do { const int ni = ((Kv) / 64) * ((Nv) / 32); \
            for (int it = gw; it < ni; it += NGW) p0_transpose_item((Wp), (Kv), (Nv), (WTp), (roff), (sc), scr, it, c.lane); base += ni; } while (0)
        for (int i = 0; i < 4; ++i) {
            TR_ITEMS(INP(c, I_PLE_WG) + (size_t)i * 1024 * 1024, 1024, 1024, (bf16*)(ws + WS_WPLEG) + (size_t)i * 1024 * 1024, 0, 1.0f);
            TR_ITEMS(INP(c, I_PLE_WP) + (size_t)i * 256 * 1024, 256, 1024, (bf16*)(ws + WS_WPLEP) + (size_t)i * 1024 * 256, 0, 1.0f);
        }
        for (int j = 0; j < 2; ++j)
            TR_ITEMS(INP(c, I_A_W_QIDX) + (size_t)j * 256 * 512, 256, 512, (bf16*)(ws + WS_WAQ + j * WAQ_STRIDE), 2048, 0.125f);
        TR_ITEMS(INP(c, I_B_W_IN), 1024, 2560, (bf16*)(ws + WS_WBIN), 0, 1.0f);
        TR_ITEMS(INP(c, I_B_W_O), 1280, 1024, (bf16*)(ws + WS_WBO), 0, 1.0f);
        TR_ITEMS(INP(c, I_C_W_IN), 1024, 6144, (bf16*)(ws + WS_WCIN), 0, 1.0f);
        TR_ITEMS(INP(c, I_C_W_O), 2048, 1024, (bf16*)(ws + WS_WCO), 0, 1.0f);
#undef TR_ITEMS
        (void)base;
    }
    for (int j = 0; j < 2; ++j) {
        const float* W = INP(c, I_A_W_IN) + (size_t)j * 1024 * 456; bf16* WT = (bf16*)(ws + WS_WAIN) + (size_t)j * 512 * 1024;
        for (int e = c.bid * NTHR + c.tid; e < 512 * 1024; e += c.G * NTHR) { const int n = e >> 10, k = e & 1023; WT[e] = (bf16)(n < 456 ? f2bf(W[(size_t)k * 456 + n]) : 0u); }
    }
    {
        float* ct = (float*)(ws + WS_ROT); float* st = ct + 2048 * 128;
        for (int e = c.bid * NTHR + c.tid; e < 2048 * 128; e += c.G * NTHR) {
            const int pos = e >> 7, f = e & 127;
            const float lin = (float)f * (1.0f / 127.0f);
            const float p = (float)pow(10000.0, (double)lin);
            const float invf = 1.0f / p;
            const float ang = (float)pos * invf;
            ct[e] = (float)cos((double)ang); st[e] = (float)sin((double)ang);
        }
    }
    for (int m = gw; m < T_TOK; m += NGW) {
        const float* xr = INP(c, I_X) + (size_t)m * DM; bf16* ob = (bf16*)(ws + WS_XB0) + (size_t)m * DM;
#pragma unroll
        for (int h = 0; h < 2; ++h) { const int col = h * 512 + 8 * c.lane; const f32x4 a = *(const f32x4*)(xr + col), b = *(const f32x4*)(xr + col + 4);
            v4u w; w.x = pk2(a[0], a[1]); w.y = pk2(a[2], a[3]); w.z = pk2(b[0], b[1]); w.w = pk2(b[2], b[3]); *(v4u*)(ob + col) = w; }
    }
    {
        int tbase = 0;
        {
            const int ntile = 4 * 16 * 2 * 16;
            for (int t = c.bid; t < ntile; t += c.G) {
                const int i = t / 512, r = t % 512, hp = r / 32, tt = r % 32, nt = tt / 16, kt = tt % 16;
                const float* A = INP(c, I_PEER_SK) + (size_t)i * 8 * 2 * 128 * 128 + (size_t)hp * 128 * 128;
                const float* Bm = INP(c, I_PEER_WQ) + (size_t)i * 1024 * 2048 + hp * 128;
                bf16* C = (bf16*)(ws + WS_WPEER) + (size_t)i * 2048 * 1024 + (size_t)hp * 128 * 1024;
                small_gemm_tile(c, A, 128, 1, Bm, 2048, 1, 128, C, 1024, nt * 64, kt * 64, 1.0f);
            }
            tbase += ntile;
        }
        {
            const int ntile = 2 * 16 * 2 * 4;
            for (int t = c.bid; t < ntile; t += c.G) {
                const int j = t / 128, r = t % 128, h = r / 8, tt = r % 8, nt = tt / 4, kt = tt % 4;
                const float* A = INP(c, I_A_W_UK) + (size_t)j * 16 * 64 * 128 + (size_t)h * 64 * 128;
                const float* Bm = INP(c, I_A_W_UQ) + (size_t)j * 256 * 1024 + h * 64;
                bf16* C = (bf16*)(ws + WS_WAQ + j * WAQ_STRIDE) + (size_t)h * 128 * 256;
                small_gemm_tile(c, A, 1, 128, Bm, 1024, 1, 64, C, 256, nt * 64, kt * 64, 0.125f * 1.4426950408889634f);
            }
        }
        {
            const int ntile = 2 * 16 * 16 * 2;
            for (int t = c.bid; t < ntile; t += c.G) {
                const int j = t / 512, r = t % 512, h = r / 32, tt = r % 32, nt = tt / 2, kt = tt % 2;
                const float* A = INP(c, I_A_W_O) + (size_t)j * 1024 * 1024 + (size_t)h * 64 * 1024;
                const float* Bm = INP(c, I_A_W_UV) + (size_t)j * 16 * 128 * 64 + (size_t)h * 128 * 64;
                bf16* C = (bf16*)(ws + WS_WAOV) + (size_t)j * 1024 * 2048 + h * 128;
                small_gemm_tile(c, A, 1, 1024, Bm, 64, 1, 64, C, 2048, nt * 64, kt * 64, 1.0f);
            }
        }
        (void)tbase;
    }
}

template <int FP4> __device__ __forceinline__ void peer_pack_row16(const float (&v)[16], unsigned char* dst) {
    if (FP4) { v2u w;
#pragma unroll
        for (int d = 0; d < 2; ++d) { unsigned p = 0u;
            p = __builtin_amdgcn_cvt_scalef32_pk_fp4_f32(p, v[8 * d + 0], v[8 * d + 1], 1.0f, 0); p = __builtin_amdgcn_cvt_scalef32_pk_fp4_f32(p, v[8 * d + 2], v[8 * d + 3], 1.0f, 1);
            p = __builtin_amdgcn_cvt_scalef32_pk_fp4_f32(p, v[8 * d + 4], v[8 * d + 5], 1.0f, 2); p = __builtin_amdgcn_cvt_scalef32_pk_fp4_f32(p, v[8 * d + 6], v[8 * d + 7], 1.0f, 3);
            w[d] = p; }
        *(v2u*)dst = w;
    } else { v4u w;
#pragma unroll
        for (int q = 0; q < 4; ++q) { int pa = 0; pa = __builtin_amdgcn_cvt_pk_fp8_f32(v[4 * q], v[4 * q + 1], pa, false); pa = __builtin_amdgcn_cvt_pk_fp8_f32(v[4 * q + 2], v[4 * q + 3], pa, true); w[q] = (unsigned)pa; }
        *(v4u*)dst = w;
    }
}

__device__ __forceinline__ void phase_ln1(const Ctx& c, int layer) {
    const int gw = c.bid * NWAVES + c.wave, NGW = c.G * NWAVES;
    const float* gain = INP(c, I_LN1_G) + layer * DM; const float* bias = INP(c, I_LN1_B) + layer * DM;
    bf16* xb = (bf16*)(c.ws + ((layer & 1) ? WS_XB1 : WS_XB0));
    for (int m = gw; m < T_TOK; m += NGW) {
        float v[16]; load_row16_bf(xb + (size_t)m * DM, v, c.lane);
        ln_store_row(v, gain, bias, nullptr, xb + (size_t)m * DM, c.lane);
    }
    {
        const float* U = INP(c, I_PEER_U) + (size_t)layer * 16384 * 1024; const float* V = INP(c, I_PEER_V) + (size_t)layer * 16384 * 1024;
        unsigned char* tu = c.ws + WS_TABU; unsigned char* tv = c.ws + WS_TABV;
        const size_t n16 = (size_t)16384 * 1024 / 16;
        for (size_t e = (size_t)c.bid * NTHR + c.tid; e < n16; e += (size_t)c.G * NTHR) {
            float ua[16], va[16];
#pragma unroll
            for (int q = 0; q < 4; ++q) { const f32x4 a4 = *(const f32x4*)(U + e * 16 + 4 * q) * PEER_USCALE, b4 = *(const f32x4*)(V + e * 16 + 4 * q) * PEER_VSCALE;
#pragma unroll
                for (int j = 0; j < 4; ++j) { ua[4 * q + j] = a4[j]; va[4 * q + j] = b4[j]; } }
            if (PEER_U4 && PEER_V4) {
                const size_t row = e >> 6, l16 = e & 63; peer_pack_row16<1>(ua, tu + row * 1024 + l16 * 8); peer_pack_row16<1>(va, tu + row * 1024 + 512 + l16 * 8);
            } else { peer_pack_row16<PEER_U4>(ua, tu + e * (PEER_UROW / 64)); peer_pack_row16<PEER_V4>(va, tv + e * (PEER_VROW / 64)); }
        }
    }
    {
        const float* P = INP(c, I_P) + (size_t)layer * T_TOK * 256; bf16* pb = (bf16*)(c.ws + WS_M + M_PB);
        const size_t n8 = (size_t)T_TOK * 256 / 8;
        for (size_t e = (size_t)c.bid * NTHR + c.tid; e < n8; e += (size_t)c.G * NTHR) {
            const f32x4 a = *(const f32x4*)(P + e * 8), b = *(const f32x4*)(P + e * 8 + 4);
            v4u w; w.x = pk2(a[0], a[1]); w.y = pk2(a[2], a[3]); w.z = pk2(b[0], b[1]); w.w = pk2(b[2], b[3]); *(v4u*)(pb + e * 8) = w;
        }
    }
}

using pg8::Unit;
constexpr int BMT = 256, HALFT = 128;

struct EpiResid {
    static constexpr bool PERM = false, AFTER_DRAIN = false;
    bf16* Y1; float alpha; const bf16* Xb;
    __device__ __forceinline__ void operator()(const pg8::f32x4 (&acc)[2][2][4][2], const Unit& u, int wr, int wc, int fr, int fq) const {
        const int row0 = u.pm * BMT + wr * 64 + fr, col0 = u.pn * BMT + wc * 32 + 4 * fq;
#pragma unroll
        for (int ai = 0; ai < 2; ++ai)
#pragma unroll
            for (int m = 0; m < 4; ++m) { const size_t roff = (size_t)(row0 + ai * HALFT + m * 16) * DM + col0; bf16* rowp = Y1 + roff; const bf16* srcp = Xb + roff;
                v2u xv[2][2];
#pragma unroll
                for (int bj = 0; bj < 2; ++bj)
#pragma unroll
                    for (int n = 0; n < 2; ++n) xv[bj][n] = *(const v2u*)(srcp + bj * HALFT + n * 16);
#pragma unroll
                for (int bj = 0; bj < 2; ++bj)
#pragma unroll
                    for (int n = 0; n < 2; ++n) { const pg8::f32x4 xf = {bflo(xv[bj][n].x), bfhi(xv[bj][n].x), bflo(xv[bj][n].y), bfhi(xv[bj][n].y)};
                        const pg8::f32x4 y = xf * alpha + acc[ai][bj][m][n];
                        v2u w; w.x = pk2(y[0], y[1]); w.y = pk2(y[2], y[3]); *(v2u*)(rowp + bj * HALFT + n * 16) = w; } }
    }
};

struct EpiF32T {
    static constexpr bool PERM = true, AFTER_DRAIN = false;
    bf16* C;
    __device__ __forceinline__ void operator()(const pg8::f32x4 (&acc)[2][2][4][2], const Unit& u, int wr, int wc, int fr, int fq) const {
        const int row0 = u.pm * BMT + wr * 64 + fr, cg0 = (u.pn * BMT + wc * 32 + 8 * fq) >> 3;
#pragma unroll
        for (int ai = 0; ai < 2; ++ai)
#pragma unroll
            for (int m = 0; m < 4; ++m) { const int r = row0 + ai * HALFT + m * 16; bf16* bp = C + (((size_t)(r >> 6) * 256 + cg0) * 64 + (r & 63)) * 8;
#pragma unroll
                for (int bj = 0; bj < 2; ++bj) { const pg8::f32x4 v0 = acc[ai][bj][m][0], v1 = acc[ai][bj][m][1];
                    v4u w; w.x = pk2(v0[0], v0[1]); w.y = pk2(v0[2], v0[3]); w.z = pk2(v1[0], v1[1]); w.w = pk2(v1[2], v1[3]);
                    *(v4u*)(bp + (size_t)(bj * 16) * 512) = w; } }
    }
};

template <int ACT0  > struct EpiBf16R {
    static constexpr bool PERM = true, AFTER_DRAIN = false;
    bf16 *O0, *O1, *O2; int ld0, ld1, ld2, c1, c2;
    __device__ __forceinline__ void operator()(const pg8::f32x4 (&acc)[2][2][4][2], const Unit& u, int wr, int wc, int fr, int fq) const {
        const int row0 = u.pm * BMT + wr * 64 + fr; int colt = u.pn * BMT; bf16* base; int ld; bool act = false;
        if (colt < c1) { base = O0; ld = ld0; act = (ACT0 == 1); } else if (colt < c2) { base = O1; ld = ld1; colt -= c1; } else { base = O2; ld = ld2; colt -= c2; }
        const int col0 = colt + wc * 32 + 8 * fq;
#pragma unroll
        for (int ai = 0; ai < 2; ++ai)
#pragma unroll
            for (int m = 0; m < 4; ++m) { bf16* rowp = base + (size_t)(row0 + ai * HALFT + m * 16) * ld + col0;
#pragma unroll
                for (int bj = 0; bj < 2; ++bj) { pg8::f32x4 v0 = acc[ai][bj][m][0], v1 = acc[ai][bj][m][1];
                    if (ACT0 == 1 && act) {
#pragma unroll
                        for (int j = 0; j < 4; ++j) { v0[j] = gelu_tanh(v0[j]); v1[j] = gelu_tanh(v1[j]); } }
                    v4u w; w.x = pk2(v0[0], v0[1]); w.y = pk2(v0[2], v0[3]); w.z = pk2(v1[0], v1[1]); w.w = pk2(v1[2], v1[3]);
                    *(v4u*)(rowp + bj * HALFT) = w; } }
    }
};

struct EpiRetIn {
    static constexpr bool PERM = true, AFTER_DRAIN = false;
    bf16 *Q, *K, *V; const float* cs; const float* sn;
    __device__ __forceinline__ void operator()(const pg8::f32x4 (&acc)[2][2][4][2], const Unit& u, int wr, int wc, int fr, int fq) const {
        const int row0 = u.pm * BMT + wr * 64 + fr; const int colt = u.pn * BMT;
        if (colt >= 2048) {
            const int col0 = colt - 2048 + wc * 32 + 8 * fq;
#pragma unroll
            for (int ai = 0; ai < 2; ++ai)
#pragma unroll
                for (int m = 0; m < 4; ++m) { bf16* rowp = V + (size_t)(row0 + ai * HALFT + m * 16) * 2048 + col0;
#pragma unroll
                    for (int bj = 0; bj < 2; ++bj) { const pg8::f32x4 v0 = acc[ai][bj][m][0], v1 = acc[ai][bj][m][1];
                        v4u w; w.x = pk2(v0[0], v0[1]); w.y = pk2(v0[2], v0[3]); w.z = pk2(v1[0], v1[1]); w.w = pk2(v1[2], v1[3]);
                        *(v4u*)(rowp + bj * HALFT) = w; } }
        } else {
            const bool isk = colt >= 1024; bf16* base = isk ? K : Q; const float sc = isk ? 0.0625f : 1.0f;
            const int col0 = (isk ? colt - 1024 : colt) + wc * 32 + 8 * fq; const int f0 = wc * 32 + 8 * fq;
#pragma unroll
            for (int ai = 0; ai < 2; ++ai)
#pragma unroll
                for (int m = 0; m < 4; ++m) { const int row = row0 + ai * HALFT + m * 16; const int pos = row & (SEQ - 1);
                    const pg8::f32x4 c0 = *(const pg8::f32x4*)(cs + pos * 128 + f0), c1 = *(const pg8::f32x4*)(cs + pos * 128 + f0 + 4);
                    const pg8::f32x4 s0 = *(const pg8::f32x4*)(sn + pos * 128 + f0), s1 = *(const pg8::f32x4*)(sn + pos * 128 + f0 + 4);
                    const pg8::f32x4 a0 = acc[ai][0][m][0] * sc, a1 = acc[ai][0][m][1] * sc, b0 = acc[ai][1][m][0] * sc, b1 = acc[ai][1][m][1] * sc;
                    const pg8::f32x4 r0 = a0 * c0 - b0 * s0, r1 = a1 * c1 - b1 * s1, q0 = a0 * s0 + b0 * c0, q1 = a1 * s1 + b1 * c1;
                    bf16* rowp = base + (size_t)row * 1024 + col0;
                    v4u w; w.x = pk2(r0[0], r0[1]); w.y = pk2(r0[2], r0[3]); w.z = pk2(r1[0], r1[1]); w.w = pk2(r1[2], r1[3]); *(v4u*)(rowp) = w;
                    v4u w2; w2.x = pk2(q0[0], q0[1]); w2.y = pk2(q0[2], q0[3]); w2.z = pk2(q1[0], q1[1]); w2.w = pk2(q1[2], q1[3]); *(v4u*)(rowp + HALFT) = w2; }
        }
    }
};

struct EpiRetGate {
    static constexpr bool PERM = true, AFTER_DRAIN = false;
    bf16* O; const float* STAT;
    __device__ __forceinline__ void operator()(const pg8::f32x4 (&acc)[2][2][4][2], const Unit& u, int wr, int wc, int fr, int fq) const {
        const int row0 = u.pm * BMT + wr * 64 + fr; const int head = u.pn >> 1; const int col0 = u.pn * BMT + wc * 32 + 8 * fq;
#pragma unroll
        for (int ai = 0; ai < 2; ++ai)
#pragma unroll
            for (int m = 0; m < 4; ++m) { const int row = row0 + ai * HALFT + m * 16;
                const pg8::f32x4 st = *(const pg8::f32x4*)(STAT + (size_t)row * 16 + head * 4);
                const float mean = (st[0] + st[2]) * (1.0f / 512.0f); const float var = (st[1] + st[3]) * (1.0f / 512.0f) - mean * mean;
                const float rstd = __builtin_amdgcn_rsqf(fmaxf(var, 0.f) + 1e-5f);
                bf16* rowp = O + (size_t)row * 2048 + col0;
#pragma unroll
                for (int bj = 0; bj < 2; ++bj) { const v4u ov = *(const v4u*)(rowp + bj * HALFT);
                    const pg8::f32x4 g0 = acc[ai][bj][m][0], g1 = acc[ai][bj][m][1];
                    float o[8] = {bflo(ov.x), bfhi(ov.x), bflo(ov.y), bfhi(ov.y), bflo(ov.z), bfhi(ov.z), bflo(ov.w), bfhi(ov.w)};
                    float r[8];
#pragma unroll
                    for (int j = 0; j < 8; ++j) { const float g = j < 4 ? g0[j] : g1[j - 4]; r[j] = g * sigmoidf_(g) * (o[j] - mean) * rstd; }
                    v4u w; w.x = pk2(r[0], r[1]); w.y = pk2(r[2], r[3]); w.z = pk2(r[4], r[5]); w.w = pk2(r[6], r[7]);
                    *(v4u*)(rowp + bj * HALFT) = w; } }
    }
};

struct EpiPle {
    static constexpr bool PERM = true, AFTER_DRAIN = false;
    const bf16* Xin; const bf16* PP; bf16* XBo; const float* bg; float* OutF;
    __device__ __forceinline__ void operator()(const pg8::f32x4 (&acc)[2][2][4][2], const Unit& u, int wr, int wc, int fr, int fq) const {
        const int row0 = u.pm * BMT + wr * 64 + fr; const int col0 = u.pn * BMT + wc * 32 + 8 * fq;
        pg8::f32x4 bv[2][2];
#pragma unroll
        for (int bj = 0; bj < 2; ++bj)
#pragma unroll
            for (int n = 0; n < 2; ++n) bv[bj][n] = *(const pg8::f32x4*)(bg + col0 + bj * HALFT + 4 * n);
#pragma unroll
        for (int ai = 0; ai < 2; ++ai)
#pragma unroll
            for (int m = 0; m < 4; ++m) { const size_t off = (size_t)(row0 + ai * HALFT + m * 16) * DM + col0;
#pragma unroll
                for (int bj = 0; bj < 2; ++bj) {
                    const v4u pv = *(const v4u*)(PP + off + bj * HALFT), xv = *(const v4u*)(Xin + off + bj * HALFT);
                    const float pp[8] = {bflo(pv.x), bfhi(pv.x), bflo(pv.y), bfhi(pv.y), bflo(pv.z), bfhi(pv.z), bflo(pv.w), bfhi(pv.w)};
                    const float xx[8] = {bflo(xv.x), bfhi(xv.x), bflo(xv.y), bfhi(xv.y), bflo(xv.z), bfhi(xv.z), bflo(xv.w), bfhi(xv.w)};
                    pg8::f32x4 o0, o1;
#pragma unroll
                    for (int j = 0; j < 4; ++j) { o0[j] = xx[j] + sigmoidf_(acc[ai][bj][m][0][j] + bv[bj][0][j]) * pp[j];
                                                  o1[j] = xx[4 + j] + sigmoidf_(acc[ai][bj][m][1][j] + bv[bj][1][j]) * pp[4 + j]; }
                    if (OutF) { *(pg8::f32x4*)(OutF + off + bj * HALFT) = o0; *(pg8::f32x4*)(OutF + off + bj * HALFT + 4) = o1; }
                    else { v4u w; w.x = pk2(o0[0], o0[1]); w.y = pk2(o0[2], o0[3]); w.z = pk2(o1[0], o1[1]); w.w = pk2(o1[2], o1[3]);
                        *(v4u*)(XBo + off + bj * HALFT) = w; } } }
    }
};

template <class Epi>
__device__ __forceinline__ void run_gemm(const Ctx& c, const bf16* A, const bf16* Bt, int N, int K, const Epi& E) {
    asm volatile("" : "+s"(K), "+s"(N));
    pg8::Gemm g{A, Bt, T_TOK, N, K}; pg8::StaticOrder S; S.init(T_TOK, N, c.G, c.bid);
    pg8::gemm_phase<Epi, pg8::StaticOrder, false>((PG8_LAS unsigned char*)c.lds, g, S, E, nullptr);
}

__device__ __forceinline__ unsigned sort_key(float f) { const unsigned u = __builtin_bit_cast(unsigned, f); return (u & 0x80000000u) ? ~u : (u | 0x80000000u); }
__device__ __forceinline__ unsigned half_sel(unsigned long long m, int half) { return half ? (unsigned)(m >> 32) : (unsigned)m; }

#define PK_CE(i, j) { const unsigned hi_ = b[i] > b[j] ? b[i] : b[j], lo_ = b[i] > b[j] ? b[j] : b[i]; b[i] = hi_; b[j] = lo_; }
__device__ __forceinline__ void sort16_desc(unsigned (&b)[16]) {
#define CE(i, j) PK_CE(i, j)
    CE(0,1) CE(2,3) CE(0,2) CE(1,3) CE(1,2) CE(4,5) CE(6,7) CE(4,6) CE(5,7) CE(5,6) CE(0,4) CE(2,6) CE(2,4) CE(1,5) CE(3,7) CE(3,5) CE(1,2) CE(3,4) CE(5,6) CE(8,9) CE(10,11) CE(8,10) CE(9,11) CE(9,10) CE(12,13) CE(14,15) CE(12,14) CE(13,15) CE(13,14) CE(8,12) CE(10,14) CE(10,12) CE(9,13) CE(11,15) CE(11,13) CE(9,10) CE(11,12) CE(13,14) CE(0,8) CE(4,12) CE(4,8) CE(2,10) CE(6,14) CE(6,10) CE(2,4) CE(6,8) CE(10,12) CE(1,9) CE(5,13) CE(5,9) CE(3,11) CE(7,15) CE(7,11) CE(3,5) CE(7,9) CE(11,13) CE(1,2) CE(3,4) CE(5,6) CE(7,8) CE(9,10) CE(11,12) CE(13,14)
#undef CE
}
__device__ __forceinline__ void merge16_desc(unsigned (&t)[16], const unsigned (&bb)[16]) {
    unsigned b[16];
#pragma unroll
    for (int i = 0; i < 16; ++i) b[i] = t[i] > bb[15 - i] ? t[i] : bb[15 - i];
#pragma unroll
    for (int d = 8; d >= 1; d >>= 1)
#pragma unroll
        for (int i = 0; i < 16; ++i) if ((i & d) == 0) PK_CE(i, i + d)
#pragma unroll
    for (int i = 0; i < 16; ++i) t[i] = b[i];
}
__device__ __forceinline__ void ins16(unsigned (&t)[16], unsigned x) {
#pragma unroll
    for (int p = 0; p < 16; ++p) { const unsigned hi = x > t[p] ? x : t[p], lo = x > t[p] ? t[p] : x; t[p] = hi; x = lo; }
}
__device__ __forceinline__ float unsort_key(unsigned k) { const unsigned u = (k & 0x80000000u) ? (k & 0x7fffffffu) : ~k; return __builtin_bit_cast(float, u); }
__device__ __forceinline__ void phase_peer_topk(const Ctx& c) {
    const int gw = c.bid * NWAVES + c.wave, NGW = c.G * NWAVES, lane = c.lane;
    const bf16* SCT = (const bf16*)(c.ws + WS_M + M_SC); int* IDS = (int*)(c.ws + WS_M + M_IDS); float* GATES = (float*)(c.ws + WS_M + M_GATES);
    LAS unsigned char* lidx = c.lds + c.wave * 2048 + lane * 32;
    for (int wu = gw; wu < 8192; wu += NGW) {
        const int tblk = wu >> 3, hd = wu & 7, tok = tblk * 64 + lane;
        unsigned tA[16], tB[16];
        const v4u* pa = (const v4u*)SCT + ((size_t)tblk * 256 + hd * 32) * 64 + lane; const v4u* pb = pa + 16 * 64;
        v4u nxa[2] = {pa[0], pa[64]}, nxb[2] = {pb[0], pb[64]};
#pragma unroll 1
        for (int blk = 0; blk < 8; ++blk) {
            unsigned ka[16], kb[16];
            const v4u cxa[2] = {nxa[0], nxa[1]}, cxb[2] = {nxb[0], nxb[1]};
            if (blk < 7) { nxa[0] = pa[(2 * blk + 2) * 64]; nxa[1] = pa[(2 * blk + 3) * 64]; nxb[0] = pb[(2 * blk + 2) * 64]; nxb[1] = pb[(2 * blk + 3) * 64]; }
#pragma unroll
            for (int gg = 0; gg < 2; ++gg) { const v4u xa = cxa[gg], xb = cxb[gg];
#pragma unroll
                for (int j = 0; j < 4; ++j) { const unsigned lo0 = (unsigned)(127 - (16 * blk + 8 * gg + 2 * j)), lo1 = lo0 - 1u;
                    ka[8 * gg + 2 * j] = (sort_key(bflo(xa[j])) & ~127u) | lo0; ka[8 * gg + 2 * j + 1] = (sort_key(bfhi(xa[j])) & ~127u) | lo1;
                    kb[8 * gg + 2 * j] = (sort_key(bflo(xb[j])) & ~127u) | lo0; kb[8 * gg + 2 * j + 1] = (sort_key(bfhi(xb[j])) & ~127u) | lo1; } }
            sort16_desc(ka); sort16_desc(kb);
            if (blk == 0) {
#pragma unroll
                for (int i = 0; i < 16; ++i) { tA[i] = ka[i]; tB[i] = kb[i]; }
            } else { merge16_desc(tA, ka); merge16_desc(tB, kb); }
        }
        float a[16], b[16];
#pragma unroll
        for (int i = 0; i < 16; ++i) { a[i] = unsort_key(tA[i] & ~127u); b[i] = unsort_key(tB[i] & ~127u); lidx[i] = (unsigned char)(127u - (tA[i] & 127u)); lidx[16 + i] = (unsigned char)(127u - (tB[i] & 127u)); }
        unsigned uu[16];
        uu[0] = (sort_key(a[0] + b[0]) & ~255u) | 0u;
        uu[1] = (sort_key(a[0] + b[1]) & ~255u) | 1u;
        uu[2] = (sort_key(a[0] + b[2]) & ~255u) | 2u;
        uu[3] = (sort_key(a[0] + b[3]) & ~255u) | 3u;
        uu[4] = (sort_key(a[0] + b[4]) & ~255u) | 4u;
        uu[5] = (sort_key(a[0] + b[5]) & ~255u) | 5u;
        uu[6] = (sort_key(a[0] + b[6]) & ~255u) | 6u;
        uu[7] = (sort_key(a[0] + b[7]) & ~255u) | 7u;
        uu[8] = (sort_key(a[0] + b[8]) & ~255u) | 8u;
        uu[9] = (sort_key(a[0] + b[9]) & ~255u) | 9u;
        uu[10] = (sort_key(a[0] + b[10]) & ~255u) | 10u;
        uu[11] = (sort_key(a[0] + b[11]) & ~255u) | 11u;
        uu[12] = (sort_key(a[0] + b[12]) & ~255u) | 12u;
        uu[13] = (sort_key(a[0] + b[13]) & ~255u) | 13u;
        uu[14] = (sort_key(a[0] + b[14]) & ~255u) | 14u;
        uu[15] = (sort_key(a[0] + b[15]) & ~255u) | 15u;
        sort16_desc(uu);
        unsigned cb[16];
        cb[0] = (sort_key(a[1] + b[0]) & ~255u) | 16u;
        cb[1] = (sort_key(a[1] + b[1]) & ~255u) | 17u;
        cb[2] = (sort_key(a[1] + b[2]) & ~255u) | 18u;
        cb[3] = (sort_key(a[1] + b[3]) & ~255u) | 19u;
        cb[4] = (sort_key(a[1] + b[4]) & ~255u) | 20u;
        cb[5] = (sort_key(a[1] + b[5]) & ~255u) | 21u;
        cb[6] = (sort_key(a[1] + b[6]) & ~255u) | 22u;
        cb[7] = (sort_key(a[1] + b[7]) & ~255u) | 23u;
        cb[8] = (sort_key(a[2] + b[0]) & ~255u) | 32u;
        cb[9] = (sort_key(a[2] + b[1]) & ~255u) | 33u;
        cb[10] = (sort_key(a[2] + b[2]) & ~255u) | 34u;
        cb[11] = (sort_key(a[2] + b[3]) & ~255u) | 35u;
        cb[12] = (sort_key(a[2] + b[4]) & ~255u) | 36u;
        cb[13] = (sort_key(a[3] + b[0]) & ~255u) | 48u;
        cb[14] = (sort_key(a[3] + b[1]) & ~255u) | 49u;
        cb[15] = (sort_key(a[3] + b[2]) & ~255u) | 50u;
        sort16_desc(cb); merge16_desc(uu, cb);
        cb[0] = (sort_key(a[3] + b[3]) & ~255u) | 51u;
        cb[1] = (sort_key(a[4] + b[0]) & ~255u) | 64u;
        cb[2] = (sort_key(a[4] + b[1]) & ~255u) | 65u;
        cb[3] = (sort_key(a[4] + b[2]) & ~255u) | 66u;
        cb[4] = (sort_key(a[5] + b[0]) & ~255u) | 80u;
        cb[5] = (sort_key(a[5] + b[1]) & ~255u) | 81u;
        cb[6] = (sort_key(a[6] + b[0]) & ~255u) | 96u;
        cb[7] = (sort_key(a[6] + b[1]) & ~255u) | 97u;
        cb[8] = (sort_key(a[7] + b[0]) & ~255u) | 112u;
        cb[9] = (sort_key(a[7] + b[1]) & ~255u) | 113u;
        cb[10] = (sort_key(a[8] + b[0]) & ~255u) | 128u;
        cb[11] = (sort_key(a[9] + b[0]) & ~255u) | 144u;
        cb[12] = (sort_key(a[10] + b[0]) & ~255u) | 160u;
        cb[13] = (sort_key(a[11] + b[0]) & ~255u) | 176u;
        cb[14] = (sort_key(a[12] + b[0]) & ~255u) | 192u;
        cb[15] = (sort_key(a[13] + b[0]) & ~255u) | 208u;
        sort16_desc(cb); merge16_desc(uu, cb);
        cb[0] = (sort_key(a[14] + b[0]) & ~255u) | 224u;
        cb[1] = (sort_key(a[15] + b[0]) & ~255u) | 240u;
        cb[2] = 0u;
        cb[3] = 0u;
        cb[4] = 0u;
        cb[5] = 0u;
        cb[6] = 0u;
        cb[7] = 0u;
        cb[8] = 0u;
        cb[9] = 0u;
        cb[10] = 0u;
        cb[11] = 0u;
        cb[12] = 0u;
        cb[13] = 0u;
        cb[14] = 0u;
        cb[15] = 0u;
        sort16_desc(cb); merge16_desc(uu, cb);
        LDS_WAIT(); asm volatile("" ::: "memory");
        float sc[16], sum = 0.f; int eid[16];
        const float s0 = unsort_key(uu[0] & ~255u);
#pragma unroll
        for (int r = 0; r < 16; ++r) { const float s = unsort_key(uu[r] & ~255u); sc[r] = __expf(s - s0); sum += sc[r];
            const int i = (uu[r] >> 4) & 15, j = uu[r] & 15; eid[r] = (int)lidx[i] * 128 + (int)lidx[16 + j]; }
        const float inv = 1.0f / sum;
#pragma unroll
        for (int q = 0; q < 4; ++q) {
            *(v4u*)(IDS + (size_t)tok * 128 + hd * 16 + 4 * q) = (v4u){(unsigned)eid[4 * q], (unsigned)eid[4 * q + 1], (unsigned)eid[4 * q + 2], (unsigned)eid[4 * q + 3]};
            *(f32x4*)(GATES + (size_t)tok * 128 + hd * 16 + 4 * q) = (f32x4){sc[4 * q] * inv, sc[4 * q + 1] * inv, sc[4 * q + 2] * inv, sc[4 * q + 3] * inv};
        }
        LDS_WAIT(); asm volatile("" ::: "memory");
    }
}

#if !(PEER_U4 && PEER_V4)
#error "this gather expects both expert tables in fp4 (interleaved rows)"
#endif
typedef int v8i_t __attribute__((ext_vector_type(8)));
constexpr float PEER_XSCALE = 8.0f;
struct PeerGroup { v4u ua[8]; float g4[4]; };
__device__ __forceinline__ void peer_load(PeerGroup& B, const unsigned char* TAB, int idv, float gv, int kb, int lane) {
    const int m = lane & 15, kg = lane >> 4;
    const int idm = __builtin_amdgcn_ds_bpermute(4 * (kb + m), idv);
    const unsigned char* up = TAB + (size_t)idm * 1024 + 16 * kg;
#pragma unroll
    for (int cc = 0; cc < 8; ++cc) B.ua[cc] = *(const v4u*)(up + 64 * cc);
#pragma unroll
    for (int r = 0; r < 4; ++r) B.g4[r] = __builtin_bit_cast(float, __builtin_amdgcn_ds_bpermute(4 * (kb + 4 * kg + r), __builtin_bit_cast(int, gv)));
}
template <int J> __device__ __forceinline__ f32x2 fp4_pair(const v4u& w) { return __builtin_amdgcn_cvt_scalef32_pk_f32_fp4(w[J >> 2], 1.0f, J & 3); }
__device__ __forceinline__ void peer_compute(const PeerGroup& B, const unsigned char* TAB, int idv, int kb, const LAS unsigned char* xb8, f32x2 (&y2)[16], int lane) {
    const int hf = lane >> 5, l31 = lane & 31;
    v4u vv[8];
#pragma unroll
    for (int e = 0; e < 8; ++e) {
        const int ida = __builtin_amdgcn_readlane(idv, kb + 2 * e), idb = __builtin_amdgcn_readlane(idv, kb + 2 * e + 1);
        vv[e] = *(const v4u*)(TAB + (size_t)(hf ? idb : ida) * 1024 + 512 + 16 * l31);
    }
    f32x4 d = {0.f, 0.f, 0.f, 0.f};
#pragma unroll
    for (int cc = 0; cc < 8; ++cc) {
        asm volatile("" ::: "memory");
        const v4u b0 = *(const LAS v4u*)(xb8 + 128 * cc), b1 = *(const LAS v4u*)(xb8 + 128 * cc + 64);
        const v8i_t bx = {(int)b0.x, (int)b0.y, (int)b0.z, (int)b0.w, (int)b1.x, (int)b1.y, (int)b1.z, (int)b1.w};
        const v8i_t ax = {(int)B.ua[cc].x, (int)B.ua[cc].y, (int)B.ua[cc].z, (int)B.ua[cc].w, 0, 0, 0, 0};
        d = __builtin_amdgcn_mfma_scale_f32_16x16x128_f8f6f4(ax, bx, d, 4  , 0  , 0, 127, 0, 127);
    }
    float a4[4];
#pragma unroll
    for (int r = 0; r < 4; ++r) a4[r] = gelu_tanh(d[r] * (1.0f / (PEER_USCALE * PEER_XSCALE))) * B.g4[r] * (1.0f / PEER_VSCALE);
#pragma unroll
    for (int e = 0; e < 8; ++e) {
        const int ma = 2 * e, mb = 2 * e + 1;
        const float a0 = __builtin_bit_cast(float, __builtin_amdgcn_readlane(__builtin_bit_cast(int, a4[ma & 3]), 16 * (ma >> 2))), a1 = __builtin_bit_cast(float, __builtin_amdgcn_readlane(__builtin_bit_cast(int, a4[mb & 3]), 16 * (mb >> 2)));
        const float a = hf ? a1 : a0; const f32x2 a2 = {a, a};
#define PEER_AXPY(J) y2[J] = __builtin_elementwise_fma(a2, fp4_pair<J>(vv[e]), y2[J]);
        PEER_AXPY(0) PEER_AXPY(1) PEER_AXPY(2) PEER_AXPY(3) PEER_AXPY(4) PEER_AXPY(5) PEER_AXPY(6) PEER_AXPY(7)
        PEER_AXPY(8) PEER_AXPY(9) PEER_AXPY(10) PEER_AXPY(11) PEER_AXPY(12) PEER_AXPY(13) PEER_AXPY(14) PEER_AXPY(15)
#undef PEER_AXPY
    }
}
template <class BarFn>
__device__ __forceinline__ void phase_peer_gather(const Ctx& c, int layer, const BarFn&) {
    const int gw = c.bid * NWAVES + c.wave, NGW = c.G * NWAVES;
    const int* IDS = (const int*)(c.ws + WS_M + M_IDS); const float* GATES = (const float*)(c.ws + WS_M + M_GATES);
    const unsigned char* TAB = c.ws + WS_TABU;
    const float* gain = INP(c, I_LN2_G) + layer * DM; const float* bias = INP(c, I_LN2_B) + layer * DM;
    bf16* xb = (bf16*)(c.ws + ((layer & 1) ? WS_XB1 : WS_XB0));
    const int lane = c.lane, hf = lane >> 5, l31 = lane & 31;
    LAS unsigned char* xbase = c.lds + c.wave * 3072;
    { unsigned z = 0u; asm volatile("" : "+v"(z));
      *(LAS v4u*)(xbase + 2048 + 16 * lane) = (v4u){z, z, z, z}; }
    const bool col0 = (lane & 15) == 0;
    auto stage_x = [&](int tk, int buf) {
        const bf16* xr = xb + (size_t)tk * DM + 32 * l31; v4u w0, w1;
#pragma unroll
        for (int q = 0; q < 4; ++q) { const v4u xv = *(const v4u*)(xr + 8 * q);
            int pa = 0, pb = 0;
            pa = __builtin_amdgcn_cvt_pk_fp8_f32(bflo(xv.x) * PEER_XSCALE, bfhi(xv.x) * PEER_XSCALE, pa, false); pa = __builtin_amdgcn_cvt_pk_fp8_f32(bflo(xv.y) * PEER_XSCALE, bfhi(xv.y) * PEER_XSCALE, pa, true);
            pb = __builtin_amdgcn_cvt_pk_fp8_f32(bflo(xv.z) * PEER_XSCALE, bfhi(xv.z) * PEER_XSCALE, pb, false); pb = __builtin_amdgcn_cvt_pk_fp8_f32(bflo(xv.w) * PEER_XSCALE, bfhi(xv.w) * PEER_XSCALE, pb, true);
            if (q < 2) { w0[2 * q] = (unsigned)pa; w0[2 * q + 1] = (unsigned)pb; } else { w1[2 * q - 4] = (unsigned)pa; w1[2 * q - 3] = (unsigned)pb; } }
        if (hf == 0) { *(LAS v4u*)(xbase + 1024 * buf + 32 * l31) = w0; *(LAS v4u*)(xbase + 1024 * buf + 32 * l31 + 16) = w1; } };
    int tok = gw, par = 0;
    int idA = 0, idB = 0; float gA = 0.f, gB = 0.f;
    PeerGroup G0, G1;
    if (tok < T_TOK) {
        idA = IDS[(size_t)tok * 128 + lane]; idB = IDS[(size_t)tok * 128 + 64 + lane]; gA = GATES[(size_t)tok * 128 + lane]; gB = GATES[(size_t)tok * 128 + 64 + lane];
        stage_x(tok, 0);
        peer_load(G0, TAB, idA, gA, 0, lane);
    }
#pragma unroll 1
    while (tok < T_TOK) {
        const int ntok = tok + NGW; const bool has_next = ntok < T_TOK;
        int nidA = 0, nidB = 0; float ngA = 0.f, ngB = 0.f;
        if (has_next) { nidA = IDS[(size_t)ntok * 128 + lane]; nidB = IDS[(size_t)ntok * 128 + 64 + lane]; ngA = GATES[(size_t)ntok * 128 + lane]; ngB = GATES[(size_t)ntok * 128 + 64 + lane]; }
        const LAS unsigned char* xb8 = col0 ? (xbase + 1024 * par + 16 * (lane >> 4)) : (xbase + 2048);
        f32x2 y2[16];
#pragma unroll
        for (int j = 0; j < 16; ++j) y2[j] = (f32x2){0.f, 0.f};
        v4u xres[2] = {(v4u){0u, 0u, 0u, 0u}, (v4u){0u, 0u, 0u, 0u}};
        LDS_WAIT(); asm volatile("" ::: "memory");
#define PEER_LD(Gx, g) peer_load(Gx, TAB, ((g) >= 4) ? idB : idA, ((g) >= 4) ? gB : gA, ((g) & 3) * 16, lane)
#define PEER_CP(Gx, g) peer_compute(Gx, TAB, ((g) >= 4) ? idB : idA, ((g) & 3) * 16, xb8, y2, lane)
#pragma unroll 1
        for (int g = 0; g < 8; g += 2) {
            PEER_LD(G1, g + 1); PEER_CP(G0, g);
            if (g == 2 && has_next) stage_x(ntok, par ^ 1);
            if (g + 2 < 8) PEER_LD(G0, g + 2); else if (has_next) peer_load(G0, TAB, nidA, ngA, 0, lane);
            if (g == 6) { xres[0] = *(const v4u*)(xb + (size_t)tok * DM + 32 * l31 + 16 * hf); xres[1] = *(const v4u*)(xb + (size_t)tok * DM + 32 * l31 + 16 * hf + 8); }
            PEER_CP(G1, g + 1);
        }
#undef PEER_LD
#undef PEER_CP
        float z[16];
#pragma unroll
        for (int j = 0; j < 16; ++j) { const float tx = y2[j].x + __shfl_xor(y2[j].x, 32), ty = y2[j].y + __shfl_xor(y2[j].y, 32); y2[j] = (f32x2){tx, ty}; }
#pragma unroll
        for (int j = 0; j < 8; ++j) { const unsigned xw = xres[j >> 2][j & 3]; z[2 * j] = (hf ? y2[8 + j].x : y2[j].x) + ALPHA_DN * bflo(xw); z[2 * j + 1] = (hf ? y2[8 + j].y : y2[j].y) + ALPHA_DN * bfhi(xw); }
        float s = 0.f;
#pragma unroll
        for (int j = 0; j < 16; ++j) s += z[j];
        const float mean = wave_sum(s) * (1.f / 1024.f);
        float s2 = 0.f;
#pragma unroll
        for (int j = 0; j < 16; ++j) { z[j] -= mean; s2 += z[j] * z[j]; }
        const float rstd = __builtin_amdgcn_rsqf(wave_sum(s2) * (1.f / 1024.f) + 1e-5f);
        const int col = 32 * l31 + 16 * hf; float o[16];
#pragma unroll
        for (int q = 0; q < 4; ++q) { const f32x4 gq = *(const f32x4*)(gain + col + 4 * q), bq = *(const f32x4*)(bias + col + 4 * q); f32x4 r;
#pragma unroll
            for (int j = 0; j < 4; ++j) { r[j] = z[4 * q + j] * rstd * gq[j] + bq[j]; o[4 * q + j] = r[j]; } }
        v4u w0, w1; w0.x = pk2(o[0], o[1]); w0.y = pk2(o[2], o[3]); w0.z = pk2(o[4], o[5]); w0.w = pk2(o[6], o[7]);
        w1.x = pk2(o[8], o[9]); w1.y = pk2(o[10], o[11]); w1.z = pk2(o[12], o[13]); w1.w = pk2(o[14], o[15]);
        *(v4u*)(xb + (size_t)tok * DM + col) = w0; *(v4u*)(xb + (size_t)tok * DM + col + 8) = w1;
        idA = nidA; idB = nidB; gA = ngA; gB = ngB; par ^= 1; tok = ntok;
    }
}

__device__ __forceinline__ void phase_dsa_norm(const Ctx& c, int j) {
    const int gw = c.bid * NWAVES + c.wave, NGW = c.G * NWAVES, lane = c.lane;
    const bf16* RAW = (const bf16*)(c.ws + WS_M + M_RAW);
    bf16* CQ = (bf16*)(c.ws + WS_M + M_CQ); bf16* CKV = (bf16*)(c.ws + WS_M + M_CKV);
    bf16* KIDX = (bf16*)(c.ws + WS_M + M_KIDX); float* WIDX = (float*)(c.ws + WS_M + M_WIDX);
    const float* gq = INP(c, I_A_CQ_GAIN) + j * 256; const float* gkv = INP(c, I_A_CKV_GAIN) + j * 128;
    const float* gk = INP(c, I_A_KIDX_GAIN) + j * 64; const float* bk = INP(c, I_A_KIDX_BIAS) + j * 64;
    for (int tok = gw; tok < T_TOK; tok += NGW) {
        const v4u rw = *(const v4u*)(RAW + (size_t)tok * 512 + 8 * lane);
        float v[8] = {bflo(rw.x), bfhi(rw.x), bflo(rw.y), bfhi(rw.y), bflo(rw.z), bfhi(rw.z), bflo(rw.w), bfhi(rw.w)};
        float ss = 0.f, s = 0.f;
#pragma unroll
        for (int i = 0; i < 8; ++i) { ss += v[i] * v[i]; s += v[i]; }
        const bool isq = lane < 32, iskv = lane >= 32 && lane < 48, isk = lane >= 48 && lane < 56;
        const float ssq_q = wave_sum(isq ? ss : 0.f), ssq_kv = wave_sum(iskv ? ss : 0.f), sum_k = wave_sum(isk ? s : 0.f);
        const float mean_k = sum_k * (1.0f / 64.0f);
        float dv = 0.f;
#pragma unroll
        for (int i = 0; i < 8; ++i) { const float d = v[i] - mean_k; dv += d * d; }
        const float var_k = wave_sum(isk ? dv : 0.f) * (1.0f / 64.0f);
        if (isq) {
            const float r = __builtin_amdgcn_rsqf(ssq_q * (1.0f / 256.0f) + 1e-6f); const float* g = gq + 8 * lane;
            v4u w; w.x = pk2(v[0] * r * g[0], v[1] * r * g[1]); w.y = pk2(v[2] * r * g[2], v[3] * r * g[3]); w.z = pk2(v[4] * r * g[4], v[5] * r * g[5]); w.w = pk2(v[6] * r * g[6], v[7] * r * g[7]);
            *(v4u*)(CQ + (size_t)tok * 256 + 8 * lane) = w;
        } else if (iskv) {
            const int c0 = 8 * (lane - 32); const float r = __builtin_amdgcn_rsqf(ssq_kv * (1.0f / 128.0f) + 1e-6f); const float* g = gkv + c0;
            float o[8];
#pragma unroll
            for (int i = 0; i < 8; ++i) o[i] = v[i] * r * g[i];
            v4u w; w.x = pk2(o[0], o[1]); w.y = pk2(o[2], o[3]); w.z = pk2(o[4], o[5]); w.w = pk2(o[6], o[7]);
            *(v4u*)(CKV + (size_t)tok * 128 + c0) = w;
        } else if (isk) {
            const int c0 = 8 * (lane - 48); const float r = __builtin_amdgcn_rsqf(var_k + 1e-5f);
            float o[8];
#pragma unroll
            for (int i = 0; i < 8; ++i) o[i] = (v[i] - mean_k) * r * gk[c0 + i] + bk[c0 + i];
            v4u w; w.x = pk2(o[0], o[1]); w.y = pk2(o[2], o[3]); w.z = pk2(o[4], o[5]); w.w = pk2(o[6], o[7]);
            *(v4u*)(KIDX + (size_t)tok * 64 + c0) = w;
        } else if (lane == 56) {
            const float sc = 0.35355339059327373f;
            f32x4 o0 = {v[0] * sc, v[1] * sc, v[2] * sc, v[3] * sc}, o1 = {v[4] * sc, v[5] * sc, v[6] * sc, v[7] * sc};
            *(f32x4*)(WIDX + (size_t)tok * 8) = o0; *(f32x4*)(WIDX + (size_t)tok * 8 + 4) = o1;
        }
    }
}

__device__ __forceinline__ unsigned half_sum_u32(unsigned v, int h) {
    auto dpp = [](unsigned x, auto ctrl, auto rmask) { return (unsigned)__builtin_amdgcn_update_dpp(0, (int)x, decltype(ctrl)::value, decltype(rmask)::value, 0xf, false); };
    v += dpp(v, std::integral_constant<int, 0xB1>{}, std::integral_constant<int, 0xf>{});
    v += dpp(v, std::integral_constant<int, 0x4E>{}, std::integral_constant<int, 0xf>{});
    v += dpp(v, std::integral_constant<int, 0x141>{}, std::integral_constant<int, 0xf>{});
    v += dpp(v, std::integral_constant<int, 0x140>{}, std::integral_constant<int, 0xf>{});
    v += dpp(v, std::integral_constant<int, 0x142>{}, std::integral_constant<int, 0xa>{});
    const unsigned t0 = (unsigned)__builtin_amdgcn_readlane((int)v, 31), t1 = (unsigned)__builtin_amdgcn_readlane((int)v, 63);
    return h ? t1 : t0;
}
__device__ __forceinline__ void phase_dsa_index(const Ctx& c) {
    const bf16* KIDX = (const bf16*)(c.ws + WS_M + M_KIDX); const bf16* QIDX = (const bf16*)(c.ws + WS_M + M_QIDX);
    const float* WIDX = (const float*)(c.ws + WS_M + M_WIDX); unsigned* MASK = (unsigned*)(c.ws + WS_M + M_MASK);
    const int lane = c.lane, n = lane & 31, h = lane >> 5;
    const unsigned ltmask = (1u << n) - 1u;
    LAS unsigned* kl = (LAS unsigned*)(c.lds + c.wave * 16384) + lane * 4;
    for (int u = c.bid; u < 2048; u += c.G) {
        const int b = u & 31, rest = u >> 5, qc = rest >> 1, sub = rest & 1;
        const int tw0 = b * 2048 + qc * 64 + sub * 32 + 4 * c.wave;
        const int nt = 2 * (qc + 1), ng = (nt + 3) >> 2;
        if (nt <= 8) {
            if (n == 0) {
                for (int tt = 0; tt < 2; ++tt)
                    for (int tile = 0; tile < nt; ++tile) MASK[(size_t)(tw0 + 2 * h + tt) * 64 + tile] = 0xffffffffu;
            }
            continue;
        }
        const int ti = 2 * ((n >> 2) & 1) + (n >> 4), hd = 4 * ((n >> 3) & 1) + (n & 3);
        bf16x8 Aq[4];
#pragma unroll
        for (int s = 0; s < 4; ++s) Aq[s] = *(const bf16x8*)(QIDX + (size_t)(tw0 + ti) * 512 + hd * 64 + 16 * s + 8 * h);
        float wv[2][8];
#pragma unroll
        for (int tt = 0; tt < 2; ++tt) { const f32x4 w0 = *(const f32x4*)(WIDX + (size_t)(tw0 + 2 * h + tt) * 8), w1 = *(const f32x4*)(WIDX + (size_t)(tw0 + 2 * h + tt) * 8 + 4);
#pragma unroll
            for (int i = 0; i < 4; ++i) { wv[tt][i] = w0[i]; wv[tt][4 + i] = w1[i]; } }
        const bf16* kbase = KIDX + (size_t)(b * 2048 + n) * 64 + 8 * h;
        auto ldgrp = [&](bf16x8 (&Bk)[2][4], int tile0) {
#pragma unroll
            for (int q = 0; q < 2; ++q) if (tile0 + q < nt) { const bf16* kr = kbase + (size_t)(tile0 + q) * 32 * 64;
#pragma unroll
                for (int s = 0; s < 4; ++s) Bk[q][s] = *(const bf16x8*)(kr + 16 * s); } };
        auto scgrp = [&](const bf16x8 (&Bk)[2][4], int tile0) {
#pragma unroll
            for (int q = 0; q < 2; ++q) if (tile0 + q < nt) {
                f32x16 acc;
#pragma unroll
                for (int i = 0; i < 16; ++i) acc[i] = 0.f;
#pragma unroll
                for (int s = 0; s < 4; ++s) acc = __builtin_amdgcn_mfma_f32_32x32x16_bf16(Aq[s], Bk[q][s], acc, 0, 0, 0);
                float sc0 = 0.f, sc1 = 0.f;
#pragma unroll
                for (int jj = 0; jj < 2; ++jj)
#pragma unroll
                    for (int k = 0; k < 4; ++k) { sc0 += wv[0][4 * jj + k] * fmaxf(acc[4 * jj + k], 0.f); sc1 += wv[1][4 * jj + k] * fmaxf(acc[8 + 4 * jj + k], 0.f); }
                kl[((tile0 + q) >> 2) * 256 + ((tile0 + q) & 3)] = (sort_key(sc0) >> 16) | (sort_key(sc1) & 0xffff0000u);
            } };
        bf16x8 BkA[2][4], BkB[2][4];
        ldgrp(BkA, 0);
#pragma unroll 1
        for (int tile0 = 0; tile0 < nt; tile0 += 4) {
            if (tile0 + 2 < nt) ldgrp(BkB, tile0 + 2);
            scgrp(BkA, tile0);
            if (tile0 + 4 < nt) ldgrp(BkA, tile0 + 4);
            if (tile0 + 2 < nt) scgrp(BkB, tile0 + 2);
        }
        if (nt & 2) { kl[(nt >> 2) * 256 + 2] = 0u; kl[(nt >> 2) * 256 + 3] = 0u; }
        LDS_WAIT(); asm volatile("" ::: "memory");
        unsigned v0 = 0u, v1 = 0u, cv0 = 0xffffu, cv1 = 0xffffu;
        for (int bit = 15; bit >= 0; --bit) {
            const unsigned c0 = v0 | (1u << bit), c1 = v1 | (1u << bit); unsigned lt0 = 0u, lt1 = 0u;
            for (int g = 0; g < ng; ++g) { const v4u k4 = *(const LAS v4u*)(kl + g * 256);
#pragma unroll
                for (int j = 0; j < 4; ++j) { lt0 += (unsigned)((int)((k4[j] & 0xffffu) - c0)) >> 31; lt1 += (unsigned)((int)((k4[j] >> 16) - c1)) >> 31; } }
            const unsigned both = half_sum_u32((4u * (unsigned)ng - lt0) | ((4u * (unsigned)ng - lt1) << 16), h);
            const unsigned cnt0 = both & 0xffffu, cnt1 = both >> 16;
            if (cnt0 >= 256u) { v0 = c0; cv0 = cnt0; }
            if (cnt1 >= 256u) { v1 = c1; cv1 = cnt1; }
            if (__all(cv0 == 256u && cv1 == 256u)) break;
        }
        unsigned g0 = 0u, g1 = 0u;
        for (int g = 0; g < ng; ++g) { const v4u k4 = *(const LAS v4u*)(kl + g * 256);
#pragma unroll
            for (int j = 0; j < 4; ++j) { g0 += (unsigned)((int)(v0 - (k4[j] & 0xffffu))) >> 31; g1 += (unsigned)((int)(v1 - (k4[j] >> 16))) >> 31; } }
        const unsigned gboth = half_sum_u32(g0 | (g1 << 16), h);
        const unsigned need0 = 256u - (gboth & 0xffffu), need1 = 256u - (gboth >> 16); unsigned eb0 = 0u, eb1 = 0u;
        for (int tile = 0; tile < nt; ++tile) {
            const unsigned kw = kl[(tile >> 2) * 256 + (tile & 3)]; const unsigned k0 = kw & 0xffffu, k1 = kw >> 16;
            { const bool gt = k0 > v0, eq = k0 == v0; const unsigned em = half_sel(__ballot(eq), h);
              const bool take = gt || (eq && (eb0 + __popc(em & ltmask) < need0)); eb0 += __popc(em);
              const unsigned word = half_sel(__ballot(take), h); if (n == 0) MASK[(size_t)(tw0 + 2 * h) * 64 + tile] = word; }
            { const bool gt = k1 > v1, eq = k1 == v1; const unsigned em = half_sel(__ballot(eq), h);
              const bool take = gt || (eq && (eb1 + __popc(em & ltmask) < need1)); eb1 += __popc(em);
              const unsigned word = half_sel(__ballot(take), h); if (n == 0) MASK[(size_t)(tw0 + 2 * h + 1) * 64 + tile] = word; }
        }
        LDS_WAIT(); asm volatile("" ::: "memory");
    }
}

__device__ __forceinline__ void tr_rd16(unsigned a, v2u (&r)[16]) {
    asm volatile("ds_read_b64_tr_b16 %0, %16\n\tds_read_b64_tr_b16 %1, %16 offset:4352\n\t"
                 "ds_read_b64_tr_b16 %2, %16 offset:32\n\tds_read_b64_tr_b16 %3, %16 offset:4384\n\t"
                 "ds_read_b64_tr_b16 %4, %16 offset:64\n\tds_read_b64_tr_b16 %5, %16 offset:4416\n\t"
                 "ds_read_b64_tr_b16 %6, %16 offset:96\n\tds_read_b64_tr_b16 %7, %16 offset:4448\n\t"
                 "ds_read_b64_tr_b16 %8, %16 offset:128\n\tds_read_b64_tr_b16 %9, %16 offset:4480\n\t"
                 "ds_read_b64_tr_b16 %10, %16 offset:160\n\tds_read_b64_tr_b16 %11, %16 offset:4512\n\t"
                 "ds_read_b64_tr_b16 %12, %16 offset:192\n\tds_read_b64_tr_b16 %13, %16 offset:4544\n\t"
                 "ds_read_b64_tr_b16 %14, %16 offset:224\n\tds_read_b64_tr_b16 %15, %16 offset:4576\n\ts_waitcnt lgkmcnt(0)"
                 : "=&v"(r[0]), "=&v"(r[1]), "=&v"(r[2]), "=&v"(r[3]), "=&v"(r[4]), "=&v"(r[5]), "=&v"(r[6]), "=&v"(r[7]),
                   "=&v"(r[8]), "=&v"(r[9]), "=&v"(r[10]), "=&v"(r[11]), "=&v"(r[12]), "=&v"(r[13]), "=&v"(r[14]), "=&v"(r[15])
                 : "v"(a) : "memory");
}
__device__ __forceinline__ void phase_dsa_attn(const Ctx& c) {
    const bf16* CKV = (const bf16*)(c.ws + WS_M + M_CKV);
    bf16* QLAT = (bf16*)(c.ws + WS_M + M_QLAT); const unsigned* MASK = (const unsigned*)(c.ws + WS_M + M_MASK);
    constexpr int RS = 272, TILE = 32 * RS;
    const int lane = c.lane, l15 = lane & 15, g = lane >> 4;
    LAS unsigned char* T0 = c.lds + c.wave * 17920;
    LAS unsigned short* klist = (LAS unsigned short*)(T0 + 2 * TILE);
    const unsigned lbase = (unsigned)(size_t)T0;
    const int prow = lane >> 4, ppc = lane & 15;
    for (int u = c.bid * NWAVES + c.wave; u < T_TOK; u += c.G * NWAVES) {
        const int tok = u, b = tok >> 11;
        const int qc = (tok & 2047) >> 6; const int nt = 2 * (qc + 1);
        const unsigned mwd = lane < nt ? MASK[(size_t)tok * 64 + lane] : 0u;
        unsigned incl = (unsigned)__popc(mwd);
#pragma unroll
        for (int d = 1; d < 64; d <<= 1) { const unsigned o = __shfl_up(incl, d); if (lane >= d) incl += o; }
        const int nsel = __builtin_amdgcn_readlane((int)incl, 63);
        { unsigned pos = incl - (unsigned)__popc(mwd), w = mwd;
          while (w) { const int bit = __builtin_ctz(w); klist[pos++] = (unsigned short)(32 * lane + bit); w &= w - 1u; } }
        bf16x8 Bq[4];
#pragma unroll
        for (int s = 0; s < 4; ++s) Bq[s] = *(const bf16x8*)(QLAT + (size_t)tok * 2048 + l15 * 128 + 32 * s + 8 * g);
        LDS_WAIT(); asm volatile("" ::: "memory");
        const int nstep = nsel >> 5;
        const bf16* kvb = CKV + (size_t)b * 2048 * 128 + ppc * 8;
        v4u gr[8];
        auto gather = [&](int step) {
#pragma unroll
            for (int j = 0; j < 8; ++j) { const int key = klist[32 * step + 4 * j + prow]; gr[j] = *(const v4u*)(kvb + (size_t)key * 128); } };
        auto lstore = [&](int buf) {
#pragma unroll
            for (int j = 0; j < 8; ++j) *(LAS v4u*)(T0 + buf * TILE + (4 * j + prow) * RS + ppc * 16) = gr[j]; };
        float m_run = -INFINITY, l_run = 0.f;
        f32x4 O[8];
#pragma unroll
        for (int dt = 0; dt < 8; ++dt) O[dt] = (f32x4){0.f, 0.f, 0.f, 0.f};
        gather(0);
#pragma unroll 1
        for (int step = 0; step < nstep; ++step) {
            const int buf = step & 1;
            lstore(buf);
            if (step + 1 < nstep) gather(step + 1);
            LDS_WAIT(); asm volatile("" ::: "memory");
            f32x4 S[2];
#pragma unroll
            for (int kt = 0; kt < 2; ++kt) { S[kt] = (f32x4){0.f, 0.f, 0.f, 0.f};
#pragma unroll
                for (int s = 0; s < 4; ++s) { const bf16x8 Ak = *(const LAS bf16x8*)(T0 + buf * TILE + (16 * kt + l15) * RS + (32 * s + 8 * g) * 2);
                    S[kt] = __builtin_amdgcn_mfma_f32_16x16x32_bf16(Ak, Bq[s], S[kt], 0, 0, 0); } }
            float mx = fmaxf(fmaxf(fmaxf(S[0][0], S[0][1]), fmaxf(S[0][2], S[0][3])), fmaxf(fmaxf(S[1][0], S[1][1]), fmaxf(S[1][2], S[1][3])));
            mx = fmaxf(mx, __shfl_xor(mx, 16)); mx = fmaxf(mx, __shfl_xor(mx, 32));
            const float m_new = fmaxf(m_run, mx);
            const float alpha = __builtin_amdgcn_exp2f(m_run - m_new);
            float p[8], ps = 0.f;
#pragma unroll
            for (int j = 0; j < 8; ++j) { p[j] = __builtin_amdgcn_exp2f(S[j >> 2][j & 3] - m_new); ps += p[j]; }
            l_run = l_run * alpha + ps; m_run = m_new;
            v4u pw; pw.x = pk2(p[0], p[1]); pw.y = pk2(p[2], p[3]); pw.z = pk2(p[4], p[5]); pw.w = pk2(p[6], p[7]);
            const bf16x8 Bp = __builtin_bit_cast(bf16x8, pw);
            const unsigned ta = lbase + buf * TILE + (4 * g + (l15 >> 2)) * RS + (4 * (l15 & 3)) * 2;
            v2u tr[16]; tr_rd16(ta, tr);
#pragma unroll
            for (int dt = 0; dt < 8; ++dt) {
                v4u aw; aw.x = tr[2 * dt].x; aw.y = tr[2 * dt].y; aw.z = tr[2 * dt + 1].x; aw.w = tr[2 * dt + 1].y;
                O[dt] = O[dt] * alpha; O[dt] = __builtin_amdgcn_mfma_f32_16x16x32_bf16(__builtin_bit_cast(bf16x8, aw), Bp, O[dt], 0, 0, 0); }
        }
        const float l_tot = l_run + __shfl_xor(l_run, 16); const float l_all = l_tot + __shfl_xor(l_tot, 32); const float inv = 1.0f / l_all;
#pragma unroll
        for (int dt = 0; dt < 8; ++dt) { v2u w; w.x = pk2(O[dt][0] * inv, O[dt][1] * inv); w.y = pk2(O[dt][2] * inv, O[dt][3] * inv);
            *(v2u*)(QLAT + (size_t)tok * 2048 + l15 * 128 + 16 * dt + 4 * g) = w; }
        LDS_WAIT(); asm volatile("" ::: "memory");
    }
}

__device__ __forceinline__ float neg_expm1_small(float x) {
    const float p = -x * (1.0f + x * 0.5f * (1.0f + x * (1.0f / 3.0f) * (1.0f + x * 0.25f * (1.0f + x * 0.2f * (1.0f + x * (1.0f / 6.0f))))));
    return x < -0.25f ? 1.0f - __expf(x) : p;
}
__device__ __forceinline__ void phase_rglru(const Ctx& c) {
    const bf16* GU = (const bf16*)(c.ws + WS_M + M_GU); bf16* Y = (bf16*)(c.ws + WS_M + M_Y);
    constexpr int CVS = 104;
    LAS float* uT = (LAS float*)c.lds;
    LAS bf16* cvb = (LAS bf16*)(c.lds + 21504);
    LAS bf16* WTa = (LAS bf16*)(c.lds + 34816);
    LAS bf16* WTx = (LAS bf16*)(c.lds + 51456);
    LAS float* a_s = (LAS float*)(c.lds + 68096);
    LAS float* b_s = (LAS float*)(c.lds + 88832);
    LAS bf16* gT = (LAS bf16*)(c.lds + 109568);
    LAS float* cst = (LAS float*)(c.lds + 120064);
    const int tid = c.tid, lane = c.lane, w = c.wave;
    for (int u = c.bid; u < 512; u += c.G) {
        const int b = u >> 4, nb = u & 15, ch0 = nb * 80;
        __syncthreads();
        for (int e = tid; e < 80 * CVS; e += NTHR) { const int d = e / CVS, k = e % CVS;
            WTa[e] = (bf16)(k < 80 ? f2bf(INP(c, I_B_W_A)[(size_t)nb * 6400 + k * 80 + d]) : 0u);
            WTx[e] = (bf16)(k < 80 ? f2bf(INP(c, I_B_W_X)[(size_t)nb * 6400 + k * 80 + d]) : 0u); }
        for (int e = tid; e < 64 * CVS; e += NTHR) cvb[e] = 0;
        if (tid < 80) {
            const int cc = ch0 + tid;
#pragma unroll
            for (int j = 0; j < 4; ++j) cst[j * 80 + tid] = INP(c, I_B_CONV_W)[j * 1280 + cc];
            cst[320 + tid] = INP(c, I_B_CONV_B)[cc]; cst[400 + tid] = INP(c, I_B_B_A)[cc]; cst[480 + tid] = INP(c, I_B_B_X)[cc];
            cst[560 + tid] = log1pf(expf(-INP(c, I_B_LAMBDA)[cc]));
        }
        float carry[10];
#pragma unroll
        for (int q = 0; q < 10; ++q) carry[q] = 0.f;
        v4u ureg[2], greg[2];
        auto issue_loads = [&](int chunk) {
#pragma unroll
            for (int q = 0; q < 2; ++q) { const int e = tid + NTHR * q;
                ureg[q] = (v4u){0u, 0u, 0u, 0u}; greg[q] = (v4u){0u, 0u, 0u, 0u};
                if (e < 670) { const int i = e / 10, cch = e % 10; const int sp = chunk * 64 - 3 + i;
                    if (sp >= 0) ureg[q] = *(const v4u*)(GU + (size_t)(b * 2048 + sp) * 2560 + 1280 + ch0 + cch * 8); }
                if (e < 640) { const int i = e / 10, cch = e % 10;
                    greg[q] = *(const v4u*)(GU + (size_t)(b * 2048 + chunk * 64 + i) * 2560 + ch0 + cch * 8); } }
        };
        issue_loads(0);
#pragma unroll 1
        for (int chunk = 0; chunk < 32; ++chunk) {
            const int t0 = b * 2048 + chunk * 64;
#pragma unroll
            for (int q = 0; q < 2; ++q) { const int e = tid + NTHR * q;
                if (e < 670) { const int i = e / 10, cch = e % 10; LAS float* d = uT + i * 80 + cch * 8;
                    *(LAS f32x4*)d = (f32x4){bflo(ureg[q].x), bfhi(ureg[q].x), bflo(ureg[q].y), bfhi(ureg[q].y)};
                    *(LAS f32x4*)(d + 4) = (f32x4){bflo(ureg[q].z), bfhi(ureg[q].z), bflo(ureg[q].w), bfhi(ureg[q].w)}; }
                if (e < 640) { const int i = e / 10, cch = e % 10; LAS unsigned* d = (LAS unsigned*)(gT + i * 82 + cch * 8);
                    d[0] = greg[q].x; d[1] = greg[q].y; d[2] = greg[q].z; d[3] = greg[q].w; } }
            __syncthreads();
            if (chunk + 1 < 32) issue_loads(chunk + 1);
            for (int e = tid; e < 5120; e += NTHR) { const int t = e / 80, cc = e % 80;
                float s = cst[320 + cc];
#pragma unroll
                for (int j = 0; j < 4; ++j) s += uT[(t + j) * 80 + cc] * cst[j * 80 + cc];
                cvb[t * CVS + cc] = (bf16)f2bf(s); }
            __syncthreads();
            {
                const int tq = w & 3, nt0 = (w >> 2) ? 3 : 0, nt1 = (w >> 2) ? 5 : 3, l15 = lane & 15, g4 = lane >> 4;
                bf16x8 Af[3];
#pragma unroll
                for (int s3 = 0; s3 < 3; ++s3) Af[s3] = *(const LAS bf16x8*)(cvb + (16 * tq + l15) * CVS + 32 * s3 + 8 * g4);
#pragma unroll
                for (int q = 0; q < 3; ++q) { const int nt = nt0 + q;
                    if (nt < nt1) {
                        f32x4 accA = {0.f, 0.f, 0.f, 0.f}, accX = {0.f, 0.f, 0.f, 0.f};
#pragma unroll
                        for (int s3 = 0; s3 < 3; ++s3) {
                            const bf16x8 Ba = *(const LAS bf16x8*)(WTa + (16 * nt + l15) * CVS + 32 * s3 + 8 * g4), Bx = *(const LAS bf16x8*)(WTx + (16 * nt + l15) * CVS + 32 * s3 + 8 * g4);
                            accA = __builtin_amdgcn_mfma_f32_16x16x32_bf16(Af[s3], Ba, accA, 0, 0, 0); accX = __builtin_amdgcn_mfma_f32_16x16x32_bf16(Af[s3], Bx, accX, 0, 0, 0); }
                        const int cc = 16 * nt + l15; const float ba = cst[400 + cc], bx = cst[480 + cc], sp = cst[560 + cc], cb = cst[320 + cc];
                        const float cw0 = cst[cc], cw1 = cst[80 + cc], cw2 = cst[160 + cc], cw3 = cst[240 + cc];
#pragma unroll
                        for (int r4 = 0; r4 < 4; ++r4) { const int t = 16 * tq + 4 * g4 + r4;
                            const float cvf = cb + uT[t * 80 + cc] * cw0 + uT[(t + 1) * 80 + cc] * cw1 + uT[(t + 2) * 80 + cc] * cw2 + uT[(t + 3) * 80 + cc] * cw3;
                            const float r = sigmoidf_(accA[r4] + ba), ig = sigmoidf_(accX[r4] + bx);
                            const float log_a = -8.0f * r * sp; const float a = __expf(log_a);
                            const float bb = __builtin_amdgcn_sqrtf(neg_expm1_small(2.0f * log_a)) * (ig * cvf);
                            a_s[t * 81 + cc] = a; b_s[t * 81 + cc] = bb; }
                    } }
            }
            __syncthreads();
            {
                LAS bf16* yT = (LAS bf16*)uT;
#pragma unroll
                for (int q = 0; q < 10; ++q) { const int cc = w + 8 * q;
                    float a = a_s[lane * 81 + cc], bq = b_s[lane * 81 + cc];
#define RG_STEP(D) { const float ap = __builtin_bit_cast(float, __builtin_amdgcn_update_dpp(0x3f800000, __builtin_bit_cast(int, a), 0x110 + D, 0xf, 0xf, false)); \
                     const float bp = __builtin_bit_cast(float, __builtin_amdgcn_update_dpp(0, __builtin_bit_cast(int, bq), 0x110 + D, 0xf, 0xf, false)); bq = a * bp + bq; a = a * ap; }
                    RG_STEP(1) RG_STEP(2) RG_STEP(4) RG_STEP(8)
#undef RG_STEP
                    { const float A0 = __builtin_bit_cast(float, __builtin_amdgcn_readlane(__builtin_bit_cast(int, a), 15)), B0 = __builtin_bit_cast(float, __builtin_amdgcn_readlane(__builtin_bit_cast(int, bq), 15));
                      const float A1 = __builtin_bit_cast(float, __builtin_amdgcn_readlane(__builtin_bit_cast(int, a), 31)), B1 = __builtin_bit_cast(float, __builtin_amdgcn_readlane(__builtin_bit_cast(int, bq), 31));
                      const float A2 = __builtin_bit_cast(float, __builtin_amdgcn_readlane(__builtin_bit_cast(int, a), 47)), B2 = __builtin_bit_cast(float, __builtin_amdgcn_readlane(__builtin_bit_cast(int, bq), 47));
                      const float C2a = A0 * A1, C2b = A1 * B0 + B1, C3a = C2a * A2, C3b = A2 * C2b + B2;
                      const int row = lane >> 4;
                      const float ca = row == 0 ? 1.0f : (row == 1 ? A0 : (row == 2 ? C2a : C3a)), cb = row == 0 ? 0.0f : (row == 1 ? B0 : (row == 2 ? C2b : C3b));
                      bq = a * cb + bq; a = a * ca; }
                    const float hval = a * carry[q] + bq;
                    carry[q] = __builtin_bit_cast(float, __builtin_amdgcn_readlane(__builtin_bit_cast(int, hval), 63));
                    yT[lane * 82 + cc] = (bf16)f2bf(bf2f(gT[lane * 82 + cc]) * hval); }
            }
            __syncthreads();
            for (int e = tid; e < 2560; e += NTHR) { const int row = e / 40, dw = e % 40;
                ((unsigned*)(Y + (size_t)(t0 + row) * 1280 + ch0))[dw] = ((const LAS unsigned*)uT)[row * 41 + dw]; }
            __syncthreads();
        }
    }
}

template <int OFF0, int OFF1>
__device__ __forceinline__ void tr_read2(unsigned a, v2u& r0, v2u& r1) {
    asm volatile("ds_read_b64_tr_b16 %0, %2 offset:%3\n\tds_read_b64_tr_b16 %1, %2 offset:%4\n\ts_waitcnt lgkmcnt(0)" : "=&v"(r0), "=&v"(r1) : "v"(a), "n"(OFF0), "n"(OFF1) : "memory");
}
template <int B0, int RSb>
__device__ __forceinline__ void tr_read8(unsigned a, v2u (&r)[8]) {
    asm volatile("ds_read_b64_tr_b16 %0, %8 offset:%9\n\tds_read_b64_tr_b16 %1, %8 offset:%10\n\tds_read_b64_tr_b16 %2, %8 offset:%11\n\tds_read_b64_tr_b16 %3, %8 offset:%12\n\t"
                 "ds_read_b64_tr_b16 %4, %8 offset:%13\n\tds_read_b64_tr_b16 %5, %8 offset:%14\n\tds_read_b64_tr_b16 %6, %8 offset:%15\n\tds_read_b64_tr_b16 %7, %8 offset:%16\n\ts_waitcnt lgkmcnt(0)"
                 : "=&v"(r[0]), "=&v"(r[1]), "=&v"(r[2]), "=&v"(r[3]), "=&v"(r[4]), "=&v"(r[5]), "=&v"(r[6]), "=&v"(r[7])
                 : "v"(a), "n"(B0), "n"(B0 + 4 * RSb), "n"(B0 + 16 * RSb), "n"(B0 + 20 * RSb), "n"(B0 + 32 * RSb), "n"(B0 + 36 * RSb), "n"(B0 + 48 * RSb), "n"(B0 + 52 * RSb) : "memory");
}
__device__ __forceinline__ void phase_ret_core(const Ctx& c) {
    const bf16* Qg = (const bf16*)(c.ws + WS_M + M_Q); const bf16* Kg = (const bf16*)(c.ws + WS_M + M_K); bf16* Vg = (bf16*)(c.ws + WS_M + M_V);
    float* STAT = (float*)(c.ws + WS_M + M_STAT);
    constexpr int RS = 528, SS = 144, QS_OFF = 0, KS_OFF = 64 * RS, VS_OFF = 2 * 64 * RS, SS_OFF = 3 * 64 * RS;
    LAS unsigned char* L = c.lds; const unsigned lbase = (unsigned)(size_t)c.lds;
    const int tid0 = c.tid, w = c.wave;
    for (int u = c.bid; u < 256; u += c.G) {
        const int b = u >> 3, hh = (u >> 1) & 3, eh = u & 1;
        const float gam = 1.0f - exp2f(-5.0f - (float)hh); const float lg0 = log2f(gam);
        f32x16 R[8];
#pragma unroll
        for (int dt = 0; dt < 8; ++dt)
#pragma unroll
            for (int i = 0; i < 16; ++i) R[dt][i] = 0.f;
        const float cdec = exp2f(lg0 * 64.0f);
#pragma unroll 1
        for (int chunk = 0; chunk < 32; ++chunk) {
            const int t0 = b * 2048 + chunk * 64;
            float lg = lg0; int tid = tid0; asm volatile("" : "+v"(lg), "+v"(tid));
            const int lane = tid & 63, n = lane & 31, h = lane >> 5, hl = h;
            const int blk = (lane >> 4) & 1, q4 = (lane & 15) >> 2, p4 = lane & 3;
            const unsigned trbK = lbase + (8 * h + q4) * RS + (16 * blk + 4 * p4) * 2;
            const unsigned trbV = trbK + VS_OFF + 64 * w;
            __syncthreads();
#pragma unroll
            for (int i = 0; i < 4; ++i) { const int e = tid + NTHR * i, row = e >> 5, ch = e & 31;
                *(LAS v4u*)(L + QS_OFF + row * RS + ch * 16) = *(const v4u*)(Qg + (size_t)(t0 + row) * 1024 + hh * 256 + ch * 8);
                *(LAS v4u*)(L + KS_OFF + row * RS + ch * 16) = *(const v4u*)(Kg + (size_t)(t0 + row) * 1024 + hh * 256 + ch * 8); }
            asm volatile("" ::: "memory");
#pragma unroll
            for (int i = 0; i < 4; ++i) { const int e = tid + NTHR * i, row = e >> 5, ch = e & 31;
                *(LAS v4u*)(L + VS_OFF + row * RS + ch * 16) = *(const v4u*)(Vg + (size_t)(t0 + row) * 2048 + hh * 512 + eh * 256 + ch * 8); }
            __syncthreads();
            {
                const int i16 = w >> 1, l15 = lane & 15, g4 = lane >> 4; const int l15d = l15, g4d = g4;
                bf16x8 Af[8];
#pragma unroll
                for (int s = 0; s < 8; ++s) Af[s] = *(const LAS bf16x8*)(L + QS_OFF + (16 * i16 + l15) * RS + (32 * s + 8 * g4) * 2);
#pragma unroll
                for (int jj = 0; jj < 2; ++jj) { const int j16 = 2 * (w & 1) + jj;
                    f32x4 acc = {0.f, 0.f, 0.f, 0.f};
                    if (j16 <= i16) {
#pragma unroll
                        for (int s = 0; s < 8; ++s) { const bf16x8 Bf = *(const LAS bf16x8*)(L + KS_OFF + (16 * j16 + l15) * RS + (32 * s + 8 * g4) * 2);
                            acc = __builtin_amdgcn_mfma_f32_16x16x32_bf16(Af[s], Bf, acc, 0, 0, 0); }
                    }
                    const int ja = 16 * j16 + l15, jad = 16 * j16 + l15d;
#pragma unroll
                    for (int r = 0; r < 4; ++r) { const int ia = 16 * i16 + 4 * g4 + r, iad = 16 * i16 + 4 * g4d + r; const float dec = (iad >= jad) ? __builtin_amdgcn_exp2f(lg * (float)(iad - jad)) : 0.f;
                        *(LAS bf16*)(L + SS_OFF + ia * SS + ja * 2) = (bf16)f2bf(acc[r] * dec); }
                }
            }
            __syncthreads();
            bf16x8 Vf[4];
            { v2u tr[8]; tr_read8<0, RS>(trbV, tr);
#pragma unroll
              for (int ks = 0; ks < 4; ++ks) { v4u wv; wv.x = tr[2 * ks].x; wv.y = tr[2 * ks].y; wv.z = tr[2 * ks + 1].x; wv.w = tr[2 * ks + 1].y; Vf[ks] = __builtin_bit_cast(bf16x8, wv); } }
            {
                f32x16 Oa[2];
#pragma unroll
                for (int it = 0; it < 2; ++it)
#pragma unroll
                    for (int i = 0; i < 16; ++i) Oa[it][i] = 0.f;
#pragma unroll
                for (int dt = 0; dt < 8; ++dt)
#pragma unroll
                    for (int s = 0; s < 2; ++s) {
                        v4u bw; bw.x = pk2(R[dt][8 * s + 0], R[dt][8 * s + 1]); bw.y = pk2(R[dt][8 * s + 2], R[dt][8 * s + 3]); bw.z = pk2(R[dt][8 * s + 4], R[dt][8 * s + 5]); bw.w = pk2(R[dt][8 * s + 6], R[dt][8 * s + 7]);
#pragma unroll
                        for (int it = 0; it < 2; ++it) {
                            const LAS unsigned char* qrow = L + QS_OFF + (32 * it + n) * RS;
                            const v2u lo = *(const LAS v2u*)(qrow + (32 * dt + 16 * s + 4 * h) * 2), hi = *(const LAS v2u*)(qrow + (32 * dt + 16 * s + 8 + 4 * h) * 2);
                            v4u aw; aw.x = lo.x; aw.y = lo.y; aw.z = hi.x; aw.w = hi.y;
                            Oa[it] = __builtin_amdgcn_mfma_f32_32x32x16_bf16(__builtin_bit_cast(bf16x8, aw), __builtin_bit_cast(bf16x8, bw), Oa[it], 0, 0, 0);
                        }
                    }
#pragma unroll
                for (int it = 0; it < 2; ++it) {
#pragma unroll
                    for (int i = 0; i < 16; ++i) { const int ia = 32 * it + 8 * (i >> 2) + 4 * h + (i & 3); Oa[it][i] *= __builtin_amdgcn_exp2f(lg * (float)(32 * it + 8 * (i >> 2) + 4 * hl + (i & 3) + 1)); }
#pragma unroll
                    for (int ks = 0; ks < 4; ++ks) if (ks < 2 * (it + 1)) {
                        const bf16x8 Sf = *(const LAS bf16x8*)(L + SS_OFF + (32 * it + n) * SS + (16 * ks + 8 * h) * 2);
                        Oa[it] = __builtin_amdgcn_mfma_f32_32x32x16_bf16(Sf, Vf[ks], Oa[it], 0, 0, 0);
                    }
#pragma unroll
                    for (int i = 0; i < 16; ++i) { const int ia = 32 * it + 8 * (i >> 2) + 4 * h + (i & 3);
                        *(LAS bf16*)(L + VS_OFF + ia * RS + (32 * w + n) * 2) = (bf16)f2bf(Oa[it][i]); }
                }
            }
            bf16x8 Vs2[4];
#pragma unroll
            for (int ks = 0; ks < 4; ++ks) { const v4u wv = __builtin_bit_cast(v4u, Vf[ks]); float f[8] = {bflo(wv.x), bfhi(wv.x), bflo(wv.y), bfhi(wv.y), bflo(wv.z), bfhi(wv.z), bflo(wv.w), bfhi(wv.w)};
#pragma unroll
                for (int j = 0; j < 8; ++j) { const int key = 16 * ks + 8 * hl + j; f[j] *= __builtin_amdgcn_exp2f(lg * (float)(63 - key)); }
                v4u o; o.x = pk2(f[0], f[1]); o.y = pk2(f[2], f[3]); o.z = pk2(f[4], f[5]); o.w = pk2(f[6], f[7]); Vs2[ks] = __builtin_bit_cast(bf16x8, o); }
#define RC_DT(dt) { _Pragma("unroll") for (int i = 0; i < 16; ++i) R[dt][i] *= cdec; v2u tr[8]; tr_read8<KS_OFF + 64 * (dt), RS>(trbK, tr); \
                _Pragma("unroll") for (int ks = 0; ks < 4; ++ks) { v4u aw; aw.x = tr[2 * ks].x; aw.y = tr[2 * ks].y; aw.z = tr[2 * ks + 1].x; aw.w = tr[2 * ks + 1].y; \
                    R[dt] = __builtin_amdgcn_mfma_f32_32x32x16_bf16(__builtin_bit_cast(bf16x8, aw), Vs2[ks], R[dt], 0, 0, 0); } }
            RC_DT(0) RC_DT(1) RC_DT(2) RC_DT(3) RC_DT(4) RC_DT(5) RC_DT(6) RC_DT(7)
#undef RC_DT
            __syncthreads();
#pragma unroll
            for (int i = 0; i < 4; ++i) { const int e = tid + NTHR * i, row = e >> 5, ch = e & 31;
                const v4u ov = *(const LAS v4u*)(L + VS_OFF + row * RS + ch * 16);
                *(v4u*)(Vg + (size_t)(t0 + row) * 2048 + hh * 512 + eh * 256 + ch * 8) = ov;
                const float f[8] = {bflo(ov.x), bfhi(ov.x), bflo(ov.y), bfhi(ov.y), bflo(ov.z), bfhi(ov.z), bflo(ov.w), bfhi(ov.w)};
                float s = 0.f, s2 = 0.f;
#pragma unroll
                for (int j = 0; j < 8; ++j) { s += f[j]; s2 += f[j] * f[j]; }
#pragma unroll
                for (int o = 1; o < 32; o <<= 1) { s += __shfl_xor(s, o); s2 += __shfl_xor(s2, o); }
                if ((tid & 31) == 0) { f32x2 st = {s, s2}; *(f32x2*)(STAT + (size_t)(t0 + row) * 16 + hh * 4 + eh * 2) = st; }
            }
        }
    }
}

__host__ __device__ __forceinline__ bool slot_active(int kind, int s) {
    if (s == 2) return kind != 1;
    if (s == 3 || s == 4) return kind == 0;
    if (s == 10) return false;
    return true;
}

#ifndef MK_EN
#define MK_EN 0xffffffffu
#endif
#define EN(b) ((MK_EN >> (b)) & 1u)
template <int PROBE>
__global__ void __launch_bounds__(NTHR, 2) mk_fwd_t(Params p) {
    extern __shared__ __attribute__((aligned(16))) unsigned char lds_raw[];
    Ctx c;
    c.lds = (LAS unsigned char*)lds_raw; c.tid = threadIdx.x; c.lane = c.tid & 63; c.wave = __builtin_amdgcn_readfirstlane(c.tid >> 6);
    c.bid = blockIdx.x; c.G = gridDim.x; c.in = (InTab)(unsigned long)__builtin_amdgcn_kernarg_segment_ptr(); c.out = p.out; c.ws = p.ws;
    volatile LAS unsigned* MISC = (volatile LAS unsigned*)(c.lds + MISC_OFF);
    for (int u = c.tid; u < (LDS_BYTES - LDSCTL_OFF) / 4; u += NTHR) ((LAS unsigned*)(c.lds + LDSCTL_OFF))[u] = 0u;
    __syncthreads();
    const bool one = (p.flags & 1) != 0;
    XcdBarrier bar; bar.bar = (unsigned*)(p.ws + WS_CTL) + CW_BAR; bar.x = 0; bar.st = MISC + 8;
    if (one) bar = xcd_barrier_post((unsigned*)(p.ws + WS_CTL) + CW_BAR, MISC + 8);
    const int lo = p.ph_lo, hi = p.ph_hi;
#define IN(k) (lo <= (k) && (k) < hi)
#if MK_PROBE
#define STAMP(k) do { if (blockIdx.x == 0 && threadIdx.x == 0) ((unsigned long long*)(p.ws + WS_CTL + 65536))[k] = __builtin_amdgcn_s_memrealtime(); } while (0)
#else
#define STAMP(k) do {} while (0)
#endif
#define LCTX() Ctx cl = c; { unsigned long k_ = (unsigned long)__builtin_amdgcn_kernarg_segment_ptr(); unsigned long w_ = (unsigned long)p.ws, o_ = (unsigned long)p.out; int t_ = threadIdx.x; asm volatile("" : "+s"(k_), "+s"(w_), "+s"(o_), "+v"(t_)); cl.tid = t_; cl.lane = t_ & 63; cl.wave = __builtin_amdgcn_readfirstlane(t_ >> 6); cl.in = (InTab)k_; cl.ws = (unsigned char*)(GAS unsigned char*)w_; cl.out = (float*)(GAS float*)o_; } unsigned char* ws = cl.ws; (void)ws
#define SEAM(k) do { if (one && IN(k) && (k) + 1 < hi) xcd_barrier(bar); } while (0)
    STAMP(0);
    if (EN(0) && IN(0)) { LCTX(); phase_prologue(cl); }
    SEAM(0);
#pragma unroll 1
    for (int layer = 0; layer < 4; ++layer) {
        const int kind = layer % 3, j = layer / 3, base = 1 + layer * NPH_LAYER;
        const size_t xin_off = (layer & 1) ? WS_XB1 : WS_XB0, xnext_off = (layer & 1) ? WS_XB0 : WS_XB1;
#define xin ((const bf16*)(ws + xin_off))
#define xnext ((bf16*)(ws + xnext_off))
        STAMP(base + 0);
        if (IN(base + 0)) { LCTX();
            if (EN(1) && kind == 0) { bf16* RAWb = (bf16*)(ws + WS_M + M_RAW); EpiBf16R<0> E{RAWb, RAWb, RAWb, 512, 512, 512, 1 << 30, 1 << 30};
                run_gemm(cl, xin, (const bf16*)(ws + WS_WAIN) + (size_t)j * 512 * 1024, 512, 1024, E); }
            else if (EN(2) && kind == 1) { bf16* GU = (bf16*)(ws + WS_M + M_GU); EpiBf16R<1> E{GU, GU + 1280, GU + 1280, 2560, 2560, 2560, 1280, 1 << 30};
                run_gemm(cl, xin, (const bf16*)(ws + WS_WBIN), 2560, 1024, E); }
            else if (EN(3) && kind == 2) { EpiRetIn E{(bf16*)(ws + WS_M + M_Q), (bf16*)(ws + WS_M + M_K), (bf16*)(ws + WS_M + M_V), (const float*)(ws + WS_ROT), (const float*)(ws + WS_ROT) + 2048 * 128};
                run_gemm(cl, xin, (const bf16*)(ws + WS_WCIN), 4096, 1024, E); }
        }
        SEAM(base + 0);
        STAMP(base + 1);
        if (IN(base + 1)) { LCTX();
            if (EN(4) && kind == 0) phase_dsa_norm(cl, j);
            else if (EN(5) && kind == 1) phase_rglru(cl);
            else if (EN(6) && kind == 2) phase_ret_core(cl);
        }
        SEAM(base + 1);
        STAMP(base + 2);
        if (IN(base + 2) && kind != 1) { LCTX();
            if (EN(7) && kind == 0) { EpiBf16R<0> E{(bf16*)(ws + WS_M + M_QLAT), (bf16*)(ws + WS_M + M_QIDX), (bf16*)(ws + WS_M + M_QIDX), 2048, 512, 512, 2048, 1 << 30};
                run_gemm(cl, (const bf16*)(ws + WS_M + M_CQ), (const bf16*)(ws + WS_WAQ + j * WAQ_STRIDE), 2560, 256, E); }
            else if (EN(8) && kind == 2) { EpiRetGate E{(bf16*)(ws + WS_M + M_V), (const float*)(ws + WS_M + M_STAT)};
                run_gemm(cl, xin, (const bf16*)(ws + WS_WCIN) + (size_t)4096 * 1024, 2048, 1024, E); }
        }
        if (kind != 1) SEAM(base + 2);
        STAMP(base + 3);
        if (EN(9) && IN(base + 3) && kind == 0) { LCTX(); phase_dsa_index(cl); }
        if (kind == 0) SEAM(base + 3);
        STAMP(base + 4);
        if (EN(10) && IN(base + 4) && kind == 0) { LCTX(); phase_dsa_attn(cl); }
        if (kind == 0) SEAM(base + 4);
        STAMP(base + 5);
        if (EN(11) && IN(base + 5)) { LCTX();
            const bf16* A = (const bf16*)(ws + WS_M + (kind == 0 ? M_QLAT : (kind == 1 ? M_Y : M_V)));
            const bf16* Bt = kind == 0 ? (const bf16*)(ws + WS_WAOV) + (size_t)j * 1024 * 2048 : (kind == 1 ? (const bf16*)(ws + WS_WBO) : (const bf16*)(ws + WS_WCO));
            const int K = kind == 1 ? 1280 : 2048;
            EpiResid E{(bf16*)xin, ALPHA_DN, xin};
            run_gemm(cl, A, Bt, 1024, K, E);
        }
        SEAM(base + 5);
        STAMP(base + 6);
        if (EN(12) && IN(base + 6)) { LCTX(); phase_ln1(cl, layer); }
        SEAM(base + 6);
        STAMP(base + 7);
        if (EN(13) && IN(base + 7)) { LCTX(); EpiF32T E{(bf16*)(ws + WS_M + M_SC)};
            run_gemm(cl, xin, (const bf16*)(ws + WS_WPEER) + (size_t)layer * 2048 * 1024, 2048, 1024, E);
            bf16* PP = (bf16*)(ws + WS_PP); EpiBf16R<0> E2{PP, PP, PP, 1024, 1024, 1024, 1 << 30, 1 << 30};
            run_gemm(cl, (const bf16*)(ws + WS_M + M_PB), (const bf16*)(ws + WS_WPLEP) + (size_t)layer * 1024 * 256, 1024, 256, E2); }
        SEAM(base + 7);
        STAMP(base + 8);
        if (EN(14) && IN(base + 8)) { LCTX(); phase_peer_topk(cl); }
        SEAM(base + 8);
        STAMP(base + 9);
        if (EN(15) && IN(base + 9)) { LCTX(); phase_peer_gather(cl, layer, [&]() {}); }
        SEAM(base + 9);
        STAMP(base + 11);
        if (EN(17) && IN(base + 11)) { LCTX(); EpiPle E{xin, (const bf16*)(ws + WS_PP), xnext, INP(cl, I_PLE_BG) + layer * DM, layer == 3 ? cl.out : nullptr};
            run_gemm(cl, xin, (const bf16*)(ws + WS_WPLEG) + (size_t)layer * 1024 * 1024, 1024, 1024, E); }
        SEAM(base + 11);
    }
#if MK_PROBE
    xcd_barrier(bar);
    STAMP(N_PHASES);
    xcd_barrier(bar);
    {
        const unsigned long long* TS = (const unsigned long long*)(p.ws + WS_CTL + 65536);
        float tA = 0.f, tC = 0.f;
        for (int k = 0; k < N_PHASES; ++k) {
            int type = 0;
            if (k > 0) { const int layer = (k - 1) / NPH_LAYER, s = (k - 1) % NPH_LAYER, kind = layer % 3;
                if (!slot_active(kind, s)) continue;
                type = s == 0 ? 1 + kind : s == 1 ? 4 + kind : s == 2 ? (kind == 0 ? 7 : 8) : s == 3 ? 9 : s == 4 ? 10 : 6 + s; }
            const float us = (float)(TS[k + 1] - TS[k]) * 0.01f;
            if ((MK_PROBE_A >> type) & 1u) tA += us;
            if ((MK_PROBE_C >> type) & 1u) tC += us;
        }
        for (size_t i = (size_t)blockIdx.x * NTHR + threadIdx.x; i < (size_t)T_TOK * DM; i += (size_t)gridDim.x * NTHR) p.out[i] = (i == 0) ? 100.f * tA : tC;
    }
#endif
#undef IN
#undef SEAM
#undef xin
#undef xnext
#undef LCTX
}

#if MK_CHECK
#include "CHECKS_PLACEHOLDER"
#endif

#define mk_fwd mk_fwd_t<0>
extern "C" void kernel_launch(void* const* d_in, const int* in_sizes, int n_in, void* d_out, int out_size, void* d_ws, size_t ws_size, hipStream_t stream) {
    static int grid = 0;
    if (grid == 0) {
        if (n_in != N_IN || out_size != T_TOK * DM || ws_size < WS_END) { fprintf(stderr, "kernel_launch: unexpected shapes (n_in %d out %d ws %zu need %zu)\n", n_in, out_size, ws_size, (size_t)WS_END); grid = -1; return; }
        int dev = 0, cus = 0, per_cu = 0;
        if (hipGetDevice(&dev) != hipSuccess || hipDeviceGetAttribute(&cus, hipDeviceAttributeMultiprocessorCount, dev) != hipSuccess) { grid = -1; return; }
        if (hipFuncSetAttribute((const void*)mk_fwd, hipFuncAttributeMaxDynamicSharedMemorySize, LDS_BYTES) != hipSuccess) { fprintf(stderr, "hipFuncSetAttribute failed\n"); grid = -1; return; }
        if (hipOccupancyMaxActiveBlocksPerMultiprocessor(&per_cu, (const void*)mk_fwd, NTHR, LDS_BYTES) != hipSuccess || per_cu < 1) { fprintf(stderr, "occupancy query: %d\n", per_cu); }
        (void)hipGetLastError();
        grid = cus;
    }
    if (grid < 0) return;
    (void)hipMemsetAsync((char*)d_ws + WS_CTL, 0, CTL_BYTES, stream);
    Params p{};
    for (int i = 0; i < N_IN; ++i) p.in[i] = (const float*)d_in[i];
    p.out = (float*)d_out; p.ws = (unsigned char*)d_ws; p.pad = 0;
#if MK_ONE_LAUNCH
#if MK_REPEAT_K >= 0
    p.ph_lo = 0; p.ph_hi = MK_REPEAT_K + 1; p.flags = 1 | MK_PROBE_FLAGS;
    (void)hipFuncSetAttribute((const void*)mk_fwd_t<MK_PROBE_KERNEL>, hipFuncAttributeMaxDynamicSharedMemorySize, LDS_BYTES);
    hipLaunchKernelGGL(mk_fwd_t<MK_PROBE_KERNEL>, dim3(grid), dim3(NTHR), LDS_BYTES, stream, p);
    (void)hipMemsetAsync((char*)d_ws + WS_CTL, 0, CTL_BYTES, stream);
#endif
    p.ph_lo = 0; p.ph_hi = N_PHASES; p.flags = 1;
    hipLaunchKernelGGL(mk_fwd, dim3(grid), dim3(NTHR), LDS_BYTES, stream, p);
#else
    p.flags = 0;
    for (int ph = 0; ph < N_PHASES; ++ph) {
        if (ph > 0) { const int layer = (ph - 1) / NPH_LAYER, s = (ph - 1) % NPH_LAYER; if (!slot_active(layer % 3, s)) continue; }
        p.ph_lo = ph; p.ph_hi = ph + 1;
#if MK_CHECK
        check_pre(ph, p, grid, stream);
#endif
        hipLaunchKernelGGL(mk_fwd, dim3(grid), dim3(NTHR), LDS_BYTES, stream, p);
#if MK_CHECK
        check_post(ph, p, grid, stream);
#endif
    }
#if MK_CHECK
    check_report(p, stream);
#endif
#endif
}
```

```cpp
#define MK_CHECK 0
#define MK_ONE_LAUNCH 1
#include <cstdio>
#include <cmath>
#include <type_traits>
#include <hip/hip_runtime.h>
namespace pg8 {
#define PG8_LAS __attribute__((address_space(3)))
typedef unsigned short bf16_t;
typedef short bf16x8 __attribute__((ext_vector_type(8)));
typedef float f32x4 __attribute__((ext_vector_type(4)));
typedef unsigned u32x4 __attribute__((ext_vector_type(4)));
constexpr int BM = 256, BK = 64, HALF = 128, HTB = HALF * BK * 2  , STAGE_BYTES = 8 * HTB, NXCD = 8, WGM = 8;

__host__ __device__ __forceinline__ int lds_byte(int r, int c) { const int st = (r >> 4) * 2 + (c >> 5), rr = r & 15, cc = c & 31, ob = rr * 64 + cc * 2; return st * 1024 + (ob ^ (((ob >> 9) & 1) << 5)); }
__host__ __device__ __forceinline__ void stage_rc(int b, int& R, int& C) { const int st = b / 1024, sb = b % 1024, swz = sb ^ (((sb >> 9) & 1) << 5); R = (st >> 1) * 16 + swz / 64; C = (st & 1) * 32 + (swz % 64) / 2; }
__host__ __device__ __forceinline__ int perm32(int rho) { const int n = rho >> 4, i = rho & 15; return 8 * (i >> 2) + 4 * n + (i & 3); }

struct Unit { int pm, pn; };
struct Gemm { const bf16_t* A; const bf16_t* Bt; int M, N, K; };

struct StaticOrder {
    int nM, nN, nwg, G, c;
    __host__ __device__ void init(int M, int N, int G_, int c_) { nM = M / BM; nN = N / BM; nwg = nM * nN; G = G_; c = c_; }
    __host__ __device__ bool next(int i, Unit& u) const {
        const long L = (long)i * G + c; if (L >= nwg) return false;
        int wgid = (int)L; { const int q = nwg / NXCD, r = nwg % NXCD, xcd = wgid % NXCD, off = wgid / NXCD; wgid = (xcd < r ? xcd * (q + 1) : r * (q + 1) + (xcd - r) * q) + off; }
        const int nig = WGM * nN, gid = wgid / nig, fm = gid * WGM, gsz = (nM - fm) < WGM ? (nM - fm) : WGM;
        u.pm = fm + ((wgid % nig) % gsz); u.pn = (wgid % nig) / gsz; return true;
    }
    __device__ __forceinline__ void a_ready(const Unit&) const {}
    __device__ __forceinline__ void done(const Unit&) const {}
};
struct CountedOrder : StaticOrder {
    const unsigned* ready; unsigned need; unsigned* tmo;
    __device__ __forceinline__ void a_ready(const Unit& u) const {
        if (threadIdx.x < 64) {
            const unsigned long long t0 = __builtin_amdgcn_s_memrealtime(); unsigned polls = 0;
            while ((unsigned)__builtin_amdgcn_readfirstlane(__hip_atomic_load(ready + 64 * u.pm, __ATOMIC_RELAXED, __HIP_MEMORY_SCOPE_AGENT)) < need) {
                if ((++polls & 255u) == 0u && __builtin_amdgcn_readfirstlane(__hip_atomic_load(tmo, __ATOMIC_RELAXED, __HIP_MEMORY_SCOPE_AGENT)) != 0u) break;
                if (__builtin_amdgcn_s_memrealtime() - t0 > 2000000ull) {
                    if (threadIdx.x == 0) { unsigned expect = 0u; __hip_atomic_compare_exchange_strong(tmo + 1, &expect, 0x600u | (unsigned)(u.pm & 0xff), __ATOMIC_RELAXED, __ATOMIC_RELAXED, __HIP_MEMORY_SCOPE_AGENT); __hip_atomic_store(tmo, 1u, __ATOMIC_RELAXED, __HIP_MEMORY_SCOPE_AGENT); }
                    break; }
                __builtin_amdgcn_s_sleep(2); }
            __builtin_amdgcn_fence(__ATOMIC_ACQUIRE, "agent");
            asm volatile("s_waitcnt vmcnt(0)" ::: "memory");
        }
#if !defined(BROKEN_HOOK_NO_BARRIER)
        asm volatile("" ::: "memory"); __builtin_amdgcn_s_barrier(); asm volatile("" ::: "memory");
#endif
    }
};

__device__ __forceinline__ unsigned cvt_pk_bf16(float lo, float hi) { unsigned r; asm volatile("v_cvt_pk_bf16_f32 %0, %1, %2" : "=v"(r) : "v"(lo), "v"(hi)); return r; }
typedef float f32x2 __attribute__((ext_vector_type(2)));
__device__ __forceinline__ f32x2 gelu_pk(f32x2 v) {
    const f32x2 av = __builtin_elementwise_abs(v), d = av * 0.2316418882f + 1.0f;
    f32x2 t; t.x = __builtin_amdgcn_rcpf(d.x); t.y = __builtin_amdgcn_rcpf(d.y);
    f32x2 q = t * 0.5307027145f + (-0.7265760135f); q = q * t + 0.7107068705f; q = q * t + (-0.142248368f); q = q * t + 0.127414796f; q = q * t;
    const f32x2 s = (v * v) * (-0.72134752044f);
    f32x2 e; e.x = __builtin_amdgcn_exp2f(s.x); e.y = __builtin_amdgcn_exp2f(s.y);
    const f32x2 m = v * (q * e), r = v - m;
    f32x2 o; o.x = v.x < 0.f ? m.x : r.x; o.y = v.y < 0.f ? m.y : r.y; return o;
}

struct EpiF32 {
    static constexpr bool PERM = false, AFTER_DRAIN = false;
    float* C; int ldc; const float* bias;
    __device__ __forceinline__ void operator()(const f32x4 (&acc)[2][2][4][2], const Unit& u, int wr, int wc, int fr, int fq) const {
        const int row0 = u.pm * BM + wr * 64 + fr, col0 = u.pn * BM + wc * 32 + 4 * fq;
        f32x4 bv[2][2];
#pragma unroll
        for (int bj = 0; bj < 2; ++bj)
#pragma unroll
            for (int n = 0; n < 2; ++n) bv[bj][n] = bias ? *(const f32x4*)(bias + col0 + bj * HALF + n * 16) : (f32x4){0.f, 0.f, 0.f, 0.f};
#pragma unroll
        for (int ai = 0; ai < 2; ++ai)
#pragma unroll
            for (int m = 0; m < 4; ++m) { float* rowp = C + (size_t)(row0 + ai * HALF + m * 16) * ldc + col0;
#pragma unroll
                for (int bj = 0; bj < 2; ++bj)
#pragma unroll
                    for (int n = 0; n < 2; ++n) *(f32x4*)(rowp + bj * HALF + n * 16) = acc[ai][bj][m][n] + bv[bj][n]; }
    }
};
template <int ACT  > struct EpiBf16 {
    static constexpr bool PERM = true, AFTER_DRAIN = false;
    bf16_t* O; int ldc; const float* bias; int split_cols; size_t split_stride;
    __device__ __forceinline__ void operator()(const f32x4 (&acc)[2][2][4][2], const Unit& u, int wr, int wc, int fr, int fq) const {
        const int row0 = u.pm * BM + wr * 64 + fr; int colt = u.pn * BM; bf16_t* base = O;
        if (split_cols) { const int t = colt / split_cols; base += (size_t)t * split_stride; colt -= t * split_cols; }
        const int col0 = colt + wc * 32 + 8 * fq, bcol0 = u.pn * BM + wc * 32 + 8 * fq;
        f32x4 bv[2][2];
#pragma unroll
        for (int bj = 0; bj < 2; ++bj)
#pragma unroll
            for (int n = 0; n < 2; ++n) bv[bj][n] = bias ? *(const f32x4*)(bias + bcol0 + bj * HALF + 4 * n) : (f32x4){0.f, 0.f, 0.f, 0.f};
#pragma unroll
        for (int ai = 0; ai < 2; ++ai)
#pragma unroll
            for (int m = 0; m < 4; ++m) { bf16_t* rowp = base + (size_t)(row0 + ai * HALF + m * 16) * ldc + col0;
#pragma unroll
                for (int bj = 0; bj < 2; ++bj) { f32x4 v0 = acc[ai][bj][m][0] + bv[bj][0], v1 = acc[ai][bj][m][1] + bv[bj][1];
                    if (ACT == 1) { f32x2 a = gelu_pk((f32x2){v0[0], v0[1]}), b = gelu_pk((f32x2){v0[2], v0[3]}), c = gelu_pk((f32x2){v1[0], v1[1]}), d = gelu_pk((f32x2){v1[2], v1[3]});
                        v0 = (f32x4){a.x, a.y, b.x, b.y}; v1 = (f32x4){c.x, c.y, d.x, d.y}; }
                    if (ACT == 2) {
#pragma unroll
                        for (int j = 0; j < 4; ++j) { v0[j] = 0.5f * v0[j] * (1.0f + erff(v0[j] * 0.70710678f)); v1[j] = 0.5f * v1[j] * (1.0f + erff(v1[j] * 0.70710678f)); } }
                    u32x4 w; w.x = cvt_pk_bf16(v0[0], v0[1]); w.y = cvt_pk_bf16(v0[2], v0[3]); w.z = cvt_pk_bf16(v1[0], v1[1]); w.w = cvt_pk_bf16(v1[2], v1[3]);
                    *(u32x4*)(rowp + bj * HALF) = w; } }
    }
};

struct PanelStats {
    unsigned* xbuf;
    unsigned* cnt;
    unsigned* tmo;
    int ntn; float eps;
    unsigned code;
    __device__ __forceinline__ bool run(const f32x4 (&v)[2][2][4][2], const Unit& u, int wr, int wc, int fr, int fq, PG8_LAS unsigned char* lds, int wid, int lane) const {
        typedef float f32x2v __attribute__((ext_vector_type(2)));
        PG8_LAS f32x2v* P = (PG8_LAS f32x2v*)lds;
        PG8_LAS f32x2v* S = (PG8_LAS f32x2v*)(lds + 8192);
        PG8_LAS unsigned* flag = (PG8_LAS unsigned*)(lds + 8192 + 2048);
#pragma unroll
        for (int ai = 0; ai < 2; ++ai)
#pragma unroll
            for (int m = 0; m < 4; ++m) {
                float s = 0.f;
#pragma unroll
                for (int bj = 0; bj < 2; ++bj)
#pragma unroll
                    for (int n = 0; n < 2; ++n) { const f32x4 x = v[ai][bj][m][n]; s += (x[0] + x[1]) + (x[2] + x[3]); }
                s += __shfl_xor(s, 16); s += __shfl_xor(s, 32);
                const float mw = s * (1.0f / 64.0f); float q = 0.f;
#pragma unroll
                for (int bj = 0; bj < 2; ++bj)
#pragma unroll
                    for (int n = 0; n < 2; ++n) { const f32x4 d = v[ai][bj][m][n] - mw; q += (d[0] * d[0] + d[1] * d[1]) + (d[2] * d[2] + d[3] * d[3]); }
                q += __shfl_xor(q, 16); q += __shfl_xor(q, 32);
                if (fq == 0) P[(ai * HALF + wr * 64 + m * 16 + fr) * 4 + wc] = (f32x2v){mw, q};
            }
        asm volatile("s_waitcnt lgkmcnt(0)" ::: "memory"); __builtin_amdgcn_s_barrier(); asm volatile("" ::: "memory");
#if defined(BROKEN_NO_WAIT)
        if (blockIdx.x >= 64) { const long long t0 = clock64(); while (clock64() - t0 < 60000) __builtin_amdgcn_s_sleep(8); }
#endif
        const int row = wid * 32 + (lane & 31);
        if (lane < 32) {
            const f32x2v a = P[row * 4 + 0], b = P[row * 4 + 1], c = P[row * 4 + 2], d = P[row * 4 + 3];
            const float mt = (a.x + b.x + c.x + d.x) * 0.25f;
            const float da = a.x - mt, db = b.x - mt, dc = c.x - mt, dd = d.x - mt;
            const float m2 = (a.y + b.y) + (c.y + d.y) + 64.0f * ((da * da + db * db) + (dc * dc + dd * dd));
            unsigned long long* slot = (unsigned long long*)xbuf + ((size_t)(u.pm * BM + row) * 4 + u.pn);
            __hip_atomic_store(slot, ((unsigned long long)__float_as_uint(m2) << 32) | __float_as_uint(mt), __ATOMIC_RELAXED, __HIP_MEMORY_SCOPE_AGENT);
        }
        asm volatile("s_waitcnt vmcnt(0)" ::: "memory");
        if (lane == 0) __hip_atomic_fetch_add(cnt + 64 * u.pm, 1u, __ATOMIC_RELAXED, __HIP_MEMORY_SCOPE_AGENT);
        if (wid == 0) {
            bool dead = false; const unsigned long long t0 = __builtin_amdgcn_s_memrealtime(); const unsigned want = 8u * (unsigned)ntn;
            for (;;) {
#if defined(BROKEN_NO_WAIT)
                break;
#endif
                if ((unsigned)__builtin_amdgcn_readfirstlane(__hip_atomic_load(cnt + 64 * u.pm, __ATOMIC_RELAXED, __HIP_MEMORY_SCOPE_AGENT)) >= want) break;
                if (__builtin_amdgcn_s_memrealtime() - t0 > 2000000ull) {
                    if (lane == 0) { unsigned expect = 0u; __hip_atomic_compare_exchange_strong(tmo + 1, &expect, code | (unsigned)(u.pm & 0xff), __ATOMIC_RELAXED, __ATOMIC_RELAXED, __HIP_MEMORY_SCOPE_AGENT);
                                     __hip_atomic_store(tmo, 1u, __ATOMIC_RELAXED, __HIP_MEMORY_SCOPE_AGENT); }
                    dead = true; break; }
                __builtin_amdgcn_s_sleep(2);
            }
            __builtin_amdgcn_fence(__ATOMIC_ACQUIRE, "agent");
            if (lane == 0) flag[0] = dead ? 1u : 0u;
        }
        asm volatile("s_waitcnt vmcnt(0) lgkmcnt(0)" ::: "memory"); __builtin_amdgcn_s_barrier(); asm volatile("" ::: "memory");
        const bool bad = flag[0] != 0u;
        if (lane < 32) {
            const unsigned long long* slot = (const unsigned long long*)xbuf + (size_t)(u.pm * BM + row) * 4; float mt[4], m2[4]; float ms = 0.f;
#pragma unroll
            for (int t = 0; t < 4; ++t) { if (t < ntn) { const unsigned long long w = __hip_atomic_load(slot + t, __ATOMIC_RELAXED, __HIP_MEMORY_SCOPE_AGENT); mt[t] = __uint_as_float((unsigned)w); m2[t] = __uint_as_float((unsigned)(w >> 32)); } else { mt[t] = 0.f; m2[t] = 0.f; } ms += mt[t]; }
            const float mean = ms / (float)ntn; float q = 0.f;
#pragma unroll
            for (int t = 0; t < 4; ++t) if (t < ntn) { const float dm = mt[t] - mean; q += m2[t] + 256.0f * dm * dm; }
            S[row] = (f32x2v){mean, 1.0f / sqrtf(q / (256.0f * (float)ntn) + eps)};
        }
        asm volatile("s_waitcnt lgkmcnt(0)" ::: "memory"); __builtin_amdgcn_s_barrier(); asm volatile("" ::: "memory");
        return bad;
    }
};
struct EpiLnRes {
    static constexpr bool PERM = false, AFTER_DRAIN = true;
    const float* base; float* out; int ldc; const float* bias; PanelStats st; unsigned poison;
    __device__ __forceinline__ void refuse(size_t i0, size_t stride, int M, int N) const { const float q = __builtin_nanf(""); for (size_t i = i0; i < (size_t)M * N; i += stride) out[(i / N) * ldc + i % N] = q;
        if (i0 == 0) { unsigned expect = 0u; __hip_atomic_compare_exchange_strong(st.tmo + 1, &expect, 0x7f0u, __ATOMIC_RELAXED, __ATOMIC_RELAXED, __HIP_MEMORY_SCOPE_AGENT); __hip_atomic_store(st.tmo, 1u, __ATOMIC_RELAXED, __HIP_MEMORY_SCOPE_AGENT); } }
    __device__ __forceinline__ void fused(f32x4 (&acc)[2][2][4][2], const Unit& u, int wr, int wc, int fr, int fq, PG8_LAS unsigned char* lds, int wid, int lane) const {
        typedef float f32x2v __attribute__((ext_vector_type(2)));
        const PG8_LAS f32x2v* S = (const PG8_LAS f32x2v*)(lds + 8192);
        const int col0 = u.pn * BM + wc * 32 + 4 * fq;
#pragma unroll
        for (int bj = 0; bj < 2; ++bj)
#pragma unroll
            for (int n = 0; n < 2; ++n) { const f32x4 bv = bias ? *(const f32x4*)(bias + col0 + bj * HALF + n * 16) : (f32x4){0.f, 0.f, 0.f, 0.f};
#pragma unroll
                for (int ai = 0; ai < 2; ++ai)
#pragma unroll
                    for (int m = 0; m < 4; ++m) acc[ai][bj][m][n] += bv; }
        const bool bad = st.run(acc, u, wr, wc, fr, fq, lds, wid, lane) || poison != 0u;
        const float qnan = __builtin_nanf("");
#pragma unroll
        for (int ai = 0; ai < 2; ++ai)
#pragma unroll
            for (int m = 0; m < 4; ++m) { const int r = ai * HALF + wr * 64 + m * 16 + fr; const f32x2v sr = S[r]; const size_t off = (size_t)(u.pm * BM + r) * ldc + col0;
#pragma unroll
                for (int bj = 0; bj < 2; ++bj)
#pragma unroll
                    for (int n = 0; n < 2; ++n) { const f32x4 bs = *(const f32x4*)(base + off + bj * HALF + n * 16); f32x4 o = bs + (acc[ai][bj][m][n] - sr.x) * sr.y;
                        if (bad) o = (f32x4){qnan, qnan, qnan, qnan}; *(f32x4*)(out + off + bj * HALF + n * 16) = o; }
                asm volatile("" ::: "memory"); }
    }
};
struct EpiLnResLn {
    static constexpr bool PERM = false, AFTER_DRAIN = true;
    const float* base; float* out; bf16_t* xn; int ldc; const float* bias; PanelStats st1, st2; unsigned poison;
    __device__ __forceinline__ void refuse(size_t i0, size_t stride, int M, int N) const { const float q = __builtin_nanf(""); for (size_t i = i0; i < (size_t)M * N; i += stride) { const size_t o = (i / N) * ldc + i % N; out[o] = q; xn[o] = (bf16_t)0x7fc0u; }
        if (i0 == 0) { unsigned expect = 0u; __hip_atomic_compare_exchange_strong(st1.tmo + 1, &expect, 0x7f0u, __ATOMIC_RELAXED, __ATOMIC_RELAXED, __HIP_MEMORY_SCOPE_AGENT); __hip_atomic_store(st1.tmo, 1u, __ATOMIC_RELAXED, __HIP_MEMORY_SCOPE_AGENT); } }
    __device__ __forceinline__ void fused(f32x4 (&acc)[2][2][4][2], const Unit& u, int wr, int wc, int fr, int fq, PG8_LAS unsigned char* lds, int wid, int lane) const {
        typedef float f32x2v __attribute__((ext_vector_type(2))); typedef unsigned u32x2v __attribute__((ext_vector_type(2)));
        const PG8_LAS f32x2v* S = (const PG8_LAS f32x2v*)(lds + 8192);
        const int col0 = u.pn * BM + wc * 32 + 4 * fq;
#pragma unroll
        for (int bj = 0; bj < 2; ++bj)
#pragma unroll
            for (int n = 0; n < 2; ++n) { const f32x4 bv = bias ? *(const f32x4*)(bias + col0 + bj * HALF + n * 16) : (f32x4){0.f, 0.f, 0.f, 0.f};
#pragma unroll
                for (int ai = 0; ai < 2; ++ai)
#pragma unroll
                    for (int m = 0; m < 4; ++m) acc[ai][bj][m][n] += bv; }
        bool bad = st1.run(acc, u, wr, wc, fr, fq, lds, wid, lane) || poison != 0u;
        const float qnan = __builtin_nanf("");
#pragma unroll
        for (int ai = 0; ai < 2; ++ai)
#pragma unroll
            for (int m = 0; m < 4; ++m) { const int r = ai * HALF + wr * 64 + m * 16 + fr; const f32x2v sr = S[r]; const size_t off = (size_t)(u.pm * BM + r) * ldc + col0;
#pragma unroll
                for (int bj = 0; bj < 2; ++bj)
#pragma unroll
                    for (int n = 0; n < 2; ++n) { const f32x4 bs = *(const f32x4*)(base + off + bj * HALF + n * 16); acc[ai][bj][m][n] = bs + (acc[ai][bj][m][n] - sr.x) * sr.y; }
                asm volatile("" : "+v"(acc[ai][0][m][0]), "+v"(acc[ai][0][m][1]), "+v"(acc[ai][1][m][0]), "+v"(acc[ai][1][m][1]));
                if (m & 1) asm volatile("" ::: "memory"); }
        const bool bad1 = bad;
        bad = st2.run(acc, u, wr, wc, fr, fq, lds, wid, lane) || bad;
#pragma unroll
        for (int ai = 0; ai < 2; ++ai)
#pragma unroll
            for (int m = 0; m < 4; ++m) { const int r = ai * HALF + wr * 64 + m * 16 + fr; const f32x2v sr = S[r]; const size_t off = (size_t)(u.pm * BM + r) * ldc + col0;
#pragma unroll
                for (int bj = 0; bj < 2; ++bj)
#pragma unroll
                    for (int n = 0; n < 2; ++n) { const f32x4 x1 = acc[ai][bj][m][n]; *(f32x4*)(out + off + bj * HALF + n * 16) = bad1 ? (f32x4){qnan, qnan, qnan, qnan} : x1;
                        const f32x4 o = (x1 - sr.x) * sr.y; u32x2v w; w.x = cvt_pk_bf16(o[0], o[1]); w.y = cvt_pk_bf16(o[2], o[3]);
                        if (bad) { w.x = 0x7fc07fc0u; w.y = 0x7fc07fc0u; } *(u32x2v*)(xn + off + bj * HALF + n * 16) = w; }
                asm volatile("" ::: "memory"); }
    }
};

template <class Epi, class Sched, bool STAMP = false>
__device__ __forceinline__ void gemm_phase(PG8_LAS unsigned char* lds, const Gemm g, const Sched& S, const Epi& E, unsigned long long* stamps) {
    int tid_l = threadIdx.x; asm volatile("" : "+v"(tid_l));
    const int tid = tid_l, wid = __builtin_amdgcn_readfirstlane(tid >> 6), lane = tid & 63, wr = wid >> 2, wc = wid & 3, fr = lane & 15, fq = lane >> 4;
    const int K = g.K, nt = K / BK;
    int ts_lo = 0, ts_hi = 0, nts = 0; const unsigned long long rt_entry = STAMP ? (unsigned long long)wall_clock64() : 0ull;
#define PG8_STAMP() do { if (STAMP && wid == 0 && nts < 64) { const unsigned long long _c = (unsigned long long)clock64(); \
        ts_lo = (lane == nts) ? (int)(unsigned)_c : ts_lo; ts_hi = (lane == nts) ? (int)(unsigned)(_c >> 32) : ts_hi; ++nts; } } while (0)
    PG8_STAMP();
    unsigned voffA[2], voffB[2];
#pragma unroll
    for (int i = 0; i < 2; ++i) { int R, C; stage_rc(tid * 16 + i * 8192, R, C); const int Rb = Epi::PERM ? ((R & ~31) + perm32(R & 31)) : R;
        voffA[i] = (unsigned)(R * K + C) * 2u; voffB[i] = (unsigned)(Rb * K + C) * 2u; }
    const size_t kstep = (size_t)(BK * 2);
    const size_t hstep = (size_t)HALF * K * 2;
    const size_t tstep = 2 * hstep;
    const unsigned ldsw = (unsigned)wid * 1024u;
    const int aoff = lds_byte(wr * 64 + fr, fq * 8), boff = lds_byte(wc * 32 + fr, fq * 8);
#define PG8_SA(b, h) (((b) * 2 + (h)) * HTB)
#define PG8_SB(b, h) ((4 + (b) * 2 + (h)) * HTB)
#define PG8_STAGE(bufoff, gbase, voff) do { _Pragma("unroll") for (int _i = 0; _i < 2; ++_i) \
        __builtin_amdgcn_global_load_lds((const unsigned*)((const char*)(gbase) + (voff)[_i]), (PG8_LAS unsigned*)(lds + (bufoff) + ldsw + _i * 8192), 16, 0, 0); } while (0)
#define PG8_LDA(dst, b, h) do { _Pragma("unroll") for (int m = 0; m < 4; ++m) _Pragma("unroll") for (int k = 0; k < 2; ++k) dst[m][k] = *(const PG8_LAS bf16x8*)(lds + PG8_SA(b, h) + aoff + m * 2048 + k * 1024); } while (0)
#define PG8_LDB(dst, b, h) do { _Pragma("unroll") for (int n = 0; n < 2; ++n) _Pragma("unroll") for (int k = 0; k < 2; ++k) dst[n][k] = *(const PG8_LAS bf16x8*)(lds + PG8_SB(b, h) + boff + n * 2048 + k * 1024); } while (0)
#define PG8_MMA(ai, bj, At, Bt) do { __builtin_amdgcn_s_setprio(1); _Pragma("unroll") for (int m = 0; m < 4; ++m) _Pragma("unroll") for (int n = 0; n < 2; ++n) _Pragma("unroll") for (int k = 0; k < 2; ++k) \
        acc[ai][bj][m][n] = __builtin_amdgcn_mfma_f32_16x16x32_bf16(Bt[n][k], At[m][k], acc[ai][bj][m][n], 0, 0, 0); __builtin_amdgcn_s_setprio(0); } while (0)
#define PG8_WAIT_V(n) asm volatile("s_waitcnt vmcnt(" #n ")" ::: "memory")
#define PG8_WAIT_L(n) asm volatile("s_waitcnt lgkmcnt(" #n ")" ::: "memory")
#define PG8_BAR __builtin_amdgcn_s_barrier()
#define PG8_SCHED __builtin_amdgcn_sched_barrier(0)
    Unit cur, nxt; int ui = 0;
    if (!S.next(0, cur)) return;
    f32x4 acc[2][2][4][2];
#pragma unroll
    for (int a = 0; a < 2; ++a)
#pragma unroll
        for (int b = 0; b < 2; ++b)
#pragma unroll
            for (int m = 0; m < 4; ++m)
#pragma unroll
                for (int n = 0; n < 2; ++n) acc[a][b][m][n] = (f32x4){0.f, 0.f, 0.f, 0.f};
    bf16x8 At[4][2], B0[2][2], B1[2][2];
    const char* cA = (const char*)g.A + (size_t)cur.pm * tstep; const char* cB = (const char*)g.Bt + (size_t)cur.pn * tstep;
    S.a_ready(cur);
    PG8_STAGE(PG8_SB(0, 0), cB, voffB); PG8_STAGE(PG8_SA(0, 0), cA, voffA); PG8_STAGE(PG8_SB(0, 1), cB + hstep, voffB); PG8_STAGE(PG8_SA(0, 1), cA + hstep, voffA);
    if (wr == 1) PG8_BAR;
    PG8_WAIT_V(4); PG8_BAR;
    PG8_STAGE(PG8_SB(1, 0), cB + kstep, voffB); PG8_STAGE(PG8_SA(1, 0), cA + kstep, voffA); PG8_STAGE(PG8_SB(1, 1), cB + hstep + kstep, voffB);
    PG8_WAIT_V(6); PG8_BAR;
    PG8_STAMP();
    for (;;) {
        const bool has_next = S.next(ui + 1, nxt);
        const char* nA = has_next ? (const char*)g.A + (size_t)nxt.pm * tstep : cA; const char* nB = has_next ? (const char*)g.Bt + (size_t)nxt.pn * tstep : cB;
        for (int t = 0; t < nt; t += 2) {
            const bool last = (t == nt - 2);
            const char* a1 = cA + (size_t)(t + 1) * kstep;
            const char* a2 = last ? nA : cA + (size_t)(t + 2) * kstep; const char* b2 = last ? nB : cB + (size_t)(t + 2) * kstep;
            const char* a3 = a2 + kstep; const char* b3 = b2 + kstep;
            if (last && has_next) S.a_ready(nxt);
            PG8_LDB(B0, 0, 0); PG8_SCHED; PG8_LDA(At, 0, 0); PG8_STAGE(PG8_SA(1, 1), a1 + hstep, voffA);
            PG8_WAIT_L(8); PG8_BAR; PG8_WAIT_L(0); PG8_MMA(0, 0, At, B0); PG8_BAR; PG8_SCHED;
            PG8_LDB(B1, 0, 1); PG8_STAGE(PG8_SB(0, 0), b2, voffB);
            PG8_BAR; PG8_WAIT_L(0); PG8_MMA(0, 1, At, B1); PG8_BAR;
            PG8_LDA(At, 0, 1); PG8_STAGE(PG8_SA(0, 0), a2, voffA);
            PG8_BAR; PG8_WAIT_L(0); PG8_MMA(1, 0, At, B0); PG8_BAR; PG8_SCHED;
            PG8_STAGE(PG8_SB(0, 1), b2 + hstep, voffB);
            PG8_WAIT_V(6); PG8_BAR; PG8_MMA(1, 1, At, B1); PG8_BAR;
            PG8_LDB(B0, 1, 0); PG8_SCHED; PG8_LDA(At, 1, 0); PG8_STAGE(PG8_SA(0, 1), a2 + hstep, voffA);
            PG8_WAIT_L(8); PG8_BAR; PG8_WAIT_L(0); PG8_MMA(0, 0, At, B0); PG8_BAR; PG8_SCHED;
            PG8_LDB(B1, 1, 1); PG8_STAGE(PG8_SB(1, 0), b3, voffB);
            PG8_BAR; PG8_WAIT_L(0); PG8_MMA(0, 1, At, B1); PG8_BAR;
            PG8_LDA(At, 1, 1); PG8_STAGE(PG8_SA(1, 0), a3, voffA);
            PG8_BAR; PG8_WAIT_L(0); PG8_MMA(1, 0, At, B0); PG8_BAR; PG8_SCHED;
            PG8_STAGE(PG8_SB(1, 1), b3 + hstep, voffB);
            PG8_WAIT_V(6); PG8_BAR; PG8_MMA(1, 1, At, B1); PG8_BAR;
        }
        PG8_STAMP();
        if constexpr (!Epi::AFTER_DRAIN) { E(acc, cur, wr, wc, fr, fq); S.done(cur); }
        PG8_STAMP();
        if (!has_next) break;
#pragma unroll
        for (int a = 0; a < 2; ++a)
#pragma unroll
            for (int b = 0; b < 2; ++b)
#pragma unroll
                for (int m = 0; m < 4; ++m)
#pragma unroll
                    for (int n = 0; n < 2; ++n) acc[a][b][m][n] = (f32x4){0.f, 0.f, 0.f, 0.f};
        cur = nxt; cA = nA; cB = nB; ++ui;
    }
    PG8_WAIT_V(0);
    if (wr == 0) PG8_BAR;
    PG8_BAR;
    if constexpr (Epi::AFTER_DRAIN) { E.fused(acc, cur, wr, wc, fr, fq, lds, wid, lane); S.done(cur); }
    PG8_STAMP();
    if (STAMP && wid == 0) { stamps[lane] = lane < nts ? (((unsigned long long)(unsigned)ts_hi << 32) | (unsigned)ts_lo) : 0ull;
        if (lane == 62) stamps[62] = rt_entry; if (lane == 63) stamps[63] = (unsigned long long)wall_clock64(); }
#undef PG8_STAMP
#undef PG8_SA
#undef PG8_SB
#undef PG8_STAGE
#undef PG8_LDA
#undef PG8_LDB
#undef PG8_MMA
#undef PG8_WAIT_V
#undef PG8_WAIT_L
#undef PG8_BAR
#undef PG8_SCHED
}
}

#define GAS __attribute__((address_space(1)))
#define LAS __attribute__((address_space(3)))
typedef unsigned short bf16;
typedef unsigned v4u __attribute__((ext_vector_type(4)));
typedef unsigned v2u __attribute__((ext_vector_type(2)));
typedef float f32x4 __attribute__((ext_vector_type(4)));
typedef float f32x2 __attribute__((ext_vector_type(2)));
typedef float f32x16 __attribute__((ext_vector_type(16)));
typedef short bf16x8 __attribute__((ext_vector_type(8)));
typedef short bf16x4 __attribute__((ext_vector_type(4)));

#ifndef MK_CHECK
#define MK_CHECK 0
#endif
#ifndef MK_ONE_LAUNCH
#define MK_ONE_LAUNCH 0
#endif
#ifndef MK_PROBE
#define MK_PROBE 0
#endif
#ifndef MK_DUP10
#define MK_DUP10 0
#endif
#ifndef MK_PROBE_KERNEL
#define MK_PROBE_KERNEL 0
#endif
#ifndef MK_PROBE_FLAGS
#define MK_PROBE_FLAGS 0
#endif
#ifndef MK_REPEAT_K
#define MK_REPEAT_K (-1)
#endif
#ifndef MK_PROBE_A
#define MK_PROBE_A 0u
#endif
#ifndef MK_PROBE_C
#define MK_PROBE_C 0u
#endif

constexpr int T_TOK = 65536, DM = 1024, SEQ = 2048, NBATCH = 32;
constexpr float ALPHA_DN = 1.6817928305074290f;
#ifndef PEER_U4
#define PEER_U4 1
#endif
#ifndef PEER_V4
#define PEER_V4 1
#endif
constexpr float PEER_USCALE = PEER_U4 ? 64.0f : 256.0f, PEER_VSCALE = PEER_V4 ? 12.8f : 32.0f;
constexpr int PEER_UROW = PEER_U4 ? 512 : 1024, PEER_VROW = PEER_V4 ? 512 : 1024;
constexpr int NWAVES = 8, NTHR = 512;
constexpr int NPH_LAYER = 12;
constexpr int N_PHASES = 1 + 4 * NPH_LAYER;

constexpr size_t MiB = 1u << 20;
constexpr size_t WS_CTL = 0, CTL_BYTES = 1 * MiB;
constexpr size_t WS_ROT = 1 * MiB;
constexpr size_t WS_WPEER = 4 * MiB;
constexpr size_t WS_WPLEG = 20 * MiB;
constexpr size_t WS_WPLEP = 28 * MiB;
constexpr size_t WS_WAIN = 30 * MiB;
constexpr size_t WS_WAQ = 32 * MiB;
constexpr size_t WAQ_STRIDE = 2560 * 256 * 2;
constexpr size_t WS_WAOV = 35 * MiB;
constexpr size_t WS_WBIN = 43 * MiB;
constexpr size_t WS_WBO = 48 * MiB;
constexpr size_t WS_WCIN = 51 * MiB;
constexpr size_t WS_WCO = 63 * MiB;
constexpr size_t WS_TABU = 68 * MiB, WS_TABV = 100 * MiB;
constexpr size_t WS_XB0 = 132 * MiB, WS_XB1 = 260 * MiB;
constexpr size_t WS_M = 388 * MiB;
constexpr size_t M_SC = 0, M_IDS = 512 * MiB, M_GATES = 544 * MiB, M_PB = 576 * MiB, M_PP = 0;
constexpr size_t M_RAW = 0, M_CQ = 128 * MiB, M_CKV = 160 * MiB, M_CKVT = 176 * MiB, M_KIDX = 192 * MiB, M_WIDX = 200 * MiB,
                 M_MASK = 202 * MiB, M_QLAT = 218 * MiB, M_QIDX = 474 * MiB;
constexpr size_t M_GU = 0, M_Y = 320 * MiB;
constexpr size_t M_Q = 0, M_K = 128 * MiB, M_V = 256 * MiB, M_STAT = 512 * MiB;
constexpr size_t WS_PP = WS_M + 608 * MiB;
constexpr size_t WS_END = WS_PP + 128 * MiB;
constexpr int CW_DIAG = 64;
constexpr int CW_BAR = 4096;

constexpr int RING_BYTES = 131072, LDS_BYTES = 147456, LDSCTL_OFF = LDS_BYTES - 512, MISC_OFF = LDSCTL_OFF + 320;

enum { I_X = 0, I_P, I_A_W_IN, I_A_CQ_GAIN, I_A_CKV_GAIN, I_A_W_UQ, I_A_W_UK, I_A_W_QIDX, I_A_KIDX_GAIN, I_A_KIDX_BIAS, I_A_W_UV, I_A_W_O,
       I_B_W_IN, I_B_CONV_W, I_B_CONV_B, I_B_W_A, I_B_B_A, I_B_W_X, I_B_B_X, I_B_LAMBDA, I_B_W_O, I_C_W_IN, I_C_W_O,
       I_LN1_G, I_LN1_B, I_PEER_WQ, I_PEER_SK, I_PEER_U, I_PEER_V, I_LN2_G, I_LN2_B, I_PLE_WP, I_PLE_WG, I_PLE_BG, N_IN };

struct Params { const float* in[N_IN]; float* out; unsigned char* ws; int ph_lo, ph_hi, flags, pad; };

typedef const float* const __attribute__((address_space(4)))* InTab;
struct Ctx {
    LAS unsigned char* lds;
    int tid, lane, wave, bid, G;
    InTab in; float* out; unsigned char* ws;
};
#define INP(cx, i) ((const float*)(const GAS float*)((cx).in[i]))

#define LDS_WAIT() asm volatile("s_waitcnt lgkmcnt(0)" ::: "memory")
#define VM_WAIT() asm volatile("s_waitcnt vmcnt(0)" ::: "memory")

typedef __bf16 bf16v2_t __attribute__((ext_vector_type(2)));
__device__ __forceinline__ unsigned pk2(float lo, float hi) { const f32x2 v = {lo, hi}; const bf16v2_t b = __builtin_convertvector(v, bf16v2_t); return __builtin_bit_cast(unsigned, b); }
__device__ __forceinline__ unsigned f2bf(float f) { return (unsigned)__builtin_bit_cast(unsigned short, (__bf16)f); }
__device__ __forceinline__ float bflo(unsigned w) { return __builtin_bit_cast(float, w << 16); }
__device__ __forceinline__ float bfhi(unsigned w) { return __builtin_bit_cast(float, w & 0xffff0000u); }
__device__ __forceinline__ float bf2f(bf16 b) { return __builtin_bit_cast(float, ((unsigned)b) << 16); }
template <int CTRL, int ROWMASK>
__device__ __forceinline__ float dpp_f(float v) { return __builtin_bit_cast(float, __builtin_amdgcn_update_dpp(0, __builtin_bit_cast(int, v), CTRL, ROWMASK, 0xf, false)); }
__device__ __forceinline__ float wave_sum_uniform(float v) {
    v += dpp_f<0xB1, 0xf>(v);
    v += dpp_f<0x4E, 0xf>(v);
    v += dpp_f<0x141, 0xf>(v);
    v += dpp_f<0x140, 0xf>(v);
    v += dpp_f<0x142, 0xa>(v);
    v += dpp_f<0x143, 0xc>(v);
    return __builtin_bit_cast(float, __builtin_amdgcn_readlane(__builtin_bit_cast(int, v), 63));
}
__device__ __forceinline__ float wave_sum(float v) { return wave_sum_uniform(v); }
__device__ __forceinline__ float gelu_tanh(float x) {
    const float u = 0.7978845608028654f * (x + 0.044715f * x * x * x);
    const float e = __expf(2.0f * u);
    const float th = 1.0f - 2.0f * __builtin_amdgcn_rcpf(e + 1.0f);
    return 0.5f * x * (1.0f + th);
}
__device__ __forceinline__ float sigmoidf_(float x) { return __builtin_amdgcn_rcpf(1.0f + __expf(-x)); }

#define XB_TMO      128
#define XB_XCNT(j)  (256  + 64 * (j))
#define XB_XSUB(j)  (1280 + 64 * (j))
#define XB_XGEN(j)  (2304 + 64 * (j))
#define XB_TOP      3328
#define XB_TOPGEN   3392
#define XCD_BAR_WORDS 3456
#define XB_SPIN_CAP (1u << 25)
__device__ __forceinline__ unsigned xb_ld(unsigned* p)              { return __hip_atomic_load(p, __ATOMIC_RELAXED, __HIP_MEMORY_SCOPE_AGENT); }
__device__ __forceinline__ unsigned xb_add(unsigned* p, unsigned v) { return __hip_atomic_fetch_add(p, v, __ATOMIC_RELAXED, __HIP_MEMORY_SCOPE_AGENT); }
__device__ __forceinline__ unsigned xb_xcc_id() { return (unsigned)__builtin_amdgcn_s_getreg((3 << 11) | 20) & 0xFu; }
#define XB_SPIN(cond, bar) do { unsigned _sp = 0; while (cond) { __builtin_amdgcn_s_sleep(1); \
    if ((++_sp & 255u) == 0u) { if (xb_ld(&(bar)[XB_TMO])) break; if (_sp > XB_SPIN_CAP) { atomicAdd(&(bar)[XB_TMO], 1u); break; } } } } while (0)
struct XcdBarrier { unsigned* bar; unsigned x; volatile LAS unsigned* st; };
__device__ __forceinline__ XcdBarrier xcd_barrier_post(unsigned* bar, volatile LAS unsigned* st) {
    XcdBarrier b; b.bar = bar; b.x = xb_xcc_id(); b.st = st;
    if (threadIdx.x == 0) (void)xb_add(&bar[XB_XCNT(b.x)], 1u);
    return b;
}
__device__ __forceinline__ void xcd_barrier_complete(unsigned* bar, unsigned x, unsigned& nloc, unsigned& nx) {
    const unsigned G = gridDim.x * gridDim.y * gridDim.z;
    unsigned sum, cnt, mine, sp = 0u;
    for (;;) {
        sum = 0u; cnt = 0u; mine = 0u;
#pragma unroll
        for (unsigned j = 0; j < 16; ++j) { const unsigned c = xb_ld(&bar[XB_XCNT(j)]); sum += c; cnt += (c > 0u) ? 1u : 0u; mine = (j == x) ? c : mine; }
        if (sum == G) break;
        __builtin_amdgcn_s_sleep(1);
        if ((++sp & 255u) == 0u) { if (xb_ld(&bar[XB_TMO])) break; if (sp > XB_SPIN_CAP) { atomicAdd(&bar[XB_TMO], 1u); break; } }
    }
    nloc = mine > 0u ? mine : 1u; nx = cnt > 0u ? cnt : 1u;
}
__device__ __forceinline__ void xcd_barrier(const XcdBarrier& b) {
    asm volatile("s_waitcnt vmcnt(0)" ::: "memory");
    __syncthreads();
    if (threadIdx.x == 0) {
        unsigned* bar = b.bar;
        __builtin_amdgcn_s_waitcnt(0);
        unsigned nloc = b.st[0], nx = b.st[1];
        if (nloc == 0u) { xcd_barrier_complete(bar, b.x, nloc, nx); b.st[0] = nloc; b.st[1] = nx; }
        const unsigned old = xb_add(&bar[XB_XSUB(b.x)], 1u);
        const unsigned gen = old / nloc;
        if (old + 1u == (gen + 1u) * nloc) {
            __builtin_amdgcn_fence(__ATOMIC_RELEASE, "agent");
            asm volatile("s_waitcnt vmcnt(0)" ::: "memory");
            const unsigned og = xb_add(&bar[XB_TOP], 1u);
            const unsigned tg = og / nx;
            if (og + 1u == (tg + 1u) * nx) xb_add(&bar[XB_TOPGEN], 1u);
            else XB_SPIN(xb_ld(&bar[XB_TOPGEN]) == tg, bar);
            __builtin_amdgcn_fence(__ATOMIC_ACQUIRE, "agent");
            xb_add(&bar[XB_XGEN(b.x)], 1u);
            asm volatile("s_waitcnt vmcnt(0)" ::: "memory");
        } else {
            XB_SPIN(xb_ld(&bar[XB_XGEN(b.x)]) == gen, bar);
            __builtin_amdgcn_fence(__ATOMIC_ACQUIRE, "agent");
            asm volatile("s_waitcnt vmcnt(0)" ::: "memory");
        }
    }
    __syncthreads();
}

__device__ __forceinline__ void p0_transpose_item(const float* W, int K, int N, bf16* WT, int row_off, float scale, LAS float* scr, int item, int lane) {
    const int nblk = N / 32, kb = item / nblk, nb = item % nblk, k0 = 64 * kb, n0 = 32 * nb;
#pragma unroll 8
    for (int i = 0; i < 32; ++i) { const int kk = 2 * i + (lane >> 5); scr[kk * 33 + (lane & 31)] = W[(size_t)(k0 + kk) * N + n0 + (lane & 31)] * scale; }
    LDS_WAIT(); asm volatile("" ::: "memory");
    const int c = lane & 7;
#pragma unroll
    for (int j = 0; j < 4; ++j) { const int n = (lane >> 3) + 8 * j; const LAS float* s = scr + (8 * c) * 33 + n;
        v4u o; o.x = pk2(s[0 * 33], s[1 * 33]); o.y = pk2(s[2 * 33], s[3 * 33]); o.z = pk2(s[4 * 33], s[5 * 33]); o.w = pk2(s[6 * 33], s[7 * 33]);
        *(v4u*)(WT + (size_t)(row_off + n0 + n) * K + k0 + 8 * c) = o; }
    LDS_WAIT(); asm volatile("" ::: "memory");
}

__device__ __forceinline__ void small_gemm_tile(const Ctx& c, const float* A, long sa_n, long sa_d, const float* Bm, long sb_k, long sb_d, int Kd,
                                                bf16* C, int ldc, int n0, int k0, float scale) {
    LAS float* As = (LAS float*)c.lds; LAS float* Bs = As + 128 * 68;
    __syncthreads();
    for (int e = c.tid; e < 64 * Kd; e += NTHR) {
        int r, d;
        if (sa_d == 1) { d = e % Kd; r = e / Kd; } else { r = e & 63; d = e >> 6; }
        As[d * 68 + r] = A[(long)(n0 + r) * sa_n + (long)d * sa_d];
    }
    for (int e = c.tid; e < 64 * Kd; e += NTHR) {
        int r, d;
        if (sb_d == 1) { d = e % Kd; r = e / Kd; } else { r = e & 63; d = e >> 6; }
        Bs[d * 68 + r] = Bm[(long)(k0 + r) * sb_k + (long)d * sb_d];
    }
    __syncthreads();
    {
        const int tn = (c.tid >> 5) * 4, tk = (c.tid & 31) * 2;
        float acc[4][2];
#pragma unroll
        for (int i = 0; i < 4; ++i) { acc[i][0] = 0.f; acc[i][1] = 0.f; }
        for (int d = 0; d < Kd; ++d) {
            const f32x4 a = *(const LAS f32x4*)(As + d * 68 + tn); const f32x2 b = *(const LAS f32x2*)(Bs + d * 68 + tk);
#pragma unroll
            for (int i = 0; i < 4; ++i) { acc[i][0] += a[i] * b[0]; acc[i][1] += a[i] * b[1]; }
        }
#pragma unroll
        for (int i = 0; i < 4; ++i) *(unsigned*)(C + (size_t)(n0 + tn + i) * ldc + k0 + tk) = pk2(acc[i][0] * scale, acc[i][1] * scale);
    }
}

__device__ __forceinline__ void ln_store_row(float (&v)[16], const float* gain, const float* bias, float* of, bf16* ob, int lane) {
    float s = 0.f;
#pragma unroll
    for (int j = 0; j < 16; ++j) s += v[j];
    const float mean = wave_sum(s) * (1.f / 1024.f);
    float s2 = 0.f;
#pragma unroll
    for (int j = 0; j < 16; ++j) { v[j] -= mean; s2 += v[j] * v[j]; }
    const float rstd = __builtin_amdgcn_rsqf(wave_sum(s2) * (1.f / 1024.f) + 1e-5f);
#pragma unroll
    for (int h = 0; h < 2; ++h) {
        const int col = h * 512 + 8 * lane;
        const f32x4 g0 = *(const f32x4*)(gain + col), g1 = *(const f32x4*)(gain + col + 4), b0 = *(const f32x4*)(bias + col), b1 = *(const f32x4*)(bias + col + 4);
        f32x4 o0, o1;
#pragma unroll
        for (int j = 0; j < 4; ++j) { o0[j] = v[h * 8 + j] * rstd * g0[j] + b0[j]; o1[j] = v[h * 8 + 4 + j] * rstd * g1[j] + b1[j]; }
        if (of) { *(f32x4*)(of + col) = o0; *(f32x4*)(of + col + 4) = o1; }
        v4u w; w.x = pk2(o0[0], o0[1]); w.y = pk2(o0[2], o0[3]); w.z = pk2(o1[0], o1[1]); w.w = pk2(o1[2], o1[3]);
        *(v4u*)(ob + col) = w;
    }
}
__device__ __forceinline__ void load_row16(const float* row, float (&v)[16], int lane) {
#pragma unroll
    for (int h = 0; h < 2; ++h) { const f32x4 a = *(const f32x4*)(row + h * 512 + 8 * lane), b = *(const f32x4*)(row + h * 512 + 8 * lane + 4);
#pragma unroll
        for (int j = 0; j < 4; ++j) { v[h * 8 + j] = a[j]; v[h * 8 + 4 + j] = b[j]; } }
}

__device__ __forceinline__ void load_row16_bf(const bf16* row, float (&v)[16], int lane) {
#pragma unroll
    for (int h = 0; h < 2; ++h) { const v4u w = *(const v4u*)(row + h * 512 + 8 * lane);
        v[h * 8 + 0] = bflo(w.x); v[h * 8 + 1] = bfhi(w.x); v[h * 8 + 2] = bflo(w.y); v[h * 8 + 3] = bfhi(w.y);
        v[h * 8 + 4] = bflo(w.z); v[h * 8 + 5] = bfhi(w.z); v[h * 8 + 6] = bflo(w.w); v[h * 8 + 7] = bfhi(w.w); }
}

__device__ __forceinline__ void load_row16c(const float* row, float (&v)[16], int lane) {
#pragma unroll
    for (int q = 0; q < 4; ++q) { const f32x4 a = *(const f32x4*)(row + 16 * lane + 4 * q);
#pragma unroll
        for (int j = 0; j < 4; ++j) v[4 * q + j] = a[j]; }
}
__device__ __forceinline__ void ln_store_row_c(float (&v)[16], const float* gain, const float* bias, float* of, bf16* ob, int lane) {
    float s = 0.f;
#pragma unroll
    for (int j = 0; j < 16; ++j) s += v[j];
    const float mean = wave_sum(s) * (1.f / 1024.f);
    float s2 = 0.f;
#pragma unroll
    for (int j = 0; j < 16; ++j) { v[j] -= mean; s2 += v[j] * v[j]; }
    const float rstd = __builtin_amdgcn_rsqf(wave_sum(s2) * (1.f / 1024.f) + 1e-5f);
    const int col = 16 * lane;
    float o[16];
#pragma unroll
    for (int q = 0; q < 4; ++q) { const f32x4 g = *(const f32x4*)(gain + col + 4 * q), b = *(const f32x4*)(bias + col + 4 * q); f32x4 r;
#pragma unroll
        for (int j = 0; j < 4; ++j) { r[j] = v[4 * q + j] * rstd * g[j] + b[j]; o[4 * q + j] = r[j]; }
        *(f32x4*)(of + col + 4 * q) = r; }
    v4u w0, w1; w0.x = pk2(o[0], o[1]); w0.y = pk2(o[2], o[3]); w0.z = pk2(o[4], o[5]); w0.w = pk2(o[6], o[7]);
    w1.x = pk2(o[8], o[9]); w1.y = pk2(o[10], o[11]); w1.z = pk2(o[12], o[13]); w1.w = pk2(o[14], o[15]);
    *(v4u*)(ob + col) = w0; *(v4u*)(ob + col + 8) = w1;
}

__device__ __forceinline__ void phase_prologue(const Ctx& c) {
    unsigned char* ws = c.ws;
    LAS float* scr = (LAS float*)(c.lds + c.wave * 16384);
    const int gw = c.bid * NWAVES + c.wave, NGW = c.G * NWAVES;
    {
        struct TI { const float* W; int K, N; bf16* WT; int row_off; float scale; };
        int base = 0;
#define TR_ITEMS(Wp, Kv, Nv, WTp, roff, sc) do { const int ni = ((Kv) / 64) * ((Nv) / 32); \
            for (int it = gw; it < ni; it += NGW) p0_transpose_item((Wp), (Kv), (Nv), (WTp), (roff), (sc), scr, it, c.lane); base += ni; } while (0)
        for (int i = 0; i < 4; ++i) {
            TR_ITEMS(INP(c, I_PLE_WG) + (size_t)i * 1024 * 1024, 1024, 1024, (bf16*)(ws + WS_WPLEG) + (size_t)i * 1024 * 1024, 0, 1.0f);
            TR_ITEMS(INP(c, I_PLE_WP) + (size_t)i * 256 * 1024, 256, 1024, (bf16*)(ws + WS_WPLEP) + (size_t)i * 1024 * 256, 0, 1.0f);
        }
        for (int j = 0; j < 2; ++j)
            TR_ITEMS(INP(c, I_A_W_QIDX) + (size_t)j * 256 * 512, 256, 512, (bf16*)(ws + WS_WAQ + j * WAQ_STRIDE), 2048, 0.125f);
        TR_ITEMS(INP(c, I_B_W_IN), 1024, 2560, (bf16*)(ws + WS_WBIN), 0, 1.0f);
        TR_ITEMS(INP(c, I_B_W_O), 1280, 1024, (bf16*)(ws + WS_WBO), 0, 1.0f);
        TR_ITEMS(INP(c, I_C_W_IN), 1024, 6144, (bf16*)(ws + WS_WCIN), 0, 1.0f);
        TR_ITEMS(INP(c, I_C_W_O), 2048, 1024, (bf16*)(ws + WS_WCO), 0, 1.0f);
#undef TR_ITEMS
        (void)base;
    }
    for (int j = 0; j < 2; ++j) {
        const float* W = INP(c, I_A_W_IN) + (size_t)j * 1024 * 456; bf16* WT = (bf16*)(ws + WS_WAIN) + (size_t)j * 512 * 1024;
        for (int e = c.bid * NTHR + c.tid; e < 512 * 1024; e += c.G * NTHR) { const int n = e >> 10, k = e & 1023; WT[e] = (bf16)(n < 456 ? f2bf(W[(size_t)k * 456 + n]) : 0u); }
    }
    {
        float* ct = (float*)(ws + WS_ROT); float* st = ct + 2048 * 128;
        for (int e = c.bid * NTHR + c.tid; e < 2048 * 128; e += c.G * NTHR) {
            const int pos = e >> 7, f = e & 127;
            const float lin = (float)f * (1.0f / 127.0f);
            const float p = (float)pow(10000.0, (double)lin);
            const float invf = 1.0f / p;
            const float ang = (float)pos * invf;
            ct[e] = (float)cos((double)ang); st[e] = (float)sin((double)ang);
        }
    }
    for (int m = gw; m < T_TOK; m += NGW) {
        const float* xr = INP(c, I_X) + (size_t)m * DM; bf16* ob = (bf16*)(ws + WS_XB0) + (size_t)m * DM;
#pragma unroll
        for (int h = 0; h < 2; ++h) { const int col = h * 512 + 8 * c.lane; const f32x4 a = *(const f32x4*)(xr + col), b = *(const f32x4*)(xr + col + 4);
            v4u w; w.x = pk2(a[0], a[1]); w.y = pk2(a[2], a[3]); w.z = pk2(b[0], b[1]); w.w = pk2(b[2], b[3]); *(v4u*)(ob + col) = w; }
    }
    {
        int tbase = 0;
        {
            const int ntile = 4 * 16 * 2 * 16;
            for (int t = c.bid; t < ntile; t += c.G) {
                const int i = t / 512, r = t % 512, hp = r / 32, tt = r % 32, nt = tt / 16, kt = tt % 16;
                const float* A = INP(c, I_PEER_SK) + (size_t)i * 8 * 2 * 128 * 128 + (size_t)hp * 128 * 128;
                const float* Bm = INP(c, I_PEER_WQ) + (size_t)i * 1024 * 2048 + hp * 128;
                bf16* C = (bf16*)(ws + WS_WPEER) + (size_t)i * 2048 * 1024 + (size_t)hp * 128 * 1024;
                small_gemm_tile(c, A, 128, 1, Bm, 2048, 1, 128, C, 1024, nt * 64, kt * 64, 1.0f);
            }
            tbase += ntile;
        }
        {
            const int ntile = 2 * 16 * 2 * 4;
            for (int t = c.bid; t < ntile; t += c.G) {
                const int j = t / 128, r = t % 128, h = r / 8, tt = r % 8, nt = tt / 4, kt = tt % 4;
                const float* A = INP(c, I_A_W_UK) + (size_t)j * 16 * 64 * 128 + (size_t)h * 64 * 128;
                const float* Bm = INP(c, I_A_W_UQ) + (size_t)j * 256 * 1024 + h * 64;
                bf16* C = (bf16*)(ws + WS_WAQ + j * WAQ_STRIDE) + (size_t)h * 128 * 256;
                small_gemm_tile(c, A, 1, 128, Bm, 1024, 1, 64, C, 256, nt * 64, kt * 64, 0.125f * 1.4426950408889634f);
            }
        }
        {
            const int ntile = 2 * 16 * 16 * 2;
            for (int t = c.bid; t < ntile; t += c.G) {
                const int j = t / 512, r = t % 512, h = r / 32, tt = r % 32, nt = tt / 2, kt = tt % 2;
                const float* A = INP(c, I_A_W_O) + (size_t)j * 1024 * 1024 + (size_t)h * 64 * 1024;
                const float* Bm = INP(c, I_A_W_UV) + (size_t)j * 16 * 128 * 64 + (size_t)h * 128 * 64;
                bf16* C = (bf16*)(ws + WS_WAOV) + (size_t)j * 1024 * 2048 + h * 128;
                small_gemm_tile(c, A, 1, 1024, Bm, 64, 1, 64, C, 2048, nt * 64, kt * 64, 1.0f);
            }
        }
        (void)tbase;
    }
}

template <int FP4> __device__ __forceinline__ void peer_pack_row16(const float (&v)[16], unsigned char* dst) {
    if (FP4) { v2u w;
#pragma unroll
        for (int d = 0; d < 2; ++d) { unsigned p = 0u;
            p = __builtin_amdgcn_cvt_scalef32_pk_fp4_f32(p, v[8 * d + 0], v[8 * d + 1], 1.0f, 0); p = __builtin_amdgcn_cvt_scalef32_pk_fp4_f32(p, v[8 * d + 2], v[8 * d + 3], 1.0f, 1);
            p = __builtin_amdgcn_cvt_scalef32_pk_fp4_f32(p, v[8 * d + 4], v[8 * d + 5], 1.0f, 2); p = __builtin_amdgcn_cvt_scalef32_pk_fp4_f32(p, v[8 * d + 6], v[8 * d + 7], 1.0f, 3);
            w[d] = p; }
        *(v2u*)dst = w;
    } else { v4u w;
#pragma unroll
        for (int q = 0; q < 4; ++q) { int pa = 0; pa = __builtin_amdgcn_cvt_pk_fp8_f32(v[4 * q], v[4 * q + 1], pa, false); pa = __builtin_amdgcn_cvt_pk_fp8_f32(v[4 * q + 2], v[4 * q + 3], pa, true); w[q] = (unsigned)pa; }
        *(v4u*)dst = w;
    }
}

__device__ __forceinline__ void phase_ln1(const Ctx& c, int layer) {
    const int gw = c.bid * NWAVES + c.wave, NGW = c.G * NWAVES;
    const float* gain = INP(c, I_LN1_G) + layer * DM; const float* bias = INP(c, I_LN1_B) + layer * DM;
    bf16* xb = (bf16*)(c.ws + ((layer & 1) ? WS_XB1 : WS_XB0));
    for (int m = gw; m < T_TOK; m += NGW) {
        float v[16]; load_row16_bf(xb + (size_t)m * DM, v, c.lane);
        ln_store_row(v, gain, bias, nullptr, xb + (size_t)m * DM, c.lane);
    }
    {
        const float* U = INP(c, I_PEER_U) + (size_t)layer * 16384 * 1024; const float* V = INP(c, I_PEER_V) + (size_t)layer * 16384 * 1024;
        unsigned char* tu = c.ws + WS_TABU; unsigned char* tv = c.ws + WS_TABV;
        const size_t n16 = (size_t)16384 * 1024 / 16;
        for (size_t e = (size_t)c.bid * NTHR + c.tid; e < n16; e += (size_t)c.G * NTHR) {
            float ua[16], va[16];
#pragma unroll
            for (int q = 0; q < 4; ++q) { const f32x4 a4 = *(const f32x4*)(U + e * 16 + 4 * q) * PEER_USCALE, b4 = *(const f32x4*)(V + e * 16 + 4 * q) * PEER_VSCALE;
#pragma unroll
                for (int j = 0; j < 4; ++j) { ua[4 * q + j] = a4[j]; va[4 * q + j] = b4[j]; } }
            if (PEER_U4 && PEER_V4) {
                const size_t row = e >> 6, l16 = e & 63; peer_pack_row16<1>(ua, tu + row * 1024 + l16 * 8); peer_pack_row16<1>(va, tu + row * 1024 + 512 + l16 * 8);
            } else { peer_pack_row16<PEER_U4>(ua, tu + e * (PEER_UROW / 64)); peer_pack_row16<PEER_V4>(va, tv + e * (PEER_VROW / 64)); }
        }
    }
    {
        const float* P = INP(c, I_P) + (size_t)layer * T_TOK * 256; bf16* pb = (bf16*)(c.ws + WS_M + M_PB);
        const size_t n8 = (size_t)T_TOK * 256 / 8;
        for (size_t e = (size_t)c.bid * NTHR + c.tid; e < n8; e += (size_t)c.G * NTHR) {
            const f32x4 a = *(const f32x4*)(P + e * 8), b = *(const f32x4*)(P + e * 8 + 4);
            v4u w; w.x = pk2(a[0], a[1]); w.y = pk2(a[2], a[3]); w.z = pk2(b[0], b[1]); w.w = pk2(b[2], b[3]); *(v4u*)(pb + e * 8) = w;
        }
    }
}

using pg8::Unit;
constexpr int BMT = 256, HALFT = 128;

struct EpiResid {
    static constexpr bool PERM = false, AFTER_DRAIN = false;
    bf16* Y1; float alpha; const bf16* Xb;
    __device__ __forceinline__ void operator()(const pg8::f32x4 (&acc)[2][2][4][2], const Unit& u, int wr, int wc, int fr, int fq) const {
        const int row0 = u.pm * BMT + wr * 64 + fr, col0 = u.pn * BMT + wc * 32 + 4 * fq;
#pragma unroll
        for (int ai = 0; ai < 2; ++ai)
#pragma unroll
            for (int m = 0; m < 4; ++m) { const size_t roff = (size_t)(row0 + ai * HALFT + m * 16) * DM + col0; bf16* rowp = Y1 + roff; const bf16* srcp = Xb + roff;
                v2u xv[2][2];
#pragma unroll
                for (int bj = 0; bj < 2; ++bj)
#pragma unroll
                    for (int n = 0; n < 2; ++n) xv[bj][n] = *(const v2u*)(srcp + bj * HALFT + n * 16);
#pragma unroll
                for (int bj = 0; bj < 2; ++bj)
#pragma unroll
                    for (int n = 0; n < 2; ++n) { const pg8::f32x4 xf = {bflo(xv[bj][n].x), bfhi(xv[bj][n].x), bflo(xv[bj][n].y), bfhi(xv[bj][n].y)};
                        const pg8::f32x4 y = xf * alpha + acc[ai][bj][m][n];
                        v2u w; w.x = pk2(y[0], y[1]); w.y = pk2(y[2], y[3]); *(v2u*)(rowp + bj * HALFT + n * 16) = w; } }
    }
};

typedef short s16x2_t __attribute__((ext_vector_type(2)));
__device__ __forceinline__ unsigned sortable_bf16x2(unsigned w) { const s16x2_t m = __builtin_bit_cast(s16x2_t, w) >> 15; return w ^ (__builtin_bit_cast(unsigned, m) | 0x80008000u); }
struct EpiF32T {
    static constexpr bool PERM = true, AFTER_DRAIN = false;
    bf16* C;
    __device__ __forceinline__ void operator()(const pg8::f32x4 (&acc)[2][2][4][2], const Unit& u, int wr, int wc, int fr, int fq) const {
        const int row0 = u.pm * BMT + wr * 64 + fr, cg0 = (u.pn * BMT + wc * 32 + 8 * fq) >> 3;
#pragma unroll
        for (int ai = 0; ai < 2; ++ai)
#pragma unroll
            for (int m = 0; m < 4; ++m) { const int r = row0 + ai * HALFT + m * 16; bf16* bp = C + (((size_t)(r >> 6) * 256 + cg0) * 64 + (r & 63)) * 8;
#pragma unroll
                for (int bj = 0; bj < 2; ++bj) { const pg8::f32x4 v0 = acc[ai][bj][m][0], v1 = acc[ai][bj][m][1];
                    v4u w; w.x = sortable_bf16x2(pk2(v0[0], v0[1])); w.y = sortable_bf16x2(pk2(v0[2], v0[3])); w.z = sortable_bf16x2(pk2(v1[0], v1[1])); w.w = sortable_bf16x2(pk2(v1[2], v1[3]));
                    *(v4u*)(bp + (size_t)(bj * 16) * 512) = w; } }
    }
};

template <int ACT0  > struct EpiBf16R {
    static constexpr bool PERM = true, AFTER_DRAIN = false;
    bf16 *O0, *O1, *O2; int ld0, ld1, ld2, c1, c2;
    __device__ __forceinline__ void operator()(const pg8::f32x4 (&acc)[2][2][4][2], const Unit& u, int wr, int wc, int fr, int fq) const {
        const int row0 = u.pm * BMT + wr * 64 + fr; int colt = u.pn * BMT; bf16* base; int ld; bool act = false;
        if (colt < c1) { base = O0; ld = ld0; act = (ACT0 == 1); } else if (colt < c2) { base = O1; ld = ld1; colt -= c1; } else { base = O2; ld = ld2; colt -= c2; }
        const int col0 = colt + wc * 32 + 8 * fq;
#pragma unroll
        for (int ai = 0; ai < 2; ++ai)
#pragma unroll
            for (int m = 0; m < 4; ++m) { bf16* rowp = base + (size_t)(row0 + ai * HALFT + m * 16) * ld + col0;
#pragma unroll
                for (int bj = 0; bj < 2; ++bj) { pg8::f32x4 v0 = acc[ai][bj][m][0], v1 = acc[ai][bj][m][1];
                    if (ACT0 == 1 && act) {
#pragma unroll
                        for (int j = 0; j < 4; ++j) { v0[j] = gelu_tanh(v0[j]); v1[j] = gelu_tanh(v1[j]); } }
                    v4u w; w.x = pk2(v0[0], v0[1]); w.y = pk2(v0[2], v0[3]); w.z = pk2(v1[0], v1[1]); w.w = pk2(v1[2], v1[3]);
                    *(v4u*)(rowp + bj * HALFT) = w; } }
    }
};

struct EpiRetIn {
    static constexpr bool PERM = true, AFTER_DRAIN = false;
    bf16 *Q, *K, *V; const float* cs; const float* sn;
    __device__ __forceinline__ void operator()(const pg8::f32x4 (&acc)[2][2][4][2], const Unit& u, int wr, int wc, int fr, int fq) const {
        const int row0 = u.pm * BMT + wr * 64 + fr; const int colt = u.pn * BMT;
        if (colt >= 2048) {
            const int col0 = colt - 2048 + wc * 32 + 8 * fq;
#pragma unroll
            for (int ai = 0; ai < 2; ++ai)
#pragma unroll
                for (int m = 0; m < 4; ++m) { bf16* rowp = V + (size_t)(row0 + ai * HALFT + m * 16) * 2048 + col0;
#pragma unroll
                    for (int bj = 0; bj < 2; ++bj) { const pg8::f32x4 v0 = acc[ai][bj][m][0], v1 = acc[ai][bj][m][1];
                        v4u w; w.x = pk2(v0[0], v0[1]); w.y = pk2(v0[2], v0[3]); w.z = pk2(v1[0], v1[1]); w.w = pk2(v1[2], v1[3]);
                        *(v4u*)(rowp + bj * HALFT) = w; } }
        } else {
            const bool isk = colt >= 1024; bf16* base = isk ? K : Q; const float sc = isk ? 0.0625f : 1.0f;
            const int col0 = (isk ? colt - 1024 : colt) + wc * 32 + 8 * fq; const int f0 = wc * 32 + 8 * fq;
#pragma unroll
            for (int ai = 0; ai < 2; ++ai)
#pragma unroll
                for (int m = 0; m < 4; ++m) { const int row = row0 + ai * HALFT + m * 16; const int pos = row & (SEQ - 1);
                    const pg8::f32x4 c0 = *(const pg8::f32x4*)(cs + pos * 128 + f0), c1 = *(const pg8::f32x4*)(cs + pos * 128 + f0 + 4);
                    const pg8::f32x4 s0 = *(const pg8::f32x4*)(sn + pos * 128 + f0), s1 = *(const pg8::f32x4*)(sn + pos * 128 + f0 + 4);
                    const pg8::f32x4 a0 = acc[ai][0][m][0] * sc, a1 = acc[ai][0][m][1] * sc, b0 = acc[ai][1][m][0] * sc, b1 = acc[ai][1][m][1] * sc;
                    const pg8::f32x4 r0 = a0 * c0 - b0 * s0, r1 = a1 * c1 - b1 * s1, q0 = a0 * s0 + b0 * c0, q1 = a1 * s1 + b1 * c1;
                    bf16* rowp = base + (size_t)row * 1024 + col0;
                    v4u w; w.x = pk2(r0[0], r0[1]); w.y = pk2(r0[2], r0[3]); w.z = pk2(r1[0], r1[1]); w.w = pk2(r1[2], r1[3]); *(v4u*)(rowp) = w;
                    v4u w2; w2.x = pk2(q0[0], q0[1]); w2.y = pk2(q0[2], q0[3]); w2.z = pk2(q1[0], q1[1]); w2.w = pk2(q1[2], q1[3]); *(v4u*)(rowp + HALFT) = w2; }
        }
    }
};

struct EpiRetGate {
    static constexpr bool PERM = true, AFTER_DRAIN = false;
    bf16* O; const float* STAT;
    __device__ __forceinline__ void operator()(const pg8::f32x4 (&acc)[2][2][4][2], const Unit& u, int wr, int wc, int fr, int fq) const {
        const int row0 = u.pm * BMT + wr * 64 + fr; const int head = u.pn >> 1; const int col0 = u.pn * BMT + wc * 32 + 8 * fq;
#pragma unroll
        for (int ai = 0; ai < 2; ++ai)
#pragma unroll
            for (int m = 0; m < 4; ++m) { const int row = row0 + ai * HALFT + m * 16;
                const pg8::f32x4 st = *(const pg8::f32x4*)(STAT + (size_t)row * 16 + head * 4);
                const float mean = (st[0] + st[2]) * (1.0f / 512.0f); const float var = (st[1] + st[3]) * (1.0f / 512.0f) - mean * mean;
                const float rstd = __builtin_amdgcn_rsqf(fmaxf(var, 0.f) + 1e-5f);
                bf16* rowp = O + (size_t)row * 2048 + col0;
#pragma unroll
                for (int bj = 0; bj < 2; ++bj) { const v4u ov = *(const v4u*)(rowp + bj * HALFT);
                    const pg8::f32x4 g0 = acc[ai][bj][m][0], g1 = acc[ai][bj][m][1];
                    float o[8] = {bflo(ov.x), bfhi(ov.x), bflo(ov.y), bfhi(ov.y), bflo(ov.z), bfhi(ov.z), bflo(ov.w), bfhi(ov.w)};
                    float r[8];
#pragma unroll
                    for (int j = 0; j < 8; ++j) { const float g = j < 4 ? g0[j] : g1[j - 4]; r[j] = g * sigmoidf_(g) * (o[j] - mean) * rstd; }
                    v4u w; w.x = pk2(r[0], r[1]); w.y = pk2(r[2], r[3]); w.z = pk2(r[4], r[5]); w.w = pk2(r[6], r[7]);
                    *(v4u*)(rowp + bj * HALFT) = w; } }
    }
};

struct EpiPle {
    static constexpr bool PERM = true, AFTER_DRAIN = false;
    const bf16* Xin; const bf16* PP; bf16* XBo; const float* bg; float* OutF;
    __device__ __forceinline__ void operator()(const pg8::f32x4 (&acc)[2][2][4][2], const Unit& u, int wr, int wc, int fr, int fq) const {
        const int row0 = u.pm * BMT + wr * 64 + fr; const int col0 = u.pn * BMT + wc * 32 + 8 * fq;
        pg8::f32x4 bv[2][2];
#pragma unroll
        for (int bj = 0; bj < 2; ++bj)
#pragma unroll
            for (int n = 0; n < 2; ++n) bv[bj][n] = *(const pg8::f32x4*)(bg + col0 + bj * HALFT + 4 * n);
#pragma unroll
        for (int ai = 0; ai < 2; ++ai)
#pragma unroll
            for (int m = 0; m < 4; ++m) { const size_t off = (size_t)(row0 + ai * HALFT + m * 16) * DM + col0;
#pragma unroll
                for (int bj = 0; bj < 2; ++bj) {
                    const v4u pv = *(const v4u*)(PP + off + bj * HALFT), xv = *(const v4u*)(Xin + off + bj * HALFT);
                    const float pp[8] = {bflo(pv.x), bfhi(pv.x), bflo(pv.y), bfhi(pv.y), bflo(pv.z), bfhi(pv.z), bflo(pv.w), bfhi(pv.w)};
                    const float xx[8] = {bflo(xv.x), bfhi(xv.x), bflo(xv.y), bfhi(xv.y), bflo(xv.z), bfhi(xv.z), bflo(xv.w), bfhi(xv.w)};
                    pg8::f32x4 o0, o1;
#pragma unroll
                    for (int j = 0; j < 4; ++j) { o0[j] = xx[j] + sigmoidf_(acc[ai][bj][m][0][j] + bv[bj][0][j]) * pp[j];
                                                  o1[j] = xx[4 + j] + sigmoidf_(acc[ai][bj][m][1][j] + bv[bj][1][j]) * pp[4 + j]; }
                    if (OutF) { *(pg8::f32x4*)(OutF + off + bj * HALFT) = o0; *(pg8::f32x4*)(OutF + off + bj * HALFT + 4) = o1; }
                    else { v4u w; w.x = pk2(o0[0], o0[1]); w.y = pk2(o0[2], o0[3]); w.z = pk2(o1[0], o1[1]); w.w = pk2(o1[2], o1[3]);
                        *(v4u*)(XBo + off + bj * HALFT) = w; } } }
    }
};

template <class Epi>
__device__ __forceinline__ void run_gemm(const Ctx& c, const bf16* A, const bf16* Bt, int N, int K, const Epi& E) {
    asm volatile("" : "+s"(K), "+s"(N));
    pg8::Gemm g{A, Bt, T_TOK, N, K}; pg8::StaticOrder S; S.init(T_TOK, N, c.G, c.bid);
    pg8::gemm_phase<Epi, pg8::StaticOrder, false>((PG8_LAS unsigned char*)c.lds, g, S, E, nullptr);
}

__device__ __forceinline__ unsigned sort_key(float f) { const unsigned u = __builtin_bit_cast(unsigned, f); return (u & 0x80000000u) ? ~u : (u | 0x80000000u); }
__device__ __forceinline__ unsigned half_sel(unsigned long long m, int half) { return half ? (unsigned)(m >> 32) : (unsigned)m; }

#define PK_CE(i, j) { const unsigned hi_ = b[i] > b[j] ? b[i] : b[j], lo_ = b[i] > b[j] ? b[j] : b[i]; b[i] = hi_; b[j] = lo_; }
__device__ __forceinline__ void sort16_desc(unsigned (&b)[16]) {
#define CE(i, j) PK_CE(i, j)
    CE(0,1) CE(2,3) CE(0,2) CE(1,3) CE(1,2) CE(4,5) CE(6,7) CE(4,6) CE(5,7) CE(5,6) CE(0,4) CE(2,6) CE(2,4) CE(1,5) CE(3,7) CE(3,5) CE(1,2) CE(3,4) CE(5,6) CE(8,9) CE(10,11) CE(8,10) CE(9,11) CE(9,10) CE(12,13) CE(14,15) CE(12,14) CE(13,15) CE(13,14) CE(8,12) CE(10,14) CE(10,12) CE(9,13) CE(11,15) CE(11,13) CE(9,10) CE(11,12) CE(13,14) CE(0,8) CE(4,12) CE(4,8) CE(2,10) CE(6,14) CE(6,10) CE(2,4) CE(6,8) CE(10,12) CE(1,9) CE(5,13) CE(5,9) CE(3,11) CE(7,15) CE(7,11) CE(3,5) CE(7,9) CE(11,13) CE(1,2) CE(3,4) CE(5,6) CE(7,8) CE(9,10) CE(11,12) CE(13,14)
#undef CE
}
__device__ __forceinline__ void merge16_desc(unsigned (&t)[16], const unsigned (&bb)[16]) {
    unsigned b[16];
#pragma unroll
    for (int i = 0; i < 16; ++i) b[i] = t[i] > bb[15 - i] ? t[i] : bb[15 - i];
#pragma unroll
    for (int d = 8; d >= 1; d >>= 1)
#pragma unroll
        for (int i = 0; i < 16; ++i) if ((i & d) == 0) PK_CE(i, i + d)
#pragma unroll
    for (int i = 0; i < 16; ++i) t[i] = b[i];
}
__device__ __forceinline__ void ins16(unsigned (&t)[16], unsigned x) {
#pragma unroll
    for (int p = 0; p < 16; ++p) { const unsigned hi = x > t[p] ? x : t[p], lo = x > t[p] ? t[p] : x; t[p] = hi; x = lo; }
}
__device__ __forceinline__ float unsort_key16(unsigned k) { const unsigned u = k ^ (~(unsigned)((int)k >> 31) | 0x80000000u); return __builtin_bit_cast(float, u & 0xffff0000u); }
__device__ __forceinline__ float unsort_key(unsigned k) { const unsigned u = (k & 0x80000000u) ? (k & 0x7fffffffu) : ~k; return __builtin_bit_cast(float, u); }
__device__ __forceinline__ void phase_peer_topk(const Ctx& c) {
    const int gw = c.bid * NWAVES + c.wave, NGW = c.G * NWAVES, lane = c.lane;
    const bf16* SCT = (const bf16*)(c.ws + WS_M + M_SC); int* IDS = (int*)(c.ws + WS_M + M_IDS); float* GATES = (float*)(c.ws + WS_M + M_GATES);
    LAS unsigned char* lidx = c.lds + c.wave * 2048 + lane * 32;
    for (int wu = gw; wu < 8192; wu += NGW) {
        const int tblk = wu >> 3, hd = wu & 7, tok = tblk * 64 + lane;
        unsigned tA[16], tB[16];
        const v4u* pa = (const v4u*)SCT + ((size_t)tblk * 256 + hd * 32) * 64 + lane; const v4u* pb = pa + 16 * 64;
        v4u nxa[2] = {pa[0], pa[64]}, nxb[2] = {pb[0], pb[64]};
#pragma unroll 1
        for (int blk = 0; blk < 8; ++blk) {
            unsigned ka[16], kb[16];
            const v4u cxa[2] = {nxa[0], nxa[1]}, cxb[2] = {nxb[0], nxb[1]};
            if (blk < 7) { nxa[0] = pa[(2 * blk + 2) * 64]; nxa[1] = pa[(2 * blk + 3) * 64]; nxb[0] = pb[(2 * blk + 2) * 64]; nxb[1] = pb[(2 * blk + 3) * 64]; }
#pragma unroll
            for (int gg = 0; gg < 2; ++gg) { const v4u xa = cxa[gg], xb = cxb[gg];
#pragma unroll
                for (int j = 0; j < 4; ++j) { const unsigned lo0 = (unsigned)(127 - (16 * blk + 8 * gg + 2 * j)), lo1 = lo0 - 1u;
                    ka[8 * gg + 2 * j] = (xa[j] << 16) | lo0; ka[8 * gg + 2 * j + 1] = (xa[j] & 0xffff0000u) | lo1;
                    kb[8 * gg + 2 * j] = (xb[j] << 16) | lo0; kb[8 * gg + 2 * j + 1] = (xb[j] & 0xffff0000u) | lo1; } }
            sort16_desc(ka); sort16_desc(kb);
            if (blk == 0) {
#pragma unroll
                for (int i = 0; i < 16; ++i) { tA[i] = ka[i]; tB[i] = kb[i]; }
            } else { merge16_desc(tA, ka); merge16_desc(tB, kb); }
        }
        float a[16], b[16];
#pragma unroll
        for (int i = 0; i < 16; ++i) { a[i] = unsort_key16(tA[i]); b[i] = unsort_key16(tB[i]); lidx[i] = (unsigned char)(127u - (tA[i] & 127u)); lidx[16 + i] = (unsigned char)(127u - (tB[i] & 127u)); }
        unsigned uu[16];
        uu[0] = (sort_key(a[0] + b[0]) & ~255u) | 0u;
        uu[1] = (sort_key(a[0] + b[1]) & ~255u) | 1u;
        uu[2] = (sort_key(a[0] + b[2]) & ~255u) | 2u;
        uu[3] = (sort_key(a[0] + b[3]) & ~255u) | 3u;
        uu[4] = (sort_key(a[0] + b[4]) & ~255u) | 4u;
        uu[5] = (sort_key(a[0] + b[5]) & ~255u) | 5u;
        uu[6] = (sort_key(a[0] + b[6]) & ~255u) | 6u;
        uu[7] = (sort_key(a[0] + b[7]) & ~255u) | 7u;
        uu[8] = (sort_key(a[0] + b[8]) & ~255u) | 8u;
        uu[9] = (sort_key(a[0] + b[9]) & ~255u) | 9u;
        uu[10] = (sort_key(a[0] + b[10]) & ~255u) | 10u;
        uu[11] = (sort_key(a[0] + b[11]) & ~255u) | 11u;
        uu[12] = (sort_key(a[0] + b[12]) & ~255u) | 12u;
        uu[13] = (sort_key(a[0] + b[13]) & ~255u) | 13u;
        uu[14] = (sort_key(a[0] + b[14]) & ~255u) | 14u;
        uu[15] = (sort_key(a[0] + b[15]) & ~255u) | 15u;
        sort16_desc(uu);
        unsigned cb[16];
        cb[0] = (sort_key(a[1] + b[0]) & ~255u) | 16u;
        cb[1] = (sort_key(a[1] + b[1]) & ~255u) | 17u;
        cb[2] = (sort_key(a[1] + b[2]) & ~255u) | 18u;
        cb[3] = (sort_key(a[1] + b[3]) & ~255u) | 19u;
        cb[4] = (sort_key(a[1] + b[4]) & ~255u) | 20u;
        cb[5] = (sort_key(a[1] + b[5]) & ~255u) | 21u;
        cb[6] = (sort_key(a[1] + b[6]) & ~255u) | 22u;
        cb[7] = (sort_key(a[1] + b[7]) & ~255u) | 23u;
        cb[8] = (sort_key(a[2] + b[0]) & ~255u) | 32u;
        cb[9] = (sort_key(a[2] + b[1]) & ~255u) | 33u;
        cb[10] = (sort_key(a[2] + b[2]) & ~255u) | 34u;
        cb[11] = (sort_key(a[2] + b[3]) & ~255u) | 35u;
        cb[12] = (sort_key(a[2] + b[4]) & ~255u) | 36u;
        cb[13] = (sort_key(a[3] + b[0]) & ~255u) | 48u;
        cb[14] = (sort_key(a[3] + b[1]) & ~255u) | 49u;
        cb[15] = (sort_key(a[3] + b[2]) & ~255u) | 50u;
        sort16_desc(cb); merge16_desc(uu, cb);
        cb[0] = (sort_key(a[3] + b[3]) & ~255u) | 51u;
        cb[1] = (sort_key(a[4] + b[0]) & ~255u) | 64u;
        cb[2] = (sort_key(a[4] + b[1]) & ~255u) | 65u;
        cb[3] = (sort_key(a[4] + b[2]) & ~255u) | 66u;
        cb[4] = (sort_key(a[5] + b[0]) & ~255u) | 80u;
        cb[5] = (sort_key(a[5] + b[1]) & ~255u) | 81u;
        cb[6] = (sort_key(a[6] + b[0]) & ~255u) | 96u;
        cb[7] = (sort_key(a[6] + b[1]) & ~255u) | 97u;
        cb[8] = (sort_key(a[7] + b[0]) & ~255u) | 112u;
        cb[9] = (sort_key(a[7] + b[1]) & ~255u) | 113u;
        cb[10] = (sort_key(a[8] + b[0]) & ~255u) | 128u;
        cb[11] = (sort_key(a[9] + b[0]) & ~255u) | 144u;
        cb[12] = (sort_key(a[10] + b[0]) & ~255u) | 160u;
        cb[13] = (sort_key(a[11] + b[0]) & ~255u) | 176u;
        cb[14] = (sort_key(a[12] + b[0]) & ~255u) | 192u;
        cb[15] = (sort_key(a[13] + b[0]) & ~255u) | 208u;
        sort16_desc(cb); merge16_desc(uu, cb);
        cb[0] = (sort_key(a[14] + b[0]) & ~255u) | 224u;
        cb[1] = (sort_key(a[15] + b[0]) & ~255u) | 240u;
        cb[2] = 0u;
        cb[3] = 0u;
        cb[4] = 0u;
        cb[5] = 0u;
        cb[6] = 0u;
        cb[7] = 0u;
        cb[8] = 0u;
        cb[9] = 0u;
        cb[10] = 0u;
        cb[11] = 0u;
        cb[12] = 0u;
        cb[13] = 0u;
        cb[14] = 0u;
        cb[15] = 0u;
        sort16_desc(cb); merge16_desc(uu, cb);
        LDS_WAIT(); asm volatile("" ::: "memory");
        float sc[16], sum = 0.f; int eid[16];
        const float s0 = unsort_key(uu[0] & ~255u);
#pragma unroll
        for (int r = 0; r < 16; ++r) { const float s = unsort_key(uu[r] & ~255u); sc[r] = __expf(s - s0); sum += sc[r];
            const int i = (uu[r] >> 4) & 15, j = uu[r] & 15; eid[r] = (int)lidx[i] * 128 + (int)lidx[16 + j]; }
        const float inv = 1.0f / sum;
#pragma unroll
        for (int q = 0; q < 4; ++q) {
            *(v4u*)(IDS + (size_t)tok * 128 + hd * 16 + 4 * q) = (v4u){(unsigned)eid[4 * q], (unsigned)eid[4 * q + 1], (unsigned)eid[4 * q + 2], (unsigned)eid[4 * q + 3]};
            *(f32x4*)(GATES + (size_t)tok * 128 + hd * 16 + 4 * q) = (f32x4){sc[4 * q] * inv, sc[4 * q + 1] * inv, sc[4 * q + 2] * inv, sc[4 * q + 3] * inv};
        }
        LDS_WAIT(); asm volatile("" ::: "memory");
    }
}

#if !(PEER_U4 && PEER_V4)
#error "this gather expects both expert tables in fp4 (interleaved rows)"
#endif
typedef int v8i_t __attribute__((ext_vector_type(8)));
constexpr float PEER_XSCALE = 8.0f;
struct PeerGroup { v4u ua[8]; float g4[4]; };
__device__ __forceinline__ void peer_load(PeerGroup& B, const unsigned char* TAB, int idv, float gv, int kb, int lane) {
    const int m = lane & 15, kg = lane >> 4;
    const int idm = __builtin_amdgcn_ds_bpermute(4 * (kb + m), idv);
    const unsigned char* up = TAB + (size_t)idm * 1024 + 16 * kg;
#pragma unroll
    for (int cc = 0; cc < 8; ++cc) B.ua[cc] = *(const v4u*)(up + 64 * cc);
#pragma unroll
    for (int r = 0; r < 4; ++r) B.g4[r] = __builtin_bit_cast(float, __builtin_amdgcn_ds_bpermute(4 * (kb + 4 * kg + r), __builtin_bit_cast(int, gv)));
}
template <int J> __device__ __forceinline__ f32x2 fp4_pair(const v4u& w) { return __builtin_amdgcn_cvt_scalef32_pk_f32_fp4(w[J >> 2], 1.0f, J & 3); }
__device__ __forceinline__ void peer_compute(const PeerGroup& B, const unsigned char* TAB, int idv, int kb, const LAS unsigned char* xb8, f32x2 (&y2)[16], int lane) {
    const int hf = lane >> 5, l31 = lane & 31;
    v4u vv[8];
#pragma unroll
    for (int e = 0; e < 8; ++e) {
        const int ida = __builtin_amdgcn_readlane(idv, kb + 2 * e), idb = __builtin_amdgcn_readlane(idv, kb + 2 * e + 1);
        vv[e] = *(const v4u*)(TAB + (size_t)(hf ? idb : ida) * 1024 + 512 + 16 * l31);
    }
    f32x4 d = {0.f, 0.f, 0.f, 0.f};
#pragma unroll
    for (int cc = 0; cc < 8; ++cc) {
        asm volatile("" ::: "memory");
        const v4u b0 = *(const LAS v4u*)(xb8 + 128 * cc), b1 = *(const LAS v4u*)(xb8 + 128 * cc + 64);
        const v8i_t bx = {(int)b0.x, (int)b0.y, (int)b0.z, (int)b0.w, (int)b1.x, (int)b1.y, (int)b1.z, (int)b1.w};
        const v8i_t ax = {(int)B.ua[cc].x, (int)B.ua[cc].y, (int)B.ua[cc].z, (int)B.ua[cc].w, 0, 0, 0, 0};
        d = __builtin_amdgcn_mfma_scale_f32_16x16x128_f8f6f4(ax, bx, d, 4  , 0  , 0, 127, 0, 127);
    }
    float a4[4];
#pragma unroll
    for (int r = 0; r < 4; ++r) a4[r] = gelu_tanh(d[r] * (1.0f / (PEER_USCALE * PEER_XSCALE))) * B.g4[r] * (1.0f / PEER_VSCALE);
#pragma unroll
    for (int e = 0; e < 8; ++e) {
        const int ma = 2 * e, mb = 2 * e + 1;
        const float a0 = __builtin_bit_cast(float, __builtin_amdgcn_readlane(__builtin_bit_cast(int, a4[ma & 3]), 16 * (ma >> 2))), a1 = __builtin_bit_cast(float, __builtin_amdgcn_readlane(__builtin_bit_cast(int, a4[mb & 3]), 16 * (mb >> 2)));
        const float a = hf ? a1 : a0; const f32x2 a2 = {a, a};
#define PEER_AXPY(J) y2[J] = __builtin_elementwise_fma(a2, fp4_pair<J>(vv[e]), y2[J]);
        PEER_AXPY(0) PEER_AXPY(1) PEER_AXPY(2) PEER_AXPY(3) PEER_AXPY(4) PEER_AXPY(5) PEER_AXPY(6) PEER_AXPY(7)
        PEER_AXPY(8) PEER_AXPY(9) PEER_AXPY(10) PEER_AXPY(11) PEER_AXPY(12) PEER_AXPY(13) PEER_AXPY(14) PEER_AXPY(15)
#undef PEER_AXPY
    }
}
template <class BarFn>
__device__ __forceinline__ void phase_peer_gather(const Ctx& c, int layer, const BarFn&) {
    const int gw = c.bid * NWAVES + c.wave, NGW = c.G * NWAVES;
    const int* IDS = (const int*)(c.ws + WS_M + M_IDS); const float* GATES = (const float*)(c.ws + WS_M + M_GATES);
    const unsigned char* TAB = c.ws + WS_TABU;
    const float* gain = INP(c, I_LN2_G) + layer * DM; const float* bias = INP(c, I_LN2_B) + layer * DM;
    bf16* xb = (bf16*)(c.ws + ((layer & 1) ? WS_XB1 : WS_XB0));
    const int lane = c.lane, hf = lane >> 5, l31 = lane & 31;
    LAS unsigned char* xbase = c.lds + c.wave * 3072;
    { unsigned z = 0u; asm volatile("" : "+v"(z));
      *(LAS v4u*)(xbase + 2048 + 16 * lane) = (v4u){z, z, z, z}; }
    const bool col0 = (lane & 15) == 0;
    auto stage_x = [&](int tk, int buf) {
        const bf16* xr = xb + (size_t)tk * DM + 32 * l31; v4u w0, w1;
#pragma unroll
        for (int q = 0; q < 4; ++q) { const v4u xv = *(const v4u*)(xr + 8 * q);
            int pa = 0, pb = 0;
            pa = __builtin_amdgcn_cvt_pk_fp8_f32(bflo(xv.x) * PEER_XSCALE, bfhi(xv.x) * PEER_XSCALE, pa, false); pa = __builtin_amdgcn_cvt_pk_fp8_f32(bflo(xv.y) * PEER_XSCALE, bfhi(xv.y) * PEER_XSCALE, pa, true);
            pb = __builtin_amdgcn_cvt_pk_fp8_f32(bflo(xv.z) * PEER_XSCALE, bfhi(xv.z) * PEER_XSCALE, pb, false); pb = __builtin_amdgcn_cvt_pk_fp8_f32(bflo(xv.w) * PEER_XSCALE, bfhi(xv.w) * PEER_XSCALE, pb, true);
            if (q < 2) { w0[2 * q] = (unsigned)pa; w0[2 * q + 1] = (unsigned)pb; } else { w1[2 * q - 4] = (unsigned)pa; w1[2 * q - 3] = (unsigned)pb; } }
        if (hf == 0) { *(LAS v4u*)(xbase + 1024 * buf + 32 * l31) = w0; *(LAS v4u*)(xbase + 1024 * buf + 32 * l31 + 16) = w1; } };
    int tok = gw, par = 0;
    int idA = 0, idB = 0; float gA = 0.f, gB = 0.f;
    PeerGroup G0, G1;
    if (tok < T_TOK) {
        idA = IDS[(size_t)tok * 128 + lane]; idB = IDS[(size_t)tok * 128 + 64 + lane]; gA = GATES[(size_t)tok * 128 + lane]; gB = GATES[(size_t)tok * 128 + 64 + lane];
        stage_x(tok, 0);
        peer_load(G0, TAB, idA, gA, 0, lane);
    }
#pragma unroll 1
    while (tok < T_TOK) {
        const int ntok = tok + NGW; const bool has_next = ntok < T_TOK;
        int nidA = 0, nidB = 0; float ngA = 0.f, ngB = 0.f;
        if (has_next) { nidA = IDS[(size_t)ntok * 128 + lane]; nidB = IDS[(size_t)ntok * 128 + 64 + lane]; ngA = GATES[(size_t)ntok * 128 + lane]; ngB = GATES[(size_t)ntok * 128 + 64 + lane]; }
        const LAS unsigned char* xb8 = col0 ? (xbase + 1024 * par + 16 * (lane >> 4)) : (xbase + 2048);
        f32x2 y2[16];
#pragma unroll
        for (int j = 0; j < 16; ++j) y2[j] = (f32x2){0.f, 0.f};
        v4u xres[2] = {(v4u){0u, 0u, 0u, 0u}, (v4u){0u, 0u, 0u, 0u}};
        LDS_WAIT(); asm volatile("" ::: "memory");
#define PEER_LD(Gx, g) peer_load(Gx, TAB, ((g) >= 4) ? idB : idA, ((g) >= 4) ? gB : gA, ((g) & 3) * 16, lane)
#define PEER_CP(Gx, g) peer_compute(Gx, TAB, ((g) >= 4) ? idB : idA, ((g) & 3) * 16, xb8, y2, lane)
#pragma unroll 1
        for (int g = 0; g < 8; g += 2) {
            PEER_LD(G1, g + 1); PEER_CP(G0, g);
            if (g == 2 && has_next) stage_x(ntok, par ^ 1);
            if (g + 2 < 8) PEER_LD(G0, g + 2); else if (has_next) peer_load(G0, TAB, nidA, ngA, 0, lane);
            if (g == 6) { xres[0] = *(const v4u*)(xb + (size_t)tok * DM + 32 * l31 + 16 * hf); xres[1] = *(const v4u*)(xb + (size_t)tok * DM + 32 * l31 + 16 * hf + 8); }
            PEER_CP(G1, g + 1);
        }
#undef PEER_LD
#undef PEER_CP
        float z[16];
#pragma unroll
        for (int j = 0; j < 16; ++j) { const float tx = y2[j].x + __shfl_xor(y2[j].x, 32), ty = y2[j].y + __shfl_xor(y2[j].y, 32); y2[j] = (f32x2){tx, ty}; }
#pragma unroll
        for (int j = 0; j < 8; ++j) { const unsigned xw = xres[j >> 2][j & 3]; z[2 * j] = (hf ? y2[8 + j].x : y2[j].x) + ALPHA_DN * bflo(xw); z[2 * j + 1] = (hf ? y2[8 + j].y : y2[j].y) + ALPHA_DN * bfhi(xw); }
        float s = 0.f;
#pragma unroll
        for (int j = 0; j < 16; ++j) s += z[j];
        const float mean = wave_sum(s) * (1.f / 1024.f);
        float s2 = 0.f;
#pragma unroll
        for (int j = 0; j < 16; ++j) { z[j] -= mean; s2 += z[j] * z[j]; }
        const float rstd = __builtin_amdgcn_rsqf(wave_sum(s2) * (1.f / 1024.f) + 1e-5f);
        const int col = 32 * l31 + 16 * hf; float o[16];
#pragma unroll
        for (int q = 0; q < 4; ++q) { const f32x4 gq = *(const f32x4*)(gain + col + 4 * q), bq = *(const f32x4*)(bias + col + 4 * q); f32x4 r;
#pragma unroll
            for (int j = 0; j < 4; ++j) { r[j] = z[4 * q + j] * rstd * gq[j] + bq[j]; o[4 * q + j] = r[j]; } }
        v4u w0, w1; w0.x = pk2(o[0], o[1]); w0.y = pk2(o[2], o[3]); w0.z = pk2(o[4], o[5]); w0.w = pk2(o[6], o[7]);
        w1.x = pk2(o[8], o[9]); w1.y = pk2(o[10], o[11]); w1.z = pk2(o[12], o[13]); w1.w = pk2(o[14], o[15]);
        *(v4u*)(xb + (size_t)tok * DM + col) = w0; *(v4u*)(xb + (size_t)tok * DM + col + 8) = w1;
        idA = nidA; idB = nidB; gA = ngA; gB = ngB; par ^= 1; tok = ntok;
    }
}

__device__ __forceinline__ void phase_dsa_norm(const Ctx& c, int j) {
    const int gw = c.bid * NWAVES + c.wave, NGW = c.G * NWAVES, lane = c.lane;
    const bf16* RAW = (const bf16*)(c.ws + WS_M + M_RAW);
    bf16* CQ = (bf16*)(c.ws + WS_M + M_CQ); bf16* CKV = (bf16*)(c.ws + WS_M + M_CKV);
    bf16* KIDX = (bf16*)(c.ws + WS_M + M_KIDX); float* WIDX = (float*)(c.ws + WS_M + M_WIDX);
    const float* gq = INP(c, I_A_CQ_GAIN) + j * 256; const float* gkv = INP(c, I_A_CKV_GAIN) + j * 128;
    const float* gk = INP(c, I_A_KIDX_GAIN) + j * 64; const float* bk = INP(c, I_A_KIDX_BIAS) + j * 64;
    for (int tok = gw; tok < T_TOK; tok += NGW) {
        const v4u rw = *(const v4u*)(RAW + (size_t)tok * 512 + 8 * lane);
        float v[8] = {bflo(rw.x), bfhi(rw.x), bflo(rw.y), bfhi(rw.y), bflo(rw.z), bfhi(rw.z), bflo(rw.w), bfhi(rw.w)};
        float ss = 0.f, s = 0.f;
#pragma unroll
        for (int i = 0; i < 8; ++i) { ss += v[i] * v[i]; s += v[i]; }
        const bool isq = lane < 32, iskv = lane >= 32 && lane < 48, isk = lane >= 48 && lane < 56;
        const float ssq_q = wave_sum(isq ? ss : 0.f), ssq_kv = wave_sum(iskv ? ss : 0.f), sum_k = wave_sum(isk ? s : 0.f);
        const float mean_k = sum_k * (1.0f / 64.0f);
        float dv = 0.f;
#pragma unroll
        for (int i = 0; i < 8; ++i) { const float d = v[i] - mean_k; dv += d * d; }
        const float var_k = wave_sum(isk ? dv : 0.f) * (1.0f / 64.0f);
        if (isq) {
            const float r = __builtin_amdgcn_rsqf(ssq_q * (1.0f / 256.0f) + 1e-6f); const float* g = gq + 8 * lane;
            v4u w; w.x = pk2(v[0] * r * g[0], v[1] * r * g[1]); w.y = pk2(v[2] * r * g[2], v[3] * r * g[3]); w.z = pk2(v[4] * r * g[4], v[5] * r * g[5]); w.w = pk2(v[6] * r * g[6], v[7] * r * g[7]);
            *(v4u*)(CQ + (size_t)tok * 256 + 8 * lane) = w;
        } else if (iskv) {
            const int c0 = 8 * (lane - 32); const float r = __builtin_amdgcn_rsqf(ssq_kv * (1.0f / 128.0f) + 1e-6f); const float* g = gkv + c0;
            float o[8];
#pragma unroll
            for (int i = 0; i < 8; ++i) o[i] = v[i] * r * g[i];
            v4u w; w.x = pk2(o[0], o[1]); w.y = pk2(o[2], o[3]); w.z = pk2(o[4], o[5]); w.w = pk2(o[6], o[7]);
            *(v4u*)(CKV + (size_t)tok * 128 + c0) = w;
        } else if (isk) {
            const int c0 = 8 * (lane - 48); const float r = __builtin_amdgcn_rsqf(var_k + 1e-5f);
            float o[8];
#pragma unroll
            for (int i = 0; i < 8; ++i) o[i] = (v[i] - mean_k) * r * gk[c0 + i] + bk[c0 + i];
            v4u w; w.x = pk2(o[0], o[1]); w.y = pk2(o[2], o[3]); w.z = pk2(o[4], o[5]); w.w = pk2(o[6], o[7]);
            *(v4u*)(KIDX + (size_t)tok * 64 + c0) = w;
        } else if (lane == 56) {
            const float sc = 0.35355339059327373f;
            f32x4 o0 = {v[0] * sc, v[1] * sc, v[2] * sc, v[3] * sc}, o1 = {v[4] * sc, v[5] * sc, v[6] * sc, v[7] * sc};
            *(f32x4*)(WIDX + (size_t)tok * 8) = o0; *(f32x4*)(WIDX + (size_t)tok * 8 + 4) = o1;
        }
    }
}

__device__ __forceinline__ unsigned half_sum_u32(unsigned v, int h) {
    auto dpp = [](unsigned x, auto ctrl, auto rmask) { return (unsigned)__builtin_amdgcn_update_dpp(0, (int)x, decltype(ctrl)::value, decltype(rmask)::value, 0xf, false); };
    v += dpp(v, std::integral_constant<int, 0xB1>{}, std::integral_constant<int, 0xf>{});
    v += dpp(v, std::integral_constant<int, 0x4E>{}, std::integral_constant<int, 0xf>{});
    v += dpp(v, std::integral_constant<int, 0x141>{}, std::integral_constant<int, 0xf>{});
    v += dpp(v, std::integral_constant<int, 0x140>{}, std::integral_constant<int, 0xf>{});
    v += dpp(v, std::integral_constant<int, 0x142>{}, std::integral_constant<int, 0xa>{});
    const unsigned t0 = (unsigned)__builtin_amdgcn_readlane((int)v, 31), t1 = (unsigned)__builtin_amdgcn_readlane((int)v, 63);
    return h ? t1 : t0;
}
__device__ __forceinline__ void phase_dsa_index(const Ctx& c) {
    const bf16* KIDX = (const bf16*)(c.ws + WS_M + M_KIDX); const bf16* QIDX = (const bf16*)(c.ws + WS_M + M_QIDX);
    const float* WIDX = (const float*)(c.ws + WS_M + M_WIDX); unsigned* MASK = (unsigned*)(c.ws + WS_M + M_MASK);
    const int lane = c.lane, n = lane & 31, h = lane >> 5;
    const unsigned ltmask = (1u << n) - 1u;
    LAS unsigned* kl = (LAS unsigned*)(c.lds + c.wave * 16384) + lane * 4;
    for (int u = c.bid; u < 2048; u += c.G) {
        const int b = u & 31, rest = u >> 5, qc = rest >> 1, sub = rest & 1;
        const int tw0 = b * 2048 + qc * 64 + sub * 32 + 4 * c.wave;
        const int nt = 2 * (qc + 1), ng = (nt + 3) >> 2;
        if (nt <= 8) {
            if (n == 0) {
                for (int tt = 0; tt < 2; ++tt)
                    for (int tile = 0; tile < nt; ++tile) MASK[(size_t)(tw0 + 2 * h + tt) * 64 + tile] = 0xffffffffu;
            }
            continue;
        }
        const int ti = 2 * ((n >> 2) & 1) + (n >> 4), hd = 4 * ((n >> 3) & 1) + (n & 3);
        bf16x8 Aq[4];
#pragma unroll
        for (int s = 0; s < 4; ++s) Aq[s] = *(const bf16x8*)(QIDX + (size_t)(tw0 + ti) * 512 + hd * 64 + 16 * s + 8 * h);
        float wv[2][8];
#pragma unroll
        for (int tt = 0; tt < 2; ++tt) { const f32x4 w0 = *(const f32x4*)(WIDX + (size_t)(tw0 + 2 * h + tt) * 8), w1 = *(const f32x4*)(WIDX + (size_t)(tw0 + 2 * h + tt) * 8 + 4);
#pragma unroll
            for (int i = 0; i < 4; ++i) { wv[tt][i] = w0[i]; wv[tt][4 + i] = w1[i]; } }
        const bf16* kbase = KIDX + (size_t)(b * 2048 + n) * 64 + 8 * h;
        auto ldgrp = [&](bf16x8 (&Bk)[2][4], int tile0) {
#pragma unroll
            for (int q = 0; q < 2; ++q) if (tile0 + q < nt) { const bf16* kr = kbase + (size_t)(tile0 + q) * 32 * 64;
#pragma unroll
                for (int s = 0; s < 4; ++s) Bk[q][s] = *(const bf16x8*)(kr + 16 * s); } };
        auto scgrp = [&](const bf16x8 (&Bk)[2][4], int tile0) {
#pragma unroll
            for (int q = 0; q < 2; ++q) if (tile0 + q < nt) {
                f32x16 acc;
#pragma unroll
                for (int i = 0; i < 16; ++i) acc[i] = 0.f;
#pragma unroll
                for (int s = 0; s < 4; ++s) acc = __builtin_amdgcn_mfma_f32_32x32x16_bf16(Aq[s], Bk[q][s], acc, 0, 0, 0);
                float sc0 = 0.f, sc1 = 0.f;
#pragma unroll
                for (int jj = 0; jj < 2; ++jj)
#pragma unroll
                    for (int k = 0; k < 4; ++k) { sc0 += wv[0][4 * jj + k] * fmaxf(acc[4 * jj + k], 0.f); sc1 += wv[1][4 * jj + k] * fmaxf(acc[8 + 4 * jj + k], 0.f); }
                kl[((tile0 + q) >> 2) * 256 + ((tile0 + q) & 3)] = (sort_key(sc0) >> 16) | (sort_key(sc1) & 0xffff0000u);
            } };
        bf16x8 BkA[2][4], BkB[2][4];
        ldgrp(BkA, 0);
#pragma unroll 1
        for (int tile0 = 0; tile0 < nt; tile0 += 4) {
            if (tile0 + 2 < nt) ldgrp(BkB, tile0 + 2);
            scgrp(BkA, tile0);
            if (tile0 + 4 < nt) ldgrp(BkA, tile0 + 4);
            if (tile0 + 2 < nt) scgrp(BkB, tile0 + 2);
        }
        if (nt & 2) { kl[(nt >> 2) * 256 + 2] = 0u; kl[(nt >> 2) * 256 + 3] = 0u; }
        LDS_WAIT(); asm volatile("" ::: "memory");
        unsigned v0 = 0u, v1 = 0u, cv0 = 0xffffu, cv1 = 0xffffu;
        for (int bit = 15; bit >= 0; --bit) {
            const unsigned c0 = v0 | (1u << bit), c1 = v1 | (1u << bit); unsigned lt0 = 0u, lt1 = 0u;
            for (int g = 0; g < ng; ++g) { const v4u k4 = *(const LAS v4u*)(kl + g * 256);
#pragma unroll
                for (int j = 0; j < 4; ++j) { lt0 += (unsigned)((int)((k4[j] & 0xffffu) - c0)) >> 31; lt1 += (unsigned)((int)((k4[j] >> 16) - c1)) >> 31; } }
            const unsigned both = half_sum_u32((4u * (unsigned)ng - lt0) | ((4u * (unsigned)ng - lt1) << 16), h);
            const unsigned cnt0 = both & 0xffffu, cnt1 = both >> 16;
            if (cnt0 >= 256u) { v0 = c0; cv0 = cnt0; }
            if (cnt1 >= 256u) { v1 = c1; cv1 = cnt1; }
            if (__all(cv0 == 256u && cv1 == 256u)) break;
        }
        unsigned g0 = 0u, g1 = 0u;
        for (int g = 0; g < ng; ++g) { const v4u k4 = *(const LAS v4u*)(kl + g * 256);
#pragma unroll
            for (int j = 0; j < 4; ++j) { g0 += (unsigned)((int)(v0 - (k4[j] & 0xffffu))) >> 31; g1 += (unsigned)((int)(v1 - (k4[j] >> 16))) >> 31; } }
        const unsigned gboth = half_sum_u32(g0 | (g1 << 16), h);
        const unsigned need0 = 256u - (gboth & 0xffffu), need1 = 256u - (gboth >> 16); unsigned eb0 = 0u, eb1 = 0u;
        for (int tile = 0; tile < nt; ++tile) {
            const unsigned kw = kl[(tile >> 2) * 256 + (tile & 3)]; const unsigned k0 = kw & 0xffffu, k1 = kw >> 16;
            { const bool gt = k0 > v0, eq = k0 == v0; const unsigned em = half_sel(__ballot(eq), h);
              const bool take = gt || (eq && (eb0 + __popc(em & ltmask) < need0)); eb0 += __popc(em);
              const unsigned word = half_sel(__ballot(take), h); if (n == 0) MASK[(size_t)(tw0 + 2 * h) * 64 + tile] = word; }
            { const bool gt = k1 > v1, eq = k1 == v1; const unsigned em = half_sel(__ballot(eq), h);
              const bool take = gt || (eq && (eb1 + __popc(em & ltmask) < need1)); eb1 += __popc(em);
              const unsigned word = half_sel(__ballot(take), h); if (n == 0) MASK[(size_t)(tw0 + 2 * h + 1) * 64 + tile] = word; }
        }
        LDS_WAIT(); asm volatile("" ::: "memory");
    }
}

__device__ __forceinline__ void tr_rd16(unsigned a, v2u (&r)[16]) {
    asm volatile("ds_read_b64_tr_b16 %0, %16\n\tds_read_b64_tr_b16 %1, %16 offset:4352\n\t"
                 "ds_read_b64_tr_b16 %2, %16 offset:32\n\tds_read_b64_tr_b16 %3, %16 offset:4384\n\t"
                 "ds_read_b64_tr_b16 %4, %16 offset:64\n\tds_read_b64_tr_b16 %5, %16 offset:4416\n\t"
                 "ds_read_b64_tr_b16 %6, %16 offset:96\n\tds_read_b64_tr_b16 %7, %16 offset:4448\n\t"
                 "ds_read_b64_tr_b16 %8, %16 offset:128\n\tds_read_b64_tr_b16 %9, %16 offset:4480\n\t"
                 "ds_read_b64_tr_b16 %10, %16 offset:160\n\tds_read_b64_tr_b16 %11, %16 offset:4512\n\t"
                 "ds_read_b64_tr_b16 %12, %16 offset:192\n\tds_read_b64_tr_b16 %13, %16 offset:4544\n\t"
                 "ds_read_b64_tr_b16 %14, %16 offset:224\n\tds_read_b64_tr_b16 %15, %16 offset:4576\n\ts_waitcnt lgkmcnt(0)"
                 : "=&v"(r[0]), "=&v"(r[1]), "=&v"(r[2]), "=&v"(r[3]), "=&v"(r[4]), "=&v"(r[5]), "=&v"(r[6]), "=&v"(r[7]),
                   "=&v"(r[8]), "=&v"(r[9]), "=&v"(r[10]), "=&v"(r[11]), "=&v"(r[12]), "=&v"(r[13]), "=&v"(r[14]), "=&v"(r[15])
                 : "v"(a) : "memory");
}
__device__ __forceinline__ void phase_dsa_attn(const Ctx& c) {
    const bf16* CKV = (const bf16*)(c.ws + WS_M + M_CKV);
    bf16* QLAT = (bf16*)(c.ws + WS_M + M_QLAT); const unsigned* MASK = (const unsigned*)(c.ws + WS_M + M_MASK);
    constexpr int RS = 272, TILE = 32 * RS;
    const int lane = c.lane, l15 = lane & 15, g = lane >> 4;
    LAS unsigned char* T0 = c.lds + c.wave * 17920;
    LAS unsigned short* klist = (LAS unsigned short*)(T0 + 2 * TILE);
    const unsigned lbase = (unsigned)(size_t)T0;
    const int prow = lane >> 4, ppc = lane & 15;
    for (int u = c.bid * NWAVES + c.wave; u < T_TOK; u += c.G * NWAVES) {
        const int tok = u, b = tok >> 11;
        const int qc = (tok & 2047) >> 6; const int nt = 2 * (qc + 1);
        const unsigned mwd = lane < nt ? MASK[(size_t)tok * 64 + lane] : 0u;
        unsigned incl = (unsigned)__popc(mwd);
#pragma unroll
        for (int d = 1; d < 64; d <<= 1) { const unsigned o = __shfl_up(incl, d); if (lane >= d) incl += o; }
        const int nsel = __builtin_amdgcn_readlane((int)incl, 63);
        { unsigned pos = incl - (unsigned)__popc(mwd), w = mwd;
          while (w) { const int bit = __builtin_ctz(w); klist[pos++] = (unsigned short)(32 * lane + bit); w &= w - 1u; } }
        bf16x8 Bq[4];
#pragma unroll
        for (int s = 0; s < 4; ++s) Bq[s] = *(const bf16x8*)(QLAT + (size_t)tok * 2048 + l15 * 128 + 32 * s + 8 * g);
        LDS_WAIT(); asm volatile("" ::: "memory");
        const int nstep = nsel >> 5;
        const bf16* kvb = CKV + (size_t)b * 2048 * 128 + ppc * 8;
        v4u gr[8];
        auto gather = [&](int step) {
#pragma unroll
            for (int j = 0; j < 8; ++j) { const int key = klist[32 * step + 4 * j + prow]; gr[j] = *(const v4u*)(kvb + (size_t)key * 128); } };
        auto lstore = [&](int buf) {
#pragma unroll
            for (int j = 0; j < 8; ++j) *(LAS v4u*)(T0 + buf * TILE + (4 * j + prow) * RS + ppc * 16) = gr[j]; };
        float m_run = -INFINITY, l_run = 0.f;
        f32x4 O[8];
#pragma unroll
        for (int dt = 0; dt < 8; ++dt) O[dt] = (f32x4){0.f, 0.f, 0.f, 0.f};
        gather(0);
#pragma unroll 1
        for (int step = 0; step < nstep; ++step) {
            const int buf = step & 1;
            lstore(buf);
            if (step + 1 < nstep) gather(step + 1);
            LDS_WAIT(); asm volatile("" ::: "memory");
            f32x4 S[2];
#pragma unroll
            for (int kt = 0; kt < 2; ++kt) { S[kt] = (f32x4){0.f, 0.f, 0.f, 0.f};
#pragma unroll
                for (int s = 0; s < 4; ++s) { const bf16x8 Ak = *(const LAS bf16x8*)(T0 + buf * TILE + (16 * kt + l15) * RS + (32 * s + 8 * g) * 2);
                    S[kt] = __builtin_amdgcn_mfma_f32_16x16x32_bf16(Ak, Bq[s], S[kt], 0, 0, 0); } }
            float mx = fmaxf(fmaxf(fmaxf(S[0][0], S[0][1]), fmaxf(S[0][2], S[0][3])), fmaxf(fmaxf(S[1][0], S[1][1]), fmaxf(S[1][2], S[1][3])));
            mx = fmaxf(mx, __shfl_xor(mx, 16)); mx = fmaxf(mx, __shfl_xor(mx, 32));
            const float m_new = fmaxf(m_run, mx);
            const float alpha = __builtin_amdgcn_exp2f(m_run - m_new);
            float p[8], ps = 0.f;
#pragma unroll
            for (int j = 0; j < 8; ++j) { p[j] = __builtin_amdgcn_exp2f(S[j >> 2][j & 3] - m_new); ps += p[j]; }
            l_run = l_run * alpha + ps; m_run = m_new;
            v4u pw; pw.x = pk2(p[0], p[1]); pw.y = pk2(p[2], p[3]); pw.z = pk2(p[4], p[5]); pw.w = pk2(p[6], p[7]);
            const bf16x8 Bp = __builtin_bit_cast(bf16x8, pw);
            const unsigned ta = lbase + buf * TILE + (4 * g + (l15 >> 2)) * RS + (4 * (l15 & 3)) * 2;
            v2u tr[16]; tr_rd16(ta, tr);
#pragma unroll
            for (int dt = 0; dt < 8; ++dt) {
                v4u aw; aw.x = tr[2 * dt].x; aw.y = tr[2 * dt].y; aw.z = tr[2 * dt + 1].x; aw.w = tr[2 * dt + 1].y;
                O[dt] = O[dt] * alpha; O[dt] = __builtin_amdgcn_mfma_f32_16x16x32_bf16(__builtin_bit_cast(bf16x8, aw), Bp, O[dt], 0, 0, 0); }
        }
        const float l_tot = l_run + __shfl_xor(l_run, 16); const float l_all = l_tot + __shfl_xor(l_tot, 32); const float inv = 1.0f / l_all;
#pragma unroll
        for (int dt = 0; dt < 8; ++dt) { v2u w; w.x = pk2(O[dt][0] * inv, O[dt][1] * inv); w.y = pk2(O[dt][2] * inv, O[dt][3] * inv);
            *(v2u*)(QLAT + (size_t)tok * 2048 + l15 * 128 + 16 * dt + 4 * g) = w; }
        LDS_WAIT(); asm volatile("" ::: "memory");
    }
}

__device__ __forceinline__ float neg_expm1_small(float x) {
    const float p = -x * (1.0f + x * 0.5f * (1.0f + x * (1.0f / 3.0f) * (1.0f + x * 0.25f * (1.0f + x * 0.2f * (1.0f + x * (1.0f / 6.0f))))));
    return x < -0.25f ? 1.0f - __expf(x) : p;
}
__device__ __forceinline__ void phase_rglru(const Ctx& c) {
    const bf16* GU = (const bf16*)(c.ws + WS_M + M_GU); bf16* Y = (bf16*)(c.ws + WS_M + M_Y);
    constexpr int CVS = 104;
    LAS float* uT = (LAS float*)c.lds;
    LAS bf16* cvb = (LAS bf16*)(c.lds + 21504);
    LAS bf16* WTa = (LAS bf16*)(c.lds + 34816);
    LAS bf16* WTx = (LAS bf16*)(c.lds + 51456);
    LAS float* a_s = (LAS float*)(c.lds + 68096);
    LAS float* b_s = (LAS float*)(c.lds + 88832);
    LAS bf16* gT = (LAS bf16*)(c.lds + 109568);
    LAS float* cst = (LAS float*)(c.lds + 120064);
    const int tid = c.tid, lane = c.lane, w = c.wave;
    for (int u = c.bid; u < 512; u += c.G) {
        const int b = u >> 4, nb = u & 15, ch0 = nb * 80;
        __syncthreads();
        for (int e = tid; e < 80 * CVS; e += NTHR) { const int d = e / CVS, k = e % CVS;
            WTa[e] = (bf16)(k < 80 ? f2bf(INP(c, I_B_W_A)[(size_t)nb * 6400 + k * 80 + d]) : 0u);
            WTx[e] = (bf16)(k < 80 ? f2bf(INP(c, I_B_W_X)[(size_t)nb * 6400 + k * 80 + d]) : 0u); }
        for (int e = tid; e < 64 * CVS; e += NTHR) cvb[e] = 0;
        if (tid < 80) {
            const int cc = ch0 + tid;
#pragma unroll
            for (int j = 0; j < 4; ++j) cst[j * 80 + tid] = INP(c, I_B_CONV_W)[j * 1280 + cc];
            cst[320 + tid] = INP(c, I_B_CONV_B)[cc]; cst[400 + tid] = INP(c, I_B_B_A)[cc]; cst[480 + tid] = INP(c, I_B_B_X)[cc];
            cst[560 + tid] = log1pf(expf(-INP(c, I_B_LAMBDA)[cc]));
        }
        float carry[10];
#pragma unroll
        for (int q = 0; q < 10; ++q) carry[q] = 0.f;
        v4u ureg[2], greg[2];
        auto issue_loads = [&](int chunk) {
#pragma unroll
            for (int q = 0; q < 2; ++q) { const int e = tid + NTHR * q;
                ureg[q] = (v4u){0u, 0u, 0u, 0u}; greg[q] = (v4u){0u, 0u, 0u, 0u};
                if (e < 670) { const int i = e / 10, cch = e % 10; const int sp = chunk * 64 - 3 + i;
                    if (sp >= 0) ureg[q] = *(const v4u*)(GU + (size_t)(b * 2048 + sp) * 2560 + 1280 + ch0 + cch * 8); }
                if (e < 640) { const int i = e / 10, cch = e % 10;
                    greg[q] = *(const v4u*)(GU + (size_t)(b * 2048 + chunk * 64 + i) * 2560 + ch0 + cch * 8); } }
        };
        issue_loads(0);
#pragma unroll 1
        for (int chunk = 0; chunk < 32; ++chunk) {
            const int t0 = b * 2048 + chunk * 64;
#pragma unroll
            for (int q = 0; q < 2; ++q) { const int e = tid + NTHR * q;
                if (e < 670) { const int i = e / 10, cch = e % 10; LAS float* d = uT + i * 80 + cch * 8;
                    *(LAS f32x4*)d = (f32x4){bflo(ureg[q].x), bfhi(ureg[q].x), bflo(ureg[q].y), bfhi(ureg[q].y)};
                    *(LAS f32x4*)(d + 4) = (f32x4){bflo(ureg[q].z), bfhi(ureg[q].z), bflo(ureg[q].w), bfhi(ureg[q].w)}; }
                if (e < 640) { const int i = e / 10, cch = e % 10; LAS unsigned* d = (LAS unsigned*)(gT + i * 82 + cch * 8);
                    d[0] = greg[q].x; d[1] = greg[q].y; d[2] = greg[q].z; d[3] = greg[q].w; } }
            __syncthreads();
            if (chunk + 1 < 32) issue_loads(chunk + 1);
            for (int e = tid; e < 5120; e += NTHR) { const int t = e / 80, cc = e % 80;
                float s = cst[320 + cc];
#pragma unroll
                for (int j = 0; j < 4; ++j) s += uT[(t + j) * 80 + cc] * cst[j * 80 + cc];
                cvb[t * CVS + cc] = (bf16)f2bf(s); }
            __syncthreads();
            {
                const int tq = w & 3, nt0 = (w >> 2) ? 3 : 0, nt1 = (w >> 2) ? 5 : 3, l15 = lane & 15, g4 = lane >> 4;
                bf16x8 Af[3];
#pragma unroll
                for (int s3 = 0; s3 < 3; ++s3) Af[s3] = *(const LAS bf16x8*)(cvb + (16 * tq + l15) * CVS + 32 * s3 + 8 * g4);
#pragma unroll
                for (int q = 0; q < 3; ++q) { const int nt = nt0 + q;
                    if (nt < nt1) {
                        f32x4 accA = {0.f, 0.f, 0.f, 0.f}, accX = {0.f, 0.f, 0.f, 0.f};
#pragma unroll
                        for (int s3 = 0; s3 < 3; ++s3) {
                            const bf16x8 Ba = *(const LAS bf16x8*)(WTa + (16 * nt + l15) * CVS + 32 * s3 + 8 * g4), Bx = *(const LAS bf16x8*)(WTx + (16 * nt + l15) * CVS + 32 * s3 + 8 * g4);
                            accA = __builtin_amdgcn_mfma_f32_16x16x32_bf16(Af[s3], Ba, accA, 0, 0, 0); accX = __builtin_amdgcn_mfma_f32_16x16x32_bf16(Af[s3], Bx, accX, 0, 0, 0); }
                        const int cc = 16 * nt + l15; const float ba = cst[400 + cc], bx = cst[480 + cc], sp = cst[560 + cc], cb = cst[320 + cc];
                        const float cw0 = cst[cc], cw1 = cst[80 + cc], cw2 = cst[160 + cc], cw3 = cst[240 + cc];
#pragma unroll
                        for (int r4 = 0; r4 < 4; ++r4) { const int t = 16 * tq + 4 * g4 + r4;
                            const float cvf = cb + uT[t * 80 + cc] * cw0 + uT[(t + 1) * 80 + cc] * cw1 + uT[(t + 2) * 80 + cc] * cw2 + uT[(t + 3) * 80 + cc] * cw3;
                            const float r = sigmoidf_(accA[r4] + ba), ig = sigmoidf_(accX[r4] + bx);
                            const float log_a = -8.0f * r * sp; const float a = __expf(log_a);
                            const float bb = __builtin_amdgcn_sqrtf(neg_expm1_small(2.0f * log_a)) * (ig * cvf);
                            a_s[t * 81 + cc] = a; b_s[t * 81 + cc] = bb; }
                    } }
            }
            __syncthreads();
            {
                LAS bf16* yT = (LAS bf16*)uT;
#pragma unroll
                for (int q = 0; q < 10; ++q) { const int cc = w + 8 * q;
                    float a = a_s[lane * 81 + cc], bq = b_s[lane * 81 + cc];
#define RG_STEP(D) { const float ap = __builtin_bit_cast(float, __builtin_amdgcn_update_dpp(0x3f800000, __builtin_bit_cast(int, a), 0x110 + D, 0xf, 0xf, false)); \
                     const float bp = __builtin_bit_cast(float, __builtin_amdgcn_update_dpp(0, __builtin_bit_cast(int, bq), 0x110 + D, 0xf, 0xf, false)); bq = a * bp + bq; a = a * ap; }
                    RG_STEP(1) RG_STEP(2) RG_STEP(4) RG_STEP(8)
#undef RG_STEP
                    { const float A0 = __builtin_bit_cast(float, __builtin_amdgcn_readlane(__builtin_bit_cast(int, a), 15)), B0 = __builtin_bit_cast(float, __builtin_amdgcn_readlane(__builtin_bit_cast(int, bq), 15));
                      const float A1 = __builtin_bit_cast(float, __builtin_amdgcn_readlane(__builtin_bit_cast(int, a), 31)), B1 = __builtin_bit_cast(float, __builtin_amdgcn_readlane(__builtin_bit_cast(int, bq), 31));
                      const float A2 = __builtin_bit_cast(float, __builtin_amdgcn_readlane(__builtin_bit_cast(int, a), 47)), B2 = __builtin_bit_cast(float, __builtin_amdgcn_readlane(__builtin_bit_cast(int, bq), 47));
                      const float C2a = A0 * A1, C2b = A1 * B0 + B1, C3a = C2a * A2, C3b = A2 * C2b + B2;
                      const int row = lane >> 4;
                      const float ca = row == 0 ? 1.0f : (row == 1 ? A0 : (row == 2 ? C2a : C3a)), cb = row == 0 ? 0.0f : (row == 1 ? B0 : (row == 2 ? C2b : C3b));
                      bq = a * cb + bq; a = a * ca; }
                    const float hval = a * carry[q] + bq;
                    carry[q] = __builtin_bit_cast(float, __builtin_amdgcn_readlane(__builtin_bit_cast(int, hval), 63));
                    yT[lane * 82 + cc] = (bf16)f2bf(bf2f(gT[lane * 82 + cc]) * hval); }
            }
            __syncthreads();
            for (int e = tid; e < 2560; e += NTHR) { const int row = e / 40, dw = e % 40;
                ((unsigned*)(Y + (size_t)(t0 + row) * 1280 + ch0))[dw] = ((const LAS unsigned*)uT)[row * 41 + dw]; }
            __syncthreads();
        }
    }
}

template <int OFF0, int OFF1>
__device__ __forceinline__ void tr_read2(unsigned a, v2u& r0, v2u& r1) {
    asm volatile("ds_read_b64_tr_b16 %0, %2 offset:%3\n\tds_read_b64_tr_b16 %1, %2 offset:%4\n\ts_waitcnt lgkmcnt(0)" : "=&v"(r0), "=&v"(r1) : "v"(a), "n"(OFF0), "n"(OFF1) : "memory");
}
template <int B0, int RSb>
__device__ __forceinline__ void tr_read8(unsigned a, v2u (&r)[8]) {
    asm volatile("ds_read_b64_tr_b16 %0, %8 offset:%9\n\tds_read_b64_tr_b16 %1, %8 offset:%10\n\tds_read_b64_tr_b16 %2, %8 offset:%11\n\tds_read_b64_tr_b16 %3, %8 offset:%12\n\t"
                 "ds_read_b64_tr_b16 %4, %8 offset:%13\n\tds_read_b64_tr_b16 %5, %8 offset:%14\n\tds_read_b64_tr_b16 %6, %8 offset:%15\n\tds_read_b64_tr_b16 %7, %8 offset:%16\n\ts_waitcnt lgkmcnt(0)"
                 : "=&v"(r[0]), "=&v"(r[1]), "=&v"(r[2]), "=&v"(r[3]), "=&v"(r[4]), "=&v"(r[5]), "=&v"(r[6]), "=&v"(r[7])
                 : "v"(a), "n"(B0), "n"(B0 + 4 * RSb), "n"(B0 + 16 * RSb), "n"(B0 + 20 * RSb), "n"(B0 + 32 * RSb), "n"(B0 + 36 * RSb), "n"(B0 + 48 * RSb), "n"(B0 + 52 * RSb) : "memory");
}
__device__ __forceinline__ void phase_ret_core(const Ctx& c) {
    const bf16* Qg = (const bf16*)(c.ws + WS_M + M_Q); const bf16* Kg = (const bf16*)(c.ws + WS_M + M_K); bf16* Vg = (bf16*)(c.ws + WS_M + M_V);
    float* STAT = (float*)(c.ws + WS_M + M_STAT);
    constexpr int RS = 528, SS = 144, QS_OFF = 0, KS_OFF = 64 * RS, VS_OFF = 2 * 64 * RS, SS_OFF = 3 * 64 * RS;
    LAS unsigned char* L = c.lds; const unsigned lbase = (unsigned)(size_t)c.lds;
    const int tid0 = c.tid, w = c.wave;
    for (int u = c.bid; u < 256; u += c.G) {
        const int b = u >> 3, hh = (u >> 1) & 3, eh = u & 1;
        const float gam = 1.0f - exp2f(-5.0f - (float)hh); const float lg0 = log2f(gam);
        f32x16 R[8];
#pragma unroll
        for (int dt = 0; dt < 8; ++dt)
#pragma unroll
            for (int i = 0; i < 16; ++i) R[dt][i] = 0.f;
        const float cdec = exp2f(lg0 * 64.0f);
#pragma unroll 1
        for (int chunk = 0; chunk < 32; ++chunk) {
            const int t0 = b * 2048 + chunk * 64;
            float lg = lg0; int tid = tid0; asm volatile("" : "+v"(lg), "+v"(tid));
            const int lane = tid & 63, n = lane & 31, h = lane >> 5, hl = h;
            const int blk = (lane >> 4) & 1, q4 = (lane & 15) >> 2, p4 = lane & 3;
            const unsigned trbK = lbase + (8 * h + q4) * RS + (16 * blk + 4 * p4) * 2;
            const unsigned trbV = trbK + VS_OFF + 64 * w;
            __syncthreads();
#pragma unroll
            for (int i = 0; i < 4; ++i) { const int e = tid + NTHR * i, row = e >> 5, ch = e & 31;
                *(LAS v4u*)(L + QS_OFF + row * RS + ch * 16) = *(const v4u*)(Qg + (size_t)(t0 + row) * 1024 + hh * 256 + ch * 8);
                *(LAS v4u*)(L + KS_OFF + row * RS + ch * 16) = *(const v4u*)(Kg + (size_t)(t0 + row) * 1024 + hh * 256 + ch * 8); }
            asm volatile("" ::: "memory");
#pragma unroll
            for (int i = 0; i < 4; ++i) { const int e = tid + NTHR * i, row = e >> 5, ch = e & 31;
                *(LAS v4u*)(L + VS_OFF + row * RS + ch * 16) = *(const v4u*)(Vg + (size_t)(t0 + row) * 2048 + hh * 512 + eh * 256 + ch * 8); }
            __syncthreads();
            {
                const int i16 = w >> 1, l15 = lane & 15, g4 = lane >> 4; const int l15d = l15, g4d = g4;
                bf16x8 Af[8];
#pragma unroll
                for (int s = 0; s < 8; ++s) Af[s] = *(const LAS bf16x8*)(L + QS_OFF + (16 * i16 + l15) * RS + (32 * s + 8 * g4) * 2);
#pragma unroll
                for (int jj = 0; jj < 2; ++jj) { const int j16 = 2 * (w & 1) + jj;
                    f32x4 acc = {0.f, 0.f, 0.f, 0.f};
                    if (j16 <= i16) {
#pragma unroll
                        for (int s = 0; s < 8; ++s) { const bf16x8 Bf = *(const LAS bf16x8*)(L + KS_OFF + (16 * j16 + l15) * RS + (32 * s + 8 * g4) * 2);
                            acc = __builtin_amdgcn_mfma_f32_16x16x32_bf16(Af[s], Bf, acc, 0, 0, 0); }
                    }
                    const int ja = 16 * j16 + l15, jad = 16 * j16 + l15d;
#pragma unroll
                    for (int r = 0; r < 4; ++r) { const int ia = 16 * i16 + 4 * g4 + r, iad = 16 * i16 + 4 * g4d + r; const float dec = (iad >= jad) ? __builtin_amdgcn_exp2f(lg * (float)(iad - jad)) : 0.f;
                        *(LAS bf16*)(L + SS_OFF + ia * SS + ja * 2) = (bf16)f2bf(acc[r] * dec); }
                }
            }
            __syncthreads();
            bf16x8 Vf[4];
            { v2u tr[8]; tr_read8<0, RS>(trbV, tr);
#pragma unroll
              for (int ks = 0; ks < 4; ++ks) { v4u wv; wv.x = tr[2 * ks].x; wv.y = tr[2 * ks].y; wv.z = tr[2 * ks + 1].x; wv.w = tr[2 * ks + 1].y; Vf[ks] = __builtin_bit_cast(bf16x8, wv); } }
            {
                f32x16 Oa[2];
#pragma unroll
                for (int it = 0; it < 2; ++it)
#pragma unroll
                    for (int i = 0; i < 16; ++i) Oa[it][i] = 0.f;
#pragma unroll
                for (int dt = 0; dt < 8; ++dt)
#pragma unroll
                    for (int s = 0; s < 2; ++s) {
                        v4u bw; bw.x = pk2(R[dt][8 * s + 0], R[dt][8 * s + 1]); bw.y = pk2(R[dt][8 * s + 2], R[dt][8 * s + 3]); bw.z = pk2(R[dt][8 * s + 4], R[dt][8 * s + 5]); bw.w = pk2(R[dt][8 * s + 6], R[dt][8 * s + 7]);
#pragma unroll
                        for (int it = 0; it < 2; ++it) {
                            const LAS unsigned char* qrow = L + QS_OFF + (32 * it + n) * RS;
                            const v2u lo = *(const LAS v2u*)(qrow + (32 * dt + 16 * s + 4 * h) * 2), hi = *(const LAS v2u*)(qrow + (32 * dt + 16 * s + 8 + 4 * h) * 2);
                            v4u aw; aw.x = lo.x; aw.y = lo.y; aw.z = hi.x; aw.w = hi.y;
                            Oa[it] = __builtin_amdgcn_mfma_f32_32x32x16_bf16(__builtin_bit_cast(bf16x8, aw), __builtin_bit_cast(bf16x8, bw), Oa[it], 0, 0, 0);
                        }
                    }
#pragma unroll
                for (int it = 0; it < 2; ++it) {
#pragma unroll
                    for (int i = 0; i < 16; ++i) { const int ia = 32 * it + 8 * (i >> 2) + 4 * h + (i & 3); Oa[it][i] *= __builtin_amdgcn_exp2f(lg * (float)(32 * it + 8 * (i >> 2) + 4 * hl + (i & 3) + 1)); }
#pragma unroll
                    for (int ks = 0; ks < 4; ++ks) if (ks < 2 * (it + 1)) {
                        const bf16x8 Sf = *(const LAS bf16x8*)(L + SS_OFF + (32 * it + n) * SS + (16 * ks + 8 * h) * 2);
                        Oa[it] = __builtin_amdgcn_mfma_f32_32x32x16_bf16(Sf, Vf[ks], Oa[it], 0, 0, 0);
                    }
#pragma unroll
                    for (int i = 0; i < 16; ++i) { const int ia = 32 * it + 8 * (i >> 2) + 4 * h + (i & 3);
                        *(LAS bf16*)(L + VS_OFF + ia * RS + (32 * w + n) * 2) = (bf16)f2bf(Oa[it][i]); }
                }
            }
            bf16x8 Vs2[4];
#pragma unroll
            for (int ks = 0; ks < 4; ++ks) { const v4u wv = __builtin_bit_cast(v4u, Vf[ks]); float f[8] = {bflo(wv.x), bfhi(wv.x), bflo(wv.y), bfhi(wv.y), bflo(wv.z), bfhi(wv.z), bflo(wv.w), bfhi(wv.w)};
#pragma unroll
                for (int j = 0; j < 8; ++j) { const int key = 16 * ks + 8 * hl + j; f[j] *= __builtin_amdgcn_exp2f(lg * (float)(63 - key)); }
                v4u o; o.x = pk2(f[0], f[1]); o.y = pk2(f[2], f[3]); o.z = pk2(f[4], f[5]); o.w = pk2(f[6], f[7]); Vs2[ks] = __builtin_bit_cast(bf16x8, o); }
#define RC_DT(dt) { _Pragma("unroll") for (int i = 0; i < 16; ++i) R[dt][i] *= cdec; v2u tr[8]; tr_read8<KS_OFF + 64 * (dt), RS>(trbK, tr); \
                _Pragma("unroll") for (int ks = 0; ks < 4; ++ks) { v4u aw; aw.x = tr[2 * ks].x; aw.y = tr[2 * ks].y; aw.z = tr[2 * ks + 1].x; aw.w = tr[2 * ks + 1].y; \
                    R[dt] = __builtin_amdgcn_mfma_f32_32x32x16_bf16(__builtin_bit_cast(bf16x8, aw), Vs2[ks], R[dt], 0, 0, 0); } }
            RC_DT(0) RC_DT(1) RC_DT(2) RC_DT(3) RC_DT(4) RC_DT(5) RC_DT(6) RC_DT(7)
#undef RC_DT
            __syncthreads();
#pragma unroll
            for (int i = 0; i < 4; ++i) { const int e = tid + NTHR * i, row = e >> 5, ch = e & 31;
                const v4u ov = *(const LAS v4u*)(L + VS_OFF + row * RS + ch * 16);
                *(v4u*)(Vg + (size_t)(t0 + row) * 2048 + hh * 512 + eh * 256 + ch * 8) = ov;
                const float f[8] = {bflo(ov.x), bfhi(ov.x), bflo(ov.y), bfhi(ov.y), bflo(ov.z), bfhi(ov.z), bflo(ov.w), bfhi(ov.w)};
                float s = 0.f, s2 = 0.f;
#pragma unroll
                for (int j = 0; j < 8; ++j) { s += f[j]; s2 += f[j] * f[j]; }
#pragma unroll
                for (int o = 1; o < 32; o <<= 1) { s += __shfl_xor(s, o); s2 += __shfl_xor(s2, o); }
                if ((tid & 31) == 0) { f32x2 st = {s, s2}; *(f32x2*)(STAT + (size_t)(t0 + row) * 16 + hh * 4 + eh * 2) = st; }
            }
        }
    }
}

__host__ __device__ __forceinline__ bool slot_active(int kind, int s) {
    if (s == 2) return kind != 1;
    if (s == 3 || s == 4) return kind == 0;
    if (s == 10) return false;
    return true;
}

#ifndef MK_EN
#define MK_EN 0xffffffffu
#endif
#define EN(b) ((MK_EN >> (b)) & 1u)
template <int PROBE>
__global__ void __launch_bounds__(NTHR, 2) mk_fwd_t(Params p) {
    extern __shared__ __attribute__((aligned(16))) unsigned char lds_raw[];
    Ctx c;
    c.lds = (LAS unsigned char*)lds_raw; c.tid = threadIdx.x; c.lane = c.tid & 63; c.wave = __builtin_amdgcn_readfirstlane(c.tid >> 6);
    c.bid = blockIdx.x; c.G = gridDim.x; c.in = (InTab)(unsigned long)__builtin_amdgcn_kernarg_segment_ptr(); c.out = p.out; c.ws = p.ws;
    volatile LAS unsigned* MISC = (volatile LAS unsigned*)(c.lds + MISC_OFF);
    for (int u = c.tid; u < (LDS_BYTES - LDSCTL_OFF) / 4; u += NTHR) ((LAS unsigned*)(c.lds + LDSCTL_OFF))[u] = 0u;
    __syncthreads();
    const bool one = (p.flags & 1) != 0;
    XcdBarrier bar; bar.bar = (unsigned*)(p.ws + WS_CTL) + CW_BAR; bar.x = 0; bar.st = MISC + 8;
    if (one) bar = xcd_barrier_post((unsigned*)(p.ws + WS_CTL) + CW_BAR, MISC + 8);
    const int lo = p.ph_lo, hi = p.ph_hi;
#define IN(k) (lo <= (k) && (k) < hi)
#if MK_PROBE
#define STAMP(k) do { if (blockIdx.x == 0 && threadIdx.x == 0) ((unsigned long long*)(p.ws + WS_CTL + 65536))[k] = __builtin_amdgcn_s_memrealtime(); } while (0)
#else
#define STAMP(k) do {} while (0)
#endif
#define LCTX() Ctx cl = c; { unsigned long k_ = (unsigned long)__builtin_amdgcn_kernarg_segment_ptr(); unsigned long w_ = (unsigned long)p.ws, o_ = (unsigned long)p.out; int t_ = threadIdx.x; asm volatile("" : "+s"(k_), "+s"(w_), "+s"(o_), "+v"(t_)); cl.tid = t_; cl.lane = t_ & 63; cl.wave = __builtin_amdgcn_readfirstlane(t_ >> 6); cl.in = (InTab)k_; cl.ws = (unsigned char*)(GAS unsigned char*)w_; cl.out = (float*)(GAS float*)o_; } unsigned char* ws = cl.ws; (void)ws
#define SEAM(k) do { if (one && IN(k) && (k) + 1 < hi) xcd_barrier(bar); } while (0)
    STAMP(0);
    if (EN(0) && IN(0)) { LCTX(); phase_prologue(cl); }
    SEAM(0);
#pragma unroll 1
    for (int layer = 0; layer < 4; ++layer) {
        const int kind = layer % 3, j = layer / 3, base = 1 + layer * NPH_LAYER;
        const size_t xin_off = (layer & 1) ? WS_XB1 : WS_XB0, xnext_off = (layer & 1) ? WS_XB0 : WS_XB1;
#define xin ((const bf16*)(ws + xin_off))
#define xnext ((bf16*)(ws + xnext_off))
        STAMP(base + 0);
        if (IN(base + 0)) { LCTX();
            if (EN(1) && kind == 0) { bf16* RAWb = (bf16*)(ws + WS_M + M_RAW); EpiBf16R<0> E{RAWb, RAWb, RAWb, 512, 512, 512, 1 << 30, 1 << 30};
                run_gemm(cl, xin, (const bf16*)(ws + WS_WAIN) + (size_t)j * 512 * 1024, 512, 1024, E); }
            else if (EN(2) && kind == 1) { bf16* GU = (bf16*)(ws + WS_M + M_GU); EpiBf16R<1> E{GU, GU + 1280, GU + 1280, 2560, 2560, 2560, 1280, 1 << 30};
                run_gemm(cl, xin, (const bf16*)(ws + WS_WBIN), 2560, 1024, E); }
            else if (EN(3) && kind == 2) { EpiRetIn E{(bf16*)(ws + WS_M + M_Q), (bf16*)(ws + WS_M + M_K), (bf16*)(ws + WS_M + M_V), (const float*)(ws + WS_ROT), (const float*)(ws + WS_ROT) + 2048 * 128};
                run_gemm(cl, xin, (const bf16*)(ws + WS_WCIN), 4096, 1024, E); }
        }
        SEAM(base + 0);
        STAMP(base + 1);
        if (IN(base + 1)) { LCTX();
            if (EN(4) && kind == 0) phase_dsa_norm(cl, j);
            else if (EN(5) && kind == 1) phase_rglru(cl);
            else if (EN(6) && kind == 2) phase_ret_core(cl);
        }
        SEAM(base + 1);
        STAMP(base + 2);
        if (IN(base + 2) && kind != 1) { LCTX();
            if (EN(7) && kind == 0) { EpiBf16R<0> E{(bf16*)(ws + WS_M + M_QLAT), (bf16*)(ws + WS_M + M_QIDX), (bf16*)(ws + WS_M + M_QIDX), 2048, 512, 512, 2048, 1 << 30};
                run_gemm(cl, (const bf16*)(ws + WS_M + M_CQ), (const bf16*)(ws + WS_WAQ + j * WAQ_STRIDE), 2560, 256, E); }
            else if (EN(8) && kind == 2) { EpiRetGate E{(bf16*)(ws + WS_M + M_V), (const float*)(ws + WS_M + M_STAT)};
                run_gemm(cl, xin, (const bf16*)(ws + WS_WCIN) + (size_t)4096 * 1024, 2048, 1024, E); }
        }
        if (kind != 1) SEAM(base + 2);
        STAMP(base + 3);
        if (EN(9) && IN(base + 3) && kind == 0) { LCTX(); phase_dsa_index(cl); }
        if (kind == 0) SEAM(base + 3);
        STAMP(base + 4);
        if (EN(10) && IN(base + 4) && kind == 0) { LCTX(); phase_dsa_attn(cl); }
        if (kind == 0) SEAM(base + 4);
        STAMP(base + 5);
        if (EN(11) && IN(base + 5)) { LCTX();
            const bf16* A = (const bf16*)(ws + WS_M + (kind == 0 ? M_QLAT : (kind == 1 ? M_Y : M_V)));
            const bf16* Bt = kind == 0 ? (const bf16*)(ws + WS_WAOV) + (size_t)j * 1024 * 2048 : (kind == 1 ? (const bf16*)(ws + WS_WBO) : (const bf16*)(ws + WS_WCO));
            const int K = kind == 1 ? 1280 : 2048;
            EpiResid E{(bf16*)xin, ALPHA_DN, xin};
            run_gemm(cl, A, Bt, 1024, K, E);
        }
        SEAM(base + 5);
        STAMP(base + 6);
        if (EN(12) && IN(base + 6)) { LCTX(); phase_ln1(cl, layer); }
        SEAM(base + 6);
        STAMP(base + 7);
        if (EN(13) && IN(base + 7)) { LCTX(); EpiF32T E{(bf16*)(ws + WS_M + M_SC)};
            run_gemm(cl, xin, (const bf16*)(ws + WS_WPEER) + (size_t)layer * 2048 * 1024, 2048, 1024, E);
            bf16* PP = (bf16*)(ws + WS_PP); EpiBf16R<0> E2{PP, PP, PP, 1024, 1024, 1024, 1 << 30, 1 << 30};
            run_gemm(cl, (const bf16*)(ws + WS_M + M_PB), (const bf16*)(ws + WS_WPLEP) + (size_t)layer * 1024 * 256, 1024, 256, E2); }
        SEAM(base + 7);
        STAMP(base + 8);
        if (EN(14) && IN(base + 8)) { LCTX(); phase_peer_topk(cl); }
        SEAM(base + 8);
        STAMP(base + 9);
        if (EN(15) && IN(base + 9)) { LCTX(); phase_peer_gather(cl, layer, [&]() {}); }
        SEAM(base + 9);
        STAMP(base + 11);
        if (EN(17) && IN(base + 11)) { LCTX(); EpiPle E{xin, (const bf16*)(ws + WS_PP), xnext, INP(cl, I_PLE_BG) + layer * DM, layer == 3 ? cl.out : nullptr};
            run_gemm(cl, xin, (const bf16*)(ws + WS_WPLEG) + (size_t)layer * 1024 * 1024, 1024, 1024, E); }
        SEAM(base + 11);
    }
#if MK_PROBE
    xcd_barrier(bar);
    STAMP(N_PHASES);
    xcd_barrier(bar);
    {
        const unsigned long long* TS = (const unsigned long long*)(p.ws + WS_CTL + 65536);
        float tA = 0.f, tC = 0.f;
        for (int k = 0; k < N_PHASES; ++k) {
            int type = 0;
            if (k > 0) { const int layer = (k - 1) / NPH_LAYER, s = (k - 1) % NPH_LAYER, kind = layer % 3;
                if (!slot_active(kind, s)) continue;
                type = s == 0 ? 1 + kind : s == 1 ? 4 + kind : s == 2 ? (kind == 0 ? 7 : 8) : s == 3 ? 9 : s == 4 ? 10 : 6 + s; }
            const float us = (float)(TS[k + 1] - TS[k]) * 0.01f;
            if ((MK_PROBE_A >> type) & 1u) tA += us;
            if ((MK_PROBE_C >> type) & 1u) tC += us;
        }
        for (size_t i = (size_t)blockIdx.x * NTHR + threadIdx.x; i < (size_t)T_TOK * DM; i += (size_t)gridDim.x * NTHR) p.out[i] = (i == 0) ? 100.f * tA : tC;
    }
#endif
#undef IN
#undef SEAM
#undef xin
#undef xnext
#undef LCTX
}

#if MK_CHECK
#include "CHECKS_PLACEHOLDER"
#endif

#define mk_fwd mk_fwd_t<0>
extern "C" void kernel_launch(void* const* d_in, const int* in_sizes, int n_in, void* d_out, int out_size, void* d_ws, size_t ws_size, hipStream_t stream) {
    static int grid = 0;
    if (grid == 0) {
        if (n_in != N_IN || out_size != T_TOK * DM || ws_size < WS_END) { fprintf(stderr, "kernel_launch: unexpected shapes (n_in %d out %d ws %zu need %zu)\n", n_in, out_size, ws_size, (size_t)WS_END); grid = -1; return; }
        int dev = 0, cus = 0, per_cu = 0;
        if (hipGetDevice(&dev) != hipSuccess || hipDeviceGetAttribute(&cus, hipDeviceAttributeMultiprocessorCount, dev) != hipSuccess) { grid = -1; return; }
        if (hipFuncSetAttribute((const void*)mk_fwd, hipFuncAttributeMaxDynamicSharedMemorySize, LDS_BYTES) != hipSuccess) { fprintf(stderr, "hipFuncSetAttribute failed\n"); grid = -1; return; }
        if (hipOccupancyMaxActiveBlocksPerMultiprocessor(&per_cu, (const void*)mk_fwd, NTHR, LDS_BYTES) != hipSuccess || per_cu < 1) { fprintf(stderr, "occupancy query: %d\n", per_cu); }
        (void)hipGetLastError();
        grid = cus;
    }
    if (grid < 0) return;
    (void)hipMemsetAsync((char*)d_ws + WS_CTL, 0, CTL_BYTES, stream);
    Params p{};
    for (int i = 0; i < N_IN; ++i) p.in[i] = (const float*)d_in[i];
    p.out = (float*)d_out; p.ws = (unsigned char*)d_ws; p.pad = 0;
#if MK_ONE_LAUNCH
#if MK_REPEAT_K >= 0
    p.ph_lo = 0; p.ph_hi = MK_REPEAT_K + 1; p.flags = 1 | MK_PROBE_FLAGS;
    (void)hipFuncSetAttribute((const void*)mk_fwd_t<MK_PROBE_KERNEL>, hipFuncAttributeMaxDynamicSharedMemorySize, LDS_BYTES);
    hipLaunchKernelGGL(mk_fwd_t<MK_PROBE_KERNEL>, dim3(grid), dim3(NTHR), LDS_BYTES, stream, p);
    (void)hipMemsetAsync((char*)d_ws + WS_CTL, 0, CTL_BYTES, stream);
#endif
    p.ph_lo = 0; p.ph_hi = N_PHASES; p.flags = 1;
    hipLaunchKernelGGL(mk_fwd, dim3(grid), dim3(NTHR), LDS_BYTES, stream, p);
#else
    p.flags = 0;
    for (int ph = 0; ph < N_PHASES; ++ph) {
        if (ph > 0) { const int layer = (ph - 1) / NPH_LAYER, s = (ph - 1) % NPH_LAYER; if (!slot_active(layer % 3, s)) continue; }
        p.ph_lo = ph; p.ph_hi = ph + 1;
#if MK_CHECK
        check_pre(ph, p, grid, stream);
#endif
        hipLaunchKernelGGL(mk_fwd, dim3(grid), dim3(NTHR), LDS_BYTES, stream, p);
#if MK_CHECK
        check_post(ph, p, grid, stream);
#endif
    }
#if MK_CHECK
    check_report(p, stream);
#endif
#endif
}
```

```cpp
#define MK_CHECK 0
#define MK_ONE_LAUNCH 1
#include <cstdio>
#include <cmath>
#include <type_traits>
#include <hip/hip_runtime.h>
namespace pg8 {
#define PG8_LAS __attribute__((address_space(3)))
typedef unsigned short bf16_t;
typedef short bf16x8 __attribute__((ext_vector_type(8)));
typedef float f32x4 __attribute__((ext_vector_type(4)));
typedef unsigned u32x4 __attribute__((ext_vector_type(4)));
constexpr int BM = 256, BK = 64, HALF = 128, HTB = HALF * BK * 2  , STAGE_BYTES = 8 * HTB, NXCD = 8, WGM = 8;

__host__ __device__ __forceinline__ int lds_byte(int r, int c) { const int st = (r >> 4) * 2 + (c >> 5), rr = r & 15, cc = c & 31, ob = rr * 64 + cc * 2; return st * 1024 + (ob ^ (((ob >> 9) & 1) << 5)); }
__host__ __device__ __forceinline__ void stage_rc(int b, int& R, int& C) { const int st = b / 1024, sb = b % 1024, swz = sb ^ (((sb >> 9) & 1) << 5); R = (st >> 1) * 16 + swz / 64; C = (st & 1) * 32 + (swz % 64) / 2; }
__host__ __device__ __forceinline__ int perm32(int rho) { const int n = rho >> 4, i = rho & 15; return 8 * (i >> 2) + 4 * n + (i & 3); }

struct Unit { int pm, pn; };
struct Gemm { const bf16_t* A; const bf16_t* Bt; int M, N, K; };

struct StaticOrder {
    int nM, nN, nwg, G, c;
    __host__ __device__ void init(int M, int N, int G_, int c_) { nM = M / BM; nN = N / BM; nwg = nM * nN; G = G_; c = c_; }
    __host__ __device__ bool next(int i, Unit& u) const {
        const long L = (long)i * G + c; if (L >= nwg) return false;
        int wgid = (int)L; { const int q = nwg / NXCD, r = nwg % NXCD, xcd = wgid % NXCD, off = wgid / NXCD; wgid = (xcd < r ? xcd * (q + 1) : r * (q + 1) + (xcd - r) * q) + off; }
        const int nig = WGM * nN, gid = wgid / nig, fm = gid * WGM, gsz = (nM - fm) < WGM ? (nM - fm) : WGM;
        u.pm = fm + ((wgid % nig) % gsz); u.pn = (wgid % nig) / gsz; return true;
    }
    __device__ __forceinline__ void a_ready(const Unit&) const {}
    __device__ __forceinline__ void done(const Unit&) const {}
};
struct CountedOrder : StaticOrder {
    const unsigned* ready; unsigned need; unsigned* tmo;
    __device__ __forceinline__ void a_ready(const Unit& u) const {
        if (threadIdx.x < 64) {
            const unsigned long long t0 = __builtin_amdgcn_s_memrealtime(); unsigned polls = 0;
            while ((unsigned)__builtin_amdgcn_readfirstlane(__hip_atomic_load(ready + 64 * u.pm, __ATOMIC_RELAXED, __HIP_MEMORY_SCOPE_AGENT)) < need) {
                if ((++polls & 255u) == 0u && __builtin_amdgcn_readfirstlane(__hip_atomic_load(tmo, __ATOMIC_RELAXED, __HIP_MEMORY_SCOPE_AGENT)) != 0u) break;
                if (__builtin_amdgcn_s_memrealtime() - t0 > 2000000ull) {
                    if (threadIdx.x == 0) { unsigned expect = 0u; __hip_atomic_compare_exchange_strong(tmo + 1, &expect, 0x600u | (unsigned)(u.pm & 0xff), __ATOMIC_RELAXED, __ATOMIC_RELAXED, __HIP_MEMORY_SCOPE_AGENT); __hip_atomic_store(tmo, 1u, __ATOMIC_RELAXED, __HIP_MEMORY_SCOPE_AGENT); }
                    break; }
                __builtin_amdgcn_s_sleep(2); }
            __builtin_amdgcn_fence(__ATOMIC_ACQUIRE, "agent");
            asm volatile("s_waitcnt vmcnt(0)" ::: "memory");
        }
#if !defined(BROKEN_HOOK_NO_BARRIER)
        asm volatile("" ::: "memory"); __builtin_amdgcn_s_barrier(); asm volatile("" ::: "memory");
#endif
    }
};

__device__ __forceinline__ unsigned cvt_pk_bf16(float lo, float hi) { unsigned r; asm volatile("v_cvt_pk_bf16_f32 %0, %1, %2" : "=v"(r) : "v"(lo), "v"(hi)); return r; }
typedef float f32x2 __attribute__((ext_vector_type(2)));
__device__ __forceinline__ f32x2 gelu_pk(f32x2 v) {
    const f32x2 av = __builtin_elementwise_abs(v), d = av * 0.2316418882f + 1.0f;
    f32x2 t; t.x = __builtin_amdgcn_rcpf(d.x); t.y = __builtin_amdgcn_rcpf(d.y);
    f32x2 q = t * 0.5307027145f + (-0.7265760135f); q = q * t + 0.7107068705f; q = q * t + (-0.142248368f); q = q * t + 0.127414796f; q = q * t;
    const f32x2 s = (v * v) * (-0.72134752044f);
    f32x2 e; e.x = __builtin_amdgcn_exp2f(s.x); e.y = __builtin_amdgcn_exp2f(s.y);
    const f32x2 m = v * (q * e), r = v - m;
    f32x2 o; o.x = v.x < 0.f ? m.x : r.x; o.y = v.y < 0.f ? m.y : r.y; return o;
}

struct EpiF32 {
    static constexpr bool PERM = false, AFTER_DRAIN = false;
    float* C; int ldc; const float* bias;
    __device__ __forceinline__ void operator()(const f32x4 (&acc)[2][2][4][2], const Unit& u, int wr, int wc, int fr, int fq) const {
        const int row0 = u.pm * BM + wr * 64 + fr, col0 = u.pn * BM + wc * 32 + 4 * fq;
        f32x4 bv[2][2];
#pragma unroll
        for (int bj = 0; bj < 2; ++bj)
#pragma unroll
            for (int n = 0; n < 2; ++n) bv[bj][n] = bias ? *(const f32x4*)(bias + col0 + bj * HALF + n * 16) : (f32x4){0.f, 0.f, 0.f, 0.f};
#pragma unroll
        for (int ai = 0; ai < 2; ++ai)
#pragma unroll
            for (int m = 0; m < 4; ++m) { float* rowp = C + (size_t)(row0 + ai * HALF + m * 16) * ldc + col0;
#pragma unroll
                for (int bj = 0; bj < 2; ++bj)
#pragma unroll
                    for (int n = 0; n < 2; ++n) *(f32x4*)(rowp + bj * HALF + n * 16) = acc[ai][bj][m][n] + bv[bj][n]; }
    }
};
template <int ACT  > struct EpiBf16 {
    static constexpr bool PERM = true, AFTER_DRAIN = false;
    bf16_t* O; int ldc; const float* bias; int split_cols; size_t split_stride;
    __device__ __forceinline__ void operator()(const f32x4 (&acc)[2][2][4][2], const Unit& u, int wr, int wc, int fr, int fq) const {
        const int row0 = u.pm * BM + wr * 64 + fr; int colt = u.pn * BM; bf16_t* base = O;
        if (split_cols) { const int t = colt / split_cols; base += (size_t)t * split_stride; colt -= t * split_cols; }
        const int col0 = colt + wc * 32 + 8 * fq, bcol0 = u.pn * BM + wc * 32 + 8 * fq;
        f32x4 bv[2][2];
#pragma unroll
        for (int bj = 0; bj < 2; ++bj)
#pragma unroll
            for (int n = 0; n < 2; ++n) bv[bj][n] = bias ? *(const f32x4*)(bias + bcol0 + bj * HALF + 4 * n) : (f32x4){0.f, 0.f, 0.f, 0.f};
#pragma unroll
        for (int ai = 0; ai < 2; ++ai)
#pragma unroll
            for (int m = 0; m < 4; ++m) { bf16_t* rowp = base + (size_t)(row0 + ai * HALF + m * 16) * ldc + col0;
#pragma unroll
                for (int bj = 0; bj < 2; ++bj) { f32x4 v0 = acc[ai][bj][m][0] + bv[bj][0], v1 = acc[ai][bj][m][1] + bv[bj][1];
                    if (ACT == 1) { f32x2 a = gelu_pk((f32x2){v0[0], v0[1]}), b = gelu_pk((f32x2){v0[2], v0[3]}), c = gelu_pk((f32x2){v1[0], v1[1]}), d = gelu_pk((f32x2){v1[2], v1[3]});
                        v0 = (f32x4){a.x, a.y, b.x, b.y}; v1 = (f32x4){c.x, c.y, d.x, d.y}; }
                    if (ACT == 2) {
#pragma unroll
                        for (int j = 0; j < 4; ++j) { v0[j] = 0.5f * v0[j] * (1.0f + erff(v0[j] * 0.70710678f)); v1[j] = 0.5f * v1[j] * (1.0f + erff(v1[j] * 0.70710678f)); } }
                    u32x4 w; w.x = cvt_pk_bf16(v0[0], v0[1]); w.y = cvt_pk_bf16(v0[2], v0[3]); w.z = cvt_pk_bf16(v1[0], v1[1]); w.w = cvt_pk_bf16(v1[2], v1[3]);
                    *(u32x4*)(rowp + bj * HALF) = w; } }
    }
};

struct PanelStats {
    unsigned* xbuf;
    unsigned* cnt;
    unsigned* tmo;
    int ntn; float eps;
    unsigned code;
    __device__ __forceinline__ bool run(const f32x4 (&v)[2][2][4][2], const Unit& u, int wr, int wc, int fr, int fq, PG8_LAS unsigned char* lds, int wid, int lane) const {
        typedef float f32x2v __attribute__((ext_vector_type(2)));
        PG8_LAS f32x2v* P = (PG8_LAS f32x2v*)lds;
        PG8_LAS f32x2v* S = (PG8_LAS f32x2v*)(lds + 8192);
        PG8_LAS unsigned* flag = (PG8_LAS unsigned*)(lds + 8192 + 2048);
#pragma unroll
        for (int ai = 0; ai < 2; ++ai)
#pragma unroll
            for (int m = 0; m < 4; ++m) {
                float s = 0.f;
#pragma unroll
                for (int bj = 0; bj < 2; ++bj)
#pragma unroll
                    for (int n = 0; n < 2; ++n) { const f32x4 x = v[ai][bj][m][n]; s += (x[0] + x[1]) + (x[2] + x[3]); }
                s += __shfl_xor(s, 16); s += __shfl_xor(s, 32);
                const float mw = s * (1.0f / 64.0f); float q = 0.f;
#pragma unroll
                for (int bj = 0; bj < 2; ++bj)
#pragma unroll
                    for (int n = 0; n < 2; ++n) { const f32x4 d = v[ai][bj][m][n] - mw; q += (d[0] * d[0] + d[1] * d[1]) + (d[2] * d[2] + d[3] * d[3]); }
                q += __shfl_xor(q, 16); q += __shfl_xor(q, 32);
                if (fq == 0) P[(ai * HALF + wr * 64 + m * 16 + fr) * 4 + wc] = (f32x2v){mw, q};
            }
        asm volatile("s_waitcnt lgkmcnt(0)" ::: "memory"); __builtin_amdgcn_s_barrier(); asm volatile("" ::: "memory");
#if defined(BROKEN_NO_WAIT)
        if (blockIdx.x >= 64) { const long long t0 = clock64(); while (clock64() - t0 < 60000) __builtin_amdgcn_s_sleep(8); }
#endif
        const int row = wid * 32 + (lane & 31);
        if (lane < 32) {
            const f32x2v a = P[row * 4 + 0], b = P[row * 4 + 1], c = P[row * 4 + 2], d = P[row * 4 + 3];
            const float mt = (a.x + b.x + c.x + d.x) * 0.25f;
            const float da = a.x - mt, db = b.x - mt, dc = c.x - mt, dd = d.x - mt;
            const float m2 = (a.y + b.y) + (c.y + d.y) + 64.0f * ((da * da + db * db) + (dc * dc + dd * dd));
            unsigned long long* slot = (unsigned long long*)xbuf + ((size_t)(u.pm * BM + row) * 4 + u.pn);
            __hip_atomic_store(slot, ((unsigned long long)__float_as_uint(m2) << 32) | __float_as_uint(mt), __ATOMIC_RELAXED, __HIP_MEMORY_SCOPE_AGENT);
        }
        asm volatile("s_waitcnt vmcnt(0)" ::: "memory");
        if (lane == 0) __hip_atomic_fetch_add(cnt + 64 * u.pm, 1u, __ATOMIC_RELAXED, __HIP_MEMORY_SCOPE_AGENT);
        if (wid == 0) {
            bool dead = false; const unsigned long long t0 = __builtin_amdgcn_s_memrealtime(); const unsigned want = 8u * (unsigned)ntn;
            for (;;) {
#if defined(BROKEN_NO_WAIT)
                break;
#endif
                if ((unsigned)__builtin_amdgcn_readfirstlane(__hip_atomic_load(cnt + 64 * u.pm, __ATOMIC_RELAXED, __HIP_MEMORY_SCOPE_AGENT)) >= want) break;
                if (__builtin_amdgcn_s_memrealtime() - t0 > 2000000ull) {
                    if (lane == 0) { unsigned expect = 0u; __hip_atomic_compare_exchange_strong(tmo + 1, &expect, code | (unsigned)(u.pm & 0xff), __ATOMIC_RELAXED, __ATOMIC_RELAXED, __HIP_MEMORY_SCOPE_AGENT);
                                     __hip_atomic_store(tmo, 1u, __ATOMIC_RELAXED, __HIP_MEMORY_SCOPE_AGENT); }
                    dead = true; break; }
                __builtin_amdgcn_s_sleep(2);
            }
            __builtin_amdgcn_fence(__ATOMIC_ACQUIRE, "agent");
            if (lane == 0) flag[0] = dead ? 1u : 0u;
        }
        asm volatile("s_waitcnt vmcnt(0) lgkmcnt(0)" ::: "memory"); __builtin_amdgcn_s_barrier(); asm volatile("" ::: "memory");
        const bool bad = flag[0] != 0u;
        if (lane < 32) {
            const unsigned long long* slot = (const unsigned long long*)xbuf + (size_t)(u.pm * BM + row) * 4; float mt[4], m2[4]; float ms = 0.f;
#pragma unroll
            for (int t = 0; t < 4; ++t) { if (t < ntn) { const unsigned long long w = __hip_atomic_load(slot + t, __ATOMIC_RELAXED, __HIP_MEMORY_SCOPE_AGENT); mt[t] = __uint_as_float((unsigned)w); m2[t] = __uint_as_float((unsigned)(w >> 32)); } else { mt[t] = 0.f; m2[t] = 0.f; } ms += mt[t]; }
            const float mean = ms / (float)ntn; float q = 0.f;
#pragma unroll
            for (int t = 0; t < 4; ++t) if (t < ntn) { const float dm = mt[t] - mean; q += m2[t] + 256.0f * dm * dm; }
            S[row] = (f32x2v){mean, 1.0f / sqrtf(q / (256.0f * (float)ntn) + eps)};
        }
        asm volatile("s_waitcnt lgkmcnt(0)" ::: "memory"); __builtin_amdgcn_s_barrier(); asm volatile("" ::: "memory");
        return bad;
    }
};
struct EpiLnRes {
    static constexpr bool PERM = false, AFTER_DRAIN = true;
    const float* base; float* out; int ldc; const float* bias; PanelStats st; unsigned poison;
    __device__ __forceinline__ void refuse(size_t i0, size_t stride, int M, int N) const { const float q = __builtin_nanf(""); for (size_t i = i0; i < (size_t)M * N; i += stride) out[(i / N) * ldc + i % N] = q;
        if (i0 == 0) { unsigned expect = 0u; __hip_atomic_compare_exchange_strong(st.tmo + 1, &expect, 0x7f0u, __ATOMIC_RELAXED, __ATOMIC_RELAXED, __HIP_MEMORY_SCOPE_AGENT); __hip_atomic_store(st.tmo, 1u, __ATOMIC_RELAXED, __HIP_MEMORY_SCOPE_AGENT); } }
    __device__ __forceinline__ void fused(f32x4 (&acc)[2][2][4][2], const Unit& u, int wr, int wc, int fr, int fq, PG8_LAS unsigned char* lds, int wid, int lane) const {
        typedef float f32x2v __attribute__((ext_vector_type(2)));
        const PG8_LAS f32x2v* S = (const PG8_LAS f32x2v*)(lds + 8192);
        const int col0 = u.pn * BM + wc * 32 + 4 * fq;
#pragma unroll
        for (int bj = 0; bj < 2; ++bj)
#pragma unroll
            for (int n = 0; n < 2; ++n) { const f32x4 bv = bias ? *(const f32x4*)(bias + col0 + bj * HALF + n * 16) : (f32x4){0.f, 0.f, 0.f, 0.f};
#pragma unroll
                for (int ai = 0; ai < 2; ++ai)
#pragma unroll
                    for (int m = 0; m < 4; ++m) acc[ai][bj][m][n] += bv; }
        const bool bad = st.run(acc, u, wr, wc, fr, fq, lds, wid, lane) || poison != 0u;
        const float qnan = __builtin_nanf("");
#pragma unroll
        for (int ai = 0; ai < 2; ++ai)
#pragma unroll
            for (int m = 0; m < 4; ++m) { const int r = ai * HALF + wr * 64 + m * 16 + fr; const f32x2v sr = S[r]; const size_t off = (size_t)(u.pm * BM + r) * ldc + col0;
#pragma unroll
                for (int bj = 0; bj < 2; ++bj)
#pragma unroll
                    for (int n = 0; n < 2; ++n) { const f32x4 bs = *(const f32x4*)(base + off + bj * HALF + n * 16); f32x4 o = bs + (acc[ai][bj][m][n] - sr.x) * sr.y;
                        if (bad) o = (f32x4){qnan, qnan, qnan, qnan}; *(f32x4*)(out + off + bj * HALF + n * 16) = o; }
                asm volatile("" ::: "memory"); }
    }
};
struct EpiLnResLn {
    static constexpr bool PERM = false, AFTER_DRAIN = true;
    const float* base; float* out; bf16_t* xn; int ldc; const float* bias; PanelStats st1, st2; unsigned poison;
    __device__ __forceinline__ void refuse(size_t i0, size_t stride, int M, int N) const { const float q = __builtin_nanf(""); for (size_t i = i0; i < (size_t)M * N; i += stride) { const size_t o = (i / N) * ldc + i % N; out[o] = q; xn[o] = (bf16_t)0x7fc0u; }
        if (i0 == 0) { unsigned expect = 0u; __hip_atomic_compare_exchange_strong(st1.tmo + 1, &expect, 0x7f0u, __ATOMIC_RELAXED, __ATOMIC_RELAXED, __HIP_MEMORY_SCOPE_AGENT); __hip_atomic_store(st1.tmo, 1u, __ATOMIC_RELAXED, __HIP_MEMORY_SCOPE_AGENT); } }
    __device__ __forceinline__ void fused(f32x4 (&acc)[2][2][4][2], const Unit& u, int wr, int wc, int fr, int fq, PG8_LAS unsigned char* lds, int wid, int lane) const {
        typedef float f32x2v __attribute__((ext_vector_type(2))); typedef unsigned u32x2v __attribute__((ext_vector_type(2)));
        const PG8_LAS f32x2v* S = (const PG8_LAS f32x2v*)(lds + 8192);
        const int col0 = u.pn * BM + wc * 32 + 4 * fq;
#pragma unroll
        for (int bj = 0; bj < 2; ++bj)
#pragma unroll
            for (int n = 0; n < 2; ++n) { const f32x4 bv = bias ? *(const f32x4*)(bias + col0 + bj * HALF + n * 16) : (f32x4){0.f, 0.f, 0.f, 0.f};
#pragma unroll
                for (int ai = 0; ai < 2; ++ai)
#pragma unroll
                    for (int m = 0; m < 4; ++m) acc[ai][bj][m][n] += bv; }
        bool bad = st1.run(acc, u, wr, wc, fr, fq, lds, wid, lane) || poison != 0u;
        const float qnan = __builtin_nanf("");
#pragma unroll
        for (int ai = 0; ai < 2; ++ai)
#pragma unroll
            for (int m = 0; m < 4; ++m) { const int r = ai * HALF + wr * 64 + m * 16 + fr; const f32x2v sr = S[r]; const size_t off = (size_t)(u.pm * BM + r) * ldc + col0;
#pragma unroll
                for (int bj = 0; bj < 2; ++bj)
#pragma unroll
                    for (int n = 0; n < 2; ++n) { const f32x4 bs = *(const f32x4*)(base + off + bj * HALF + n * 16); acc[ai][bj][m][n] = bs + (acc[ai][bj][m][n] - sr.x) * sr.y; }
                asm volatile("" : "+v"(acc[ai][0][m][0]), "+v"(acc[ai][0][m][1]), "+v"(acc[ai][1][m][0]), "+v"(acc[ai][1][m][1]));
                if (m & 1) asm volatile("" ::: "memory"); }
        const bool bad1 = bad;
        bad = st2.run(acc, u, wr, wc, fr, fq, lds, wid, lane) || bad;
#pragma unroll
        for (int ai = 0; ai < 2; ++ai)
#pragma unroll
            for (int m = 0; m < 4; ++m) { const int r = ai * HALF + wr * 64 + m * 16 + fr; const f32x2v sr = S[r]; const size_t off = (size_t)(u.pm * BM + r) * ldc + col0;
#pragma unroll
                for (int bj = 0; bj < 2; ++bj)
#pragma unroll
                    for (int n = 0; n < 2; ++n) { const f32x4 x1 = acc[ai][bj][m][n]; *(f32x4*)(out + off + bj * HALF + n * 16) = bad1 ? (f32x4){qnan, qnan, qnan, qnan} : x1;
                        const f32x4 o = (x1 - sr.x) * sr.y; u32x2v w; w.x = cvt_pk_bf16(o[0], o[1]); w.y = cvt_pk_bf16(o[2], o[3]);
                        if (bad) { w.x = 0x7fc07fc0u; w.y = 0x7fc07fc0u; } *(u32x2v*)(xn + off + bj * HALF + n * 16) = w; }
                asm volatile("" ::: "memory"); }
    }
};

template <class Epi, class Sched, bool STAMP = false>
__device__ __forceinline__ void gemm_phase(PG8_LAS unsigned char* lds, const Gemm g, const Sched& S, const Epi& E, unsigned long long* stamps) {
    int tid_l = threadIdx.x; asm volatile("" : "+v"(tid_l));
    const int tid = tid_l, wid = __builtin_amdgcn_readfirstlane(tid >> 6), lane = tid & 63, wr = wid >> 2, wc = wid & 3, fr = lane & 15, fq = lane >> 4;
    const int K = g.K, nt = K / BK;
    int ts_lo = 0, ts_hi = 0, nts = 0; const unsigned long long rt_entry = STAMP ? (unsigned long long)wall_clock64() : 0ull;
#define PG8_STAMP() do { if (STAMP && wid == 0 && nts < 64) { const unsigned long long _c = (unsigned long long)clock64(); \
        ts_lo = (lane == nts) ? (int)(unsigned)_c : ts_lo; ts_hi = (lane == nts) ? (int)(unsigned)(_c >> 32) : ts_hi; ++nts; } } while (0)
    PG8_STAMP();
    unsigned voffA[2], voffB[2];
#pragma unroll
    for (int i = 0; i < 2; ++i) { int R, C; stage_rc(tid * 16 + i * 8192, R, C); const int Rb = Epi::PERM ? ((R & ~31) + perm32(R & 31)) : R;
        voffA[i] = (unsigned)(R * K + C) * 2u; voffB[i] = (unsigned)(Rb * K + C) * 2u; }
    const size_t kstep = (size_t)(BK * 2);
    const size_t hstep = (size_t)HALF * K * 2;
    const size_t tstep = 2 * hstep;
    const unsigned ldsw = (unsigned)wid * 1024u;
    const int aoff = lds_byte(wr * 64 + fr, fq * 8), boff = lds_byte(wc * 32 + fr, fq * 8);
#define PG8_SA(b, h) (((b) * 2 + (h)) * HTB)
#define PG8_SB(b, h) ((4 + (b) * 2 + (h)) * HTB)
#define PG8_STAGE(bufoff, gbase, voff) do { _Pragma("unroll") for (int _i = 0; _i < 2; ++_i) \
        __builtin_amdgcn_global_load_lds((const unsigned*)((const char*)(gbase) + (voff)[_i]), (PG8_LAS unsigned*)(lds + (bufoff) + ldsw + _i * 8192), 16, 0, 0); } while (0)
#define PG8_LDA(dst, b, h) do { _Pragma("unroll") for (int m = 0; m < 4; ++m) _Pragma("unroll") for (int k = 0; k < 2; ++k) dst[m][k] = *(const PG8_LAS bf16x8*)(lds + PG8_SA(b, h) + aoff + m * 2048 + k * 1024); } while (0)
#define PG8_LDB(dst, b, h) do { _Pragma("unroll") for (int n = 0; n < 2; ++n) _Pragma("unroll") for (int k = 0; k < 2; ++k) dst[n][k] = *(const PG8_LAS bf16x8*)(lds + PG8_SB(b, h) + boff + n * 2048 + k * 1024); } while (0)
#define PG8_MMA(ai, bj, At, Bt) do { __builtin_amdgcn_s_setprio(1); _Pragma("unroll") for (int m = 0; m < 4; ++m) _Pragma("unroll") for (int n = 0; n < 2; ++n) _Pragma("unroll") for (int k = 0; k < 2; ++k) \
        acc[ai][bj][m][n] = __builtin_amdgcn_mfma_f32_16x16x32_bf16(Bt[n][k], At[m][k], acc[ai][bj][m][n], 0, 0, 0); __builtin_amdgcn_s_setprio(0); } while (0)
#define PG8_WAIT_V(n) asm volatile("s_waitcnt vmcnt(" #n ")" ::: "memory")
#define PG8_WAIT_L(n) asm volatile("s_waitcnt lgkmcnt(" #n ")" ::: "memory")
#define PG8_BAR __builtin_amdgcn_s_barrier()
#define PG8_SCHED __builtin_amdgcn_sched_barrier(0)
    Unit cur, nxt; int ui = 0;
    if (!S.next(0, cur)) return;
    f32x4 acc[2][2][4][2];
#pragma unroll
    for (int a = 0; a < 2; ++a)
#pragma unroll
        for (int b = 0; b < 2; ++b)
#pragma unroll
            for (int m = 0; m < 4; ++m)
#pragma unroll
                for (int n = 0; n < 2; ++n) acc[a][b][m][n] = (f32x4){0.f, 0.f, 0.f, 0.f};
    bf16x8 At[4][2], B0[2][2], B1[2][2];
    const char* cA = (const char*)g.A + (size_t)cur.pm * tstep; const char* cB = (const char*)g.Bt + (size_t)cur.pn * tstep;
    S.a_ready(cur);
    PG8_STAGE(PG8_SB(0, 0), cB, voffB); PG8_STAGE(PG8_SA(0, 0), cA, voffA); PG8_STAGE(PG8_SB(0, 1), cB + hstep, voffB); PG8_STAGE(PG8_SA(0, 1), cA + hstep, voffA);
    if (wr == 1) PG8_BAR;
    PG8_WAIT_V(4); PG8_BAR;
    PG8_STAGE(PG8_SB(1, 0), cB + kstep, voffB); PG8_STAGE(PG8_SA(1, 0), cA + kstep, voffA); PG8_STAGE(PG8_SB(1, 1), cB + hstep + kstep, voffB);
    PG8_WAIT_V(6); PG8_BAR;
    PG8_STAMP();
    for (;;) {
        const bool has_next = S.next(ui + 1, nxt);
        const char* nA = has_next ? (const char*)g.A + (size_t)nxt.pm * tstep : cA; const char* nB = has_next ? (const char*)g.Bt + (size_t)nxt.pn * tstep : cB;
        for (int t = 0; t < nt; t += 2) {
            const bool last = (t == nt - 2);
            const char* a1 = cA + (size_t)(t + 1) * kstep;
            const char* a2 = last ? nA : cA + (size_t)(t + 2) * kstep; const char* b2 = last ? nB : cB + (size_t)(t + 2) * kstep;
            const char* a3 = a2 + kstep; const char* b3 = b2 + kstep;
            if (last && has_next) S.a_ready(nxt);
            PG8_LDB(B0, 0, 0); PG8_SCHED; PG8_LDA(At, 0, 0); PG8_STAGE(PG8_SA(1, 1), a1 + hstep, voffA);
            PG8_WAIT_L(8); PG8_BAR; PG8_WAIT_L(0); PG8_MMA(0, 0, At, B0); PG8_BAR; PG8_SCHED;
            PG8_LDB(B1, 0, 1); PG8_STAGE(PG8_SB(0, 0), b2, voffB);
            PG8_BAR; PG8_WAIT_L(0); PG8_MMA(0, 1, At, B1); PG8_BAR;
            PG8_LDA(At, 0, 1); PG8_STAGE(PG8_SA(0, 0), a2, voffA);
            PG8_BAR; PG8_WAIT_L(0); PG8_MMA(1, 0, At, B0); PG8_BAR; PG8_SCHED;
            PG8_STAGE(PG8_SB(0, 1), b2 + hstep, voffB);
            PG8_WAIT_V(6); PG8_BAR; PG8_MMA(1, 1, At, B1); PG8_BAR;
            PG8_LDB(B0, 1, 0); PG8_SCHED; PG8_LDA(At, 1, 0); PG8_STAGE(PG8_SA(0, 1), a2 + hstep, voffA);
            PG8_WAIT_L(8); PG8_BAR; PG8_WAIT_L(0); PG8_MMA(0, 0, At, B0); PG8_BAR; PG8_SCHED;
            PG8_LDB(B1, 1, 1); PG8_STAGE(PG8_SB(1, 0), b3, voffB);
            PG8_BAR; PG8_WAIT_L(0); PG8_MMA(0, 1, At, B1); PG8_BAR;
            PG8_LDA(At, 1, 1); PG8_STAGE(PG8_SA(1, 0), a3, voffA);
            PG8_BAR; PG8_WAIT_L(0); PG8_MMA(1, 0, At, B0); PG8_BAR; PG8_SCHED;
            PG8_STAGE(PG8_SB(1, 1), b3 + hstep, voffB);
            PG8_WAIT_V(6); PG8_BAR; PG8_MMA(1, 1, At, B1); PG8_BAR;
        }
        PG8_STAMP();
        if constexpr (!Epi::AFTER_DRAIN) { E(acc, cur, wr, wc, fr, fq); S.done(cur); }
        PG8_STAMP();
        if (!has_next) break;
#pragma unroll
        for (int a = 0; a < 2; ++a)
#pragma unroll
            for (int b = 0; b < 2; ++b)
#pragma unroll
                for (int m = 0; m < 4; ++m)
#pragma unroll
                    for (int n = 0; n < 2; ++n) acc[a][b][m][n] = (f32x4){0.f, 0.f, 0.f, 0.f};
        cur = nxt; cA = nA; cB = nB; ++ui;
    }
    PG8_WAIT_V(0);
    if (wr == 0) PG8_BAR;
    PG8_BAR;
    if constexpr (Epi::AFTER_DRAIN) { E.fused(acc, cur, wr, wc, fr, fq, lds, wid, lane); S.done(cur); }
    PG8_STAMP();
    if (STAMP && wid == 0) { stamps[lane] = lane < nts ? (((unsigned long long)(unsigned)ts_hi << 32) | (unsigned)ts_lo) : 0ull;
        if (lane == 62) stamps[62] = rt_entry; if (lane == 63) stamps[63] = (unsigned long long)wall_clock64(); }
#undef PG8_STAMP
#undef PG8_SA
#undef PG8_SB
#undef PG8_STAGE
#undef PG8_LDA
#undef PG8_LDB
#undef PG8_MMA
#undef PG8_WAIT_V
#undef PG8_WAIT_L
#undef PG8_BAR
#undef PG8_SCHED
}
}

#define GAS __attribute__((address_space(1)))
#define LAS __attribute__((address_space(3)))
typedef unsigned short bf16;
typedef unsigned v4u __attribute__((ext_vector_type(4)));
typedef unsigned v2u __attribute__((ext_vector_type(2)));
typedef float f32x4 __attribute__((ext_vector_type(4)));
typedef float f32x2 __attribute__((ext_vector_type(2)));
typedef float f32x16 __attribute__((ext_vector_type(16)));
typedef short bf16x8 __attribute__((ext_vector_type(8)));
typedef short bf16x4 __attribute__((ext_vector_type(4)));

#ifndef MK_CHECK
#define MK_CHECK 0
#endif
#ifndef MK_ONE_LAUNCH
#define MK_ONE_LAUNCH 0
#endif
#ifndef MK_PROBE
#define MK_PROBE 0
#endif
#ifndef MK_DUP10
#define MK_DUP10 0
#endif
#ifndef MK_PROBE_KERNEL
#define MK_PROBE_KERNEL 0
#endif
#ifndef MK_PROBE_FLAGS
#define MK_PROBE_FLAGS 0
#endif
#ifndef MK_REPEAT_K
#define MK_REPEAT_K (-1)
#endif
#ifndef MK_PROBE_A
#define MK_PROBE_A 0u
#endif
#ifndef MK_PROBE_C
#define MK_PROBE_C 0u
#endif

constexpr int T_TOK = 65536, DM = 1024, SEQ = 2048, NBATCH = 32;
constexpr float ALPHA_DN = 1.6817928305074290f;
#ifndef PEER_U4
#define PEER_U4 1
#endif
#ifndef PEER_V4
#define PEER_V4 1
#endif
constexpr float PEER_USCALE = PEER_U4 ? 64.0f : 256.0f, PEER_VSCALE = PEER_V4 ? 12.8f : 32.0f;
constexpr int PEER_UROW = PEER_U4 ? 512 : 1024, PEER_VROW = PEER_V4 ? 512 : 1024;
constexpr int NWAVES = 8, NTHR = 512;
constexpr int NPH_LAYER = 12;
constexpr int N_PHASES = 1 + 4 * NPH_LAYER;

constexpr size_t MiB = 1u << 20;
constexpr size_t WS_CTL = 0, CTL_BYTES = 1 * MiB;
constexpr size_t WS_ROT = 1 * MiB;
constexpr size_t WS_WPEER = 4 * MiB;
constexpr size_t WS_WPLEG = 20 * MiB;
constexpr size_t WS_WPLEP = 28 * MiB;
constexpr size_t WS_WAIN = 30 * MiB;
constexpr size_t WS_WAQ = 32 * MiB;
constexpr size_t WAQ_STRIDE = 2560 * 256 * 2;
constexpr size_t WS_WAOV = 35 * MiB;
constexpr size_t WS_WBIN = 43 * MiB;
constexpr size_t WS_WBO = 48 * MiB;
constexpr size_t WS_WCIN = 51 * MiB;
constexpr size_t WS_WCO = 63 * MiB;
constexpr size_t WS_TABU = 68 * MiB, WS_TABV = 100 * MiB;
constexpr size_t WS_XB0 = 132 * MiB, WS_XB1 = 260 * MiB;
constexpr size_t WS_M = 388 * MiB;
constexpr size_t M_SC = 0, M_IDS = 512 * MiB, M_GATES = 544 * MiB, M_PB = 576 * MiB, M_PP = 0;
constexpr size_t M_RAW = 0, M_CQ = 128 * MiB, M_CKV = 160 * MiB, M_CKVT = 176 * MiB, M_KIDX = 192 * MiB, M_WIDX = 200 * MiB,
                 M_MASK = 202 * MiB, M_QLAT = 218 * MiB, M_QIDX = 474 * MiB;
constexpr size_t M_GU = 0, M_Y = 320 * MiB;
constexpr size_t M_Q = 0, M_K = 128 * MiB, M_V = 256 * MiB, M_STAT = 512 * MiB;
constexpr size_t WS_PP = WS_M + 608 * MiB;
constexpr size_t WS_END = WS_PP + 128 * MiB;
constexpr int CW_DIAG = 64;
constexpr int CW_BAR = 4096;

constexpr int RING_BYTES = 131072, LDS_BYTES = 147456, LDSCTL_OFF = LDS_BYTES - 512, MISC_OFF = LDSCTL_OFF + 320;

enum { I_X = 0, I_P, I_A_W_IN, I_A_CQ_GAIN, I_A_CKV_GAIN, I_A_W_UQ, I_A_W_UK, I_A_W_QIDX, I_A_KIDX_GAIN, I_A_KIDX_BIAS, I_A_W_UV, I_A_W_O,
       I_B_W_IN, I_B_CONV_W, I_B_CONV_B, I_B_W_A, I_B_B_A, I_B_W_X, I_B_B_X, I_B_LAMBDA, I_B_W_O, I_C_W_IN, I_C_W_O,
       I_LN1_G, I_LN1_B, I_PEER_WQ, I_PEER_SK, I_PEER_U, I_PEER_V, I_LN2_G, I_LN2_B, I_PLE_WP, I_PLE_WG, I_PLE_BG, N_IN };

struct Params { const float* in[N_IN]; float* out; unsigned char* ws; int ph_lo, ph_hi, flags, pad; };

typedef const float* const __attribute__((address_space(4)))* InTab;
struct Ctx {
    LAS unsigned char* lds;
    int tid, lane, wave, bid, G;
    InTab in; float* out; unsigned char* ws;
};
#define INP(cx, i) ((const float*)(const GAS float*)((cx).in[i]))

#define LDS_WAIT() asm volatile("s_waitcnt lgkmcnt(0)" ::: "memory")
#define VM_WAIT() asm volatile("s_waitcnt vmcnt(0)" ::: "memory")

typedef __bf16 bf16v2_t __attribute__((ext_vector_type(2)));
__device__ __forceinline__ unsigned pk2(float lo, float hi) { const f32x2 v = {lo, hi}; const bf16v2_t b = __builtin_convertvector(v, bf16v2_t); return __builtin_bit_cast(unsigned, b); }
__device__ __forceinline__ unsigned f2bf(float f) { return (unsigned)__builtin_bit_cast(unsigned short, (__bf16)f); }
__device__ __forceinline__ float bflo(unsigned w) { return __builtin_bit_cast(float, w << 16); }
__device__ __forceinline__ float bfhi(unsigned w) { return __builtin_bit_cast(float, w & 0xffff0000u); }
__device__ __forceinline__ float bf2f(bf16 b) { return __builtin_bit_cast(float, ((unsigned)b) << 16); }
template <int CTRL, int ROWMASK>
__device__ __forceinline__ float dpp_f(float v) { return __builtin_bit_cast(float, __builtin_amdgcn_update_dpp(0, __builtin_bit_cast(int, v), CTRL, ROWMASK, 0xf, false)); }
__device__ __forceinline__ float wave_sum_uniform(float v) {
    v += dpp_f<0xB1, 0xf>(v);
    v += dpp_f<0x4E, 0xf>(v);
    v += dpp_f<0x141, 0xf>(v);
    v += dpp_f<0x140, 0xf>(v);
    v += dpp_f<0x142, 0xa>(v);
    v += dpp_f<0x143, 0xc>(v);
    return __builtin_bit_cast(float, __builtin_amdgcn_readlane(__builtin_bit_cast(int, v), 63));
}
__device__ __forceinline__ float wave_sum(float v) { return wave_sum_uniform(v); }
__device__ __forceinline__ float gelu_tanh(float x) {
    const float u = 0.7978845608028654f * (x + 0.044715f * x * x * x);
    const float e = __expf(2.0f * u);
    const float th = 1.0f - 2.0f * __builtin_amdgcn_rcpf(e + 1.0f);
    return 0.5f * x * (1.0f + th);
}
__device__ __forceinline__ float sigmoidf_(float x) { return __builtin_amdgcn_rcpf(1.0f + __expf(-x)); }

#define XB_TMO      128
#define XB_XCNT(j)  (256  + 64 * (j))
#define XB_XSUB(j)  (1280 + 64 * (j))
#define XB_XGEN(j)  (2304 + 64 * (j))
#define XB_TOP      3328
#define XB_TOPGEN   3392
#define XCD_BAR_WORDS 3456
#define XB_SPIN_CAP (1u << 25)
__device__ __forceinline__ unsigned xb_ld(unsigned* p)              { return __hip_atomic_load(p, __ATOMIC_RELAXED, __HIP_MEMORY_SCOPE_AGENT); }
__device__ __forceinline__ unsigned xb_add(unsigned* p, unsigned v) { return __hip_atomic_fetch_add(p, v, __ATOMIC_RELAXED, __HIP_MEMORY_SCOPE_AGENT); }
__device__ __forceinline__ unsigned xb_xcc_id() { return (unsigned)__builtin_amdgcn_s_getreg((3 << 11) | 20) & 0xFu; }
#define XB_SPIN(cond, bar) do { unsigned _sp = 0; while (cond) { __builtin_amdgcn_s_sleep(1); \
    if ((++_sp & 255u) == 0u) { if (xb_ld(&(bar)[XB_TMO])) break; if (_sp > XB_SPIN_CAP) { atomicAdd(&(bar)[XB_TMO], 1u); break; } } } } while (0)
struct XcdBarrier { unsigned* bar; unsigned x; volatile LAS unsigned* st; };
__device__ __forceinline__ XcdBarrier xcd_barrier_post(unsigned* bar, volatile LAS unsigned* st) {
    XcdBarrier b; b.bar = bar; b.x = xb_xcc_id(); b.st = st;
    if (threadIdx.x == 0) (void)xb_add(&bar[XB_XCNT(b.x)], 1u);
    return b;
}
__device__ __forceinline__ void xcd_barrier_complete(unsigned* bar, unsigned x, unsigned& nloc, unsigned& nx) {
    const unsigned G = gridDim.x * gridDim.y * gridDim.z;
    unsigned sum, cnt, mine, sp = 0u;
    for (;;) {
        sum = 0u; cnt = 0u; mine = 0u;
#pragma unroll
        for (unsigned j = 0; j < 16; ++j) { const unsigned c = xb_ld(&bar[XB_XCNT(j)]); sum += c; cnt += (c > 0u) ? 1u : 0u; mine = (j == x) ? c : mine; }
        if (sum == G) break;
        __builtin_amdgcn_s_sleep(1);
        if ((++sp & 255u) == 0u) { if (xb_ld(&bar[XB_TMO])) break; if (sp > XB_SPIN_CAP) { atomicAdd(&bar[XB_TMO], 1u); break; } }
    }
    nloc = mine > 0u ? mine : 1u; nx = cnt > 0u ? cnt : 1u;
}
__device__ __forceinline__ void xcd_barrier(const XcdBarrier& b) {
    asm volatile("s_waitcnt vmcnt(0)" ::: "memory");
    __syncthreads();
    if (threadIdx.x == 0) {
        unsigned* bar = b.bar;
        __builtin_amdgcn_s_waitcnt(0);
        unsigned nloc = b.st[0], nx = b.st[1];
        if (nloc == 0u) { xcd_barrier_complete(bar, b.x, nloc, nx); b.st[0] = nloc; b.st[1] = nx; }
        const unsigned old = xb_add(&bar[XB_XSUB(b.x)], 1u);
        const unsigned gen = old / nloc;
        if (old + 1u == (gen + 1u) * nloc) {
            __builtin_amdgcn_fence(__ATOMIC_RELEASE, "agent");
            asm volatile("s_waitcnt vmcnt(0)" ::: "memory");
            const unsigned og = xb_add(&bar[XB_TOP], 1u);
            const unsigned tg = og / nx;
            if (og + 1u == (tg + 1u) * nx) xb_add(&bar[XB_TOPGEN], 1u);
            else XB_SPIN(xb_ld(&bar[XB_TOPGEN]) == tg, bar);
            __builtin_amdgcn_fence(__ATOMIC_ACQUIRE, "agent");
            xb_add(&bar[XB_XGEN(b.x)], 1u);
            asm volatile("s_waitcnt vmcnt(0)" ::: "memory");
        } else {
            XB_SPIN(xb_ld(&bar[XB_XGEN(b.x)]) == gen, bar);
            __builtin_amdgcn_fence(__ATOMIC_ACQUIRE, "agent");
            asm volatile("s_waitcnt vmcnt(0)" ::: "memory");
        }
    }
    __syncthreads();
}

__device__ __forceinline__ void p0_transpose_item(const float* W, int K, int N, bf16* WT, int row_off, float scale, LAS float* scr, int item, int lane) {
    const int nblk = N / 32, kb = item / nblk, nb = item % nblk, k0 = 64 * kb, n0 = 32 * nb;
#pragma unroll 8
    for (int i = 0; i < 32; ++i) { const int kk = 2 * i + (lane >> 5); scr[kk * 33 + (lane & 31)] = W[(size_t)(k0 + kk) * N + n0 + (lane & 31)] * scale; }
    LDS_WAIT(); asm volatile("" ::: "memory");
    const int c = lane & 7;
#pragma unroll
    for (int j = 0; j < 4; ++j) { const int n = (lane >> 3) + 8 * j; const LAS float* s = scr + (8 * c) * 33 + n;
        v4u o; o.x = pk2(s[0 * 33], s[1 * 33]); o.y = pk2(s[2 * 33], s[3 * 33]); o.z = pk2(s[4 * 33], s[5 * 33]); o.w = pk2(s[6 * 33], s[7 * 33]);
        *(v4u*)(WT + (size_t)(row_off + n0 + n) * K + k0 + 8 * c) = o; }
    LDS_WAIT(); asm volatile("" ::: "memory");
}

__device__ __forceinline__ void small_gemm_tile(const Ctx& c, const float* A, long sa_n, long sa_d, const float* Bm, long sb_k, long sb_d, int Kd,
                                                bf16* C, int ldc, int n0, int k0, float scale) {
    LAS float* As = (LAS float*)c.lds; LAS float* Bs = As + 128 * 68;
    __syncthreads();
    for (int e = c.tid; e < 64 * Kd; e += NTHR) {
        int r, d;
        if (sa_d == 1) { d = e % Kd; r = e / Kd; } else { r = e & 63; d = e >> 6; }
        As[d * 68 + r] = A[(long)(n0 + r) * sa_n + (long)d * sa_d];
    }
    for (int e = c.tid; e < 64 * Kd; e += NTHR) {
        int r, d;
        if (sb_d == 1) { d = e % Kd; r = e / Kd; } else { r = e & 63; d = e >> 6; }
        Bs[d * 68 + r] = Bm[(long)(k0 + r) * sb_k + (long)d * sb_d];
    }
    __syncthreads();
    {
        const int tn = (c.tid >> 5) * 4, tk = (c.tid & 31) * 2;
        float acc[4][2];
#pragma unroll
        for (int i = 0; i < 4; ++i) { acc[i][0] = 0.f; acc[i][1] = 0.f; }
        for (int d = 0; d < Kd; ++d) {
            const f32x4 a = *(const LAS f32x4*)(As + d * 68 + tn); const f32x2 b = *(const LAS f32x2*)(Bs + d * 68 + tk);
#pragma unroll
            for (int i = 0; i < 4; ++i) { acc[i][0] += a[i] * b[0]; acc[i][1] += a[i] * b[1]; }
        }
#pragma unroll
        for (int i = 0; i < 4; ++i) *(unsigned*)(C + (size_t)(n0 + tn + i) * ldc + k0 + tk) = pk2(acc[i][0] * scale, acc[i][1] * scale);
    }
}

__device__ __forceinline__ void ln_store_row(float (&v)[16], const float* gain, const float* bias, float* of, bf16* ob, int lane) {
    float s = 0.f;
#pragma unroll
    for (int j = 0; j < 16; ++j) s += v[j];
    const float mean = wave_sum(s) * (1.f / 1024.f);
    float s2 = 0.f;
#pragma unroll
    for (int j = 0; j < 16; ++j) { v[j] -= mean; s2 += v[j] * v[j]; }
    const float rstd = __builtin_amdgcn_rsqf(wave_sum(s2) * (1.f / 1024.f) + 1e-5f);
#pragma unroll
    for (int h = 0; h < 2; ++h) {
        const int col = h * 512 + 8 * lane;
        const f32x4 g0 = *(const f32x4*)(gain + col), g1 = *(const f32x4*)(gain + col + 4), b0 = *(const f32x4*)(bias + col), b1 = *(const f32x4*)(bias + col + 4);
        f32x4 o0, o1;
#pragma unroll
        for (int j = 0; j < 4; ++j) { o0[j] = v[h * 8 + j] * rstd * g0[j] + b0[j]; o1[j] = v[h * 8 + 4 + j] * rstd * g1[j] + b1[j]; }
        if (of) { *(f32x4*)(of + col) = o0; *(f32x4*)(of + col + 4) = o1; }
        v4u w; w.x = pk2(o0[0], o0[1]); w.y = pk2(o0[2], o0[3]); w.z = pk2(o1[0], o1[1]); w.w = pk2(o1[2], o1[3]);
        *(v4u*)(ob + col) = w;
    }
}
__device__ __forceinline__ void load_row16(const float* row, float (&v)[16], int lane) {
#pragma unroll
    for (int h = 0; h < 2; ++h) { const f32x4 a = *(const f32x4*)(row + h * 512 + 8 * lane), b = *(const f32x4*)(row + h * 512 + 8 * lane + 4);
#pragma unroll
        for (int j = 0; j < 4; ++j) { v[h * 8 + j] = a[j]; v[h * 8 + 4 + j] = b[j]; } }
}

__device__ __forceinline__ void load_row16_bf(const bf16* row, float (&v)[16], int lane) {
#pragma unroll
    for (int h = 0; h < 2; ++h) { const v4u w = *(const v4u*)(row + h * 512 + 8 * lane);
        v[h * 8 + 0] = bflo(w.x); v[h * 8 + 1] = bfhi(w.x); v[h * 8 + 2] = bflo(w.y); v[h * 8 + 3] = bfhi(w.y);
        v[h * 8 + 4] = bflo(w.z); v[h * 8 + 5] = bfhi(w.z); v[h * 8 + 6] = bflo(w.w); v[h * 8 + 7] = bfhi(w.w); }
}

__device__ __forceinline__ void load_row16c(const float* row, float (&v)[16], int lane) {
#pragma unroll
    for (int q = 0; q < 4; ++q) { const f32x4 a = *(const f32x4*)(row + 16 * lane + 4 * q);
#pragma unroll
        for (int j = 0; j < 4; ++j) v[4 * q + j] = a[j]; }
}
__device__ __forceinline__ void ln_store_row_c(float (&v)[16], const float* gain, const float* bias, float* of, bf16* ob, int lane) {
    float s = 0.f;
#pragma unroll
    for (int j = 0; j < 16; ++j) s += v[j];
    const float mean = wave_sum(s) * (1.f / 1024.f);
    float s2 = 0.f;
#pragma unroll
    for (int j = 0; j < 16; ++j) { v[j] -= mean; s2 += v[j] * v[j]; }
    const float rstd = __builtin_amdgcn_rsqf(wave_sum(s2) * (1.f / 1024.f) + 1e-5f);
    const int col = 16 * lane;
    float o[16];
#pragma unroll
    for (int q = 0; q < 4; ++q) { const f32x4 g = *(const f32x4*)(gain + col + 4 * q), b = *(const f32x4*)(bias + col + 4 * q); f32x4 r;
#pragma unroll
        for (int j = 0; j < 4; ++j) { r[j] = v[4 * q + j] * rstd * g[j] + b[j]; o[4 * q + j] = r[j]; }
        *(f32x4*)(of + col + 4 * q) = r; }
    v4u w0, w1; w0.x = pk2(o[0], o[1]); w0.y = pk2(o[2], o[3]); w0.z = pk2(o[4], o[5]); w0.w = pk2(o[6], o[7]);
    w1.x = pk2(o[8], o[9]); w1.y = pk2(o[10], o[11]); w1.z = pk2(o[12], o[13]); w1.w = pk2(o[14], o[15]);
    *(v4u*)(ob + col) = w0; *(v4u*)(ob + col + 8) = w1;
}

__device__ __forceinline__ void phase_prologue(const Ctx& c) {
    unsigned char* ws = c.ws;
    LAS float* scr = (LAS float*)(c.lds + c.wave * 16384);
    const int gw = c.bid * NWAVES + c.wave, NGW = c.G * NWAVES;
    {
        struct TI { const float* W; int K, N; bf16* WT; int row_off; float scale; };
        int base = 0;
#define TR_ITEMS(Wp, Kv, Nv, WTp, roff, sc) do { const int ni = ((Kv) / 64) * ((Nv) / 32); \
            for (int it = gw; it < ni; it += NGW) p0_transpose_item((Wp), (Kv), (Nv), (WTp), (roff), (sc), scr, it, c.lane); base += ni; } while (0)
        for (int i = 0; i < 4; ++i) {
            TR_ITEMS(INP(c, I_PLE_WG) + (size_t)i * 1024 * 1024, 1024, 1024, (bf16*)(ws + WS_WPLEG) + (size_t)i * 1024 * 1024, 0, 1.0f);
            TR_ITEMS(INP(c, I_PLE_WP) + (size_t)i * 256 * 1024, 256, 1024, (bf16*)(ws + WS_WPLEP) + (size_t)i * 1024 * 256, 0, 1.0f);
        }
        for (int j = 0; j < 2; ++j)
            TR_ITEMS(INP(c, I_A_W_QIDX) + (size_t)j * 256 * 512, 256, 512, (bf16*)(ws + WS_WAQ + j * WAQ_STRIDE), 2048, 0.125f);
        TR_ITEMS(INP(c, I_B_W_IN), 1024, 2560, (bf16*)(ws + WS_WBIN), 0, 1.0f);
        TR_ITEMS(INP(c, I_B_W_O), 1280, 1024, (bf16*)(ws + WS_WBO), 0, 1.0f);
        TR_ITEMS(INP(c, I_C_W_IN), 1024, 6144, (bf16*)(ws + WS_WCIN), 0, 1.0f);
        TR_ITEMS(INP(c, I_C_W_O), 2048, 1024, (bf16*)(ws + WS_WCO), 0, 1.0f);
#undef TR_ITEMS
        (void)base;
    }
    for (int j = 0; j < 2; ++j) {
        const float* W = INP(c, I_A_W_IN) + (size_t)j * 1024 * 456; bf16* WT = (bf16*)(ws + WS_WAIN) + (size_t)j * 512 * 1024;
        for (int e = c.bid * NTHR + c.tid; e < 512 * 1024; e += c.G * NTHR) { const int n = e >> 10, k = e & 1023; WT[e] = (bf16)(n < 456 ? f2bf(W[(size_t)k * 456 + n]) : 0u); }
    }
    {
        float* ct = (float*)(ws + WS_ROT); float* st = ct + 2048 * 128;
        for (int e = c.bid * NTHR + c.tid; e < 2048 * 128; e += c.G * NTHR) {
            const int pos = e >> 7, f = e & 127;
            const float lin = (float)f * (1.0f / 127.0f);
            const float p = (float)pow(10000.0, (double)lin);
            const float invf = 1.0f / p;
            const float ang = (float)pos * invf;
            ct[e] = (float)cos((double)ang); st[e] = (float)sin((double)ang);
        }
    }
    for (int m = gw; m < T_TOK; m += NGW) {
        const float* xr = INP(c, I_X) + (size_t)m * DM; bf16* ob = (bf16*)(ws + WS_XB0) + (size_t)m * DM;
#pragma unroll
        for (int h = 0; h < 2; ++h) { const int col = h * 512 + 8 * c.lane; const f32x4 a = *(const f32x4*)(xr + col), b = *(const f32x4*)(xr + col + 4);
            v4u w; w.x = pk2(a[0], a[1]); w.y = pk2(a[2], a[3]); w.z = pk2(b[0], b[1]); w.w = pk2(b[2], b[3]); *(v4u*)(ob + col) = w; }
    }
    {
        int tbase = 0;
        {
            const int ntile = 4 * 16 * 2 * 16;
            for (int t = c.bid; t < ntile; t += c.G) {
                const int i = t / 512, r = t % 512, hp = r / 32, tt = r % 32, nt = tt / 16, kt = tt % 16;
                const float* A = INP(c, I_PEER_SK) + (size_t)i * 8 * 2 * 128 * 128 + (size_t)hp * 128 * 128;
                const float* Bm = INP(c, I_PEER_WQ) + (size_t)i * 1024 * 2048 + hp * 128;
                bf16* C = (bf16*)(ws + WS_WPEER) + (size_t)i * 2048 * 1024 + (size_t)hp * 128 * 1024;
                small_gemm_tile(c, A, 128, 1, Bm, 2048, 1, 128, C, 1024, nt * 64, kt * 64, 1.0f);
            }
            tbase += ntile;
        }
        {
            const int ntile = 2 * 16 * 2 * 4;
            for (int t = c.bid; t < ntile; t += c.G) {
                const int j = t / 128, r = t % 128, h = r / 8, tt = r % 8, nt = tt / 4, kt = tt % 4;
                const float* A = INP(c, I_A_W_UK) + (size_t)j * 16 * 64 * 128 + (size_t)h * 64 * 128;
                const float* Bm = INP(c, I_A_W_UQ) + (size_t)j * 256 * 1024 + h * 64;
                bf16* C = (bf16*)(ws + WS_WAQ + j * WAQ_STRIDE) + (size_t)h * 128 * 256;
                small_gemm_tile(c, A, 1, 128, Bm, 1024, 1, 64, C, 256, nt * 64, kt * 64, 0.125f * 1.4426950408889634f);
            }
        }
        {
            const int ntile = 2 * 16 * 16 * 2;
            for (int t = c.bid; t < ntile; t += c.G) {
                const int j = t / 512, r = t % 512, h = r / 32, tt = r % 32, nt = tt / 2, kt = tt % 2;
                const float* A = INP(c, I_A_W_O) + (size_t)j * 1024 * 1024 + (size_t)h * 64 * 1024;
                const float* Bm = INP(c, I_A_W_UV) + (size_t)j * 16 * 128 * 64 + (size_t)h * 128 * 64;
                bf16* C = (bf16*)(ws + WS_WAOV) + (size_t)j * 1024 * 2048 + h * 128;
                small_gemm_tile(c, A, 1, 1024, Bm, 64, 1, 64, C, 2048, nt * 64, kt * 64, 1.0f);
            }
        }
        (void)tbase;
    }
}

template <int FP4> __device__ __forceinline__ void peer_pack_row16(const float (&v)[16], unsigned char* dst) {
    if (FP4) { v2u w;
#pragma unroll
        for (int d = 0; d < 2; ++d) { unsigned p = 0u;
            p = __builtin_amdgcn_cvt_scalef32_pk_fp4_f32(p, v[8 * d + 0], v[8 * d + 1], 1.0f, 0); p = __builtin_amdgcn_cvt_scalef32_pk_fp4_f32(p, v[8 * d + 2], v[8 * d + 3], 1.0f, 1);
            p = __builtin_amdgcn_cvt_scalef32_pk_fp4_f32(p, v[8 * d + 4], v[8 * d + 5], 1.0f, 2); p = __builtin_amdgcn_cvt_scalef32_pk_fp4_f32(p, v[8 * d + 6], v[8 * d + 7], 1.0f, 3);
            w[d] = p; }
        *(v2u*)dst = w;
    } else { v4u w;
#pragma unroll
        for (int q = 0; q < 4; ++q) { int pa = 0; pa = __builtin_amdgcn_cvt_pk_fp8_f32(v[4 * q], v[4 * q + 1], pa, false); pa = __builtin_amdgcn_cvt_pk_fp8_f32(v[4 * q + 2], v[4 * q + 3], pa, true); w[q] = (unsigned)pa; }
        *(v4u*)dst = w;
    }
}

__device__ __forceinline__ void phase_ln1(const Ctx& c, int layer) {
    const int gw = c.bid * NWAVES + c.wave, NGW = c.G * NWAVES;
    const float* gain = INP(c, I_LN1_G) + layer * DM; const float* bias = INP(c, I_LN1_B) + layer * DM;
    bf16* xb = (bf16*)(c.ws + ((layer & 1) ? WS_XB1 : WS_XB0));
    for (int m = gw; m < T_TOK; m += NGW) {
        float v[16]; load_row16_bf(xb + (size_t)m * DM, v, c.lane);
        ln_store_row(v, gain, bias, nullptr, xb + (size_t)m * DM, c.lane);
    }
    {
        const float* U = INP(c, I_PEER_U) + (size_t)layer * 16384 * 1024; const float* V = INP(c, I_PEER_V) + (size_t)layer * 16384 * 1024;
        unsigned char* tu = c.ws + WS_TABU; unsigned char* tv = c.ws + WS_TABV;
        const size_t n16 = (size_t)16384 * 1024 / 16;
        for (size_t e = (size_t)c.bid * NTHR + c.tid; e < n16; e += (size_t)c.G * NTHR) {
            float ua[16], va[16];
#pragma unroll
            for (int q = 0; q < 4; ++q) { const f32x4 a4 = *(const f32x4*)(U + e * 16 + 4 * q) * PEER_USCALE, b4 = *(const f32x4*)(V + e * 16 + 4 * q) * PEER_VSCALE;
#pragma unroll
                for (int j = 0; j < 4; ++j) { ua[4 * q + j] = a4[j]; va[4 * q + j] = b4[j]; } }
            if (PEER_U4 && PEER_V4) {
                const size_t row = e >> 6, l16 = e & 63; peer_pack_row16<1>(ua, tu + row * 1024 + l16 * 8); peer_pack_row16<1>(va, tu + row * 1024 + 512 + l16 * 8);
            } else { peer_pack_row16<PEER_U4>(ua, tu + e * (PEER_UROW / 64)); peer_pack_row16<PEER_V4>(va, tv + e * (PEER_VROW / 64)); }
        }
    }
    {
        const float* P = INP(c, I_P) + (size_t)layer * T_TOK * 256; bf16* pb = (bf16*)(c.ws + WS_M + M_PB);
        const size_t n8 = (size_t)T_TOK * 256 / 8;
        for (size_t e = (size_t)c.bid * NTHR + c.tid; e < n8; e += (size_t)c.G * NTHR) {
            const f32x4 a = *(const f32x4*)(P + e * 8), b = *(const f32x4*)(P + e * 8 + 4);
            v4u w; w.x = pk2(a[0], a[1]); w.y = pk2(a[2], a[3]); w.z = pk2(b[0], b[1]); w.w = pk2(b[2], b[3]); *(v4u*)(pb + e * 8) = w;
        }
    }
}

using pg8::Unit;
constexpr int BMT = 256, HALFT = 128;

struct EpiResid {
    static constexpr bool PERM = false, AFTER_DRAIN = false;
    bf16* Y1; float alpha; const bf16* Xb;
    __device__ __forceinline__ void operator()(const pg8::f32x4 (&acc)[2][2][4][2], const Unit& u, int wr, int wc, int fr, int fq) const {
        const int row0 = u.pm * BMT + wr * 64 + fr, col0 = u.pn * BMT + wc * 32 + 4 * fq;
#pragma unroll
        for (int ai = 0; ai < 2; ++ai)
#pragma unroll
            for (int m = 0; m < 4; ++m) { const size_t roff = (size_t)(row0 + ai * HALFT + m * 16) * DM + col0; bf16* rowp = Y1 + roff; const bf16* srcp = Xb + roff;
                v2u xv[2][2];
#pragma unroll
                for (int bj = 0; bj < 2; ++bj)
#pragma unroll
                    for (int n = 0; n < 2; ++n) xv[bj][n] = *(const v2u*)(srcp + bj * HALFT + n * 16);
#pragma unroll
                for (int bj = 0; bj < 2; ++bj)
#pragma unroll
                    for (int n = 0; n < 2; ++n) { const pg8::f32x4 xf = {bflo(xv[bj][n].x), bfhi(xv[bj][n].x), bflo(xv[bj][n].y), bfhi(xv[bj][n].y)};
                        const pg8::f32x4 y = xf * alpha + acc[ai][bj][m][n];
                        v2u w; w.x = pk2(y[0], y[1]); w.y = pk2(y[2], y[3]); *(v2u*)(rowp + bj * HALFT + n * 16) = w; } }
    }
};

typedef short s16x2_t __attribute__((ext_vector_type(2)));
__device__ __forceinline__ unsigned sortable_bf16x2(unsigned w) { const s16x2_t m = __builtin_bit_cast(s16x2_t, w) >> 15; return w ^ (__builtin_bit_cast(unsigned, m) | 0x80008000u); }
struct EpiF32T {
    static constexpr bool PERM = true, AFTER_DRAIN = false;
    bf16* C;
    __device__ __forceinline__ void operator()(const pg8::f32x4 (&acc)[2][2][4][2], const Unit& u, int wr, int wc, int fr, int fq) const {
        const int row0 = u.pm * BMT + wr * 64 + fr, cg0 = (u.pn * BMT + wc * 32 + 8 * fq) >> 3;
#pragma unroll
        for (int ai = 0; ai < 2; ++ai)
#pragma unroll
            for (int m = 0; m < 4; ++m) { const int r = row0 + ai * HALFT + m * 16; bf16* bp = C + (((size_t)(r >> 6) * 256 + cg0) * 64 + (r & 63)) * 8;
#pragma unroll
                for (int bj = 0; bj < 2; ++bj) { const pg8::f32x4 v0 = acc[ai][bj][m][0], v1 = acc[ai][bj][m][1];
                    v4u w; w.x = sortable_bf16x2(pk2(v0[0], v0[1])); w.y = sortable_bf16x2(pk2(v0[2], v0[3])); w.z = sortable_bf16x2(pk2(v1[0], v1[1])); w.w = sortable_bf16x2(pk2(v1[2], v1[3]));
                    *(v4u*)(bp + (size_t)(bj * 16) * 512) = w; } }
    }
};

template <int ACT0  > struct EpiBf16R {
    static constexpr bool PERM = true, AFTER_DRAIN = false;
    bf16 *O0, *O1, *O2; int ld0, ld1, ld2, c1, c2;
    __device__ __forceinline__ void operator()(const pg8::f32x4 (&acc)[2][2][4][2], const Unit& u, int wr, int wc, int fr, int fq) const {
        const int row0 = u.pm * BMT + wr * 64 + fr; int colt = u.pn * BMT; bf16* base; int ld; bool act = false;
        if (colt < c1) { base = O0; ld = ld0; act = (ACT0 == 1); } else if (colt < c2) { base = O1; ld = ld1; colt -= c1; } else { base = O2; ld = ld2; colt -= c2; }
        const int col0 = colt + wc * 32 + 8 * fq;
#pragma unroll
        for (int ai = 0; ai < 2; ++ai)
#pragma unroll
            for (int m = 0; m < 4; ++m) { bf16* rowp = base + (size_t)(row0 + ai * HALFT + m * 16) * ld + col0;
#pragma unroll
                for (int bj = 0; bj < 2; ++bj) { pg8::f32x4 v0 = acc[ai][bj][m][0], v1 = acc[ai][bj][m][1];
                    if (ACT0 == 1 && act) {
#pragma unroll
                        for (int j = 0; j < 4; ++j) { v0[j] = gelu_tanh(v0[j]); v1[j] = gelu_tanh(v1[j]); } }
                    v4u w; w.x = pk2(v0[0], v0[1]); w.y = pk2(v0[2], v0[3]); w.z = pk2(v1[0], v1[1]); w.w = pk2(v1[2], v1[3]);
                    *(v4u*)(rowp + bj * HALFT) = w; } }
    }
};

struct EpiRetIn {
    static constexpr bool PERM = true, AFTER_DRAIN = false;
    bf16 *Q, *K, *V; const float* cs; const float* sn;
    __device__ __forceinline__ void operator()(const pg8::f32x4 (&acc)[2][2][4][2], const Unit& u, int wr, int wc, int fr, int fq) const {
        const int row0 = u.pm * BMT + wr * 64 + fr; const int colt = u.pn * BMT;
        if (colt >= 2048) {
            const int col0 = colt - 2048 + wc * 32 + 8 * fq;
#pragma unroll
            for (int ai = 0; ai < 2; ++ai)
#pragma unroll
                for (int m = 0; m < 4; ++m) { bf16* rowp = V + (size_t)(row0 + ai * HALFT + m * 16) * 2048 + col0;
#pragma unroll
                    for (int bj = 0; bj < 2; ++bj) { const pg8::f32x4 v0 = acc[ai][bj][m][0], v1 = acc[ai][bj][m][1];
                        v4u w; w.x = pk2(v0[0], v0[1]); w.y = pk2(v0[2], v0[3]); w.z = pk2(v1[0], v1[1]); w.w = pk2(v1[2], v1[3]);
                        *(v4u*)(rowp + bj * HALFT) = w; } }
        } else {
            const bool isk = colt >= 1024; bf16* base = isk ? K : Q; const float sc = isk ? 0.0625f : 1.0f;
            const int col0 = (isk ? colt - 1024 : colt) + wc * 32 + 8 * fq; const int f0 = wc * 32 + 8 * fq;
#pragma unroll
            for (int ai = 0; ai < 2; ++ai)
#pragma unroll
                for (int m = 0; m < 4; ++m) { const int row = row0 + ai * HALFT + m * 16; const int pos = row & (SEQ - 1);
                    const pg8::f32x4 c0 = *(const pg8::f32x4*)(cs + pos * 128 + f0), c1 = *(const pg8::f32x4*)(cs + pos * 128 + f0 + 4);
                    const pg8::f32x4 s0 = *(const pg8::f32x4*)(sn + pos * 128 + f0), s1 = *(const pg8::f32x4*)(sn + pos * 128 + f0 + 4);
                    const pg8::f32x4 a0 = acc[ai][0][m][0] * sc, a1 = acc[ai][0][m][1] * sc, b0 = acc[ai][1][m][0] * sc, b1 = acc[ai][1][m][1] * sc;
                    const pg8::f32x4 r0 = a0 * c0 - b0 * s0, r1 = a1 * c1 - b1 * s1, q0 = a0 * s0 + b0 * c0, q1 = a1 * s1 + b1 * c1;
                    bf16* rowp = base + (size_t)row * 1024 + col0;
                    v4u w; w.x = pk2(r0[0], r0[1]); w.y = pk2(r0[2], r0[3]); w.z = pk2(r1[0], r1[1]); w.w = pk2(r1[2], r1[3]); *(v4u*)(rowp) = w;
                    v4u w2; w2.x = pk2(q0[0], q0[1]); w2.y = pk2(q0[2], q0[3]); w2.z = pk2(q1[0], q1[1]); w2.w = pk2(q1[2], q1[3]); *(v4u*)(rowp + HALFT) = w2; }
        }
    }
};

struct EpiRetGate {
    static constexpr bool PERM = true, AFTER_DRAIN = false;
    bf16* O; const float* STAT;
    __device__ __forceinline__ void operator()(const pg8::f32x4 (&acc)[2][2][4][2], const Unit& u, int wr, int wc, int fr, int fq) const {
        const int row0 = u.pm * BMT + wr * 64 + fr; const int head = u.pn >> 1; const int col0 = u.pn * BMT + wc * 32 + 8 * fq;
#pragma unroll
        for (int ai = 0; ai < 2; ++ai)
#pragma unroll
            for (int m = 0; m < 4; ++m) { const int row = row0 + ai * HALFT + m * 16;
                const pg8::f32x4 st = *(const pg8::f32x4*)(STAT + (size_t)row * 16 + head * 4);
                const float mean = (st[0] + st[2]) * (1.0f / 512.0f); const float var = (st[1] + st[3]) * (1.0f / 512.0f) - mean * mean;
                const float rstd = __builtin_amdgcn_rsqf(fmaxf(var, 0.f) + 1e-5f);
                bf16* rowp = O + (size_t)row * 2048 + col0;
#pragma unroll
                for (int bj = 0; bj < 2; ++bj) { const v4u ov = *(const v4u*)(rowp + bj * HALFT);
                    const pg8::f32x4 g0 = acc[ai][bj][m][0], g1 = acc[ai][bj][m][1];
                    float o[8] = {bflo(ov.x), bfhi(ov.x), bflo(ov.y), bfhi(ov.y), bflo(ov.z), bfhi(ov.z), bflo(ov.w), bfhi(ov.w)};
                    float r[8];
#pragma unroll
                    for (int j = 0; j < 8; ++j) { const float g = j < 4 ? g0[j] : g1[j - 4]; r[j] = g * sigmoidf_(g) * (o[j] - mean) * rstd; }
                    v4u w; w.x = pk2(r[0], r[1]); w.y = pk2(r[2], r[3]); w.z = pk2(r[4], r[5]); w.w = pk2(r[6], r[7]);
                    *(v4u*)(rowp + bj * HALFT) = w; } }
    }
};

struct EpiPle {
    static constexpr bool PERM = true, AFTER_DRAIN = false;
    const bf16* Xin; const bf16* PP; bf16* XBo; const float* bg; float* OutF;
    __device__ __forceinline__ void operator()(const pg8::f32x4 (&acc)[2][2][4][2], const Unit& u, int wr, int wc, int fr, int fq) const {
        const int row0 = u.pm * BMT + wr * 64 + fr; const int col0 = u.pn * BMT + wc * 32 + 8 * fq;
        pg8::f32x4 bv[2][2];
#pragma unroll
        for (int bj = 0; bj < 2; ++bj)
#pragma unroll
            for (int n = 0; n < 2; ++n) bv[bj][n] = *(const pg8::f32x4*)(bg + col0 + bj * HALFT + 4 * n);
#pragma unroll
        for (int ai = 0; ai < 2; ++ai)
#pragma unroll
            for (int m = 0; m < 4; ++m) { const size_t off = (size_t)(row0 + ai * HALFT + m * 16) * DM + col0;
#pragma unroll
                for (int bj = 0; bj < 2; ++bj) {
                    const v4u pv = *(const v4u*)(PP + off + bj * HALFT), xv = *(const v4u*)(Xin + off + bj * HALFT);
                    const float pp[8] = {bflo(pv.x), bfhi(pv.x), bflo(pv.y), bfhi(pv.y), bflo(pv.z), bfhi(pv.z), bflo(pv.w), bfhi(pv.w)};
                    const float xx[8] = {bflo(xv.x), bfhi(xv.x), bflo(xv.y), bfhi(xv.y), bflo(xv.z), bfhi(xv.z), bflo(xv.w), bfhi(xv.w)};
                    pg8::f32x4 o0, o1;
#pragma unroll
                    for (int j = 0; j < 4; ++j) { o0[j] = xx[j] + sigmoidf_(acc[ai][bj][m][0][j] + bv[bj][0][j]) * pp[j];
                                                  o1[j] = xx[4 + j] + sigmoidf_(acc[ai][bj][m][1][j] + bv[bj][1][j]) * pp[4 + j]; }
                    if (OutF) { *(pg8::f32x4*)(OutF + off + bj * HALFT) = o0; *(pg8::f32x4*)(OutF + off + bj * HALFT + 4) = o1; }
                    else { v4u w; w.x = pk2(o0[0], o0[1]); w.y = pk2(o0[2], o0[3]); w.z = pk2(o1[0], o1[1]); w.w = pk2(o1[2], o1[3]);
                        *(v4u*)(XBo + off + bj * HALFT) = w; } } }
    }
};

template <class Epi>
__device__ __forceinline__ void run_gemm(const Ctx& c, const bf16* A, const bf16* Bt, int N, int K, const Epi& E) {
    asm volatile("" : "+s"(K), "+s"(N));
    pg8::Gemm g{A, Bt, T_TOK, N, K}; pg8::StaticOrder S; S.init(T_TOK, N, c.G, c.bid);
    pg8::gemm_phase<Epi, pg8::StaticOrder, false>((PG8_LAS unsigned char*)c.lds, g, S, E, nullptr);
}

__device__ __forceinline__ unsigned sort_key(float f) { const unsigned u = __builtin_bit_cast(unsigned, f); return (u & 0x80000000u) ? ~u : (u | 0x80000000u); }
__device__ __forceinline__ unsigned half_sel(unsigned long long m, int half) { return half ? (unsigned)(m >> 32) : (unsigned)m; }

#define PK_CE(i, j) { const unsigned hi_ = b[i] > b[j] ? b[i] : b[j], lo_ = b[i] > b[j] ? b[j] : b[i]; b[i] = hi_; b[j] = lo_; }
__device__ __forceinline__ void sort16_desc(unsigned (&b)[16]) {
#define CE(i, j) PK_CE(i, j)
    CE(0,1) CE(2,3) CE(0,2) CE(1,3) CE(1,2) CE(4,5) CE(6,7) CE(4,6) CE(5,7) CE(5,6) CE(0,4) CE(2,6) CE(2,4) CE(1,5) CE(3,7) CE(3,5) CE(1,2) CE(3,4) CE(5,6) CE(8,9) CE(10,11) CE(8,10) CE(9,11) CE(9,10) CE(12,13) CE(14,15) CE(12,14) CE(13,15) CE(13,14) CE(8,12) CE(10,14) CE(10,12) CE(9,13) CE(11,15) CE(11,13) CE(9,10) CE(11,12) CE(13,14) CE(0,8) CE(4,12) CE(4,8) CE(2,10) CE(6,14) CE(6,10) CE(2,4) CE(6,8) CE(10,12) CE(1,9) CE(5,13) CE(5,9) CE(3,11) CE(7,15) CE(7,11) CE(3,5) CE(7,9) CE(11,13) CE(1,2) CE(3,4) CE(5,6) CE(7,8) CE(9,10) CE(11,12) CE(13,14)
#undef CE
}
__device__ __forceinline__ void merge16_desc(unsigned (&t)[16], const unsigned (&bb)[16]) {
    unsigned b[16];
#pragma unroll
    for (int i = 0; i < 16; ++i) b[i] = t[i] > bb[15 - i] ? t[i] : bb[15 - i];
#pragma unroll
    for (int d = 8; d >= 1; d >>= 1)
#pragma unroll
        for (int i = 0; i < 16; ++i) if ((i & d) == 0) PK_CE(i, i + d)
#pragma unroll
    for (int i = 0; i < 16; ++i) t[i] = b[i];
}
__device__ __forceinline__ void ins16(unsigned (&t)[16], unsigned x) {
#pragma unroll
    for (int p = 0; p < 16; ++p) { const unsigned hi = x > t[p] ? x : t[p], lo = x > t[p] ? t[p] : x; t[p] = hi; x = lo; }
}
__device__ __forceinline__ float unsort_key16(unsigned k) { const unsigned u = k ^ (~(unsigned)((int)k >> 31) | 0x80000000u); return __builtin_bit_cast(float, u & 0xffff0000u); }
__device__ __forceinline__ float unsort_key(unsigned k) { const unsigned u = (k & 0x80000000u) ? (k & 0x7fffffffu) : ~k; return __builtin_bit_cast(float, u); }
__device__ __forceinline__ void phase_peer_topk(const Ctx& c) {
    const int gw = c.bid * NWAVES + c.wave, NGW = c.G * NWAVES, lane = c.lane;
    const bf16* SCT = (const bf16*)(c.ws + WS_M + M_SC); int* IDS = (int*)(c.ws + WS_M + M_IDS); float* GATES = (float*)(c.ws + WS_M + M_GATES);
    LAS unsigned char* lidx = c.lds + c.wave * 2048 + lane * 32;
    for (int wu = gw; wu < 8192; wu += NGW) {
        const int tblk = wu >> 3, hd = wu & 7, tok = tblk * 64 + lane;
        unsigned tA[16], tB[16];
        const v4u* pa = (const v4u*)SCT + ((size_t)tblk * 256 + hd * 32) * 64 + lane; const v4u* pb = pa + 16 * 64;
        v4u nxa[2] = {pa[0], pa[64]}, nxb[2] = {pb[0], pb[64]};
#pragma unroll 1
        for (int blk = 0; blk < 8; ++blk) {
            unsigned ka[16], kb[16];
            const v4u cxa[2] = {nxa[0], nxa[1]}, cxb[2] = {nxb[0], nxb[1]};
            if (blk < 7) { nxa[0] = pa[(2 * blk + 2) * 64]; nxa[1] = pa[(2 * blk + 3) * 64]; nxb[0] = pb[(2 * blk + 2) * 64]; nxb[1] = pb[(2 * blk + 3) * 64]; }
#pragma unroll
            for (int gg = 0; gg < 2; ++gg) { const v4u xa = cxa[gg], xb = cxb[gg];
#pragma unroll
                for (int j = 0; j < 4; ++j) { const unsigned lo0 = (unsigned)(127 - (16 * blk + 8 * gg + 2 * j)), lo1 = lo0 - 1u;
                    ka[8 * gg + 2 * j] = (xa[j] << 16) | lo0; ka[8 * gg + 2 * j + 1] = (xa[j] & 0xffff0000u) | lo1;
                    kb[8 * gg + 2 * j] = (xb[j] << 16) | lo0; kb[8 * gg + 2 * j + 1] = (xb[j] & 0xffff0000u) | lo1; } }
            sort16_desc(ka); sort16_desc(kb);
            if (blk == 0) {
#pragma unroll
                for (int i = 0; i < 16; ++i) { tA[i] = ka[i]; tB[i] = kb[i]; }
            } else { merge16_desc(tA, ka); merge16_desc(tB, kb); }
        }
        float a[16], b[16];
#pragma unroll
        for (int i = 0; i < 16; ++i) { a[i] = unsort_key16(tA[i]); b[i] = unsort_key16(tB[i]); lidx[i] = (unsigned char)(127u - (tA[i] & 127u)); lidx[16 + i] = (unsigned char)(127u - (tB[i] & 127u)); }
        unsigned uu[16];
        uu[0] = (sort_key(a[0] + b[0]) & ~255u) | 0u;
        uu[1] = (sort_key(a[0] + b[1]) & ~255u) | 1u;
        uu[2] = (sort_key(a[0] + b[2]) & ~255u) | 2u;
        uu[3] = (sort_key(a[0] + b[3]) & ~255u) | 3u;
        uu[4] = (sort_key(a[0] + b[4]) & ~255u) | 4u;
        uu[5] = (sort_key(a[0] + b[5]) & ~255u) | 5u;
        uu[6] = (sort_key(a[0] + b[6]) & ~255u) | 6u;
        uu[7] = (sort_key(a[0] + b[7]) & ~255u) | 7u;
        uu[8] = (sort_key(a[0] + b[8]) & ~255u) | 8u;
        uu[9] = (sort_key(a[0] + b[9]) & ~255u) | 9u;
        uu[10] = (sort_key(a[0] + b[10]) & ~255u) | 10u;
        uu[11] = (sort_key(a[0] + b[11]) & ~255u) | 11u;
        uu[12] = (sort_key(a[0] + b[12]) & ~255u) | 12u;
        uu[13] = (sort_key(a[0] + b[13]) & ~255u) | 13u;
        uu[14] = (sort_key(a[0] + b[14]) & ~255u) | 14u;
        uu[15] = (sort_key(a[0] + b[15]) & ~255u) | 15u;
        sort16_desc(uu);
        unsigned cb[16];
        cb[0] = (sort_key(a[1] + b[0]) & ~255u) | 16u;
        cb[1] = (sort_key(a[1] + b[1]) & ~255u) | 17u;
        cb[2] = (sort_key(a[1] + b[2]) & ~255u) | 18u;
        cb[3] = (sort_key(a[1] + b[3]) & ~255u) | 19u;
        cb[4] = (sort_key(a[1] + b[4]) & ~255u) | 20u;
        cb[5] = (sort_key(a[1] + b[5]) & ~255u) | 21u;
        cb[6] = (sort_key(a[1] + b[6]) & ~255u) | 22u;
        cb[7] = (sort_key(a[1] + b[7]) & ~255u) | 23u;
        cb[8] = (sort_key(a[2] + b[0]) & ~255u) | 32u;
        cb[9] = (sort_key(a[2] + b[1]) & ~255u) | 33u;
        cb[10] = (sort_key(a[2] + b[2]) & ~255u) | 34u;
        cb[11] = (sort_key(a[2] + b[3]) & ~255u) | 35u;
        cb[12] = (sort_key(a[2] + b[4]) & ~255u) | 36u;
        cb[13] = (sort_key(a[3] + b[0]) & ~255u) | 48u;
        cb[14] = (sort_key(a[3] + b[1]) & ~255u) | 49u;
        cb[15] = (sort_key(a[3] + b[2]) & ~255u) | 50u;
        sort16_desc(cb); merge16_desc(uu, cb);
        cb[0] = (sort_key(a[3] + b[3]) & ~255u) | 51u;
        cb[1] = (sort_key(a[4] + b[0]) & ~255u) | 64u;
        cb[2] = (sort_key(a[4] + b[1]) & ~255u) | 65u;
        cb[3] = (sort_key(a[4] + b[2]) & ~255u) | 66u;
        cb[4] = (sort_key(a[5] + b[0]) & ~255u) | 80u;
        cb[5] = (sort_key(a[5] + b[1]) & ~255u) | 81u;
        cb[6] = (sort_key(a[6] + b[0]) & ~255u) | 96u;
        cb[7] = (sort_key(a[6] + b[1]) & ~255u) | 97u;
        cb[8] = (sort_key(a[7] + b[0]) & ~255u) | 112u;
        cb[9] = (sort_key(a[7] + b[1]) & ~255u) | 113u;
        cb[10] = (sort_key(a[8] + b[0]) & ~255u) | 128u;
        cb[11] = (sort_key(a[9] + b[0]) & ~255u) | 144u;
        cb[12] = (sort_key(a[10] + b[0]) & ~255u) | 160u;
        cb[13] = (sort_key(a[11] + b[0]) & ~255u) | 176u;
        cb[14] = (sort_key(a[12] + b[0]) & ~255u) | 192u;
        cb[15] = (sort_key(a[13] + b[0]) & ~255u) | 208u;
        sort16_desc(cb); merge16_desc(uu, cb);
        cb[0] = (sort_key(a[14] + b[0]) & ~255u) | 224u;
        cb[1] = (sort_key(a[15] + b[0]) & ~255u) | 240u;
        cb[2] = 0u;
        cb[3] = 0u;
        cb[4] = 0u;
        cb[5] = 0u;
        cb[6] = 0u;
        cb[7] = 0u;
        cb[8] = 0u;
        cb[9] = 0u;
        cb[10] = 0u;
        cb[11] = 0u;
        cb[12] = 0u;
        cb[13] = 0u;
        cb[14] = 0u;
        cb[15] = 0u;
        sort16_desc(cb); merge16_desc(uu, cb);
        LDS_WAIT(); asm volatile("" ::: "memory");
        float sc[16], sum = 0.f; int eid[16];
        const float s0 = unsort_key(uu[0] & ~255u);
#pragma unroll
        for (int r = 0; r < 16; ++r) { const float s = unsort_key(uu[r] & ~255u); sc[r] = __expf(s - s0); sum += sc[r];
            const int i = (uu[r] >> 4) & 15, j = uu[r] & 15; eid[r] = (int)lidx[i] * 128 + (int)lidx[16 + j]; }
        const float inv = 1.0f / sum;
#pragma unroll
        for (int q = 0; q < 4; ++q) {
            *(v4u*)(IDS + (size_t)tok * 128 + hd * 16 + 4 * q) = (v4u){(unsigned)eid[4 * q], (unsigned)eid[4 * q + 1], (unsigned)eid[4 * q + 2], (unsigned)eid[4 * q + 3]};
            *(f32x4*)(GATES + (size_t)tok * 128 + hd * 16 + 4 * q) = (f32x4){sc[4 * q] * inv, sc[4 * q + 1] * inv, sc[4 * q + 2] * inv, sc[4 * q + 3] * inv};
        }
        LDS_WAIT(); asm volatile("" ::: "memory");
    }
}

#if !(PEER_U4 && PEER_V4)
#error "this gather expects both expert tables in fp4 (interleaved rows)"
#endif
typedef int v8i_t __attribute__((ext_vector_type(8)));
constexpr float PEER_XSCALE = 8.0f;
struct PeerGroup { v4u ua[8]; float g4[4]; };
__device__ __forceinline__ void peer_load(PeerGroup& B, const unsigned char* TAB, int idv, float gv, int kb, int lane) {
    const int m = lane & 15, kg = lane >> 4;
    const int idm = __builtin_amdgcn_ds_bpermute(4 * (kb + m), idv);
    const unsigned char* up = TAB + (size_t)idm * 1024 + 16 * kg;
#pragma unroll
    for (int cc = 0; cc < 8; ++cc) B.ua[cc] = *(const v4u*)(up + 64 * cc);
#pragma unroll
    for (int r = 0; r < 4; ++r) B.g4[r] = __builtin_bit_cast(float, __builtin_amdgcn_ds_bpermute(4 * (kb + 4 * kg + r), __builtin_bit_cast(int, gv)));
}
template <int J> __device__ __forceinline__ f32x2 fp4_pair(const v4u& w) { return __builtin_amdgcn_cvt_scalef32_pk_f32_fp4(w[J >> 2], 1.0f, J & 3); }
__device__ __forceinline__ void peer_compute(const PeerGroup& B, const unsigned char* TAB, int idv, int kb, const LAS unsigned char* xb8, f32x2 (&y2)[16], int lane) {
    const int hf = lane >> 5, l31 = lane & 31;
    v4u vv[8];
#pragma unroll
    for (int e = 0; e < 8; ++e) {
        const int ida = __builtin_amdgcn_readlane(idv, kb + 2 * e), idb = __builtin_amdgcn_readlane(idv, kb + 2 * e + 1);
        vv[e] = *(const v4u*)(TAB + (size_t)(hf ? idb : ida) * 1024 + 512 + 16 * l31);
    }
    f32x4 d = {0.f, 0.f, 0.f, 0.f};
#pragma unroll
    for (int cc = 0; cc < 8; ++cc) {
        asm volatile("" ::: "memory");
        const v4u b0 = *(const LAS v4u*)(xb8 + 128 * cc), b1 = *(const LAS v4u*)(xb8 + 128 * cc + 64);
        const v8i_t bx = {(int)b0.x, (int)b0.y, (int)b0.z, (int)b0.w, (int)b1.x, (int)b1.y, (int)b1.z, (int)b1.w};
        const v8i_t ax = {(int)B.ua[cc].x, (int)B.ua[cc].y, (int)B.ua[cc].z, (int)B.ua[cc].w, 0, 0, 0, 0};
        d = __builtin_amdgcn_mfma_scale_f32_16x16x128_f8f6f4(ax, bx, d, 4  , 0  , 0, 127, 0, 127);
    }
    float a4[4];
#pragma unroll
    for (int r = 0; r < 4; ++r) a4[r] = gelu_tanh(d[r] * (1.0f / (PEER_USCALE * PEER_XSCALE))) * B.g4[r] * (1.0f / PEER_VSCALE);
#pragma unroll
    for (int e = 0; e < 8; ++e) {
        const int ma = 2 * e, mb = 2 * e + 1;
        const float a0 = __builtin_bit_cast(float, __builtin_amdgcn_readlane(__builtin_bit_cast(int, a4[ma & 3]), 16 * (ma >> 2))), a1 = __builtin_bit_cast(float, __builtin_amdgcn_readlane(__builtin_bit_cast(int, a4[mb & 3]), 16 * (mb >> 2)));
        const float a = hf ? a1 : a0; const f32x2 a2 = {a, a};
#define PEER_AXPY(J) y2[J] = __builtin_elementwise_fma(a2, fp4_pair<J>(vv[e]), y2[J]);
        PEER_AXPY(0) PEER_AXPY(1) PEER_AXPY(2) PEER_AXPY(3) PEER_AXPY(4) PEER_AXPY(5) PEER_AXPY(6) PEER_AXPY(7)
        PEER_AXPY(8) PEER_AXPY(9) PEER_AXPY(10) PEER_AXPY(11) PEER_AXPY(12) PEER_AXPY(13) PEER_AXPY(14) PEER_AXPY(15)
#undef PEER_AXPY
    }
}
template <class BarFn>
__device__ __forceinline__ void phase_peer_gather(const Ctx& c, int layer, const BarFn&) {
    const int gw = c.bid * NWAVES + c.wave, NGW = c.G * NWAVES;
    const int* IDS = (const int*)(c.ws + WS_M + M_IDS); const float* GATES = (const float*)(c.ws + WS_M + M_GATES);
    const unsigned char* TAB = c.ws + WS_TABU;
    const float* gain = INP(c, I_LN2_G) + layer * DM; const float* bias = INP(c, I_LN2_B) + layer * DM;
    bf16* xb = (bf16*)(c.ws + ((layer & 1) ? WS_XB1 : WS_XB0));
    const int lane = c.lane, hf = lane >> 5, l31 = lane & 31;
    LAS unsigned char* xbase = c.lds + c.wave * 3072;
    { unsigned z = 0u; asm volatile("" : "+v"(z));
      *(LAS v4u*)(xbase + 2048 + 16 * lane) = (v4u){z, z, z, z}; }
    const bool col0 = (lane & 15) == 0;
    auto stage_x = [&](int tk, int buf) {
        const bf16* xr = xb + (size_t)tk * DM + 32 * l31; v4u w0, w1;
#pragma unroll
        for (int q = 0; q < 4; ++q) { const v4u xv = *(const v4u*)(xr + 8 * q);
            int pa = 0, pb = 0;
            pa = __builtin_amdgcn_cvt_pk_fp8_f32(bflo(xv.x) * PEER_XSCALE, bfhi(xv.x) * PEER_XSCALE, pa, false); pa = __builtin_amdgcn_cvt_pk_fp8_f32(bflo(xv.y) * PEER_XSCALE, bfhi(xv.y) * PEER_XSCALE, pa, true);
            pb = __builtin_amdgcn_cvt_pk_fp8_f32(bflo(xv.z) * PEER_XSCALE, bfhi(xv.z) * PEER_XSCALE, pb, false); pb = __builtin_amdgcn_cvt_pk_fp8_f32(bflo(xv.w) * PEER_XSCALE, bfhi(xv.w) * PEER_XSCALE, pb, true);
            if (q < 2) { w0[2 * q] = (unsigned)pa; w0[2 * q + 1] = (unsigned)pb; } else { w1[2 * q - 4] = (unsigned)pa; w1[2 * q - 3] = (unsigned)pb; } }
        if (hf == 0) { *(LAS v4u*)(xbase + 1024 * buf + 32 * l31) = w0; *(LAS v4u*)(xbase + 1024 * buf + 32 * l31 + 16) = w1; } };
    int tok = gw, par = 0;
    int idA = 0, idB = 0; float gA = 0.f, gB = 0.f;
    PeerGroup G0, G1;
    if (tok < T_TOK) {
        idA = IDS[(size_t)tok * 128 + lane]; idB = IDS[(size_t)tok * 128 + 64 + lane]; gA = GATES[(size_t)tok * 128 + lane]; gB = GATES[(size_t)tok * 128 + 64 + lane];
        stage_x(tok, 0);
        peer_load(G0, TAB, idA, gA, 0, lane);
    }
#pragma unroll 1
    while (tok < T_TOK) {
        const int ntok = tok + NGW; const bool has_next = ntok < T_TOK;
        int nidA = 0, nidB = 0; float ngA = 0.f, ngB = 0.f;
        if (has_next) { nidA = IDS[(size_t)ntok * 128 + lane]; nidB = IDS[(size_t)ntok * 128 + 64 + lane]; ngA = GATES[(size_t)ntok * 128 + lane]; ngB = GATES[(size_t)ntok * 128 + 64 + lane]; }
        const LAS unsigned char* xb8 = col0 ? (xbase + 1024 * par + 16 * (lane >> 4)) : (xbase + 2048);
        f32x2 y2[16];
#pragma unroll
        for (int j = 0; j < 16; ++j) y2[j] = (f32x2){0.f, 0.f};
        v4u xres[2] = {(v4u){0u, 0u, 0u, 0u}, (v4u){0u, 0u, 0u, 0u}};
        LDS_WAIT(); asm volatile("" ::: "memory");
#define PEER_LD(Gx, g) peer_load(Gx, TAB, ((g) >= 4) ? idB : idA, ((g) >= 4) ? gB : gA, ((g) & 3) * 16, lane)
#define PEER_CP(Gx, g) peer_compute(Gx, TAB, ((g) >= 4) ? idB : idA, ((g) & 3) * 16, xb8, y2, lane)
#pragma unroll 1
        for (int g = 0; g < 8; g += 2) {
            PEER_LD(G1, g + 1); PEER_CP(G0, g);
            if (g == 2 && has_next) stage_x(ntok, par ^ 1);
            if (g + 2 < 8) PEER_LD(G0, g + 2); else if (has_next) peer_load(G0, TAB, nidA, ngA, 0, lane);
            if (g == 6) { xres[0] = *(const v4u*)(xb + (size_t)tok * DM + 32 * l31 + 16 * hf); xres[1] = *(const v4u*)(xb + (size_t)tok * DM + 32 * l31 + 16 * hf + 8); }
            PEER_CP(G1, g + 1);
        }
#undef PEER_LD
#undef PEER_CP
        float z[16];
#pragma unroll
        for (int j = 0; j < 16; ++j) { const float tx = y2[j].x + __shfl_xor(y2[j].x, 32), ty = y2[j].y + __shfl_xor(y2[j].y, 32); y2[j] = (f32x2){tx, ty}; }
#pragma unroll
        for (int j = 0; j < 8; ++j) { const unsigned xw = xres[j >> 2][j & 3]; z[2 * j] = (hf ? y2[8 + j].x : y2[j].x) + ALPHA_DN * bflo(xw); z[2 * j + 1] = (hf ? y2[8 + j].y : y2[j].y) + ALPHA_DN * bfhi(xw); }
        float s = 0.f;
#pragma unroll
        for (int j = 0; j < 16; ++j) s += z[j];
        const float mean = wave_sum(s) * (1.f / 1024.f);
        float s2 = 0.f;
#pragma unroll
        for (int j = 0; j < 16; ++j) { z[j] -= mean; s2 += z[j] * z[j]; }
        const float rstd = __builtin_amdgcn_rsqf(wave_sum(s2) * (1.f / 1024.f) + 1e-5f);
        const int col = 32 * l31 + 16 * hf; float o[16];
#pragma unroll
        for (int q = 0; q < 4; ++q) { const f32x4 gq = *(const f32x4*)(gain + col + 4 * q), bq = *(const f32x4*)(bias + col + 4 * q); f32x4 r;
#pragma unroll
            for (int j = 0; j < 4; ++j) { r[j] = z[4 * q + j] * rstd * gq[j] + bq[j]; o[4 * q + j] = r[j]; } }
        v4u w0, w1; w0.x = pk2(o[0], o[1]); w0.y = pk2(o[2], o[3]); w0.z = pk2(o[4], o[5]); w0.w = pk2(o[6], o[7]);
        w1.x = pk2(o[8], o[9]); w1.y = pk2(o[10], o[11]); w1.z = pk2(o[12], o[13]); w1.w = pk2(o[14], o[15]);
        *(v4u*)(xb + (size_t)tok * DM + col) = w0; *(v4u*)(xb + (size_t)tok * DM + col + 8) = w1;
        idA = nidA; idB = nidB; gA = ngA; gB = ngB; par ^= 1; tok = ntok;
    }
}

__device__ __forceinline__ void phase_dsa_norm(const Ctx& c, int j) {
    const int gw = c.bid * NWAVES + c.wave, NGW = c.G * NWAVES, lane = c.lane;
    const bf16* RAW = (const bf16*)(c.ws + WS_M + M_RAW);
    bf16* CQ = (bf16*)(c.ws + WS_M + M_CQ); bf16* CKV = (bf16*)(c.ws + WS_M + M_CKV);
    bf16* KIDX = (bf16*)(c.ws + WS_M + M_KIDX); float* WIDX = (float*)(c.ws + WS_M + M_WIDX);
    const float* gq = INP(c, I_A_CQ_GAIN) + j * 256; const float* gkv = INP(c, I_A_CKV_GAIN) + j * 128;
    const float* gk = INP(c, I_A_KIDX_GAIN) + j * 64; const float* bk = INP(c, I_A_KIDX_BIAS) + j * 64;
    for (int tok = gw; tok < T_TOK; tok += NGW) {
        const v4u rw = *(const v4u*)(RAW + (size_t)tok * 512 + 8 * lane);
        float v[8] = {bflo(rw.x), bfhi(rw.x), bflo(rw.y), bfhi(rw.y), bflo(rw.z), bfhi(rw.z), bflo(rw.w), bfhi(rw.w)};
        float ss = 0.f, s = 0.f;
#pragma unroll
        for (int i = 0; i < 8; ++i) { ss += v[i] * v[i]; s += v[i]; }
        const bool isq = lane < 32, iskv = lane >= 32 && lane < 48, isk = lane >= 48 && lane < 56;
        const float ssq_q = wave_sum(isq ? ss : 0.f), ssq_kv = wave_sum(iskv ? ss : 0.f), sum_k = wave_sum(isk ? s : 0.f);
        const float mean_k = sum_k * (1.0f / 64.0f);
        float dv = 0.f;
#pragma unroll
        for (int i = 0; i < 8; ++i) { const float d = v[i] - mean_k; dv += d * d; }
        const float var_k = wave_sum(isk ? dv : 0.f) * (1.0f / 64.0f);
        if (isq) {
            const float r = __builtin_amdgcn_rsqf(ssq_q * (1.0f / 256.0f) + 1e-6f); const float* g = gq + 8 * lane;
            v4u w; w.x = pk2(v[0] * r * g[0], v[1] * r * g[1]); w.y = pk2(v[2] * r * g[2], v[3] * r * g[3]); w.z = pk2(v[4] * r * g[4], v[5] * r * g[5]); w.w = pk2(v[6] * r * g[6], v[7] * r * g[7]);
            *(v4u*)(CQ + (size_t)tok * 256 + 8 * lane) = w;
        } else if (iskv) {
            const int c0 = 8 * (lane - 32); const float r = __builtin_amdgcn_rsqf(ssq_kv * (1.0f / 128.0f) + 1e-6f); const float* g = gkv + c0;
            float o[8];
#pragma unroll
            for (int i = 0; i < 8; ++i) o[i] = v[i] * r * g[i];
            v4u w; w.x = pk2(o[0], o[1]); w.y = pk2(o[2], o[3]); w.z = pk2(o[4], o[5]); w.w = pk2(o[6], o[7]);
            *(v4u*)(CKV + (size_t)tok * 128 + c0) = w;
        } else if (isk) {
            const int c0 = 8 * (lane - 48); const float r = __builtin_amdgcn_rsqf(var_k + 1e-5f);
            float o[8];
#pragma unroll
            for (int i = 0; i < 8; ++i) o[i] = (v[i] - mean_k) * r * gk[c0 + i] + bk[c0 + i];
            v4u w; w.x = pk2(o[0], o[1]); w.y = pk2(o[2], o[3]); w.z = pk2(o[4], o[5]); w.w = pk2(o[6], o[7]);
            *(v4u*)(KIDX + (size_t)tok * 64 + c0) = w;
        } else if (lane == 56) {
            const float sc = 0.35355339059327373f;
            f32x4 o0 = {v[0] * sc, v[1] * sc, v[2] * sc, v[3] * sc}, o1 = {v[4] * sc, v[5] * sc, v[6] * sc, v[7] * sc};
            *(f32x4*)(WIDX + (size_t)tok * 8) = o0; *(f32x4*)(WIDX + (size_t)tok * 8 + 4) = o1;
        }
    }
}

__device__ __forceinline__ unsigned half_sum_u32(unsigned v, int h) {
    auto dpp = [](unsigned x, auto ctrl, auto rmask) { return (unsigned)__builtin_amdgcn_update_dpp(0, (int)x, decltype(ctrl)::value, decltype(rmask)::value, 0xf, false); };
    v += dpp(v, std::integral_constant<int, 0xB1>{}, std::integral_constant<int, 0xf>{});
    v += dpp(v, std::integral_constant<int, 0x4E>{}, std::integral_constant<int, 0xf>{});
    v += dpp(v, std::integral_constant<int, 0x141>{}, std::integral_constant<int, 0xf>{});
    v += dpp(v, std::integral_constant<int, 0x140>{}, std::integral_constant<int, 0xf>{});
    v += dpp(v, std::integral_constant<int, 0x142>{}, std::integral_constant<int, 0xa>{});
    const unsigned t0 = (unsigned)__builtin_amdgcn_readlane((int)v, 31), t1 = (unsigned)__builtin_amdgcn_readlane((int)v, 63);
    return h ? t1 : t0;
}
__device__ __forceinline__ void phase_dsa_index(const Ctx& c) {
    const bf16* KIDX = (const bf16*)(c.ws + WS_M + M_KIDX); const bf16* QIDX = (const bf16*)(c.ws + WS_M + M_QIDX);
    const float* WIDX = (const float*)(c.ws + WS_M + M_WIDX); unsigned* MASK = (unsigned*)(c.ws + WS_M + M_MASK);
    const int lane = c.lane, n = lane & 31, h = lane >> 5;
    const unsigned ltmask = (1u << n) - 1u;
    LAS unsigned* kl = (LAS unsigned*)(c.lds + c.wave * 16384) + lane * 4;
    for (int u = c.bid; u < 2048; u += c.G) {
        const int b = u & 31, rest = u >> 5, qc = rest >> 1, sub = rest & 1;
        const int tw0 = b * 2048 + qc * 64 + sub * 32 + 4 * c.wave;
        const int nt = 2 * (qc + 1), ng = (nt + 3) >> 2;
        if (nt <= 8) {
            if (n == 0) {
                for (int tt = 0; tt < 2; ++tt)
                    for (int tile = 0; tile < nt; ++tile) MASK[(size_t)(tw0 + 2 * h + tt) * 64 + tile] = 0xffffffffu;
            }
            continue;
        }
        const int ti = 2 * ((n >> 2) & 1) + (n >> 4), hd = 4 * ((n >> 3) & 1) + (n & 3);
        bf16x8 Aq[4];
#pragma unroll
        for (int s = 0; s < 4; ++s) Aq[s] = *(const bf16x8*)(QIDX + (size_t)(tw0 + ti) * 512 + hd * 64 + 16 * s + 8 * h);
        float wv[2][8];
#pragma unroll
        for (int tt = 0; tt < 2; ++tt) { const f32x4 w0 = *(const f32x4*)(WIDX + (size_t)(tw0 + 2 * h + tt) * 8), w1 = *(const f32x4*)(WIDX + (size_t)(tw0 + 2 * h + tt) * 8 + 4);
#pragma unroll
            for (int i = 0; i < 4; ++i) { wv[tt][i] = w0[i]; wv[tt][4 + i] = w1[i]; } }
        const bf16* kbase = KIDX + (size_t)(b * 2048 + n) * 64 + 8 * h;
        auto ldgrp = [&](bf16x8 (&Bk)[2][4], int tile0) {
#pragma unroll
            for (int q = 0; q < 2; ++q) if (tile0 + q < nt) { const bf16* kr = kbase + (size_t)(tile0 + q) * 32 * 64;
#pragma unroll
                for (int s = 0; s < 4; ++s) Bk[q][s] = *(const bf16x8*)(kr + 16 * s); } };
        auto scgrp = [&](const bf16x8 (&Bk)[2][4], int tile0) {
#pragma unroll
            for (int q = 0; q < 2; ++q) if (tile0 + q < nt) {
                f32x16 acc;
#pragma unroll
                for (int i = 0; i < 16; ++i) acc[i] = 0.f;
#pragma unroll
                for (int s = 0; s < 4; ++s) acc = __builtin_amdgcn_mfma_f32_32x32x16_bf16(Aq[s], Bk[q][s], acc, 0, 0, 0);
                float sc0 = 0.f, sc1 = 0.f;
#pragma unroll
                for (int jj = 0; jj < 2; ++jj)
#pragma unroll
                    for (int k = 0; k < 4; ++k) { sc0 += wv[0][4 * jj + k] * fmaxf(acc[4 * jj + k], 0.f); sc1 += wv[1][4 * jj + k] * fmaxf(acc[8 + 4 * jj + k], 0.f); }
                kl[((tile0 + q) >> 2) * 256 + ((tile0 + q) & 3)] = (sort_key(sc0) >> 16) | (sort_key(sc1) & 0xffff0000u);
            } };
        bf16x8 BkA[2][4], BkB[2][4];
        ldgrp(BkA, 0);
#pragma unroll 1
        for (int tile0 = 0; tile0 < nt; tile0 += 4) {
            if (tile0 + 2 < nt) ldgrp(BkB, tile0 + 2);
            scgrp(BkA, tile0);
            if (tile0 + 4 < nt) ldgrp(BkA, tile0 + 4);
            if (tile0 + 2 < nt) scgrp(BkB, tile0 + 2);
        }
        if (nt & 2) { kl[(nt >> 2) * 256 + 2] = 0u; kl[(nt >> 2) * 256 + 3] = 0u; }
        LDS_WAIT(); asm volatile("" ::: "memory");
        unsigned v0 = 0u, v1 = 0u, cv0 = 0xffffu, cv1 = 0xffffu;
        for (int bit = 15; bit >= 0; --bit) {
            const unsigned c0 = v0 | (1u << bit), c1 = v1 | (1u << bit); unsigned lt0 = 0u, lt1 = 0u;
            for (int g = 0; g < ng; ++g) { const v4u k4 = *(const LAS v4u*)(kl + g * 256);
#pragma unroll
                for (int j = 0; j < 4; ++j) { lt0 += (unsigned)((int)((k4[j] & 0xffffu) - c0)) >> 31; lt1 += (unsigned)((int)((k4[j] >> 16) - c1)) >> 31; } }
            const unsigned both = half_sum_u32((4u * (unsigned)ng - lt0) | ((4u * (unsigned)ng - lt1) << 16), h);
            const unsigned cnt0 = both & 0xffffu, cnt1 = both >> 16;
            if (cnt0 >= 256u) { v0 = c0; cv0 = cnt0; }
            if (cnt1 >= 256u) { v1 = c1; cv1 = cnt1; }
            if (__all(cv0 == 256u && cv1 == 256u)) break;
        }
        unsigned g0 = 0u, g1 = 0u;
        for (int g = 0; g < ng; ++g) { const v4u k4 = *(const LAS v4u*)(kl + g * 256);
#pragma unroll
            for (int j = 0; j < 4; ++j) { g0 += (unsigned)((int)(v0 - (k4[j] & 0xffffu))) >> 31; g1 += (unsigned)((int)(v1 - (k4[j] >> 16))) >> 31; } }
        const unsigned gboth = half_sum_u32(g0 | (g1 << 16), h);
        const unsigned need0 = 256u - (gboth & 0xffffu), need1 = 256u - (gboth >> 16); unsigned eb0 = 0u, eb1 = 0u;
        for (int tile = 0; tile < nt; ++tile) {
            const unsigned kw = kl[(tile >> 2) * 256 + (tile & 3)]; const unsigned k0 = kw & 0xffffu, k1 = kw >> 16;
            { const bool gt = k0 > v0, eq = k0 == v0; const unsigned em = half_sel(__ballot(eq), h);
              const bool take = gt || (eq && (eb0 + __popc(em & ltmask) < need0)); eb0 += __popc(em);
              const unsigned word = half_sel(__ballot(take), h); if (n == 0) MASK[(size_t)(tw0 + 2 * h) * 64 + tile] = word; }
            { const bool gt = k1 > v1, eq = k1 == v1; const unsigned em = half_sel(__ballot(eq), h);
              const bool take = gt || (eq && (eb1 + __popc(em & ltmask) < need1)); eb1 += __popc(em);
              const unsigned word = half_sel(__ballot(take), h); if (n == 0) MASK[(size_t)(tw0 + 2 * h + 1) * 64 + tile] = word; }
        }
        LDS_WAIT(); asm volatile("" ::: "memory");
    }
}

__device__ __forceinline__ void tr_rd16(unsigned a, v2u (&r)[16]) {
    asm volatile("ds_read_b64_tr_b16 %0, %16\n\tds_read_b64_tr_b16 %1, %16 offset:4352\n\t"
                 "ds_read_b64_tr_b16 %2, %16 offset:32\n\tds_read_b64_tr_b16 %3, %16 offset:4384\n\t"
                 "ds_read_b64_tr_b16 %4, %16 offset:64\n\tds_read_b64_tr_b16 %5, %16 offset:4416\n\t"
                 "ds_read_b64_tr_b16 %6, %16 offset:96\n\tds_read_b64_tr_b16 %7, %16 offset:4448\n\t"
                 "ds_read_b64_tr_b16 %8, %16 offset:128\n\tds_read_b64_tr_b16 %9, %16 offset:4480\n\t"
                 "ds_read_b64_tr_b16 %10, %16 offset:160\n\tds_read_b64_tr_b16 %11, %16 offset:4512\n\t"
                 "ds_read_b64_tr_b16 %12, %16 offset:192\n\tds_read_b64_tr_b16 %13, %16 offset:4544\n\t"
                 "ds_read_b64_tr_b16 %14, %16 offset:224\n\tds_read_b64_tr_b16 %15, %16 offset:4576\n\ts_waitcnt lgkmcnt(0)"
                 : "=&v"(r[0]), "=&v"(r[1]), "=&v"(r[2]), "=&v"(r[3]), "=&v"(r[4]), "=&v"(r[5]), "=&v"(r[6]), "=&v"(r[7]),
                   "=&v"(r[8]), "=&v"(r[9]), "=&v"(r[10]), "=&v"(r[11]), "=&v"(r[12]), "=&v"(r[13]), "=&v"(r[14]), "=&v"(r[15])
                 : "v"(a) : "memory");
}
__device__ __forceinline__ void phase_dsa_attn(const Ctx& c) {
    const bf16* CKV = (const bf16*)(c.ws + WS_M + M_CKV);
    bf16* QLAT = (bf16*)(c.ws + WS_M + M_QLAT); const unsigned* MASK = (const unsigned*)(c.ws + WS_M + M_MASK);
    constexpr int RS = 272, TILE = 32 * RS;
    const int lane = c.lane, l15 = lane & 15, g = lane >> 4;
    LAS unsigned char* T0 = c.lds + c.wave * 17920;
    LAS unsigned short* klist = (LAS unsigned short*)(T0 + 2 * TILE);
    const unsigned lbase = (unsigned)(size_t)T0;
    const int prow = lane >> 4, ppc = lane & 15;
    for (int u = c.bid * NWAVES + c.wave; u < T_TOK; u += c.G * NWAVES) {
        const int tok = u, b = tok >> 11;
        const int qc = (tok & 2047) >> 6; const int nt = 2 * (qc + 1);
        const unsigned mwd = lane < nt ? MASK[(size_t)tok * 64 + lane] : 0u;
        unsigned incl = (unsigned)__popc(mwd);
#pragma unroll
        for (int d = 1; d < 64; d <<= 1) { const unsigned o = __shfl_up(incl, d); if (lane >= d) incl += o; }
        const int nsel = __builtin_amdgcn_readlane((int)incl, 63);
        { unsigned pos = incl - (unsigned)__popc(mwd), w = mwd;
          while (w) { const int bit = __builtin_ctz(w); klist[pos++] = (unsigned short)(32 * lane + bit); w &= w - 1u; } }
        bf16x8 Bq[4];
#pragma unroll
        for (int s = 0; s < 4; ++s) Bq[s] = *(const bf16x8*)(QLAT + (size_t)tok * 2048 + l15 * 128 + 32 * s + 8 * g);
        LDS_WAIT(); asm volatile("" ::: "memory");
        const int nstep = nsel >> 5;
        const bf16* kvb = CKV + (size_t)b * 2048 * 128 + ppc * 8;
        v4u gr[8];
        auto gather = [&](int step) {
#pragma unroll
            for (int j = 0; j < 8; ++j) { const int key = klist[32 * step + 4 * j + prow]; gr[j] = *(const v4u*)(kvb + (size_t)key * 128); } };
        auto lstore = [&](int buf) {
#pragma unroll
            for (int j = 0; j < 8; ++j) *(LAS v4u*)(T0 + buf * TILE + (4 * j + prow) * RS + ppc * 16) = gr[j]; };
        float m_run = -INFINITY, l_run = 0.f;
        f32x4 O[8];
#pragma unroll
        for (int dt = 0; dt < 8; ++dt) O[dt] = (f32x4){0.f, 0.f, 0.f, 0.f};
        gather(0);
#pragma unroll 1
        for (int step = 0; step < nstep; ++step) {
            const int buf = step & 1;
            lstore(buf);
            if (step + 1 < nstep) gather(step + 1);
            LDS_WAIT(); asm volatile("" ::: "memory");
            f32x4 S[2];
#pragma unroll
            for (int kt = 0; kt < 2; ++kt) { S[kt] = (f32x4){0.f, 0.f, 0.f, 0.f};
#pragma unroll
                for (int s = 0; s < 4; ++s) { const bf16x8 Ak = *(const LAS bf16x8*)(T0 + buf * TILE + (16 * kt + l15) * RS + (32 * s + 8 * g) * 2);
                    S[kt] = __builtin_amdgcn_mfma_f32_16x16x32_bf16(Ak, Bq[s], S[kt], 0, 0, 0); } }
            float mx = fmaxf(fmaxf(fmaxf(S[0][0], S[0][1]), fmaxf(S[0][2], S[0][3])), fmaxf(fmaxf(S[1][0], S[1][1]), fmaxf(S[1][2], S[1][3])));
            mx = fmaxf(mx, __shfl_xor(mx, 16)); mx = fmaxf(mx, __shfl_xor(mx, 32));
            const float m_new = fmaxf(m_run, mx);
            const float alpha = __builtin_amdgcn_exp2f(m_run - m_new);
            float p[8], ps = 0.f;
#pragma unroll
            for (int j = 0; j < 8; ++j) { p[j] = __builtin_amdgcn_exp2f(S[j >> 2][j & 3] - m_new); ps += p[j]; }
            l_run = l_run * alpha + ps; m_run = m_new;
            v4u pw; pw.x = pk2(p[0], p[1]); pw.y = pk2(p[2], p[3]); pw.z = pk2(p[4], p[5]); pw.w = pk2(p[6], p[7]);
            const bf16x8 Bp = __builtin_bit_cast(bf16x8, pw);
            const unsigned ta = lbase + buf * TILE + (4 * g + (l15 >> 2)) * RS + (4 * (l15 & 3)) * 2;
            v2u tr[16]; tr_rd16(ta, tr);
#pragma unroll
            for (int dt = 0; dt < 8; ++dt) {
                v4u aw; aw.x = tr[2 * dt].x; aw.y = tr[2 * dt].y; aw.z = tr[2 * dt + 1].x; aw.w = tr[2 * dt + 1].y;
                O[dt] = O[dt] * alpha; O[dt] = __builtin_amdgcn_mfma_f32_16x16x32_bf16(__builtin_bit_cast(bf16x8, aw), Bp, O[dt], 0, 0, 0); }
        }
        const float l_tot = l_run + __shfl_xor(l_run, 16); const float l_all = l_tot + __shfl_xor(l_tot, 32); const float inv = 1.0f / l_all;
#pragma unroll
        for (int dt = 0; dt < 8; ++dt) { v2u w; w.x = pk2(O[dt][0] * inv, O[dt][1] * inv); w.y = pk2(O[dt][2] * inv, O[dt][3] * inv);
            *(v2u*)(QLAT + (size_t)tok * 2048 + l15 * 128 + 16 * dt + 4 * g) = w; }
        LDS_WAIT(); asm volatile("" ::: "memory");
    }
}

__device__ __forceinline__ float neg_expm1_small(float x) {
    const float p = -x * (1.0f + x * 0.5f * (1.0f + x * (1.0f / 3.0f) * (1.0f + x * 0.25f * (1.0f + x * 0.2f * (1.0f + x * (1.0f / 6.0f))))));
    return x < -0.25f ? 1.0f - __expf(x) : p;
}
__device__ __forceinline__ void phase_rglru(const Ctx& c) {
    const bf16* GU = (const bf16*)(c.ws + WS_M + M_GU); bf16* Y = (bf16*)(c.ws + WS_M + M_Y);
    constexpr int CVS = 104;
    LAS float* uT = (LAS float*)c.lds;
    LAS bf16* cvb = (LAS bf16*)(c.lds + 21504);
    LAS bf16* WTa = (LAS bf16*)(c.lds + 34816);
    LAS bf16* WTx = (LAS bf16*)(c.lds + 51456);
    LAS float* a_s = (LAS float*)(c.lds + 68096);
    LAS float* b_s = (LAS float*)(c.lds + 88832);
    LAS bf16* gT = (LAS bf16*)(c.lds + 109568);
    LAS float* cst = (LAS float*)(c.lds + 120064);
    const int tid = c.tid, lane = c.lane, w = c.wave;
    for (int u = c.bid; u < 512; u += c.G) {
        const int b = u >> 4, nb = u & 15, ch0 = nb * 80;
        __syncthreads();
        for (int e = tid; e < 80 * CVS; e += NTHR) { const int d = e / CVS, k = e % CVS;
            WTa[e] = (bf16)(k < 80 ? f2bf(INP(c, I_B_W_A)[(size_t)nb * 6400 + k * 80 + d]) : 0u);
            WTx[e] = (bf16)(k < 80 ? f2bf(INP(c, I_B_W_X)[(size_t)nb * 6400 + k * 80 + d]) : 0u); }
        for (int e = tid; e < 64 * CVS; e += NTHR) cvb[e] = 0;
        if (tid < 80) {
            const int cc = ch0 + tid;
#pragma unroll
            for (int j = 0; j < 4; ++j) cst[j * 80 + tid] = INP(c, I_B_CONV_W)[j * 1280 + cc];
            cst[320 + tid] = INP(c, I_B_CONV_B)[cc]; cst[400 + tid] = INP(c, I_B_B_A)[cc]; cst[480 + tid] = INP(c, I_B_B_X)[cc];
            cst[560 + tid] = log1pf(expf(-INP(c, I_B_LAMBDA)[cc]));
        }
        float carry[10];
#pragma unroll
        for (int q = 0; q < 10; ++q) carry[q] = 0.f;
        v4u ureg[2], greg[2];
        auto issue_loads = [&](int chunk) {
#pragma unroll
            for (int q = 0; q < 2; ++q) { const int e = tid + NTHR * q;
                ureg[q] = (v4u){0u, 0u, 0u, 0u}; greg[q] = (v4u){0u, 0u, 0u, 0u};
                if (e < 670) { const int i = e / 10, cch = e % 10; const int sp = chunk * 64 - 3 + i;
                    if (sp >= 0) ureg[q] = *(const v4u*)(GU + (size_t)(b * 2048 + sp) * 2560 + 1280 + ch0 + cch * 8); }
                if (e < 640) { const int i = e / 10, cch = e % 10;
                    greg[q] = *(const v4u*)(GU + (size_t)(b * 2048 + chunk * 64 + i) * 2560 + ch0 + cch * 8); } }
        };
        issue_loads(0);
#pragma unroll 1
        for (int chunk = 0; chunk < 32; ++chunk) {
            const int t0 = b * 2048 + chunk * 64;
#pragma unroll
            for (int q = 0; q < 2; ++q) { const int e = tid + NTHR * q;
                if (e < 670) { const int i = e / 10, cch = e % 10; LAS float* d = uT + i * 80 + cch * 8;
                    *(LAS f32x4*)d = (f32x4){bflo(ureg[q].x), bfhi(ureg[q].x), bflo(ureg[q].y), bfhi(ureg[q].y)};
                    *(LAS f32x4*)(d + 4) = (f32x4){bflo(ureg[q].z), bfhi(ureg[q].z), bflo(ureg[q].w), bfhi(ureg[q].w)}; }
                if (e < 640) { const int i = e / 10, cch = e % 10; LAS unsigned* d = (LAS unsigned*)(gT + i * 82 + cch * 8);
                    d[0] = greg[q].x; d[1] = greg[q].y; d[2] = greg[q].z; d[3] = greg[q].w; } }
            __syncthreads();
            if (chunk + 1 < 32) issue_loads(chunk + 1);
            for (int e = tid; e < 5120; e += NTHR) { const int t = e / 80, cc = e % 80;
                float s = cst[320 + cc];
#pragma unroll
                for (int j = 0; j < 4; ++j) s += uT[(t + j) * 80 + cc] * cst[j * 80 + cc];
                cvb[t * CVS + cc] = (bf16)f2bf(s); }
            __syncthreads();
            {
                const int tq = w & 3, nt0 = (w >> 2) ? 3 : 0, nt1 = (w >> 2) ? 5 : 3, l15 = lane & 15, g4 = lane >> 4;
                bf16x8 Af[3];
#pragma unroll
                for (int s3 = 0; s3 < 3; ++s3) Af[s3] = *(const LAS bf16x8*)(cvb + (16 * tq + l15) * CVS + 32 * s3 + 8 * g4);
#pragma unroll
                for (int q = 0; q < 3; ++q) { const int nt = nt0 + q;
                    if (nt < nt1) {
                        f32x4 accA = {0.f, 0.f, 0.f, 0.f}, accX = {0.f, 0.f, 0.f, 0.f};
#pragma unroll
                        for (int s3 = 0; s3 < 3; ++s3) {
                            const bf16x8 Ba = *(const LAS bf16x8*)(WTa + (16 * nt + l15) * CVS + 32 * s3 + 8 * g4), Bx = *(const LAS bf16x8*)(WTx + (16 * nt + l15) * CVS + 32 * s3 + 8 * g4);
                            accA = __builtin_amdgcn_mfma_f32_16x16x32_bf16(Af[s3], Ba, accA, 0, 0, 0); accX = __builtin_amdgcn_mfma_f32_16x16x32_bf16(Af[s3], Bx, accX, 0, 0, 0); }
                        const int cc = 16 * nt + l15; const float ba = cst[400 + cc], bx = cst[480 + cc], sp = cst[560 + cc], cb = cst[320 + cc];
                        const float cw0 = cst[cc], cw1 = cst[80 + cc], cw2 = cst[160 + cc], cw3 = cst[240 + cc];
#pragma unroll
                        for (int r4 = 0; r4 < 4; ++r4) { const int t = 16 * tq + 4 * g4 + r4;
                            const float cvf = cb + uT[t * 80 + cc] * cw0 + uT[(t + 1) * 80 + cc] * cw1 + uT[(t + 2) * 80 + cc] * cw2 + uT[(t + 3) * 80 + cc] * cw3;
                            const float r = sigmoidf_(accA[r4] + ba), ig = sigmoidf_(accX[r4] + bx);
                            const float log_a = -8.0f * r * sp; const float a = __expf(log_a);
                            const float bb = __builtin_amdgcn_sqrtf(neg_expm1_small(2.0f * log_a)) * (ig * cvf);
                            a_s[t * 81 + cc] = a; b_s[t * 81 + cc] = bb; }
                    } }
            }
            __syncthreads();
            {
                LAS bf16* yT = (LAS bf16*)uT;
#pragma unroll
                for (int q = 0; q < 10; ++q) { const int cc = w + 8 * q;
                    float a = a_s[lane * 81 + cc], bq = b_s[lane * 81 + cc];
#define RG_STEP(D) { const float ap = __builtin_bit_cast(float, __builtin_amdgcn_update_dpp(0x3f800000, __builtin_bit_cast(int, a), 0x110 + D, 0xf, 0xf, false)); \
                     const float bp = __builtin_bit_cast(float, __builtin_amdgcn_update_dpp(0, __builtin_bit_cast(int, bq), 0x110 + D, 0xf, 0xf, false)); bq = a * bp + bq; a = a * ap; }
                    RG_STEP(1) RG_STEP(2) RG_STEP(4) RG_STEP(8)
#undef RG_STEP
                    { const float A0 = __builtin_bit_cast(float, __builtin_amdgcn_readlane(__builtin_bit_cast(int, a), 15)), B0 = __builtin_bit_cast(float, __builtin_amdgcn_readlane(__builtin_bit_cast(int, bq), 15));
                      const float A1 = __builtin_bit_cast(float, __builtin_amdgcn_readlane(__builtin_bit_cast(int, a), 31)), B1 = __builtin_bit_cast(float, __builtin_amdgcn_readlane(__builtin_bit_cast(int, bq), 31));
                      const float A2 = __builtin_bit_cast(float, __builtin_amdgcn_readlane(__builtin_bit_cast(int, a), 47)), B2 = __builtin_bit_cast(float, __builtin_amdgcn_readlane(__builtin_bit_cast(int, bq), 47));
                      const float C2a = A0 * A1, C2b = A1 * B0 + B1, C3a = C2a * A2, C3b = A2 * C2b + B2;
                      const int row = lane >> 4;
                      const float ca = row == 0 ? 1.0f : (row == 1 ? A0 : (row == 2 ? C2a : C3a)), cb = row == 0 ? 0.0f : (row == 1 ? B0 : (row == 2 ? C2b : C3b));
                      bq = a * cb + bq; a = a * ca; }
                    const float hval = a * carry[q] + bq;
                    carry[q] = __builtin_bit_cast(float, __builtin_amdgcn_readlane(__builtin_bit_cast(int, hval), 63));
                    yT[lane * 82 + cc] = (bf16)f2bf(bf2f(gT[lane * 82 + cc]) * hval); }
            }
            __syncthreads();
            for (int e = tid; e < 2560; e += NTHR) { const int row = e / 40, dw = e % 40;
                ((unsigned*)(Y + (size_t)(t0 + row) * 1280 + ch0))[dw] = ((const LAS unsigned*)uT)[row * 41 + dw]; }
            __syncthreads();
        }
    }
}

template <int OFF0, int OFF1>
__device__ __forceinline__ void tr_read2(unsigned a, v2u& r0, v2u& r1) {
    asm volatile("ds_read_b64_tr_b16 %0, %2 offset:%3\n\tds_read_b64_tr_b16 %1, %2 offset:%4\n\ts_waitcnt lgkmcnt(0)" : "=&v"(r0), "=&v"(r1) : "v"(a), "n"(OFF0), "n"(OFF1) : "memory");
}
template <int B0, int RSb>
__device__ __forceinline__ void tr_read8(unsigned a, v2u (&r)[8]) {
    asm volatile("ds_read_b64_tr_b16 %0, %8 offset:%9\n\tds_read_b64_tr_b16 %1, %8 offset:%10\n\tds_read_b64_tr_b16 %2, %8 offset:%11\n\tds_read_b64_tr_b16 %3, %8 offset:%12\n\t"
                 "ds_read_b64_tr_b16 %4, %8 offset:%13\n\tds_read_b64_tr_b16 %5, %8 offset:%14\n\tds_read_b64_tr_b16 %6, %8 offset:%15\n\tds_read_b64_tr_b16 %7, %8 offset:%16\n\ts_waitcnt lgkmcnt(0)"
                 : "=&v"(r[0]), "=&v"(r[1]), "=&v"(r[2]), "=&v"(r[3]), "=&v"(r[4]), "=&v"(r[5]), "=&v"(r[6]), "=&v"(r[7])
                 : "v"(a), "n"(B0), "n"(B0 + 4 * RSb), "n"(B0 + 16 * RSb), "n"(B0 + 20 * RSb), "n"(B0 + 32 * RSb), "n"(B0 + 36 * RSb), "n"(B0 + 48 * RSb), "n"(B0 + 52 * RSb) : "memory");
}
__device__ __forceinline__ void phase_ret_core(const Ctx& c) {
    const bf16* Qg = (const bf16*)(c.ws + WS_M + M_Q); const bf16* Kg = (const bf16*)(c.ws + WS_M + M_K); bf16* Vg = (bf16*)(c.ws + WS_M + M_V);
    float* STAT = (float*)(c.ws + WS_M + M_STAT);
    constexpr int RS = 528, SS = 144, QS_OFF = 0, KS_OFF = 64 * RS, VS_OFF = 2 * 64 * RS, SS_OFF = 3 * 64 * RS;
    LAS unsigned char* L = c.lds; const unsigned lbase = (unsigned)(size_t)c.lds;
    const int tid0 = c.tid, w = c.wave;
    for (int u = c.bid; u < 256; u += c.G) {
        const int b = u >> 3, hh = (u >> 1) & 3, eh = u & 1;
        const float gam = 1.0f - exp2f(-5.0f - (float)hh); const float lg0 = log2f(gam);
        f32x16 R[8];
#pragma unroll
        for (int dt = 0; dt < 8; ++dt)
#pragma unroll
            for (int i = 0; i < 16; ++i) R[dt][i] = 0.f;
        const float cdec = exp2f(lg0 * 64.0f);
#pragma unroll 1
        for (int chunk = 0; chunk < 32; ++chunk) {
            const int t0 = b * 2048 + chunk * 64;
            float lg = lg0; int tid = tid0; asm volatile("" : "+v"(lg), "+v"(tid));
            const int lane = tid & 63, n = lane & 31, h = lane >> 5, hl = h;
            const int blk = (lane >> 4) & 1, q4 = (lane & 15) >> 2, p4 = lane & 3;
            const unsigned trbK = lbase + (8 * h + q4) * RS + (16 * blk + 4 * p4) * 2;
            const unsigned trbV = trbK + VS_OFF + 64 * w;
            v4u tq[4], tk[4], tv[4];
#pragma unroll
            for (int i = 0; i < 4; ++i) { const int e = tid + NTHR * i, row = e >> 5, ch = e & 31;
                tq[i] = *(const v4u*)(Qg + (size_t)(t0 + row) * 1024 + hh * 256 + ch * 8); tk[i] = *(const v4u*)(Kg + (size_t)(t0 + row) * 1024 + hh * 256 + ch * 8); }
#pragma unroll
            for (int i = 0; i < 4; ++i) { const int e = tid + NTHR * i, row = e >> 5, ch = e & 31;
                tv[i] = *(const v4u*)(Vg + (size_t)(t0 + row) * 2048 + hh * 512 + eh * 256 + ch * 8); }
#pragma unroll
            for (int i = 0; i < 4; ++i) { const int e = tid + NTHR * i, row = e >> 5, ch = e & 31;
                *(LAS v4u*)(L + QS_OFF + row * RS + ch * 16) = tq[i]; *(LAS v4u*)(L + KS_OFF + row * RS + ch * 16) = tk[i]; }
            __syncthreads();
            {
                const int i16 = w >> 1, l15 = lane & 15, g4 = lane >> 4; const int l15d = l15, g4d = g4;
#pragma unroll
                for (int jj = 0; jj < 2; ++jj) { const int j16 = 2 * (w & 1) + jj;
                    f32x4 acc = {0.f, 0.f, 0.f, 0.f};
                    if (j16 <= i16) {
#pragma unroll
                        for (int s = 0; s < 8; ++s) { const bf16x8 Af = *(const LAS bf16x8*)(L + QS_OFF + (16 * i16 + l15) * RS + (32 * s + 8 * g4) * 2);
                            const bf16x8 Bf = *(const LAS bf16x8*)(L + KS_OFF + (16 * j16 + l15) * RS + (32 * s + 8 * g4) * 2);
                            acc = __builtin_amdgcn_mfma_f32_16x16x32_bf16(Af, Bf, acc, 0, 0, 0); }
                    }
                    const int ja = 16 * j16 + l15, jad = 16 * j16 + l15d;
#pragma unroll
                    for (int r = 0; r < 4; ++r) { const int ia = 16 * i16 + 4 * g4 + r, iad = 16 * i16 + 4 * g4d + r; const float dec = (iad >= jad) ? __builtin_amdgcn_exp2f(lg * (float)(iad - jad)) : 0.f;
                        *(LAS bf16*)(L + SS_OFF + ia * SS + ja * 2) = (bf16)f2bf(acc[r] * dec); }
                }
            }
#pragma unroll
            for (int i = 0; i < 4; ++i) { const int e = tid + NTHR * i, row = e >> 5, ch = e & 31; *(LAS v4u*)(L + VS_OFF + row * RS + ch * 16) = tv[i]; }
            __syncthreads();
            bf16x8 Vf[4];
            { v2u tr[8]; tr_read8<0, RS>(trbV, tr);
#pragma unroll
              for (int ks = 0; ks < 4; ++ks) { v4u wv; wv.x = tr[2 * ks].x; wv.y = tr[2 * ks].y; wv.z = tr[2 * ks + 1].x; wv.w = tr[2 * ks + 1].y; Vf[ks] = __builtin_bit_cast(bf16x8, wv); } }
            {
                f32x16 Oa[2];
#pragma unroll
                for (int it = 0; it < 2; ++it)
#pragma unroll
                    for (int i = 0; i < 16; ++i) Oa[it][i] = 0.f;
#pragma unroll
                for (int dt = 0; dt < 8; ++dt)
#pragma unroll
                    for (int s = 0; s < 2; ++s) {
                        v4u bw; bw.x = pk2(R[dt][8 * s + 0], R[dt][8 * s + 1]); bw.y = pk2(R[dt][8 * s + 2], R[dt][8 * s + 3]); bw.z = pk2(R[dt][8 * s + 4], R[dt][8 * s + 5]); bw.w = pk2(R[dt][8 * s + 6], R[dt][8 * s + 7]);
#pragma unroll
                        for (int it = 0; it < 2; ++it) {
                            const LAS unsigned char* qrow = L + QS_OFF + (32 * it + n) * RS;
                            const v2u lo = *(const LAS v2u*)(qrow + (32 * dt + 16 * s + 4 * h) * 2), hi = *(const LAS v2u*)(qrow + (32 * dt + 16 * s + 8 + 4 * h) * 2);
                            v4u aw; aw.x = lo.x; aw.y = lo.y; aw.z = hi.x; aw.w = hi.y;
                            Oa[it] = __builtin_amdgcn_mfma_f32_32x32x16_bf16(__builtin_bit_cast(bf16x8, aw), __builtin_bit_cast(bf16x8, bw), Oa[it], 0, 0, 0);
                        }
                    }
#pragma unroll
                for (int it = 0; it < 2; ++it) {
#pragma unroll
                    for (int i = 0; i < 16; ++i) { const int ia = 32 * it + 8 * (i >> 2) + 4 * h + (i & 3); Oa[it][i] *= __builtin_amdgcn_exp2f(lg * (float)(32 * it + 8 * (i >> 2) + 4 * hl + (i & 3) + 1)); }
#pragma unroll
                    for (int ks = 0; ks < 4; ++ks) if (ks < 2 * (it + 1)) {
                        const bf16x8 Sf = *(const LAS bf16x8*)(L + SS_OFF + (32 * it + n) * SS + (16 * ks + 8 * h) * 2);
                        Oa[it] = __builtin_amdgcn_mfma_f32_32x32x16_bf16(Sf, Vf[ks], Oa[it], 0, 0, 0);
                    }
#pragma unroll
                    for (int i = 0; i < 16; ++i) { const int ia = 32 * it + 8 * (i >> 2) + 4 * h + (i & 3);
                        *(LAS bf16*)(L + VS_OFF + ia * RS + (32 * w + n) * 2) = (bf16)f2bf(Oa[it][i]); }
                }
            }
            bf16x8 Vs2[4];
#pragma unroll
            for (int ks = 0; ks < 4; ++ks) { const v4u wv = __builtin_bit_cast(v4u, Vf[ks]); float f[8] = {bflo(wv.x), bfhi(wv.x), bflo(wv.y), bfhi(wv.y), bflo(wv.z), bfhi(wv.z), bflo(wv.w), bfhi(wv.w)};
#pragma unroll
                for (int j = 0; j < 8; ++j) { const int key = 16 * ks + 8 * hl + j; f[j] *= __builtin_amdgcn_exp2f(lg * (float)(63 - key)); }
                v4u o; o.x = pk2(f[0], f[1]); o.y = pk2(f[2], f[3]); o.z = pk2(f[4], f[5]); o.w = pk2(f[6], f[7]); Vs2[ks] = __builtin_bit_cast(bf16x8, o); }
#define RC_DT(dt) { _Pragma("unroll") for (int i = 0; i < 16; ++i) R[dt][i] *= cdec; v2u tr[8]; tr_read8<KS_OFF + 64 * (dt), RS>(trbK, tr); \
                _Pragma("unroll") for (int ks = 0; ks < 4; ++ks) { v4u aw; aw.x = tr[2 * ks].x; aw.y = tr[2 * ks].y; aw.z = tr[2 * ks + 1].x; aw.w = tr[2 * ks + 1].y; \
                    R[dt] = __builtin_amdgcn_mfma_f32_32x32x16_bf16(__builtin_bit_cast(bf16x8, aw), Vs2[ks], R[dt], 0, 0, 0); } }
            RC_DT(0) RC_DT(1) RC_DT(2) RC_DT(3) RC_DT(4) RC_DT(5) RC_DT(6) RC_DT(7)
#undef RC_DT
            __syncthreads();
#pragma unroll
            for (int i = 0; i < 4; ++i) { const int e = tid + NTHR * i, row = e >> 5, ch = e & 31;
                const v4u ov = *(const LAS v4u*)(L + VS_OFF + row * RS + ch * 16);
                *(v4u*)(Vg + (size_t)(t0 + row) * 2048 + hh * 512 + eh * 256 + ch * 8) = ov;
                const float f[8] = {bflo(ov.x), bfhi(ov.x), bflo(ov.y), bfhi(ov.y), bflo(ov.z), bfhi(ov.z), bflo(ov.w), bfhi(ov.w)};
                float s = 0.f, s2 = 0.f;
#pragma unroll
                for (int j = 0; j < 8; ++j) { s += f[j]; s2 += f[j] * f[j]; }
#pragma unroll
                for (int o = 1; o < 32; o <<= 1) { s += __shfl_xor(s, o); s2 += __shfl_xor(s2, o); }
                if ((tid & 31) == 0) { f32x2 st = {s, s2}; *(f32x2*)(STAT + (size_t)(t0 + row) * 16 + hh * 4 + eh * 2) = st; }
            }
        }
    }
}

__host__ __device__ __forceinline__ bool slot_active(int kind, int s) {
    if (s == 2) return kind != 1;
    if (s == 3 || s == 4) return kind == 0;
    if (s == 10) return false;
    return true;
}

#ifndef MK_EN
#define MK_EN 0xffffffffu
#endif
#define EN(b) ((MK_EN >> (b)) & 1u)
template <int PROBE>
__global__ void __launch_bounds__(NTHR, 2) mk_fwd_t(Params p) {
    extern __shared__ __attribute__((aligned(16))) unsigned char lds_raw[];
    Ctx c;
    c.lds = (LAS unsigned char*)lds_raw; c.tid = threadIdx.x; c.lane = c.tid & 63; c.wave = __builtin_amdgcn_readfirstlane(c.tid >> 6);
    c.bid = blockIdx.x; c.G = gridDim.x; c.in = (InTab)(unsigned long)__builtin_amdgcn_kernarg_segment_ptr(); c.out = p.out; c.ws = p.ws;
    volatile LAS unsigned* MISC = (volatile LAS unsigned*)(c.lds + MISC_OFF);
    for (int u = c.tid; u < (LDS_BYTES - LDSCTL_OFF) / 4; u += NTHR) ((LAS unsigned*)(c.lds + LDSCTL_OFF))[u] = 0u;
    __syncthreads();
    const bool one = (p.flags & 1) != 0;
    XcdBarrier bar; bar.bar = (unsigned*)(p.ws + WS_CTL) + CW_BAR; bar.x = 0; bar.st = MISC + 8;
    if (one) bar = xcd_barrier_post((unsigned*)(p.ws + WS_CTL) + CW_BAR, MISC + 8);
    const int lo = p.ph_lo, hi = p.ph_hi;
#define IN(k) (lo <= (k) && (k) < hi)
#if MK_PROBE
#define STAMP(k) do { if (blockIdx.x == 0 && threadIdx.x == 0) ((unsigned long long*)(p.ws + WS_CTL + 65536))[k] = __builtin_amdgcn_s_memrealtime(); } while (0)
#else
#define STAMP(k) do {} while (0)
#endif
#define LCTX() Ctx cl = c; { unsigned long k_ = (unsigned long)__builtin_amdgcn_kernarg_segment_ptr(); unsigned long w_ = (unsigned long)p.ws, o_ = (unsigned long)p.out; int t_ = threadIdx.x; asm volatile("" : "+s"(k_), "+s"(w_), "+s"(o_), "+v"(t_)); cl.tid = t_; cl.lane = t_ & 63; cl.wave = __builtin_amdgcn_readfirstlane(t_ >> 6); cl.in = (InTab)k_; cl.ws = (unsigned char*)(GAS unsigned char*)w_; cl.out = (float*)(GAS float*)o_; } unsigned char* ws = cl.ws; (void)ws
#define SEAM(k) do { if (one && IN(k) && (k) + 1 < hi) xcd_barrier(bar); } while (0)
    STAMP(0);
    if (EN(0) && IN(0)) { LCTX(); phase_prologue(cl); }
    SEAM(0);
#pragma unroll 1
    for (int layer = 0; layer < 4; ++layer) {
        const int kind = layer % 3, j = layer / 3, base = 1 + layer * NPH_LAYER;
        const size_t xin_off = (layer & 1) ? WS_XB1 : WS_XB0, xnext_off = (layer & 1) ? WS_XB0 : WS_XB1;
#define xin ((const bf16*)(ws + xin_off))
#define xnext ((bf16*)(ws + xnext_off))
        STAMP(base + 0);
        if (IN(base + 0)) { LCTX();
            if (EN(1) && kind == 0) { bf16* RAWb = (bf16*)(ws + WS_M + M_RAW); EpiBf16R<0> E{RAWb, RAWb, RAWb, 512, 512, 512, 1 << 30, 1 << 30};
                run_gemm(cl, xin, (const bf16*)(ws + WS_WAIN) + (size_t)j * 512 * 1024, 512, 1024, E); }
            else if (EN(2) && kind == 1) { bf16* GU = (bf16*)(ws + WS_M + M_GU); EpiBf16R<1> E{GU, GU + 1280, GU + 1280, 2560, 2560, 2560, 1280, 1 << 30};
                run_gemm(cl, xin, (const bf16*)(ws + WS_WBIN), 2560, 1024, E); }
            else if (EN(3) && kind == 2) { EpiRetIn E{(bf16*)(ws + WS_M + M_Q), (bf16*)(ws + WS_M + M_K), (bf16*)(ws + WS_M + M_V), (const float*)(ws + WS_ROT), (const float*)(ws + WS_ROT) + 2048 * 128};
                run_gemm(cl, xin, (const bf16*)(ws + WS_WCIN), 4096, 1024, E); }
        }
        SEAM(base + 0);
        STAMP(base + 1);
        if (IN(base + 1)) { LCTX();
            if (EN(4) && kind == 0) phase_dsa_norm(cl, j);
            else if (EN(5) && kind == 1) phase_rglru(cl);
            else if (EN(6) && kind == 2) phase_ret_core(cl);
        }
        SEAM(base + 1);
        STAMP(base + 2);
        if (IN(base + 2) && kind != 1) { LCTX();
            if (EN(7) && kind == 0) { EpiBf16R<0> E{(bf16*)(ws + WS_M + M_QLAT), (bf16*)(ws + WS_M + M_QIDX), (bf16*)(ws + WS_M + M_QIDX), 2048, 512, 512, 2048, 1 << 30};
                run_gemm(cl, (const bf16*)(ws + WS_M + M_CQ), (const bf16*)(ws + WS_WAQ + j * WAQ_STRIDE), 2560, 256, E); }
            else if (EN(8) && kind == 2) { EpiRetGate E{(bf16*)(ws + WS_M + M_V), (const float*)(ws + WS_M + M_STAT)};
                run_gemm(cl, xin, (const bf16*)(ws + WS_WCIN) + (size_t)4096 * 1024, 2048, 1024, E); }
        }
        if (kind != 1) SEAM(base + 2);
        STAMP(base + 3);
        if (EN(9) && IN(base + 3) && kind == 0) { LCTX(); phase_dsa_index(cl); }
        if (kind == 0) SEAM(base + 3);
        STAMP(base + 4);
        if (EN(10) && IN(base + 4) && kind == 0) { LCTX(); phase_dsa_attn(cl); }
        if (kind == 0) SEAM(base + 4);
        STAMP(base + 5);
        if (EN(11) && IN(base + 5)) { LCTX();
            const bf16* A = (const bf16*)(ws + WS_M + (kind == 0 ? M_QLAT : (kind == 1 ? M_Y : M_V)));
            const bf16* Bt = kind == 0 ? (const bf16*)(ws + WS_WAOV) + (size_t)j * 1024 * 2048 : (kind == 1 ? (const bf16*)(ws + WS_WBO) : (const bf16*)(ws + WS_WCO));
            const int K = kind == 1 ? 1280 : 2048;
            EpiResid E{(bf16*)xin, ALPHA_DN, xin};
            run_gemm(cl, A, Bt, 1024, K, E);
        }
        SEAM(base + 5);
        STAMP(base + 6);
        if (EN(12) && IN(base + 6)) { LCTX(); phase_ln1(cl, layer); }
        SEAM(base + 6);
        STAMP(base + 7);
        if (EN(13) && IN(base + 7)) { LCTX(); EpiF32T E{(bf16*)(ws + WS_M + M_SC)};
            run_gemm(cl, xin, (const bf16*)(ws + WS_WPEER) + (size_t)layer * 2048 * 1024, 2048, 1024, E);
            bf16* PP = (bf16*)(ws + WS_PP); EpiBf16R<0> E2{PP, PP, PP, 1024, 1024, 1024, 1 << 30, 1 << 30};
            run_gemm(cl, (const bf16*)(ws + WS_M + M_PB), (const bf16*)(ws + WS_WPLEP) + (size_t)layer * 1024 * 256, 1024, 256, E2); }
        SEAM(base + 7);
        STAMP(base + 8);
        if (EN(14) && IN(base + 8)) { LCTX(); phase_peer_topk(cl); }
        SEAM(base + 8);
        STAMP(base + 9);
        if (EN(15) && IN(base + 9)) { LCTX(); phase_peer_gather(cl, layer, [&]() {}); }
        SEAM(base + 9);
        STAMP(base + 11);
        if (EN(17) && IN(base + 11)) { LCTX(); EpiPle E{xin, (const bf16*)(ws + WS_PP), xnext, INP(cl, I_PLE_BG) + layer * DM, layer == 3 ? cl.out : nullptr};
            run_gemm(cl, xin, (const bf16*)(ws + WS_WPLEG) + (size_t)layer * 1024 * 1024, 1024, 1024, E); }
        SEAM(base + 11);
    }
#if MK_PROBE
    xcd_barrier(bar);
    STAMP(N_PHASES);
    xcd_barrier(bar);
    {
        const unsigned long long* TS = (const unsigned long long*)(p.ws + WS_CTL + 65536);
        float tA = 0.f, tC = 0.f;
        for (int k = 0; k < N_PHASES; ++k) {
            int type = 0;
            if (k > 0) { const int layer = (k - 1) / NPH_LAYER, s = (k - 1) % NPH_LAYER, kind = layer % 3;
                if (!slot_active(kind, s)) continue;
                type = s == 0 ? 1 + kind : s == 1 ? 4 + kind : s == 2 ? (kind == 0 ? 7 : 8) : s == 3 ? 9 : s == 4 ? 10 : 6 + s; }
            const float us = (float)(TS[k + 1] - TS[k]) * 0.01f;
            if ((MK_PROBE_A >> type) & 1u) tA += us;
            if ((MK_PROBE_C >> type) & 1u) tC += us;
        }
        for (size_t i = (size_t)blockIdx.x * NTHR + threadIdx.x; i < (size_t)T_TOK * DM; i += (size_t)gridDim.x * NTHR) p.out[i] = (i == 0) ? 100.f * tA : tC;
    }
#endif
#undef IN
#undef SEAM
#undef xin
#undef xnext
#undef LCTX
}

#if MK_CHECK
#include "CHECKS_PLACEHOLDER"
#endif

#define mk_fwd mk_fwd_t<0>
extern "C" void kernel_launch(void* const* d_in, const int* in_sizes, int n_in, void* d_out, int out_size, void* d_ws, size_t ws_size, hipStream_t stream) {
    static int grid = 0;
    if (grid == 0) {
        if (n_in != N_IN || out_size != T_TOK * DM || ws_size < WS_END) { fprintf(stderr, "kernel_launch: unexpected shapes (n_in %d out %d ws %zu need %zu)\n", n_in, out_size, ws_size, (size_t)WS_END); grid = -1; return; }
        int dev = 0, cus = 0, per_cu = 0;
        if (hipGetDevice(&dev) != hipSuccess || hipDeviceGetAttribute(&cus, hipDeviceAttributeMultiprocessorCount, dev) != hipSuccess) { grid = -1; return; }
        if (hipFuncSetAttribute((const void*)mk_fwd, hipFuncAttributeMaxDynamicSharedMemorySize, LDS_BYTES) != hipSuccess) { fprintf(stderr, "hipFuncSetAttribute failed\n"); grid = -1; return; }
        if (hipOccupancyMaxActiveBlocksPerMultiprocessor(&per_cu, (const void*)mk_fwd, NTHR, LDS_BYTES) != hipSuccess || per_cu < 1) { fprintf(stderr, "occupancy query: %d\n", per_cu); }
        (void)hipGetLastError();
        grid = cus;
    }
    if (grid < 0) return;
    (void)hipMemsetAsync((char*)d_ws + WS_CTL, 0, CTL_BYTES, stream);
    Params p{};
    for (int i = 0; i < N_IN; ++i) p.in[i] = (const float*)d_in[i];
    p.out = (float*)d_out; p.ws = (unsigned char*)d_ws; p.pad = 0;
#if MK_ONE_LAUNCH
#if MK_REPEAT_K >= 0
    p.ph_lo = 0; p.ph_hi = MK_REPEAT_K + 1; p.flags = 1 | MK_PROBE_FLAGS;
    (void)hipFuncSetAttribute((const void*)mk_fwd_t<MK_PROBE_KERNEL>, hipFuncAttributeMaxDynamicSharedMemorySize, LDS_BYTES);
    hipLaunchKernelGGL(mk_fwd_t<MK_PROBE_KERNEL>, dim3(grid), dim3(NTHR), LDS_BYTES, stream, p);
    (void)hipMemsetAsync((char*)d_ws + WS_CTL, 0, CTL_BYTES, stream);
#endif
    p.ph_lo = 0; p.ph_hi = N_PHASES; p.flags = 1;
    hipLaunchKernelGGL(mk_fwd, dim3(grid), dim3(NTHR), LDS_BYTES, stream, p);
#else
    p.flags = 0;
    for (int ph = 0; ph < N_PHASES; ++ph) {
        if (ph > 0) { const int layer = (ph - 1) / NPH_LAYER, s = (ph - 1) % NPH_LAYER; if (!slot_active(layer % 3, s)) continue; }
        p.ph_lo = ph; p.ph_hi = ph + 1;
#if MK_CHECK
        check_pre(ph, p, grid, stream);
#endif
        hipLaunchKernelGGL(mk_fwd, dim3(grid), dim3(NTHR), LDS_BYTES, stream, p);
#if MK_CHECK
        check_post(ph, p, grid, stream);
#endif
    }
#if MK_CHECK
    check_report(p, stream);
#endif
#endif
}
```
